# Optimizing an MI355X kernel written in HIP

```python
import jax
import jax.numpy as jnp
from jax import lax
import numpy as np

D_MODEL = 1024
BATCH = 2
SEQ = 8192
DEPTH = 2

GRID_W = 64
CTX_LEN = 256
EPS = 1e-6

GLA_HEADS = 4
GLA_DK = 64
GLA_DV = 128
GLA_GATE_RANK = 16
GLA_GATE_NORM = 16.0
GLA_CHUNK = 64

MLA_HEADS = 4
MLA_NOPE = 128
MLA_ROPE = 64
MLA_V = 128
MLA_Q_RANK = 256
MLA_KV_RANK = 128
MLA_SCALE = (MLA_NOPE + MLA_ROPE) ** -0.5
ROPE_BASE = 10000.0
Q_BLOCK = 128

GLA_QK_W = GLA_HEADS * GLA_DK
GLA_V_W = GLA_HEADS * GLA_DV
MLA_V_W = MLA_HEADS * MLA_V
D_MIX = GLA_V_W + MLA_V_W

IN_PARTS = (('gla_q', GLA_QK_W), ('gla_k', GLA_QK_W), ('gla_v', GLA_V_W),
            ('gla_gf', GLA_GATE_RANK), ('gla_gb', GLA_GATE_RANK), ('gla_r', GLA_V_W),
            ('mla_cq', MLA_Q_RANK), ('mla_ckv', MLA_KV_RANK), ('mla_kr', MLA_ROPE))
D_IN = sum(w for _, w in IN_PARTS)
ALL_PARTS = tuple(n for n, _ in IN_PARTS)
CTX_STATE_PARTS = ('gla_k', 'gla_v', 'gla_gf', 'gla_gb', 'mla_ckv', 'mla_kr')

D_FF_DENSE = 2816
N_EXPERTS = 8
TOP_K = 2
D_FF_EXPERT = 3584
N_DENSE = (DEPTH + 1) // 2
N_MOE = DEPTH // 2

kernel_name = 'hybrid_gla_mla_moe_diffusion_block'


def rmsnorm(x, g):
    xf = x.astype(jnp.float32)
    y = xf * lax.rsqrt(jnp.mean(xf * xf, axis=-1, keepdims=True) + EPS)
    return (y * g.astype(jnp.float32)).astype(x.dtype)


def in_proj(h, w_in, names):
    offs, o = {}, 0
    for n, w in IN_PARTS:
        offs[n] = (o, o + w)
        o += w
    w = jnp.concatenate([w_in[:, offs[n][0]:offs[n][1]] for n in names], axis=1)
    y = h @ w
    sizes = [offs[n][1] - offs[n][0] for n in names]
    splits = np.cumsum(sizes)[:-1].tolist()
    return dict(zip(names, jnp.split(y, splits, axis=-1)))


def axial_rope_tables(n_tok):
    rows = n_tok // GRID_W
    row = jnp.repeat(jnp.arange(rows, dtype=jnp.float32), GRID_W)
    col = jnp.tile(jnp.arange(GRID_W, dtype=jnp.float32), rows)
    nfreq = MLA_ROPE // 4
    inv = ROPE_BASE ** (-jnp.arange(nfreq, dtype=jnp.float32) / nfreq)
    ar = row[:, None] * inv
    ac = col[:, None] * inv
    return (jnp.cos(ar), jnp.sin(ar), jnp.cos(ac), jnp.sin(ac))


def rope_half(x, cos, sin):
    x1, x2 = jnp.split(x, 2, axis=-1)
    return jnp.concatenate([x1 * cos - x2 * sin, x2 * cos + x1 * sin], axis=-1)


def axial_rope(x, tabs):
    cr, sr, cc, sc = tabs
    extra = x.ndim - 3
    shp = lambda t: t.reshape(t.shape[:1] + (1,) * extra + t.shape[1:]).astype(x.dtype)
    xr, xc = jnp.split(x, 2, axis=-1)
    return jnp.concatenate([rope_half(xr, shp(cr), shp(sr)), rope_half(xc, shp(cc), shp(sc))], axis=-1)


def bidir(a):
    return jnp.stack([a, jnp.flip(a, axis=-3)])


def gla_q(p):
    b, t = p.shape[:2]
    return p.reshape(b, t, GLA_HEADS, GLA_DK).astype(jnp.float32) * (GLA_DK ** -0.5)


def gla_kvg(p, w_g2, b_g2):
    b, t = p['gla_k'].shape[:2]
    k = p['gla_k'].reshape(b, t, GLA_HEADS, GLA_DK).astype(jnp.float32)
    v = p['gla_v'].reshape(b, t, GLA_HEADS, GLA_DV).astype(jnp.float32)
    codes = jnp.stack([p['gla_gf'], p['gla_gb']]).astype(jnp.float32)
    pre = jnp.einsum('zbtr,zrk->zbtk', codes, w_g2.astype(jnp.float32)) + b_g2.astype(jnp.float32)[:, None, None, :]
    g = (jax.nn.log_sigmoid(pre) / GLA_GATE_NORM).reshape(2, b, t, GLA_HEADS, GLA_DK)
    g = jnp.stack([g[0], jnp.flip(g[1], axis=-3)])
    return bidir(k), bidir(v), g


def gla_chunked(q, k, v, g, s0):
    t = q.shape[-3]
    n = t // GLA_CHUNK

    def to_chunks(a):
        a = a.reshape(a.shape[:-3] + (n, GLA_CHUNK) + a.shape[-2:])
        return jnp.swapaxes(jnp.moveaxis(a, -4, 0), -3, -2)

    qc, kc, vc, gc = to_chunks(q), to_chunks(k), to_chunks(v), to_chunks(g)
    bc = jnp.cumsum(gc, axis=-2)
    mask = jnp.tril(jnp.ones((GLA_CHUNK, GLA_CHUNK), dtype=bool))[:, :, None]

    def step(s, xs):
        qi, ki, vi, bi = xs
        b_last = bi[..., -1:, :]
        o_inter = jnp.einsum('...hcd,...hde->...hce', qi * jnp.exp(bi), s)
        diff = bi[..., :, None, :] - bi[..., None, :, :]
        decay = jnp.exp(jnp.where(mask, diff, -jnp.inf))
        attn = jnp.einsum('...htd,...hsd,...htsd->...hts', qi, ki, decay)
        o_intra = jnp.einsum('...hts,...hse->...hte', attn, vi)
        s_new = s * jnp.exp(b_last[..., 0, :])[..., None] + jnp.einsum('...hcd,...hce->...hde', ki * jnp.exp(b_last - bi), vi)
        return s_new, o_inter + o_intra

    s_fin, oc = lax.scan(step, s0, (qc, kc, vc, bc))
    o = jnp.moveaxis(jnp.swapaxes(oc, -3, -2), 0, -4)
    return o.reshape(o.shape[:-4] + (t,) + o.shape[-2:]), s_fin


def gla_final_state(k, v, g):
    b = jnp.cumsum(g, axis=-3)
    w = jnp.exp(b[..., -1:, :, :] - b)
    return jnp.einsum('...thd,...the->...hde', k * w, v)


def gla_out(o_dirs, r, gla_g):
    o = o_dirs[0] + jnp.flip(o_dirs[1], axis=-3)
    o = rmsnorm(o, gla_g)
    b, t = o.shape[:2]
    return (o.reshape(b, t, GLA_V_W) * jax.nn.silu(r.astype(jnp.float32))).astype(r.dtype)


def mla_q(cq, qn_g, w_uq, tabs):
    b, t = cq.shape[:2]
    q = (rmsnorm(cq, qn_g) @ w_uq).reshape(b, t, MLA_HEADS, MLA_NOPE + MLA_ROPE)
    if tabs is not None:
        q = jnp.concatenate([q[..., :MLA_NOPE], axial_rope(q[..., MLA_NOPE:], tabs)], axis=-1)
    return q


def mla_kv(p, kvn_g, w_ukv, tabs):
    b, t = p['mla_ckv'].shape[:2]
    kv = (rmsnorm(p['mla_ckv'], kvn_g) @ w_ukv).reshape(b, t, MLA_HEADS, MLA_NOPE + MLA_V)
    k_nope, v = kv[..., :MLA_NOPE], kv[..., MLA_NOPE:]
    kr = p['mla_kr']
    if tabs is not None:
        kr = axial_rope(kr, tabs)
    k = jnp.concatenate([k_nope, jnp.broadcast_to(kr[:, :, None, :], (b, t, MLA_HEADS, MLA_ROPE))], axis=-1)
    return k, v


def dense_attn(q, k, v):
    s = jnp.einsum('bqhd,bkhd->bhqk', q, k).astype(jnp.float32) * MLA_SCALE
    p = jax.nn.softmax(s, axis=-1).astype(v.dtype)
    return jnp.einsum('bhqk,bkhe->bqhe', p, v)


def block_attention(q, k, v):
    b, t, h, dq = q.shape
    nb = t // Q_BLOCK
    qb = jnp.moveaxis(q.reshape(b, nb, Q_BLOCK, h, dq), 1, 0)
    o = lax.map(lambda blk: dense_attn(blk, k, v), qb)
    return jnp.moveaxis(o, 0, 1).reshape(b, t, h * v.shape[-1])


def token_mixing(hl, hc, w_in, w_g2, b_g2, gla_g, qn_g, w_uq, kvn_g, w_ukv, w_out, tabs, need_ctx):
    b, t = hl.shape[:2]
    pl = in_proj(hl, w_in, ALL_PARTS)
    pc = in_proj(hc, w_in, ALL_PARTS if need_ctx else CTX_STATE_PARTS)

    kc, vc, gc = gla_kvg(pc, w_g2, b_g2)
    kl, vl, gl = gla_kvg(pl, w_g2, b_g2)
    if need_ctx:
        s0 = jnp.zeros((2, b, GLA_HEADS, GLA_DK, GLA_DV), jnp.float32)
        oc_dirs, s_ctx = gla_chunked(bidir(gla_q(pc['gla_q'])), kc, vc, gc, s0)
    else:
        s_ctx = gla_final_state(kc, vc, gc)
    ol_dirs, _ = gla_chunked(bidir(gla_q(pl['gla_q'])), kl, vl, gl, s_ctx)

    kl_m, vl_m = mla_kv(pl, kvn_g, w_ukv, tabs)
    kc_m, vc_m = mla_kv(pc, kvn_g, w_ukv, None)
    ql_m = mla_q(pl['mla_cq'], qn_g, w_uq, tabs)
    keys = jnp.concatenate([kl_m, kc_m], axis=1)
    vals = jnp.concatenate([vl_m, vc_m], axis=1)
    ml = block_attention(ql_m, keys, vals)

    yl = jnp.concatenate([gla_out(ol_dirs, pl['gla_r'], gla_g), ml], axis=-1) @ w_out
    if need_ctx:
        qc_m = mla_q(pc['mla_cq'], qn_g, w_uq, None)
        mc = dense_attn(qc_m, kc_m, vc_m).reshape(b, hc.shape[1], MLA_V_W)
        yc = jnp.concatenate([gla_out(oc_dirs, pc['gla_r'], gla_g), mc], axis=-1) @ w_out
        return yl, yc
    return yl, None


def swiglu(h, w_gate, w_up, w_down):
    return (jax.nn.silu(h @ w_gate) * (h @ w_up)) @ w_down


def moe_swiglu(h, w_router, e_gate, e_up, e_down):
    logits = jnp.einsum('btd,de->bte', h, w_router).astype(jnp.float32)
    top_v, top_i = lax.top_k(logits, TOP_K)
    wts = jax.nn.softmax(top_v, axis=-1)
    comb = jnp.einsum('btk,btke->bte', wts, jax.nn.one_hot(top_i, N_EXPERTS, dtype=jnp.float32)).astype(h.dtype)
    out = jnp.zeros_like(h)
    for e in range(N_EXPERTS):
        out = out + comb[..., e:e + 1] * swiglu(h, e_gate[e], e_up[e], e_down[e])
    return out


def channel_mix(h, i, ffn_w_gate, ffn_w_up, ffn_w_down, router_w, exp_w_gate, exp_w_up, exp_w_down):
    j = i // 2
    if i % 2 == 0:
        return swiglu(h, ffn_w_gate[j], ffn_w_up[j], ffn_w_down[j])
    return moe_swiglu(h, router_w[j], exp_w_gate[j], exp_w_up[j], exp_w_down[j])


def setup_inputs(seed: int = 0) -> dict:
    key = jax.random.key(seed)
    ks = iter(jax.random.split(key, 32))
    nrm = lambda shape, scale: jax.random.normal(next(ks), shape, jnp.float32) * scale
    gain = lambda shape: 1.0 + 0.02 * jax.random.normal(next(ks), shape, jnp.float32)
    D = D_MODEL
    return {
        'x': nrm((BATCH, SEQ, D), 1.0),
        'c': nrm((BATCH, D), 1.0),
        'ctx': nrm((BATCH, CTX_LEN, D), 1.0),
        'c_ctx': nrm((D,), 1.0),
        'w_mod': nrm((DEPTH, D, 6 * D), 0.5 * D ** -0.5),
        'b_mod': nrm((DEPTH, 6 * D), 0.02),
        'ln1_g': gain((DEPTH, D)),
        'ln2_g': gain((DEPTH, D)),
        'w_in': nrm((DEPTH, D, D_IN), D ** -0.5),
        'w_gla_g2': nrm((DEPTH, 2, GLA_GATE_RANK, GLA_QK_W), GLA_GATE_RANK ** -0.5),
        'b_gla_g2': nrm((DEPTH, 2, GLA_QK_W), 0.1),
        'gla_norm_g': gain((DEPTH, GLA_DV)),
        'mla_q_norm_g': gain((DEPTH, MLA_Q_RANK)),
        'w_uq': nrm((DEPTH, MLA_Q_RANK, MLA_HEADS * (MLA_NOPE + MLA_ROPE)), MLA_Q_RANK ** -0.5),
        'mla_kv_norm_g': gain((DEPTH, MLA_KV_RANK)),
        'w_ukv': nrm((DEPTH, MLA_KV_RANK, MLA_HEADS * (MLA_NOPE + MLA_V)), MLA_KV_RANK ** -0.5),
        'w_out': nrm((DEPTH, D_MIX, D), D_MIX ** -0.5),
        'ffn_w_gate': nrm((N_DENSE, D, D_FF_DENSE), D ** -0.5),
        'ffn_w_up': nrm((N_DENSE, D, D_FF_DENSE), D ** -0.5),
        'ffn_w_down': nrm((N_DENSE, D_FF_DENSE, D), D_FF_DENSE ** -0.5),
        'router_w': nrm((N_MOE, D, N_EXPERTS), D ** -0.5),
        'exp_w_gate': nrm((N_MOE, N_EXPERTS, D, D_FF_EXPERT), D ** -0.5),
        'exp_w_up': nrm((N_MOE, N_EXPERTS, D, D_FF_EXPERT), D ** -0.5),
        'exp_w_down': nrm((N_MOE, N_EXPERTS, D_FF_EXPERT, D), D_FF_EXPERT ** -0.5),
        'final_norm_g': gain((D,)),
    }


def reference(x, c, ctx, c_ctx, w_mod, b_mod, ln1_g, ln2_g, w_in, w_gla_g2, b_gla_g2, gla_norm_g,
              mla_q_norm_g, w_uq, mla_kv_norm_g, w_ukv, w_out, ffn_w_gate, ffn_w_up, ffn_w_down,
              router_w, exp_w_gate, exp_w_up, exp_w_down, final_norm_g):
    tabs = axial_rope_tables(x.shape[1])
    xl, xc = x, ctx
    for i in range(DEPTH):
        need_ctx = i < DEPTH - 1
        mod_l = (jax.nn.silu(c) @ w_mod[i] + b_mod[i])[:, None, :]
        mod_c = (jax.nn.silu(c_ctx) @ w_mod[i] + b_mod[i])[None, None, :]
        sh1, sc1, g1, sh2, sc2, g2 = jnp.split(mod_l, 6, axis=-1)
        ch1, cs1, cg1, ch2, cs2, cg2 = jnp.split(mod_c, 6, axis=-1)

        hl = rmsnorm(xl, ln1_g[i]) * (1.0 + sc1) + sh1
        hc = rmsnorm(xc, ln1_g[i]) * (1.0 + cs1) + ch1
        yl, yc = token_mixing(hl, hc, w_in[i], w_gla_g2[i], b_gla_g2[i], gla_norm_g[i],
                              mla_q_norm_g[i], w_uq[i], mla_kv_norm_g[i], w_ukv[i], w_out[i],
                              tabs, need_ctx)
        xl = xl + g1 * yl

        hl2 = rmsnorm(xl, ln2_g[i]) * (1.0 + sc2) + sh2
        xl = xl + g2 * channel_mix(hl2, i, ffn_w_gate, ffn_w_up, ffn_w_down,
                                   router_w, exp_w_gate, exp_w_up, exp_w_down)
        if need_ctx:
            xc = xc + cg1 * yc
            hc2 = rmsnorm(xc, ln2_g[i]) * (1.0 + cs2) + ch2
            xc = xc + cg2 * channel_mix(hc2, i, ffn_w_gate, ffn_w_up, ffn_w_down,
                                        router_w, exp_w_gate, exp_w_up, exp_w_down)
    return rmsnorm(xl, final_norm_g)
```

```cpp
#include <hip/hip_runtime.h>
#include <cstdio>
#include <cstdint>

#define LAS __attribute__((address_space(3)))
#define GAS __attribute__((address_space(1)))
typedef unsigned short bf16;
typedef short bf16x8 __attribute__((ext_vector_type(8)));
typedef short s16x4 __attribute__((ext_vector_type(4)));
typedef float f32x2 __attribute__((ext_vector_type(2)));
typedef float f32x4 __attribute__((ext_vector_type(4)));
typedef float f32x16 __attribute__((ext_vector_type(16)));
typedef unsigned u32x2 __attribute__((ext_vector_type(2)));
typedef unsigned u32x4 __attribute__((ext_vector_type(4)));

#ifndef MK_PER_PHASE
#define MK_PER_PHASE 0
#endif

constexpr int DM = 1024, NB = 2, TT = 8192, TC = 256, NLAT = NB * TT, NCTXR = NB * TC, MR = NLAT + NCTXR;
constexpr int TKV = TT + TC;
constexpr int PW = 2048;
constexpr int PC_Q = 0, PC_K = 256, PC_V = 512, PC_R = 1024, PC_CQ = 1536, PC_CKV = 1792, PC_KR = 1920, PC_GF = 1984, PC_GB = 2000;
constexpr int NCH = 132;
constexpr int DFF = 2816, DFE = 3584, NEXP = 8, DFEH = DFE / 2;
constexpr int MAXT = 136;
constexpr float EPS = 1e-6f;
constexpr float MLA_SCALE = 0.07216878364870322f;
namespace att {
constexpr int KT_BYTES = 24576, VT_BYTES = 16384;
__host__ __device__ __forceinline__ int v_st(int k, int c) { const int kk = (k & ~0xC) | ((k & 4) << 1) | ((k & 8) >> 1); return ((kk >> 3) * 4 + (c >> 5)) * 512 + ((kk & 7) * 32 + (c & 31)) * 2; }
}

constexpr size_t AL(size_t x) { return (x + 255) & ~(size_t)255; }
constexpr size_t WS_CTL = 0, CTL_BYTES = 65536;
constexpr size_t WS_MOD = WS_CTL + CTL_BYTES;
constexpr size_t WS_ROPE = WS_MOD + AL(2 * 3 * 6144 * 4);
constexpr size_t WS_XL = WS_ROPE + AL((128 + 64) * 32 * 4);
constexpr size_t WS_H = WS_XL + AL((size_t)MR * DM * 4);
constexpr size_t WS_LIST = WS_H + AL((size_t)MR * DM * 2);
constexpr size_t LIST_BYTES = AL((size_t)NLAT * 2 * 4 * 3) + AL((size_t)MAXT * 256 * 4 * 2);
constexpr size_t WS_ARENA = WS_LIST + LIST_BYTES;
constexpr size_t A_WIN = 0;
constexpr size_t A_WQKV = A_WIN + AL((size_t)2 * 2048 * 1024 * 2);
constexpr size_t A_WOUT = A_WQKV + AL((size_t)2 * 1792 * 384 * 2);
constexpr size_t A_FGU = A_WOUT + AL((size_t)2 * 1024 * 1024 * 2);
constexpr size_t A_FD = A_FGU + AL((size_t)2 * DFF * 1024 * 2);
constexpr size_t A_R = A_FD + AL((size_t)1024 * DFF * 2);
constexpr size_t R_P = A_R;
constexpr size_t R_QT = R_P + AL((size_t)MR * PW * 2);
constexpr size_t R_KT = R_QT + AL((size_t)2 * MR * 256 * 2);
constexpr size_t R_SLOC = R_KT + AL((size_t)2 * MR * 256 * 2);
constexpr size_t R_DEC = R_SLOC + AL((size_t)16 * NCH * 8192 * 4);
constexpr size_t R_SST = R_DEC + AL((size_t)16 * NCH * 64 * 4);
constexpr size_t R_CQKV = R_SST + AL((size_t)16 * NCH * 8192 * 2);
constexpr size_t R_QB = R_CQKV + AL((size_t)MR * 384 * 2);
constexpr size_t R_KB = R_QB + AL((size_t)8 * TKV * 192 * 2);
constexpr size_t R_VB = R_KB + AL((size_t)8 * TKV * 192 * 2);
constexpr size_t R_MIX = R_VB + AL((size_t)8 * TKV * 128 * 2);
constexpr size_t R_END = R_MIX + AL((size_t)MR * DM * 2);
constexpr size_t R_ACT = A_R;
static_assert(R_ACT + (size_t)MR * DFF * 2 <= R_END, "ACT fits R");
constexpr size_t M_EGU = 0;
constexpr size_t M_ED = M_EGU + AL((size_t)NEXP * 2 * DFE * 1024 * 2);
constexpr size_t M_HS = M_ED + AL((size_t)NEXP * 1024 * DFE * 2);
constexpr size_t M_ACT = M_HS + AL((size_t)MAXT * 256 * 1024 * 2);
constexpr size_t M_END = M_ACT + AL((size_t)MAXT * 256 * DFEH * 2);
constexpr size_t ARENA_BYTES = (R_END > M_END) ? R_END : M_END;
constexpr size_t WS_END = WS_ARENA + ARENA_BYTES;
static_assert(WS_END <= 534000000ull, "workspace map exceeds the guaranteed scratch size");

constexpr int CW_BAR = 4096;
constexpr int CW_CNT = 64;

constexpr int LDS_BYTES = 147456, MISC_OFF = LDS_BYTES - 256;

__device__ __forceinline__ unsigned f2bf(float f) { unsigned u = __builtin_bit_cast(unsigned, f); return (u + 0x7fffu + ((u >> 16) & 1u)) >> 16; }
__device__ __forceinline__ unsigned pk2(float lo, float hi) { return f2bf(lo) | (f2bf(hi) << 16); }
__device__ __forceinline__ float bf2f(unsigned b) { return __builtin_bit_cast(float, b << 16); }
__device__ __forceinline__ float bflo(unsigned w) { return __builtin_bit_cast(float, w << 16); }
__device__ __forceinline__ float bfhi(unsigned w) { return __builtin_bit_cast(float, w & 0xffff0000u); }
__device__ __forceinline__ u32x4 pack8(const float* v) { u32x4 w; w.x = pk2(v[0], v[1]); w.y = pk2(v[2], v[3]); w.z = pk2(v[4], v[5]); w.w = pk2(v[6], v[7]); return w; }
__device__ __forceinline__ void unpack8(u32x4 w, float* v) { v[0] = bflo(w.x); v[1] = bfhi(w.x); v[2] = bflo(w.y); v[3] = bfhi(w.y); v[4] = bflo(w.z); v[5] = bfhi(w.z); v[6] = bflo(w.w); v[7] = bfhi(w.w); }
__device__ __forceinline__ float wave_sum(float v) {
#pragma unroll
    for (int o = 1; o < 64; o <<= 1) v += __shfl_xor(v, o);
    return v;
}
__device__ __forceinline__ float silu_f(float x) { return x / (1.f + __expf(-x)); }
__device__ __forceinline__ float logsig_f(float x) { return fminf(x, 0.f) - log1pf(__expf(-fabsf(x))); }
#define LDS_WAIT() asm volatile("s_waitcnt lgkmcnt(0)" ::: "memory")
#define VM_WAIT() asm volatile("s_waitcnt vmcnt(0)" ::: "memory")

namespace pg8 {
constexpr int BM = 256, BK = 64, HALF = 128, HTB = HALF * BK * 2, NXCD = 8, WGM = 8;
__host__ __device__ __forceinline__ int lds_byte(int r, int c) { const int st = (r >> 4) * 2 + (c >> 5), rr = r & 15, cc = c & 31, ob = rr * 64 + cc * 2; return st * 1024 + (ob ^ (((ob >> 9) & 1) << 5)); }
__host__ __device__ __forceinline__ void stage_rc(int b, int& R, int& C) { const int st = b / 1024, sb = b % 1024, swz = sb ^ (((sb >> 9) & 1) << 5); R = (st >> 1) * 16 + swz / 64; C = (st & 1) * 32 + (swz % 64) / 2; }
__host__ __device__ __forceinline__ int perm32(int rho) { const int n = rho >> 4, i = rho & 15; return 8 * (i >> 2) + 4 * n + (i & 3); }

struct Unit { int pm, pn; };
struct Gemm { const bf16* A; const bf16* Bt; int K, lda, ldb; };

struct StaticOrder {
    int nM, nN, nwg, G, c;
    __device__ void init(int M, int N, int G_, int c_) { nM = M / BM; nN = N / BM; nwg = nM * nN; G = G_; c = c_; }
    __device__ bool next(int i, Unit& u) const {
        const long L = (long)i * G + c; if (L >= nwg) return false;
        int wgid = (int)L; { const int q = nwg / NXCD, r = nwg % NXCD, xcd = wgid % NXCD, off = wgid / NXCD; wgid = (xcd < r ? xcd * (q + 1) : r * (q + 1) + (xcd - r) * q) + off; }
        const int nig = WGM * nN, gid = wgid / nig, fm = gid * WGM, gsz = (nM - fm) < WGM ? (nM - fm) : WGM;
        u.pm = fm + ((wgid % nig) % gsz); u.pn = (wgid % nig) / gsz; return true;
    }
};
struct MoeOrder {
    int tb[9]; int ncol, tpe, joff, G, c;
    __device__ bool next(int i, Unit& u) const {
        const long L = (long)i * G + c; if (L >= (long)tb[8] * ncol) return false;
        const int tile = (int)(L / ncol), j = (int)(L % ncol); int e = 0;
#pragma unroll
        for (int k = 1; k < 8; ++k) e += (tile >= tb[k]) ? 1 : 0;
        u.pm = tile; u.pn = e * tpe + joff + j; return true;
    }
};

template <class Epi, class Sched>
__device__ __forceinline__ void gemm_phase(LAS unsigned char* lds, const Gemm g, const Sched& S, const Epi& E) {
    int tid = threadIdx.x; asm volatile("" : "+v"(tid));
    const int wid = __builtin_amdgcn_readfirstlane(tid >> 6), lane = tid & 63, wr = wid >> 2, wc = wid & 3, fr = lane & 15, fq = lane >> 4;
    const int K = g.K, nt = K / BK;
    unsigned voffA[2], voffB[2];
#pragma unroll
    for (int i = 0; i < 2; ++i) { int R, C; stage_rc(tid * 16 + i * 8192, R, C); const int Rb = (R & ~31) + perm32(R & 31);
        voffA[i] = (unsigned)(R * g.lda + C) * 2u; voffB[i] = (unsigned)(Rb * g.ldb + C) * 2u; }
    const size_t kstep = (size_t)(BK * 2);
    const size_t hstepA = (size_t)HALF * g.lda * 2, hstepB = (size_t)HALF * g.ldb * 2;
    const size_t tstepA = 2 * hstepA, tstepB = 2 * hstepB;
    const unsigned ldsw = (unsigned)wid * 1024u;
    const int aoff = lds_byte(wr * 64 + fr, fq * 8), boff = lds_byte(wc * 32 + fr, fq * 8);
#define PG8_SA(b, h) (((b) * 2 + (h)) * HTB)
#define PG8_SB(b, h) ((4 + (b) * 2 + (h)) * HTB)
#define PG8_STAGE(bufoff, gbase, voff) do { _Pragma("unroll") for (int _i = 0; _i < 2; ++_i) \
        __builtin_amdgcn_global_load_lds((const unsigned*)((const char*)(gbase) + (voff)[_i]), (LAS unsigned*)(lds + (bufoff) + ldsw + _i * 8192), 16, 0, 0); } while (0)
#define PG8_LDA(dst, b, h) do { _Pragma("unroll") for (int m = 0; m < 4; ++m) _Pragma("unroll") for (int k = 0; k < 2; ++k) dst[m][k] = *(const LAS bf16x8*)(lds + PG8_SA(b, h) + aoff + m * 2048 + k * 1024); } while (0)
#define PG8_LDB(dst, b, h) do { _Pragma("unroll") for (int n = 0; n < 2; ++n) _Pragma("unroll") for (int k = 0; k < 2; ++k) dst[n][k] = *(const LAS bf16x8*)(lds + PG8_SB(b, h) + boff + n * 2048 + k * 1024); } while (0)
#define PG8_MMA(ai, bj, At, Bt) do { __builtin_amdgcn_s_setprio(1); _Pragma("unroll") for (int m = 0; m < 4; ++m) _Pragma("unroll") for (int n = 0; n < 2; ++n) _Pragma("unroll") for (int k = 0; k < 2; ++k) \
        acc[ai][bj][m][n] = __builtin_amdgcn_mfma_f32_16x16x32_bf16(Bt[n][k], At[m][k], acc[ai][bj][m][n], 0, 0, 0); __builtin_amdgcn_s_setprio(0); } while (0)
#define PG8_WAIT_V(n) asm volatile("s_waitcnt vmcnt(" #n ")" ::: "memory")
#define PG8_WAIT_L(n) asm volatile("s_waitcnt lgkmcnt(" #n ")" ::: "memory")
#define PG8_BAR __builtin_amdgcn_s_barrier()
#define PG8_SCHED __builtin_amdgcn_sched_barrier(0)
    Unit cur, nxt; int ui = 0;
    if (!S.next(0, cur)) return;
    f32x4 acc[2][2][4][2];
#pragma unroll
    for (int a = 0; a < 2; ++a)
#pragma unroll
        for (int b = 0; b < 2; ++b)
#pragma unroll
            for (int m = 0; m < 4; ++m)
#pragma unroll
                for (int n = 0; n < 2; ++n) acc[a][b][m][n] = (f32x4){0.f, 0.f, 0.f, 0.f};
    bf16x8 At[4][2], B0[2][2], B1[2][2];
    const char* cA = (const char*)g.A + (size_t)cur.pm * tstepA; const char* cB = (const char*)g.Bt + (size_t)cur.pn * tstepB;
    PG8_STAGE(PG8_SB(0, 0), cB, voffB); PG8_STAGE(PG8_SB(0, 1), cB + hstepB, voffB); PG8_STAGE(PG8_SA(0, 0), cA, voffA); PG8_STAGE(PG8_SA(0, 1), cA + hstepA, voffA);
    if (wr == 1) PG8_BAR;
    PG8_WAIT_V(2); PG8_BAR;
    PG8_STAGE(PG8_SB(1, 0), cB + kstep, voffB); PG8_STAGE(PG8_SA(1, 0), cA + kstep, voffA); PG8_STAGE(PG8_SB(1, 1), cB + hstepB + kstep, voffB);
    PG8_WAIT_V(6); PG8_BAR;
    for (;;) {
        const bool has_next = S.next(ui + 1, nxt);
        const char* nA = has_next ? (const char*)g.A + (size_t)nxt.pm * tstepA : cA; const char* nB = has_next ? (const char*)g.Bt + (size_t)nxt.pn * tstepB : cB;
#pragma unroll 1
        for (int t = 0; t < nt; t += 2) {
            const bool last = (t == nt - 2);
            const char* a1 = cA + (size_t)(t + 1) * kstep;
            const char* a2 = last ? nA : cA + (size_t)(t + 2) * kstep; const char* b2 = last ? nB : cB + (size_t)(t + 2) * kstep;
            const char* a3 = a2 + kstep; const char* b3 = b2 + kstep;
            PG8_LDB(B0, 0, 0); PG8_LDB(B1, 0, 1); PG8_SCHED; PG8_LDA(At, 0, 0); PG8_STAGE(PG8_SA(1, 1), a1 + hstepA, voffA);
            PG8_WAIT_V(8); PG8_WAIT_L(0); PG8_BAR; PG8_MMA(0, 0, At, B0); PG8_MMA(0, 1, At, B1); PG8_BAR; PG8_SCHED;
            PG8_LDA(At, 0, 1); PG8_STAGE(PG8_SB(0, 0), b2, voffB); PG8_STAGE(PG8_SB(0, 1), b2 + hstepB, voffB); PG8_STAGE(PG8_SA(0, 0), a2, voffA);
            PG8_WAIT_V(8); PG8_WAIT_L(0); PG8_BAR; PG8_MMA(1, 0, At, B0); PG8_MMA(1, 1, At, B1); PG8_BAR; PG8_SCHED;
            PG8_LDB(B0, 1, 0); PG8_LDB(B1, 1, 1); PG8_SCHED; PG8_LDA(At, 1, 0); PG8_STAGE(PG8_SA(0, 1), a2 + hstepA, voffA);
            PG8_WAIT_V(8); PG8_WAIT_L(0); PG8_BAR; PG8_MMA(0, 0, At, B0); PG8_MMA(0, 1, At, B1); PG8_BAR; PG8_SCHED;
            PG8_LDA(At, 1, 1); PG8_STAGE(PG8_SB(1, 0), b3, voffB); PG8_STAGE(PG8_SB(1, 1), b3 + hstepB, voffB); PG8_STAGE(PG8_SA(1, 0), a3, voffA);
            PG8_WAIT_V(8); PG8_WAIT_L(0); PG8_BAR; PG8_MMA(1, 0, At, B0); PG8_MMA(1, 1, At, B1); PG8_BAR; PG8_SCHED;
        }
        if (wr == 0) PG8_BAR;
        E(acc, cur, wr, wc, fr, fq);
        if (!has_next) break;
#pragma unroll
        for (int a = 0; a < 2; ++a)
#pragma unroll
            for (int b = 0; b < 2; ++b)
#pragma unroll
                for (int m = 0; m < 4; ++m)
#pragma unroll
                    for (int n = 0; n < 2; ++n) acc[a][b][m][n] = (f32x4){0.f, 0.f, 0.f, 0.f};
        cur = nxt; cA = nA; cB = nB; ++ui;
        if (wr == 1) PG8_BAR;
    }
    PG8_WAIT_V(0);
    PG8_BAR;
#undef PG8_SA
#undef PG8_SB
#undef PG8_STAGE
#undef PG8_LDA
#undef PG8_LDB
#undef PG8_MMA
#undef PG8_WAIT_V
#undef PG8_WAIT_L
#undef PG8_BAR
#undef PG8_SCHED
}

template <class F> struct Epi8 {
    F f;
    __device__ __forceinline__ void operator()(const f32x4 (&acc)[2][2][4][2], const Unit& u, int wr, int wc, int fr, int fq) const {
        const int row0 = u.pm * BM + wr * 64 + fr, col0 = u.pn * BM + wc * 32 + 8 * fq;
#pragma unroll
        for (int ai = 0; ai < 2; ++ai)
#pragma unroll
            for (int m = 0; m < 4; ++m)
#pragma unroll
                for (int bj = 0; bj < 2; ++bj) { f(row0 + ai * HALF + m * 16, col0 + bj * HALF, acc[ai][bj][m][0], acc[ai][bj][m][1]); __builtin_amdgcn_sched_barrier(0); }
    }
};
template <class F> struct EpiGU {
    F f; int tiles_per_mat;
    __device__ __forceinline__ void operator()(const f32x4 (&acc)[2][2][4][2], const Unit& u, int wr, int wc, int fr, int fq) const {
        const int row0 = u.pm * BM + wr * 64 + fr, col0 = (u.pn % tiles_per_mat) * HALF + wc * 32 + 8 * fq;
#pragma unroll
        for (int ai = 0; ai < 2; ++ai)
#pragma unroll
            for (int m = 0; m < 4; ++m) {
                float o[8];
#pragma unroll
                for (int n = 0; n < 2; ++n)
#pragma unroll
                    for (int q = 0; q < 4; ++q) { const float gt = acc[ai][0][m][n][q], up = acc[ai][1][m][n][q]; o[n * 4 + q] = gt / (1.f + __expf(-gt)) * up; }
                f(row0 + ai * HALF + m * 16, col0, o);
            }
    }
};
}

#define XB_TMO      128
#define XB_XCNT(j)  (256  + 64 * (j))
#define XB_XSUB(j)  (1280 + 64 * (j))
#define XB_XGEN(j)  (2304 + 64 * (j))
#define XB_TOP      3328
#define XB_TOPGEN   3392
#define XCD_BAR_WORDS 3456
#define XB_SPIN_CAP (1u << 18)
__device__ __forceinline__ unsigned xb_ld(unsigned* p)              { return __hip_atomic_load(p, __ATOMIC_RELAXED, __HIP_MEMORY_SCOPE_AGENT); }
__device__ __forceinline__ unsigned xb_add(unsigned* p, unsigned v) { return __hip_atomic_fetch_add(p, v, __ATOMIC_RELAXED, __HIP_MEMORY_SCOPE_AGENT); }
__device__ __forceinline__ unsigned xb_xcc_id() { return (unsigned)__builtin_amdgcn_s_getreg((3 << 11) | 20) & 0xFu; }
#define XB_SPIN(cond, bar) do { unsigned _sp = 0; while (cond) { __builtin_amdgcn_s_sleep(1); \
    if ((++_sp & 255u) == 0u) { if (xb_ld(&(bar)[XB_TMO])) break; if (_sp > XB_SPIN_CAP) { atomicAdd(&(bar)[XB_TMO], 1u); break; } } } } while (0)
struct XcdBarrier { unsigned* bar; unsigned x; volatile LAS unsigned* st; };
__device__ __forceinline__ XcdBarrier xcd_barrier_post(unsigned* bar, volatile LAS unsigned* st) {
    XcdBarrier b; b.bar = bar; b.x = xb_xcc_id(); b.st = st;
    if (threadIdx.x == 0) (void)xb_add(&bar[XB_XCNT(b.x)], 1u);
    return b;
}
__device__ __forceinline__ void xcd_barrier_complete(unsigned* bar, unsigned x, unsigned& nloc, unsigned& nx) {
    const unsigned G = gridDim.x * gridDim.y * gridDim.z;
    unsigned sum, cnt, mine, sp = 0u;
    for (;;) {
        sum = 0u; cnt = 0u; mine = 0u;
#pragma unroll
        for (unsigned j = 0; j < 16; ++j) { const unsigned c = xb_ld(&bar[XB_XCNT(j)]); sum += c; cnt += (c > 0u) ? 1u : 0u; mine = (j == x) ? c : mine; }
        if (sum == G) break;
        __builtin_amdgcn_s_sleep(1);
        if ((++sp & 255u) == 0u) { if (xb_ld(&bar[XB_TMO])) break; if (sp > XB_SPIN_CAP) { atomicAdd(&bar[XB_TMO], 1u); break; } }
    }
    nloc = mine > 0u ? mine : 1u; nx = cnt > 0u ? cnt : 1u;
}
__device__ __forceinline__ void xcd_barrier(const XcdBarrier& b) {
    asm volatile("s_waitcnt vmcnt(0)" ::: "memory");
    __syncthreads();
    if (threadIdx.x == 0) {
        unsigned* bar = b.bar;
        __builtin_amdgcn_s_waitcnt(0);
        unsigned nloc = b.st[0], nx = b.st[1];
        if (nloc == 0u) { xcd_barrier_complete(bar, b.x, nloc, nx); b.st[0] = nloc; b.st[1] = nx; }
        const unsigned old = xb_add(&bar[XB_XSUB(b.x)], 1u);
        const unsigned gen = old / nloc;
        if (old + 1u == (gen + 1u) * nloc) {
            __builtin_amdgcn_fence(__ATOMIC_RELEASE, "agent");
            asm volatile("s_waitcnt vmcnt(0)" ::: "memory");
            const unsigned og = xb_add(&bar[XB_TOP], 1u);
            const unsigned tg = og / nx;
            if (og + 1u == (tg + 1u) * nx) xb_add(&bar[XB_TOPGEN], 1u);
            else XB_SPIN(xb_ld(&bar[XB_TOPGEN]) == tg, bar);
            __builtin_amdgcn_fence(__ATOMIC_ACQUIRE, "agent");
            xb_add(&bar[XB_XGEN(b.x)], 1u);
            asm volatile("s_waitcnt vmcnt(0)" ::: "memory");
        } else {
            XB_SPIN(xb_ld(&bar[XB_XGEN(b.x)]) == gen, bar);
            __builtin_amdgcn_fence(__ATOMIC_ACQUIRE, "agent");
            asm volatile("s_waitcnt vmcnt(0)" ::: "memory");
        }
    }
    __syncthreads();
}

struct Args {
    const float* in[25];
    float* out; unsigned char* ws;
    int ph_lo, ph_hi;
};
enum { I_X = 0, I_C, I_CTX, I_CCTX, I_WMOD, I_BMOD, I_LN1, I_LN2, I_WIN, I_WG2, I_BG2, I_GLAG, I_QNG, I_WUQ, I_KVNG, I_WUKV, I_WOUT, I_FG, I_FU, I_FD, I_RW, I_EG, I_EU, I_ED, I_FNG };

struct Ctx {
    LAS unsigned char* lds; unsigned char* ldsg; unsigned char* ws; unsigned char* arena; const float* const* in; float* out;
    int tid, lane, wave, G, bid, vcu;
};

__device__ __forceinline__ int mod_row(int row) { return row < NLAT ? (row >> 13) : 2; }
__device__ __forceinline__ void row_bpos(int row, int& b, int& pos) { if (row < NLAT) { b = row >> 13; pos = row & (TT - 1); } else { const int r2 = row - NLAT; b = r2 >> 8; pos = TT + (r2 & 255); } }
__device__ __forceinline__ int chunk_row(int b, int a) { return a < 128 ? b * TT + a * 64 : NLAT + b * TC + (a - 128) * 64; }

template <class SrcFn>
__device__ __forceinline__ void transpose_item(const SrcFn& src, bf16* dst, int ldk, int k0, int n0, LAS float* scr, int lane) {
#pragma unroll 8
    for (int i = 0; i < 64; ++i) scr[i * 65 + lane] = src(k0 + i, n0 + lane);
    LDS_WAIT(); asm volatile("" ::: "memory");
    const int c = lane & 7;
#pragma unroll
    for (int j = 0; j < 8; ++j) { const int n = (lane >> 3) + 8 * j; const LAS float* s = scr + (8 * c) * 65 + n;
        u32x4 o; o.x = pk2(s[0 * 65], s[1 * 65]); o.y = pk2(s[2 * 65], s[3 * 65]); o.z = pk2(s[4 * 65], s[5 * 65]); o.w = pk2(s[6 * 65], s[7 * 65]);
        *(u32x4*)(dst + (size_t)(n0 + n) * ldk + k0 + 8 * c) = o; }
    LDS_WAIT(); asm volatile("" ::: "memory");
}
__device__ __forceinline__ void transpose_item_fast(const float* S, int ld, bf16* dst, int ldk, int k0, int n0, LAS float* scr, int lane) {
    f32x4 v[16];
#pragma unroll
    for (int i = 0; i < 16; ++i) v[i] = *(const f32x4*)(S + (size_t)(i * 4 + (lane >> 4)) * ld + (lane & 15) * 4);
#pragma unroll
    for (int i = 0; i < 16; ++i) { LAS float* p = scr + (i * 4 + (lane >> 4)) * 65 + (lane & 15) * 4; p[0] = v[i].x; p[1] = v[i].y; p[2] = v[i].z; p[3] = v[i].w; }
    LDS_WAIT(); asm volatile("" ::: "memory");
    const int c = lane & 7;
#pragma unroll
    for (int j = 0; j < 8; ++j) { const int n = (lane >> 3) + 8 * j; const LAS float* s = scr + (8 * c) * 65 + n;
        u32x4 o; o.x = pk2(s[0 * 65], s[1 * 65]); o.y = pk2(s[2 * 65], s[3 * 65]); o.z = pk2(s[4 * 65], s[5 * 65]); o.w = pk2(s[6 * 65], s[7 * 65]);
        *(u32x4*)(dst + (size_t)(n0 + n) * ldk + k0 + 8 * c) = o; }
    LDS_WAIT(); asm volatile("" ::: "memory");
}
__device__ __forceinline__ int rope_unperm(int jj) { const int pair = jj >> 1, which = jj & 1; return pair < 16 ? pair + 16 * which : 32 + (pair - 16) + 16 * which; }
__device__ __forceinline__ int win_src_col(int n) {
    if (n < 1024) return n;
    if (n < 1536) return 1056 + (n - 1024);
    if (n < 1792) return 1568 + (n - 1536);
    if (n < 1920) return 1824 + (n - 1792);
    if (n < 1984) return 1952 + rope_unperm(n - 1920);
    if (n < 2000) return 1024 + (n - 1984);
    if (n < 2016) return 1040 + (n - 2000);
    return -1;
}

__device__ __forceinline__ void prologue(const Ctx& C) {
    const int gw = C.vcu * 8 + C.wave, NGW = C.G * 8;
    LAS float* scr = (LAS float*)(C.lds + C.wave * 16640);
    for (int l = 0; l < 2; ++l) {
        {
            const float* W = C.in[I_WIN] + (size_t)l * 1024 * 2016; bf16* dst = (bf16*)(C.arena + A_WIN) + (size_t)l * 2048 * 1024;
            auto f = [=](int k, int n) -> float { const int sc = win_src_col(n); return sc < 0 ? 0.f : W[(size_t)k * 2016 + sc]; };
            for (int it = gw; it < 16 * 32; it += NGW) transpose_item(f, dst, 1024, (it >> 5) * 64, (it & 31) * 64, scr, C.lane);
        }
        {
            const float* Wq = C.in[I_WUQ] + (size_t)l * 256 * 768; const float* gq = C.in[I_QNG] + l * 256; const float* Wk = C.in[I_WUKV] + (size_t)l * 128 * 1024; const float* gk = C.in[I_KVNG] + l * 128;
            bf16* dst = (bf16*)(C.arena + A_WQKV) + (size_t)l * 1792 * 384;
            auto f = [=](int k, int n) -> float {
                if (n < 768) { if (k >= 256) return 0.f; const int h = n / 192, j = n % 192; const int sc = h * 192 + (j < 128 ? j : 128 + rope_unperm(j - 128)); return gq[k] * Wq[(size_t)k * 768 + sc]; }
                if (k < 256) return 0.f; return gk[k - 256] * Wk[(size_t)(k - 256) * 1024 + (n - 768)]; };
            for (int it = gw; it < 6 * 28; it += NGW) transpose_item(f, dst, 384, (it / 28) * 64, (it % 28) * 64, scr, C.lane);
        }
        {
            const float* W = C.in[I_WOUT] + (size_t)l * 1024 * 1024; bf16* dst = (bf16*)(C.arena + A_WOUT) + (size_t)l * 1024 * 1024;
            for (int it = gw; it < 16 * 16; it += NGW) { const int k0 = (it >> 4) * 64, n0 = (it & 15) * 64; transpose_item_fast(W + (size_t)k0 * 1024 + n0, 1024, dst, 1024, k0, n0, scr, C.lane); }
        }
    }
    {
        bf16* dst = (bf16*)(C.arena + A_FGU);
        for (int it = gw; it < 16 * 88; it += NGW) { const int k0 = (it / 88) * 64, n0 = (it % 88) * 64; const int tj = n0 >> 8, c = n0 & 255;
            const float* W = (c < 128) ? C.in[I_FG] : C.in[I_FU]; const int sc = tj * 128 + (c & 127);
            transpose_item_fast(W + (size_t)k0 * DFF + sc, DFF, dst, 1024, k0, n0, scr, C.lane); }
    }
    {
        bf16* dst = (bf16*)(C.arena + A_FD); const float* W = C.in[I_FD];
        for (int it = gw; it < 44 * 16; it += NGW) { const int k0 = (it >> 4) * 64, n0 = (it & 15) * 64; transpose_item_fast(W + (size_t)k0 * 1024 + n0, 1024, dst, DFF, k0, n0, scr, C.lane); }
    }
    __syncthreads();
    if (C.vcu == C.G - 1) {
        float* R = (float*)(C.ws + WS_ROPE);
        for (int i = C.tid; i < (128 + 64) * 16; i += 512) { const int j = i & 15, p = i >> 4; const int pos = p < 128 ? p : p - 128;
            const float inv = powf(10000.f, -(float)j / 16.f); const float ang = (float)pos * inv; R[2 * i] = cosf(ang); R[2 * i + 1] = sinf(ang); }
    }
    for (int item = C.vcu; item < 96; item += C.G) {
        const int l = item / 48, cg = item % 48;
        LAS float* sil = (LAS float*)C.lds; LAS float* part = sil + 3 * 1024;
        for (int i = C.tid; i < 3 * 1024; i += 512) { const int v = i >> 10, k = i & 1023; const float x = v < 2 ? C.in[I_C][v * 1024 + k] : C.in[I_CCTX][k]; sil[i] = silu_f(x); }
        __syncthreads();
        const int half = C.lane >> 5, c4 = (C.lane & 31) * 4;
        f32x4 a0 = {0, 0, 0, 0}, a1 = a0, a2 = a0;
        const float* W = C.in[I_WMOD] + (size_t)l * 1024 * 6144 + cg * 128 + c4;
#pragma unroll 8
        for (int i = 0; i < 64; ++i) { const int k = C.wave * 128 + 2 * i + half; const f32x4 w = *(const f32x4*)(W + (size_t)k * 6144);
            a0 += w * sil[k]; a1 += w * sil[1024 + k]; a2 += w * sil[2048 + k]; }
        LAS float* pp = part + (C.wave * 2 + half) * 384 + c4;
#pragma unroll
        for (int q = 0; q < 4; ++q) { pp[q] = a0[q]; pp[128 + q] = a1[q]; pp[256 + q] = a2[q]; }
        __syncthreads();
        if (C.tid < 384) { const int v = C.tid >> 7, c = C.tid & 127; float s = C.in[I_BMOD][l * 6144 + cg * 128 + c];
#pragma unroll
            for (int p = 0; p < 16; ++p) s += part[p * 384 + v * 128 + c];
            ((float*)(C.ws + WS_MOD))[(l * 3 + v) * 6144 + cg * 128 + c] = s; }
        __syncthreads();
    }
}

__device__ __forceinline__ void load_row16(const float* p, int lane, f32x4 (&v)[4]) {
#pragma unroll
    for (int j = 0; j < 4; ++j) v[j] = *(const f32x4*)(p + 256 * j + 4 * lane);
}
__device__ __forceinline__ void norm_mod_row(f32x4 (&v)[4], const float* g, const float* sc, const float* sh, int lane) {
    float ss = 0.f;
#pragma unroll
    for (int j = 0; j < 4; ++j) ss += (v[j].x * v[j].x + v[j].y * v[j].y) + (v[j].z * v[j].z + v[j].w * v[j].w);
    const float rs = 1.f / sqrtf(wave_sum(ss) * (1.f / DM) + EPS);
#pragma unroll
    for (int j = 0; j < 4; ++j) { const f32x4 gg = *(const f32x4*)(g + 256 * j + 4 * lane), s1 = *(const f32x4*)(sc + 256 * j + 4 * lane), s0 = *(const f32x4*)(sh + 256 * j + 4 * lane);
        v[j] = (v[j] * rs * gg) * (s1 + 1.f) + s0; }
}
__device__ __forceinline__ void store_row16_bf16(bf16* p, int lane, const f32x4 (&v)[4]) {
#pragma unroll
    for (int j = 0; j < 4; ++j) { u32x2 w; w.x = pk2(v[j].x, v[j].y); w.y = pk2(v[j].z, v[j].w); *(u32x2*)(p + 256 * j + 4 * lane) = w; }
}
__device__ __forceinline__ const float* xin_row(const Ctx& C, int layer, int row) {
    if (layer == 0) return row < NLAT ? C.in[I_X] + (size_t)row * DM : C.in[I_CTX] + (size_t)(row - NLAT) * DM;
    return (const float*)(C.ws + WS_XL) + (size_t)row * DM;
}

__device__ __forceinline__ void phase_norm1(const Ctx& C, int layer) {
    const int gw = C.vcu * 8 + C.wave, NGW = C.G * 8;
    const float* g = C.in[I_LN1] + layer * DM; const float* MOD = (const float*)(C.ws + WS_MOD) + (size_t)layer * 3 * 6144; bf16* H = (bf16*)(C.ws + WS_H);
    for (int row = gw; row < MR; row += NGW) {
        f32x4 v[4]; load_row16(xin_row(C, layer, row), C.lane, v);
        const float* m = MOD + mod_row(row) * 6144;
        norm_mod_row(v, g, m + 1024, m, C.lane);
        store_row16_bf16(H + (size_t)row * DM, C.lane, v);
    }
}

__device__ __forceinline__ void phase_norm2(const Ctx& C, int layer) {
    const int gw = C.vcu * 8 + C.wave, NGW = C.G * 8;
    const float* g = C.in[I_LN2] + layer * DM; const float* MOD = (const float*)(C.ws + WS_MOD) + (size_t)layer * 3 * 6144; bf16* H = (bf16*)(C.ws + WS_H);
    const float* XL = (const float*)(C.ws + WS_XL);
    const int nrow = layer == 0 ? MR : NLAT;
    unsigned* ctl = (unsigned*)(C.ws + WS_CTL);
    int* PE = (int*)(C.ws + WS_LIST); int* PS = PE + NLAT * 2; float* PWt = (float*)(PS + NLAT * 2);
    for (int row = gw; row < nrow; row += NGW) {
        f32x4 v[4]; load_row16(XL + (size_t)row * DM, C.lane, v);
        const float* m = MOD + mod_row(row) * 6144;
        norm_mod_row(v, g, m + 4096, m + 3072, C.lane);
        store_row16_bf16(H + (size_t)row * DM, C.lane, v);
        if (layer == 1) {
            const float* RW = C.in[I_RW];
            float lg[8];
#pragma unroll
            for (int e = 0; e < 8; ++e) lg[e] = 0.f;
#pragma unroll
            for (int j = 0; j < 4; ++j)
#pragma unroll
                for (int q = 0; q < 4; ++q) { const int n = 256 * j + 4 * C.lane + q; const f32x4 w0 = *(const f32x4*)(RW + n * 8), w1 = *(const f32x4*)(RW + n * 8 + 4); const float x = v[j][q];
                    lg[0] += x * w0.x; lg[1] += x * w0.y; lg[2] += x * w0.z; lg[3] += x * w0.w; lg[4] += x * w1.x; lg[5] += x * w1.y; lg[6] += x * w1.z; lg[7] += x * w1.w; }
#pragma unroll
            for (int e = 0; e < 8; ++e) lg[e] = wave_sum(lg[e]);
            int e1 = 0; float v1 = lg[0];
#pragma unroll
            for (int e = 1; e < 8; ++e) if (lg[e] > v1) { v1 = lg[e]; e1 = e; }
            int e2 = -1; float v2 = -3.0e38f;
#pragma unroll
            for (int e = 0; e < 8; ++e) if (e != e1 && lg[e] > v2) { v2 = lg[e]; e2 = e; }
            if (C.lane == 0) {
                const float w1 = 1.f / (1.f + expf(v2 - v1)), w2 = 1.f - w1;
                const unsigned s1 = atomicAdd(ctl + CW_CNT + 64 * e1, 1u), s2 = atomicAdd(ctl + CW_CNT + 64 * e2, 1u);
                PE[row * 2] = e1; PE[row * 2 + 1] = e2; PS[row * 2] = (int)s1; PS[row * 2 + 1] = (int)s2; PWt[row * 2] = w1; PWt[row * 2 + 1] = w2;
            }
        }
    }
    if (layer == 1) {
        int* ENT = (int*)(C.ws + WS_LIST + AL((size_t)NLAT * 2 * 4 * 3));
        for (int i = C.vcu * 512 + C.tid; i < MAXT * 256; i += C.G * 512) ENT[i] = -1;
    }
}

__device__ __forceinline__ void phase_expert_weights(const Ctx& C) {
    const int gw = C.vcu * 8 + C.wave, NGW = C.G * 8;
    LAS float* scr = (LAS float*)(C.lds + C.wave * 16640);
    bf16* EGU = (bf16*)(C.arena + M_EGU); bf16* ED = (bf16*)(C.arena + M_ED);
    for (int it = gw; it < NEXP * 16 * 112; it += NGW) { const int e = it / (16 * 112), r = it % (16 * 112), k0 = (r / 112) * 64, n0 = (r % 112) * 64; const int tj = n0 >> 8, c = n0 & 255;
        const float* W = ((c < 128) ? C.in[I_EG] : C.in[I_EU]) + (size_t)e * 1024 * DFE; const int sc = tj * 128 + (c & 127);
        transpose_item_fast(W + (size_t)k0 * DFE + sc, DFE, EGU + (size_t)e * 2 * DFE * 1024, 1024, k0, n0, scr, C.lane); }
    for (int it = gw; it < NEXP * 56 * 16; it += NGW) { const int e = it / (56 * 16), r = it % (56 * 16), k0 = (r >> 4) * 64, n0 = (r & 15) * 64;
        const float* W = C.in[I_ED] + (size_t)e * DFE * 1024;
        transpose_item_fast(W + (size_t)k0 * 1024 + n0, 1024, ED + (size_t)e * 1024 * DFE, DFE, k0, n0, scr, C.lane); }
}

__device__ __forceinline__ void moe_tile_bases(const Ctx& C, int (&tb)[9]) {
    unsigned* ctl = (unsigned*)(C.ws + WS_CTL); int acc = 0;
#pragma unroll
    for (int e = 0; e < 8; ++e) { tb[e] = acc; const unsigned c = __hip_atomic_load(ctl + CW_CNT + 64 * e, __ATOMIC_RELAXED, __HIP_MEMORY_SCOPE_AGENT); acc += (int)((c + 255u) >> 8); }
    tb[8] = acc;
}
__device__ __forceinline__ void phase_gather(const Ctx& C) {
    const int gw = C.vcu * 8 + C.wave, NGW = C.G * 8;
    int tb[9]; moe_tile_bases(C, tb);
    const int* PE = (const int*)(C.ws + WS_LIST); const int* PS = PE + NLAT * 2; const float* PWt = (const float*)(PS + NLAT * 2);
    int* ENT = (int*)(C.ws + WS_LIST + AL((size_t)NLAT * 2 * 4 * 3)); float* WTS = (float*)(ENT + MAXT * 256);
    const bf16* H = (const bf16*)(C.ws + WS_H); bf16* HS = (bf16*)(C.arena + M_HS);
    for (int pr = gw; pr < NLAT * 2; pr += NGW) {
        const int e = PE[pr], s = PS[pr]; int base = 0;
#pragma unroll
        for (int k = 0; k < 8; ++k) base = (e == k) ? tb[k] : base;
        const int pos = base * 256 + s;
        const u32x4* srcp = (const u32x4*)(H + (size_t)(pr >> 1) * DM); u32x4* dstp = (u32x4*)(HS + (size_t)pos * DM);
        const u32x4 a = srcp[C.lane], b = srcp[64 + C.lane]; dstp[C.lane] = a; dstp[64 + C.lane] = b;
        if (C.lane == 0) { ENT[pos] = pr; WTS[pos] = PWt[pr]; }
    }
}

__device__ __forceinline__ void phase_final(const Ctx& C) {
    const int gw = C.vcu * 8 + C.wave, NGW = C.G * 8;
    const float* XL = (const float*)(C.ws + WS_XL); const bf16* Y2 = (const bf16*)(C.ws + WS_H); const float* g = C.in[I_FNG];
    for (int row = gw; row < NLAT; row += NGW) {
        f32x4 v[4]; load_row16(XL + (size_t)row * DM, C.lane, v);
        float ss = 0.f;
#pragma unroll
        for (int j = 0; j < 4; ++j) { const u32x2 y = *(const u32x2*)(Y2 + (size_t)row * DM + 256 * j + 4 * C.lane);
            v[j].x += bflo(y.x); v[j].y += bfhi(y.x); v[j].z += bflo(y.y); v[j].w += bfhi(y.y);
            ss += (v[j].x * v[j].x + v[j].y * v[j].y) + (v[j].z * v[j].z + v[j].w * v[j].w); }
        const float rs = 1.f / sqrtf(wave_sum(ss) * (1.f / DM) + EPS);
#pragma unroll
        for (int j = 0; j < 4; ++j) { const f32x4 gg = *(const f32x4*)(g + 256 * j + 4 * C.lane); *(f32x4*)(C.out + (size_t)row * DM + 256 * j + 4 * C.lane) = v[j] * rs * gg; }
    }
}

__device__ __forceinline__ void phase_mla_prep(const Ctx& C) {
    const int gw = C.vcu * 8 + C.wave, NGW = C.G * 8;
    const bf16* P = (const bf16*)(C.arena + R_P); bf16* CQKV = (bf16*)(C.arena + R_CQKV); char* KBc = (char*)(C.arena + R_KB);
    const float* ROPE = (const float*)(C.ws + WS_ROPE);
    for (int row = gw; row < MR; row += NGW) {
        const bf16* pr = P + (size_t)row * PW;
        {   const u32x2 w = *(const u32x2*)(pr + PC_CQ + 4 * C.lane); float x0 = bflo(w.x), x1 = bfhi(w.x), x2 = bflo(w.y), x3 = bfhi(w.y);
            const float rs = 1.f / sqrtf(wave_sum(x0 * x0 + x1 * x1 + x2 * x2 + x3 * x3) * (1.f / 256.f) + EPS);
            u32x2 o; o.x = pk2(x0 * rs, x1 * rs); o.y = pk2(x2 * rs, x3 * rs); *(u32x2*)(CQKV + (size_t)row * 384 + 4 * C.lane) = o; }
        {   const unsigned w = *(const unsigned*)(pr + PC_CKV + 2 * C.lane); float x0 = bflo(w), x1 = bfhi(w);
            const float rs = 1.f / sqrtf(wave_sum(x0 * x0 + x1 * x1) * (1.f / 128.f) + EPS);
            *(unsigned*)(CQKV + (size_t)row * 384 + 256 + 2 * C.lane) = pk2(x0 * rs, x1 * rs); }
        {   float x = bf2f(pr[PC_KR + C.lane]); const float xo = __shfl_xor(x, 1);
            int b, pos; row_bpos(row, b, pos);
            if (row < NLAT) { const int pair = C.lane >> 1, fi = pair & 15, axis = pair >> 4; const int pidx = axis ? (pos & 63) : (pos >> 6);
                const float* cs = ROPE + ((axis ? 128 : 0) + pidx) * 32 + fi * 2; const float c = cs[0], s = cs[1];
                x = (C.lane & 1) ? (x * c + xo * s) : (x * c - xo * s); }
            const bf16 xb = (bf16)f2bf(x);
#pragma unroll
            for (int h = 0; h < 4; ++h) *(bf16*)(KBc + ((size_t)(b * 4 + h) * 132 + (pos >> 6)) * att::KT_BYTES + (16 + (C.lane >> 3)) * 1024 + (pos & 63) * 16 + (C.lane & 7) * 2) = xb; }
    }
}

__device__ __forceinline__ f32x4 mma16(bf16x8 a, bf16x8 b, f32x4 c) { return __builtin_amdgcn_mfma_f32_16x16x32_bf16(a, b, c, 0, 0, 0); }
constexpr int LS = 72;

__device__ __forceinline__ void phase_gla_local(const Ctx& C, int layer) {
    LAS float* codes = (LAS float*)C.lds;
    LAS float* bcum = codes + 64 * 32;
    LAS float* gsum = bcum + 2 * 64 * 64;
    LAS float* tot = gsum + 2 * 4 * 64;
    LAS bf16* vT = (LAS bf16*)(tot + 128);
    LAS bf16* khT = vT + 128 * LS;
    const bf16* P = (const bf16*)(C.arena + R_P);
    bf16* QT = (bf16*)(C.arena + R_QT); bf16* KT = (bf16*)(C.arena + R_KT);
    float* SLOC = (float*)(C.arena + R_SLOC); float* DEC = (float*)(C.arena + R_DEC);
    const float* WG2 = C.in[I_WG2] + (size_t)layer * 2 * 16 * 256; const float* BG2 = C.in[I_BG2] + (size_t)layer * 2 * 256;
    const int tid = C.tid, lane = C.lane;
    for (int L = C.bid; L < NB * NCH * 4; L += C.G) {
        const int h = L & 3, a = (L >> 2) % NCH, b = L / (NCH * 4);
        const int rbase = chunk_row(b, a);
        {
            const int t = tid >> 3, j4 = (tid & 7) * 4; const u32x2 w = *(const u32x2*)(P + (size_t)(rbase + t) * PW + PC_GF + j4);
            LAS float* cp = codes + t * 32 + j4; cp[0] = bflo(w.x); cp[1] = bfhi(w.x); cp[2] = bflo(w.y); cp[3] = bfhi(w.y);
            const int e0 = (tid & 7) * 16; const bf16* vp = P + (size_t)(rbase + t) * PW + PC_V + h * 128 + e0;
            const u32x4 v0 = *(const u32x4*)vp, v1 = *(const u32x4*)(vp + 8); float vf[16]; unpack8(v0, vf); unpack8(v1, vf + 8);
#pragma unroll
            for (int i = 0; i < 16; ++i) vT[(e0 + i) * LS + t] = (bf16)f2bf(vf[i]);
        }
        __syncthreads();
        const int dir = tid >> 8, tg = (tid >> 6) & 3, d = tid & 63;
        {
            float w[16];
#pragma unroll
            for (int r = 0; r < 16; ++r) w[r] = WG2[(dir * 16 + r) * 256 + h * 64 + d];
            const float bias = BG2[dir * 256 + h * 64 + d];
            float acc = 0.f;
#pragma unroll
            for (int ii = 0; ii < 16; ++ii) { const int i = dir ? 15 - ii : ii; const int t = tg * 16 + i; float pre = bias;
#pragma unroll
                for (int r = 0; r < 16; ++r) pre += codes[t * 32 + dir * 16 + r] * w[r];
                acc += logsig_f(pre) * (1.f / 16.f); bcum[(dir * 64 + t) * 64 + d] = acc; }
            gsum[(dir * 4 + tg) * 64 + d] = acc;
        }
        __syncthreads();
        {   float off = 0.f, total = 0.f;
#pragma unroll
            for (int g2 = 0; g2 < 4; ++g2) { const float s = gsum[(dir * 4 + g2) * 64 + d]; total += s; if (dir ? (g2 > tg) : (g2 < tg)) off += s; }
#pragma unroll
            for (int i = 0; i < 16; ++i) bcum[(dir * 64 + tg * 16 + i) * 64 + d] += off;
            if (tg == 0) tot[dir * 64 + d] = total;
        }
        __syncthreads();
        {
            const int t = (tid >> 2) & 63, d0 = (tid & 3) * 16; const size_t row = (size_t)(rbase + t);
            const bf16* qp = P + row * PW + PC_Q + h * 64 + d0; const bf16* kp = P + row * PW + PC_K + h * 64 + d0;
            float q[16], k[16]; unpack8(*(const u32x4*)qp, q); unpack8(*(const u32x4*)(qp + 8), q + 8); unpack8(*(const u32x4*)kp, k); unpack8(*(const u32x4*)(kp + 8), k + 8);
            float qo[16], ko[16];
#pragma unroll
            for (int i = 0; i < 16; ++i) { const float B = bcum[(dir * 64 + t) * 64 + d0 + i], tt = tot[dir * 64 + d0 + i];
                qo[i] = q[i] * 0.125f * __expf(B); ko[i] = k[i] * __expf(-B); khT[(dir * 64 + d0 + i) * LS + t] = (bf16)f2bf(k[i] * __expf(tt - B)); }
            bf16* qd = QT + ((size_t)dir * MR + row) * 256 + h * 64 + d0; bf16* kd = KT + ((size_t)dir * MR + row) * 256 + h * 64 + d0;
            *(u32x4*)qd = pack8(qo); *(u32x4*)(qd + 8) = pack8(qo + 8); *(u32x4*)kd = pack8(ko); *(u32x4*)(kd + 8) = pack8(ko + 8);
        }
        const int pf = a < 128 ? a + 4 : a - 128, pb = 131 - a;
        if (tid < 128) { const int dd = tid >> 6, d2 = tid & 63; const int chain = dd * 8 + b * 4 + h, p = dd ? pb : pf; DEC[((size_t)chain * NCH + p) * 64 + d2] = __expf(tot[dd * 64 + d2]); }
        __syncthreads();
        {
            const int fr = lane & 15, fq = lane >> 4;
#pragma unroll 2
            for (int i = 0; i < 8; ++i) { const int id = C.wave * 8 + i, dd = id >> 5, et = (id >> 2) & 7, dt = id & 3;
                f32x4 acc = {0.f, 0.f, 0.f, 0.f};
#pragma unroll
                for (int ks = 0; ks < 2; ++ks) { const bf16x8 av = *(const LAS bf16x8*)(vT + (et * 16 + fr) * LS + ks * 32 + fq * 8); const bf16x8 bv = *(const LAS bf16x8*)(khT + (dd * 64 + dt * 16 + fr) * LS + ks * 32 + fq * 8);
                    acc = mma16(av, bv, acc); }
                const int chain = dd * 8 + b * 4 + h, p = dd ? pb : pf; float* S = SLOC + ((size_t)chain * NCH + p) * 8192;
#pragma unroll
                for (int r = 0; r < 4; ++r) S[(et * 16 + fq * 4 + r) * 64 + dt * 16 + fr] = acc[r]; }
        }
        __syncthreads();
    }
}

__device__ __forceinline__ void phase_gla_scan(const Ctx& C) {
    const float* SLOC = (const float*)(C.arena + R_SLOC); const float* DEC = (const float*)(C.arena + R_DEC); bf16* SST = (bf16*)(C.arena + R_SST);
    for (int idx = C.bid * 512 + C.tid; idx < 16 * 8192; idx += C.G * 512) {
        const int chain = idx >> 13, el = idx & 8191, d = el & 63;
        const float* sl = SLOC + (size_t)chain * NCH * 8192 + el; const float* dc = DEC + (size_t)chain * NCH * 64 + d; bf16* so = SST + (size_t)chain * NCH * 8192 + el;
        float S = 0.f;
        for (int p0 = 0; p0 < NCH; p0 += 12) {
            float x[12], g[12];
#pragma unroll
            for (int i = 0; i < 12; ++i) { x[i] = sl[(size_t)(p0 + i) * 8192]; g[i] = dc[(p0 + i) * 64]; }
#pragma unroll
            for (int i = 0; i < 12; ++i) { so[(size_t)(p0 + i) * 8192] = (bf16)f2bf(S); S = S * g[i] + x[i]; }
        }
    }
}

__device__ __forceinline__ void phase_gla_out(const Ctx& C, int layer) {
    LAS bf16* qf = (LAS bf16*)C.lds; LAS bf16* kf = qf + 64 * LS; LAS bf16* qb = kf + 64 * LS; LAS bf16* kb = qb + 64 * LS;
    LAS bf16* vT = kb + 64 * LS;
    LAS bf16* SfT = vT + 128 * LS; LAS bf16* SbT = SfT + 128 * LS;
    LAS bf16* As = SbT + 128 * LS;
    LAS float* O = (LAS float*)(As + 64 * LS);
    const bf16* P = (const bf16*)(C.arena + R_P); const bf16* QT = (const bf16*)(C.arena + R_QT); const bf16* KT = (const bf16*)(C.arena + R_KT);
    const bf16* SST = (const bf16*)(C.arena + R_SST); bf16* MIX = (bf16*)(C.arena + R_MIX);
    const float* GG = C.in[I_GLAG] + layer * 128;
    const int tid = C.tid, lane = C.lane, fr = lane & 15, fq = lane >> 4;
    const int na = layer == 0 ? NCH : 128;
    for (int L = C.bid; L < NB * na * 4; L += C.G) {
        const int h = L & 3, a = (L >> 2) % na, b = L / (na * 4);
        const int rbase = chunk_row(b, a);
        const int pf = a < 128 ? a + 4 : a - 128, pb = 131 - a;
        {
            const int which = tid >> 7, t = (tid >> 1) & 63, hf = tid & 1; const int dd = which >> 1;
            const bf16* src = ((which & 1) ? KT : QT) + ((size_t)dd * MR + rbase + t) * 256 + h * 64 + hf * 32;
            LAS bf16* dst = (which == 0 ? qf : which == 1 ? kf : which == 2 ? qb : kb) + t * LS + hf * 32;
#pragma unroll
            for (int i = 0; i < 4; ++i) *(LAS u32x4*)(dst + 8 * i) = *(const u32x4*)(src + 8 * i);
        }
        {
            const int t = tid >> 3, e0 = (tid & 7) * 16; const bf16* vp = P + (size_t)(rbase + t) * PW + PC_V + h * 128 + e0;
            const u32x4 v0 = *(const u32x4*)vp, v1 = *(const u32x4*)(vp + 8); float vf[16]; unpack8(v0, vf); unpack8(v1, vf + 8);
#pragma unroll
            for (int i = 0; i < 16; ++i) vT[(e0 + i) * LS + t] = (bf16)f2bf(vf[i]);
        }
        {
            const int dd = tid >> 8, e = (tid >> 1) & 127, hf = tid & 1; const int chain = dd * 8 + b * 4 + h, p = dd ? pb : pf;
            const bf16* src = SST + ((size_t)chain * NCH + p) * 8192 + e * 64 + hf * 32; LAS bf16* dst = (dd ? SbT : SfT) + e * LS + hf * 32;
#pragma unroll
            for (int i = 0; i < 4; ++i) *(LAS u32x4*)(dst + 8 * i) = *(const u32x4*)(src + 8 * i);
        }
        __syncthreads();
        {
#pragma unroll
            for (int i = 0; i < 2; ++i) { const int pos = C.wave * 2 + i, ti = pos >> 2, si = pos & 3;
                f32x4 af = {0.f, 0.f, 0.f, 0.f}, ab = af;
#pragma unroll
                for (int ks = 0; ks < 2; ++ks) {
                    const bf16x8 a1 = *(const LAS bf16x8*)(qf + (ti * 16 + fr) * LS + ks * 32 + fq * 8), b1 = *(const LAS bf16x8*)(kf + (si * 16 + fr) * LS + ks * 32 + fq * 8);
                    const bf16x8 a2 = *(const LAS bf16x8*)(qb + (ti * 16 + fr) * LS + ks * 32 + fq * 8), b2 = *(const LAS bf16x8*)(kb + (si * 16 + fr) * LS + ks * 32 + fq * 8);
                    af = mma16(a1, b1, af); ab = mma16(a2, b2, ab); }
#pragma unroll
                for (int r = 0; r < 4; ++r) { const int t = ti * 16 + fq * 4 + r, s = si * 16 + fr; const float val = (s <= t ? af[r] : 0.f) + (s >= t ? ab[r] : 0.f); As[t * LS + s] = (bf16)f2bf(val); } }
        }
        __syncthreads();
        {
#pragma unroll 2
            for (int i = 0; i < 4; ++i) { const int id = C.wave * 4 + i, tt = id >> 3, et = id & 7;
                f32x4 acc = {0.f, 0.f, 0.f, 0.f};
#pragma unroll
                for (int ks = 0; ks < 2; ++ks) {
                    const bf16x8 bv = *(const LAS bf16x8*)(vT + (et * 16 + fr) * LS + ks * 32 + fq * 8);
                    acc = mma16(*(const LAS bf16x8*)(As + (tt * 16 + fr) * LS + ks * 32 + fq * 8), bv, acc);
                    acc = mma16(*(const LAS bf16x8*)(qf + (tt * 16 + fr) * LS + ks * 32 + fq * 8), *(const LAS bf16x8*)(SfT + (et * 16 + fr) * LS + ks * 32 + fq * 8), acc);
                    acc = mma16(*(const LAS bf16x8*)(qb + (tt * 16 + fr) * LS + ks * 32 + fq * 8), *(const LAS bf16x8*)(SbT + (et * 16 + fr) * LS + ks * 32 + fq * 8), acc); }
#pragma unroll
                for (int r = 0; r < 4; ++r) O[(tt * 16 + fq * 4 + r) * 132 + et * 16 + fr] = acc[r]; }
        }
        __syncthreads();
        {
            const int t = tid >> 3, e0 = (tid & 7) * 16; float o[16], ss = 0.f;
#pragma unroll
            for (int i = 0; i < 16; ++i) { o[i] = O[t * 132 + e0 + i]; ss += o[i] * o[i]; }
            ss += __shfl_xor(ss, 1); ss += __shfl_xor(ss, 2); ss += __shfl_xor(ss, 4);
            const float rs = 1.f / sqrtf(ss * (1.f / 128.f) + EPS);
            const size_t row = (size_t)(rbase + t); const bf16* rp = P + row * PW + PC_R + h * 128 + e0; float rv[16]; unpack8(*(const u32x4*)rp, rv); unpack8(*(const u32x4*)(rp + 8), rv + 8);
#pragma unroll
            for (int i = 0; i < 16; ++i) o[i] = o[i] * rs * GG[e0 + i] * silu_f(rv[i]);
            bf16* mp = MIX + row * DM + h * 128 + e0; *(u32x4*)mp = pack8(o); *(u32x4*)(mp + 8) = pack8(o + 8);
        }
        __syncthreads();
    }
}

namespace att {
constexpr int NW = 8, QBLK = 32, KVBLK = 64;
constexpr float THR = 8.f;
constexpr int OFF_K = 0, OFF_V = 2 * KT_BYTES, OFF_WS = OFF_V + 3 * VT_BYTES, OFF_QR = OFF_WS + NW * 64 * 4, SHM_ATTN = OFF_QR + NW * 4096;
#define SBAR() __builtin_amdgcn_sched_barrier(0)
__device__ __forceinline__ int crow(int r, int hi) { return (r & 3) + 8 * (r >> 2) + 4 * hi; }
__device__ __forceinline__ unsigned cvtpk(float lo, float hi) { unsigned r; asm volatile("v_cvt_pk_bf16_f32 %0, %1, %2" : "=v"(r) : "v"(lo), "v"(hi)); return r; }
__device__ __forceinline__ void glds16(const void* gsrc, unsigned lds_dst) { unsigned keep;
    asm volatile("s_mov_b32 %0, m0\n\ts_mov_b32 m0, %2\n\ts_nop 0\n\tglobal_load_lds_dwordx4 %1, off\n\ts_mov_b32 m0, %0" : "=&s"(keep) : "v"(gsrc), "s"(lds_dst) : "memory"); }
__device__ __forceinline__ void partialSM(f32x16& p0, f32x16& p1, float& m_reg, float& mn, float& alpha) {
    constexpr float Cc = MLA_SCALE * 1.4426950408889634f;
    float pmax = p0[0];
#pragma unroll
    for (int r = 1; r < 16; ++r) pmax = fmaxf(pmax, p0[r]);
#pragma unroll
    for (int r = 0; r < 16; ++r) pmax = fmaxf(pmax, p1[r]);
    { auto rr = __builtin_amdgcn_permlane32_swap(__float_as_uint(pmax), __float_as_uint(pmax), false, false);
      pmax = fmaxf(__uint_as_float(rr[0]), __uint_as_float(rr[1])); }
    if (__builtin_expect(__all(pmax - m_reg <= THR / MLA_SCALE), 1)) { mn = m_reg; alpha = 1.f; }
    else { mn = fmaxf(m_reg, pmax); alpha = __builtin_amdgcn_exp2f((m_reg - mn) * Cc); m_reg = mn; }
    const float mnC = -mn * Cc;
#pragma unroll
    for (int r = 0; r < 16; ++r) p0[r] = fmaf(p0[r], Cc, mnC);
#pragma unroll
    for (int r = 0; r < 16; ++r) p1[r] = fmaf(p1[r], Cc, mnC);
#pragma unroll
    for (int r = 0; r < 16; ++r) p0[r] = __builtin_amdgcn_exp2f(p0[r]);
}
__device__ __forceinline__ void finishSM(f32x16& p0, f32x16& p1, float alpha, float& l_reg, bf16x8& pa0, bf16x8& pa1, bf16x8& pa2, bf16x8& pa3) {
#pragma unroll
    for (int r = 0; r < 16; ++r) p1[r] = __builtin_amdgcn_exp2f(p1[r]);
    float ps = 0;
#pragma unroll
    for (int r = 0; r < 16; ++r) ps += p0[r];
#pragma unroll
    for (int r = 0; r < 16; ++r) ps += p1[r];
    { auto rr = __builtin_amdgcn_permlane32_swap(__float_as_uint(ps), __float_as_uint(ps), false, false);
      ps = __uint_as_float(rr[0]) + __uint_as_float(rr[1]); }
    l_reg = l_reg * alpha + ps;
#define PK4(P, BASE, OUT) do { unsigned a0 = cvtpk(P[BASE + 0], P[BASE + 1]), a1 = cvtpk(P[BASE + 2], P[BASE + 3]);   \
    unsigned b0 = cvtpk(P[BASE + 4], P[BASE + 5]), b1 = cvtpk(P[BASE + 6], P[BASE + 7]);                              \
    auto r0 = __builtin_amdgcn_permlane32_swap(a0, b0, false, false); auto r1 = __builtin_amdgcn_permlane32_swap(a1, b1, false, false); \
    u32x4 w = {r0[0], r1[0], r0[1], r1[1]}; OUT = *reinterpret_cast<bf16x8*>(&w); } while (0)
    PK4(p0, 0, pa0); PK4(p0, 8, pa1); PK4(p1, 0, pa2); PK4(p1, 8, pa3);
#undef PK4
}
__device__ __forceinline__ void qkt(f32x16& p0, f32x16& p1, const char* kl, const bf16x8* qr, const char* qrl) {
    p0 = f32x16{}; p1 = f32x16{};
#pragma unroll
    for (int d0 = 0; d0 < 8; ++d0) {
        const bf16x8 b0 = *reinterpret_cast<const bf16x8*>(kl + d0 * 2048);
        const bf16x8 b1 = *reinterpret_cast<const bf16x8*>(kl + d0 * 2048 + 512);
        p0 = __builtin_amdgcn_mfma_f32_32x32x16_bf16(b0, qr[d0], p0, 0, 0, 0);
        p1 = __builtin_amdgcn_mfma_f32_32x32x16_bf16(b1, qr[d0], p1, 0, 0, 0); }
#pragma unroll
    for (int d0 = 8; d0 < 12; ++d0) {
        const bf16x8 b0 = *reinterpret_cast<const bf16x8*>(kl + d0 * 2048);
        const bf16x8 b1 = *reinterpret_cast<const bf16x8*>(kl + d0 * 2048 + 512);
        const bf16x8 qv = *reinterpret_cast<const bf16x8*>(qrl + (d0 - 8) * 1024);
        p0 = __builtin_amdgcn_mfma_f32_32x32x16_bf16(b0, qv, p0, 0, 0, 0);
        p1 = __builtin_amdgcn_mfma_f32_32x32x16_bf16(b1, qv, p1, 0, 0, 0); }
}
__device__ __forceinline__ int v_rd_base(int lane) { return ((lane & 3) << 3) | (((lane >> 2) & 3) << 6) | (((lane >> 4) & 1) << 5) | (((lane >> 5) & 1) << 8); }
constexpr int v_rd_off(int d0, int ks, int half) { return d0 * 512 + ks * 4096 + half * 2048; }
template <int OFF> __device__ __forceinline__ s16x4 tr_read(int vb) {
    s16x4 r; asm volatile("ds_read_b64_tr_b16 %0, %1 offset:%2" : "=&v"(r) : "v"(vb), "i"(OFF) : "memory"); return r;
}
template <int D0> __device__ __forceinline__ void pv_one(f32x16& od, int vb, bf16x8 pa0, bf16x8 pa1, bf16x8 pa2, bf16x8 pa3) {
    const s16x4 l0 = tr_read<v_rd_off(D0, 0, 0)>(vb), h0 = tr_read<v_rd_off(D0, 0, 1)>(vb), l1 = tr_read<v_rd_off(D0, 1, 0)>(vb), h1 = tr_read<v_rd_off(D0, 1, 1)>(vb);
    const s16x4 l2 = tr_read<v_rd_off(D0, 2, 0)>(vb), h2 = tr_read<v_rd_off(D0, 2, 1)>(vb), l3 = tr_read<v_rd_off(D0, 3, 0)>(vb), h3 = tr_read<v_rd_off(D0, 3, 1)>(vb);
    asm volatile("s_waitcnt lgkmcnt(0)" ::: "memory"); SBAR();
#define PKV(L, H) (bf16x8){L[0], L[1], L[2], L[3], H[0], H[1], H[2], H[3]}
    od = __builtin_amdgcn_mfma_f32_32x32x16_bf16(pa0, PKV(l0, h0), od, 0, 0, 0);
    od = __builtin_amdgcn_mfma_f32_32x32x16_bf16(pa1, PKV(l1, h1), od, 0, 0, 0);
    od = __builtin_amdgcn_mfma_f32_32x32x16_bf16(pa2, PKV(l2, h2), od, 0, 0, 0);
    od = __builtin_amdgcn_mfma_f32_32x32x16_bf16(pa3, PKV(l3, h3), od, 0, 0, 0);
#undef PKV
}
__device__ __forceinline__ void pv_d0(f32x16* o, int vb, bf16x8 pa0, bf16x8 pa1, bf16x8 pa2, bf16x8 pa3) {
    pv_one<0>(o[0], vb, pa0, pa1, pa2, pa3); pv_one<1>(o[1], vb, pa0, pa1, pa2, pa3); pv_one<2>(o[2], vb, pa0, pa1, pa2, pa3); pv_one<3>(o[3], vb, pa0, pa1, pa2, pa3);
}
__device__ __forceinline__ void attn_body(const bf16* __restrict__ Qb, const char* __restrict__ Kt, const char* __restrict__ Vt, bf16* __restrict__ Ob, int t0, int NT, char* lds, const float* __restrict__ ROPE, int qpos0) {
    int tid = threadIdx.x; asm volatile("" : "+v"(tid));
    const int wid = __builtin_amdgcn_readfirstlane(tid >> 6), lane = tid & 63, r32 = lane & 31, hi = lane >> 5;
    float* ws = (float*)(lds + OFF_WS) + wid * 64; float* li_l = ws; float* al_l = ws + 32;
    float m_reg = -1e30f, l_reg = 0; f32x16 o[4] = {}; bf16x8 qr[8];
    const bf16* Qw = Qb + (long)(wid * QBLK + r32) * 192 + hi * 8;
#pragma unroll
    for (int d0 = 0; d0 < 8; ++d0) qr[d0] = *reinterpret_cast<const bf16x8*>(Qw + d0 * 16);
    char* qrl = lds + OFF_QR + wid * 4096 + lane * 16;
#pragma unroll
    for (int d0 = 0; d0 < 4; ++d0) {
        const u32x4 w = *reinterpret_cast<const u32x4*>(Qw + 128 + d0 * 16); float v[8]; unpack8(w, v);
        if (qpos0 >= 0) { const int pos = qpos0 + wid * QBLK + r32;
#pragma unroll
            for (int q = 0; q < 4; ++q) { const int pair = d0 * 8 + hi * 4 + q, fi = pair & 15, axis = pair >> 4; const int pidx = axis ? (pos & 63) : (pos >> 6);
                const float* cs = ROPE + ((axis ? 128 : 0) + pidx) * 32 + fi * 2; const float c = cs[0], sn = cs[1]; const float x1 = v[2 * q], x2 = v[2 * q + 1];
                v[2 * q] = x1 * c - x2 * sn; v[2 * q + 1] = x2 * c + x1 * sn; } }
        *reinterpret_cast<u32x4*>(qrl + d0 * 1024) = pack8(v); }
    asm volatile("s_waitcnt vmcnt(0)" ::: "memory");
    const unsigned ldsb = (unsigned)(uintptr_t)lds;
    const char* Ktw = Kt + (size_t)t0 * KT_BYTES + lane * 16; const char* Vtw = Vt + (size_t)t0 * VT_BYTES + lane * 16;
#define ISSUE(j, ks, vs) do { _Pragma("unroll") for (int _i = 0; _i < 5; ++_i) { const int q = wid * 5 + _i; \
        if (q < 24) glds16(Ktw + (size_t)(j) * KT_BYTES + q * 1024, __builtin_amdgcn_readfirstlane(ldsb + OFF_K + (ks) * KT_BYTES + q * 1024)); \
        else glds16(Vtw + (size_t)(j) * VT_BYTES + (q - 24) * 1024, __builtin_amdgcn_readfirstlane(ldsb + OFF_V + (vs) * VT_BYTES + (q - 24) * 1024)); } } while (0)
#define RESC(a) do { if (__any((a) < 1.f)) { if (hi == 0) al_l[r32] = (a); asm volatile("s_waitcnt lgkmcnt(0)" ::: "memory"); \
    _Pragma("unroll") for (int d = 0; d < 4; ++d) _Pragma("unroll") for (int r = 0; r < 16; ++r) o[d][r] *= al_l[crow(r, hi)]; } } while (0)
    const char* kl0 = lds + OFF_K + hi * 1024 + r32 * 16;
    const int vb0 = (int)ldsb + OFF_V + v_rd_base(lane);
    f32x16 pA0, pA1, pB0, pB1; float mnA, mnB, alA, alB; bf16x8 pa0, pa1, pa2, pa3;
    ISSUE(0, 0, 0); ISSUE(1, 1, 1);
    asm volatile("s_waitcnt vmcnt(5)" ::: "memory"); __builtin_amdgcn_s_barrier(); SBAR();
    qkt(pA0, pA1, kl0, qr, qrl); partialSM(pA0, pA1, m_reg, mnA, alA);
    int vprev = 0, vcur = 1, vnext = 2;
    for (int j = 1; j < NT; j += 2) {
        asm volatile("s_waitcnt vmcnt(0)" ::: "memory"); __builtin_amdgcn_s_barrier(); SBAR();
        if (j + 1 < NT) ISSUE(j + 1, 0, vnext);
        SBAR(); qkt(pB0, pB1, kl0 + KT_BYTES, qr, qrl);
        finishSM(pA0, pA1, alA, l_reg, pa0, pa1, pa2, pa3); SBAR();
        pv_d0(o, vb0 + vprev * VT_BYTES, pa0, pa1, pa2, pa3); partialSM(pB0, pB1, m_reg, mnB, alB);
        RESC(alB);
        { const int t = vprev; vprev = vcur; vcur = vnext; vnext = t; }
        if (j + 1 < NT) {
            asm volatile("s_waitcnt vmcnt(0)" ::: "memory"); __builtin_amdgcn_s_barrier(); SBAR();
            if (j + 2 < NT) ISSUE(j + 2, 1, vnext);
            SBAR(); qkt(pA0, pA1, kl0, qr, qrl);
            finishSM(pB0, pB1, alB, l_reg, pa0, pa1, pa2, pa3); SBAR();
            pv_d0(o, vb0 + vprev * VT_BYTES, pa0, pa1, pa2, pa3); partialSM(pA0, pA1, m_reg, mnA, alA);
            RESC(alA);
            { const int t = vprev; vprev = vcur; vcur = vnext; vnext = t; }
        }
    }
    finishSM(pB0, pB1, alB, l_reg, pa0, pa1, pa2, pa3); SBAR();
    pv_d0(o, vb0 + vprev * VT_BYTES, pa0, pa1, pa2, pa3);
    if (hi == 0) li_l[r32] = l_reg; asm volatile("s_waitcnt lgkmcnt(0)" ::: "memory");
    float rli[16];
#pragma unroll
    for (int r = 0; r < 16; ++r) rli[r] = __builtin_amdgcn_rcpf(li_l[crow(r, hi)]);
    bf16* Ow = Ob + (long)(wid * QBLK) * DM;
#pragma unroll
    for (int r = 0; r < 16; ++r) { const int orow = crow(r, hi);
#pragma unroll
        for (int d0 = 0; d0 < 4; ++d0) Ow[(long)orow * DM + d0 * 32 + r32] = (bf16)f2bf(o[d0][r] * rli[r]); }
    __syncthreads();
#undef ISSUE
#undef RESC
}
}

__device__ __forceinline__ void phase_attention(const Ctx& C, int layer) {
    const bf16* QB = (const bf16*)(C.arena + R_QB); const char* KB = (const char*)(C.arena + R_KB); const char* VB = (const char*)(C.arena + R_VB); bf16* MIX = (bf16*)(C.arena + R_MIX);
    const float* ROPE = (const float*)(C.ws + WS_ROPE);
    const int nunit = layer == 0 ? 264 : 256;
    for (int L = C.bid; L < nunit; L += C.G) {
        const bool lat = L < 256; const int bh = lat ? (L & 7) : (L - 256), qb = L >> 3, b = bh >> 2, h = bh & 3;
        const int qrow = lat ? qb * 256 : TT, orow = lat ? b * TT + qb * 256 : NLAT + b * TC;
        att::attn_body(QB + ((size_t)bh * TKV + qrow) * 192, KB + (size_t)bh * 132 * att::KT_BYTES, VB + (size_t)bh * 132 * att::VT_BYTES, MIX + (size_t)orow * DM + 512 + h * 128,
                       lat ? 0 : 128, lat ? 132 : 4, (char*)C.ldsg, ROPE, lat ? qb * 256 : -1);
    }
}

struct FStoreP { bf16* P;
    __device__ __forceinline__ void operator()(int row, int col, f32x4 v0, f32x4 v1) const { u32x4 w; w.x = pk2(v0[0], v0[1]); w.y = pk2(v0[2], v0[3]); w.z = pk2(v1[0], v1[1]); w.w = pk2(v1[2], v1[3]); *(u32x4*)(P + (size_t)row * PW + col) = w; } };
struct FStoreQKV { bf16* QB; char* KB; char* VB;
    __device__ __forceinline__ void operator()(int row, int col, f32x4 v0, f32x4 v1) const {
        int b, pos; row_bpos(row, b, pos);
        u32x4 w; w.x = pk2(v0[0], v0[1]); w.y = pk2(v0[2], v0[3]); w.z = pk2(v1[0], v1[1]); w.w = pk2(v1[2], v1[3]);
        if (col < 768) { const int h = col / 192, j = col - h * 192; *(u32x4*)(QB + ((size_t)(b * 4 + h) * TKV + pos) * 192 + j) = w; }
        else { const int c2 = col - 768, h = c2 >> 8, j = c2 & 255; const size_t tile = (size_t)(b * 4 + h) * 132 + (pos >> 6); const int k = pos & 63;
            if (j < 128) *(u32x4*)(KB + tile * att::KT_BYTES + (j >> 3) * 1024 + k * 16) = w;
            else *(u32x4*)(VB + tile * att::VT_BYTES + att::v_st(k, j - 128)) = w; }
    } };
struct FResidual { const float* x; const float* ctx; float* XL; const float* gate; int layer0;
    __device__ __forceinline__ void operator()(int row, int col, f32x4 v0, f32x4 v1) const {
        const float* src = layer0 ? (row < NLAT ? x + (size_t)row * DM : ctx + (size_t)(row - NLAT) * DM) : XL + (size_t)row * DM;
        const float* g = gate + mod_row(row) * 6144 + col;
        const f32x4 s0 = *(const f32x4*)(src + col), s1 = *(const f32x4*)(src + col + 4), g0 = *(const f32x4*)g, g1 = *(const f32x4*)(g + 4);
        float* d = XL + (size_t)row * DM + col; *(f32x4*)d = s0 + g0 * v0; *(f32x4*)(d + 4) = s1 + g1 * v1;
    } };
struct FStoreAct { bf16* ACT; int ld;
    __device__ __forceinline__ void operator()(int row, int col, const float* o) const { *(u32x4*)(ACT + (size_t)row * ld + col) = pack8(o); } };
struct FMoeDown { const int* ENT; const float* WTS; float* XL; bf16* Y2; const float* gate; int accum;
    __device__ __forceinline__ void operator()(int row, int colx, f32x4 v0, f32x4 v1) const {
        const int col = colx & (DM - 1);
        const int ent = ENT[row]; if (ent < 0) return;
        const int tok = ent >> 1; const float w = WTS[row]; const float* g = gate + (tok >> 13) * 6144 + col;
        const f32x4 g0 = *(const f32x4*)g * w, g1 = *(const f32x4*)(g + 4) * w;
        if ((ent & 1) == 0) { float* d = XL + (size_t)tok * DM + col; *(f32x4*)d = *(const f32x4*)d + g0 * v0; *(f32x4*)(d + 4) = *(const f32x4*)(d + 4) + g1 * v1; }
        else { bf16* d = Y2 + (size_t)tok * DM + col; float y[8] = {0.f, 0.f, 0.f, 0.f, 0.f, 0.f, 0.f, 0.f}; if (accum) unpack8(*(const u32x4*)d, y);
            const f32x4 a0 = g0 * v0, a1 = g1 * v1; y[0] += a0[0]; y[1] += a0[1]; y[2] += a0[2]; y[3] += a0[3]; y[4] += a1[0]; y[5] += a1[1]; y[6] += a1[2]; y[7] += a1[3];
            *(u32x4*)d = pack8(y); }
    } };

constexpr int PH_PER_LAYER = 13, PH_FINAL = 1 + 2 * PH_PER_LAYER, N_PHASES = PH_FINAL + 1;
__host__ __device__ constexpr bool phase_exists(int ph) { return ph == 0 || ph == PH_FINAL || (ph >= 1 && ph < PH_FINAL && (((ph - 1) / PH_PER_LAYER) == 1 || ((ph - 1) % PH_PER_LAYER) < 9)); }

#ifndef DBG_STOP
#define DBG_STOP 0
#endif
#ifndef DBG_SRC
#define DBG_SRC 0
#endif
__device__ __forceinline__ void phase_dump(const Ctx& C) {
    const int gw = C.vcu * 8 + C.wave, NGW = C.G * 8;
    for (int row = gw; row < NLAT; row += NGW) {
        float* o = C.out + (size_t)row * DM;
        if (DBG_SRC == 0) { const float* s = (const float*)(C.ws + WS_XL) + (size_t)row * DM; for (int c = C.lane; c < DM; c += 64) o[c] = s[c]; }
        else { const bf16* s = DBG_SRC == 1 ? (const bf16*)(C.arena + R_MIX) + (size_t)row * DM : DBG_SRC == 2 ? (const bf16*)(C.ws + WS_H) + (size_t)row * DM
                             : DBG_SRC == 3 ? (const bf16*)(C.arena + R_P) + (size_t)row * PW : DBG_SRC == 4 ? (const bf16*)(C.arena + R_P) + (size_t)row * PW + 1024
                             : DBG_SRC == 5 ? (const bf16*)(C.arena + R_ACT) + (size_t)row * DFF : DBG_SRC == 6 ? (const bf16*)(C.arena + R_QT) + (size_t)row * 256
                             : (const bf16*)(C.arena + R_QB) + (size_t)row * 192;
            const int n = DBG_SRC == 6 ? 256 : DBG_SRC == 7 ? 192 : DM;
            for (int c = C.lane; c < DM; c += 64) o[c] = c < n ? bf2f(s[c]) : 0.f; }
    }
}
template <int PH> __device__ __forceinline__ void run_phase(const Ctx& C0) {
    Ctx C = C0; { int t = threadIdx.x; asm volatile("" : "+v"(t)); C.tid = t; C.lane = t & 63; C.wave = __builtin_amdgcn_readfirstlane(t >> 6); }
    constexpr int layer = (PH - 1) / PH_PER_LAYER, k = (PH - 1) % PH_PER_LAYER;
    const float* MODB = (const float*)(C.ws + WS_MOD);
    if constexpr (DBG_STOP > 0 && PH > DBG_STOP && PH != PH_FINAL) { }
    else if constexpr (DBG_STOP > 0 && PH == PH_FINAL) { phase_dump(C); }
    else if constexpr (PH == 0) { prologue(C); }
    else if constexpr (PH == PH_FINAL) { phase_final(C); }
    else if constexpr (k == 0) { phase_norm1(C, layer); }
    else if constexpr (k == 1) {
        pg8::Gemm g{(const bf16*)(C.ws + WS_H), (const bf16*)(C.arena + A_WIN) + (size_t)layer * 2048 * 1024, 1024, 1024, 1024};
        pg8::StaticOrder S; S.init(MR, PW, C.G, C.bid); pg8::Epi8<FStoreP> E{{(bf16*)(C.arena + R_P)}};
        pg8::gemm_phase(C.lds, g, S, E);
    } else if constexpr (k == 2) {
#ifndef DIS_GLA
        phase_gla_local(C, layer);
#endif
        phase_mla_prep(C);
    } else if constexpr (k == 3) {
#ifndef DIS_GLA
        phase_gla_scan(C);
#endif
        { pg8::Gemm g{(const bf16*)(C.arena + R_CQKV), (const bf16*)(C.arena + A_WQKV) + (size_t)layer * 1792 * 384, 384, 384, 384};
          pg8::StaticOrder S; S.init(MR, 1792, C.G, C.bid); pg8::Epi8<FStoreQKV> E{{(bf16*)(C.arena + R_QB), (char*)(C.arena + R_KB), (char*)(C.arena + R_VB)}};
          pg8::gemm_phase(C.lds, g, S, E); }
    } else if constexpr (k == 4) {
#ifndef DIS_GLA
        phase_gla_out(C, layer);
#endif
#ifndef DIS_ATT
        phase_attention(C, layer);
#endif
    } else if constexpr (k == 5) {
        pg8::Gemm g{(const bf16*)(C.arena + R_MIX), (const bf16*)(C.arena + A_WOUT) + (size_t)layer * 1024 * 1024, 1024, 1024, 1024};
        pg8::StaticOrder S; S.init(layer == 0 ? MR : NLAT, DM, C.G, C.bid);
        pg8::Epi8<FResidual> E{{C.in[I_X], C.in[I_CTX], (float*)(C.ws + WS_XL), MODB + (size_t)layer * 3 * 6144 + 2 * 1024, layer == 0 ? 1 : 0}};
        pg8::gemm_phase(C.lds, g, S, E);
    } else if constexpr (k == 6) { phase_norm2(C, layer); }
    else if constexpr (layer == 0 && k == 7) {
        pg8::Gemm g{(const bf16*)(C.ws + WS_H), (const bf16*)(C.arena + A_FGU), 1024, 1024, 1024};
        pg8::StaticOrder S; S.init(MR, 2 * DFF, C.G, C.bid); pg8::EpiGU<FStoreAct> E{{(bf16*)(C.arena + R_ACT), DFF}, 1 << 20};
        pg8::gemm_phase(C.lds, g, S, E);
    } else if constexpr (layer == 0 && k == 8) {
        pg8::Gemm g{(const bf16*)(C.arena + R_ACT), (const bf16*)(C.arena + A_FD), DFF, DFF, DFF};
        pg8::StaticOrder S; S.init(MR, DM, C.G, C.bid);
        pg8::Epi8<FResidual> E{{C.in[I_X], C.in[I_CTX], (float*)(C.ws + WS_XL), MODB + 5 * 1024, 0}};
        pg8::gemm_phase(C.lds, g, S, E);
    } else if constexpr (layer == 1 && k == 7) { phase_expert_weights(C); }
    else if constexpr (layer == 1 && k == 8) { phase_gather(C); }
    else if constexpr (layer == 1 && (k == 9 || k == 11)) {
        constexpr int half = (k - 9) / 2;
        pg8::MoeOrder S; moe_tile_bases(C, S.tb); S.ncol = 14; S.tpe = 28; S.joff = 14 * half; S.G = C.G; S.c = C.bid;
        pg8::Gemm g{(const bf16*)(C.arena + M_HS), (const bf16*)(C.arena + M_EGU), 1024, 1024, 1024};
        pg8::EpiGU<FStoreAct> E{{(bf16*)(C.arena + M_ACT) - (size_t)half * 14 * 128, DFEH}, 28};
        pg8::gemm_phase(C.lds, g, S, E);
    } else if constexpr (layer == 1 && (k == 10 || k == 12)) {
        constexpr int half = (k - 10) / 2;
        const int* ENT = (const int*)(C.ws + WS_LIST + AL((size_t)NLAT * 2 * 4 * 3)); const float* WTS = (const float*)(ENT + MAXT * 256);
        pg8::MoeOrder S; moe_tile_bases(C, S.tb); S.ncol = 4; S.tpe = 4; S.joff = 0; S.G = C.G; S.c = C.bid;
        pg8::Gemm g{(const bf16*)(C.arena + M_ACT), (const bf16*)(C.arena + M_ED) + (size_t)half * DFEH, DFEH, DFEH, DFE};
        pg8::Epi8<FMoeDown> E{{ENT, WTS, (float*)(C.ws + WS_XL), (bf16*)(C.ws + WS_H), MODB + (size_t)3 * 6144 + 5 * 1024, half}};
        pg8::gemm_phase(C.lds, g, S, E);
    }
}

__device__ __forceinline__ void make_ctx(Ctx& C, const Args& args, unsigned char* lds_raw) {
    C.lds = (LAS unsigned char*)lds_raw; C.ldsg = lds_raw; C.ws = args.ws; C.arena = args.ws + WS_ARENA; C.in = args.in; C.out = args.out;
    C.tid = threadIdx.x; C.lane = C.tid & 63; C.wave = __builtin_amdgcn_readfirstlane(C.tid >> 6);
    C.G = gridDim.x; C.bid = blockIdx.x; C.vcu = (C.G % 8 == 0) ? (C.bid % 8) * (C.G / 8) + C.bid / 8 : C.bid;
}

template <int PH> __device__ __forceinline__ void run_from(const Ctx& C, const XcdBarrier& bar) {
    if constexpr (PH < N_PHASES) {
        if constexpr (phase_exists(PH)) { run_phase<PH>(C); if constexpr (PH != PH_FINAL) xcd_barrier(bar); }
        run_from<PH + 1>(C, bar);
    }
}

#if !MK_PER_PHASE
__global__ void __launch_bounds__(512, 2) mega_fwd(Args args) {
    extern __shared__ __attribute__((aligned(16))) unsigned char lds_raw[];
    Ctx C; make_ctx(C, args, lds_raw);
    volatile LAS unsigned* MISC = (volatile LAS unsigned*)(C.lds + MISC_OFF);
    if (C.tid < 64) MISC[C.tid] = 0u;
    __syncthreads();
    unsigned* ctl = (unsigned*)(C.ws + WS_CTL);
    const XcdBarrier bar = xcd_barrier_post(ctl + CW_BAR, MISC + 8);
    run_from<0>(C, bar);
}
#else
template <int PH> __global__ void __launch_bounds__(512, 2) phase_kernel(Args args) {
    extern __shared__ __attribute__((aligned(16))) unsigned char lds_raw[];
    Ctx C; make_ctx(C, args, lds_raw);
    run_phase<PH>(C);
}
template <int PH> void launch_from(int grid, hipStream_t stream, const Args& a) {
    if constexpr (PH < N_PHASES) {
        if constexpr (phase_exists(PH)) {
            (void)hipFuncSetAttribute((const void*)phase_kernel<PH>, hipFuncAttributeMaxDynamicSharedMemorySize, LDS_BYTES);
            hipLaunchKernelGGL(phase_kernel<PH>, dim3(grid), dim3(512), LDS_BYTES, stream, a);
        }
        launch_from<PH + 1>(grid, stream, a);
    }
}
#endif

extern "C" void kernel_launch(void* const* d_in, const int* in_sizes, int n_in, void* d_out, int out_size, void* d_ws, size_t ws_size, hipStream_t stream) {
    static int grid = 0;
    if (grid == 0) {
        if (n_in != 25 || out_size != NLAT * DM || ws_size < WS_END) { fprintf(stderr, "kernel_launch: unexpected shapes (n_in %d, out %d, ws %zu < %zu); nothing launched\n", n_in, out_size, ws_size, (size_t)WS_END); grid = -1; return; }
        int dev = 0, cus = 0;
        if (hipGetDevice(&dev) != hipSuccess || hipDeviceGetAttribute(&cus, hipDeviceAttributeMultiprocessorCount, dev) != hipSuccess) { grid = -1; return; }
#if !MK_PER_PHASE
        if (hipFuncSetAttribute((const void*)mega_fwd, hipFuncAttributeMaxDynamicSharedMemorySize, LDS_BYTES) != hipSuccess) { fprintf(stderr, "kernel_launch: hipFuncSetAttribute failed\n"); grid = -1; return; }
        int per_cu = 0;
        if (hipOccupancyMaxActiveBlocksPerMultiprocessor(&per_cu, (const void*)mega_fwd, 512, LDS_BYTES) != hipSuccess || per_cu < 1) { fprintf(stderr, "kernel_launch: occupancy query reports %d blocks per CU\n", per_cu); }
        (void)hipGetLastError();
#endif
        grid = cus;
    }
    if (grid < 0) return;
    if (hipMemsetAsync((char*)d_ws + WS_CTL, 0, CTL_BYTES, stream) != hipSuccess) return;
    Args a{};
    for (int i = 0; i < 25; ++i) a.in[i] = (const float*)d_in[i];
    a.out = (float*)d_out; a.ws = (unsigned char*)d_ws;
#if MK_PER_PHASE
    launch_from<0>(grid, stream, a);
#else
    hipLaunchKernelGGL(mega_fwd, dim3(grid), dim3(512), LDS_BYTES, stream, a);
#endif
    const hipError_t le = hipPeekAtLastError();
    if (le != hipSuccess) fprintf(stderr, "kernel_launch: launch failed: %s\n", hipGetErrorName(le));
}
```

```cpp
#include <hip/hip_runtime.h>
#include <cstdio>
#include <cstdint>

#define LAS __attribute__((address_space(3)))
#define GAS __attribute__((address_space(1)))
typedef unsigned short bf16;
typedef short bf16x8 __attribute__((ext_vector_type(8)));
typedef short s16x4 __attribute__((ext_vector_type(4)));
typedef float f32x2 __attribute__((ext_vector_type(2)));
typedef float f32x4 __attribute__((ext_vector_type(4)));
typedef float f32x16 __attribute__((ext_vector_type(16)));
typedef unsigned u32x2 __attribute__((ext_vector_type(2)));
typedef unsigned u32x4 __attribute__((ext_vector_type(4)));

#ifndef MK_PER_PHASE
#define MK_PER_PHASE 0
#endif

constexpr int DM = 1024, NB = 2, TT = 8192, TC = 256, NLAT = NB * TT, NCTXR = NB * TC, MR = NLAT + NCTXR;
constexpr int TKV = TT + TC;
constexpr int PW = 2048;
constexpr int PC_Q = 0, PC_K = 256, PC_V = 512, PC_R = 1024, PC_CQ = 1536, PC_CKV = 1792, PC_KR = 1920, PC_GF = 1984, PC_GB = 2000;
constexpr int NCH = 132;
constexpr int DFF = 2816, DFE = 3584, NEXP = 8, DFEH = DFE / 2;
constexpr int MAXT = 136;
constexpr float EPS = 1e-6f;
constexpr float MLA_SCALE = 0.07216878364870322f;
namespace att {
constexpr int KT_BYTES = 24576, VT_BYTES = 16384;
__host__ __device__ __forceinline__ int v_st(int k, int c) { const int kk = (k & ~0xC) | ((k & 4) << 1) | ((k & 8) >> 1); return ((kk >> 3) * 4 + (c >> 5)) * 512 + ((kk & 7) * 32 + (c & 31)) * 2; }
}

constexpr size_t AL(size_t x) { return (x + 255) & ~(size_t)255; }
constexpr size_t WS_CTL = 0, CTL_BYTES = 65536;
constexpr size_t WS_MOD = WS_CTL + CTL_BYTES;
constexpr size_t WS_ROPE = WS_MOD + AL(2 * 3 * 6144 * 4);
constexpr size_t WS_XL = WS_ROPE + AL((128 + 64) * 32 * 4);
constexpr size_t WS_H = WS_XL + AL((size_t)MR * DM * 4);
constexpr size_t WS_LIST = WS_H + AL((size_t)MR * DM * 2);
constexpr size_t LIST_BYTES = AL((size_t)NLAT * 2 * 4 * 3) + AL((size_t)MAXT * 256 * 4 * 2);
constexpr size_t WS_ARENA = WS_LIST + LIST_BYTES;
constexpr size_t A_WIN = 0;
constexpr size_t A_WQKV = A_WIN + AL((size_t)2 * 2048 * 1024 * 2);
constexpr size_t A_WOUT = A_WQKV + AL((size_t)2 * 1792 * 384 * 2);
constexpr size_t A_FGU = A_WOUT + AL((size_t)2 * 1024 * 1024 * 2);
constexpr size_t A_FD = A_FGU + AL((size_t)2 * DFF * 1024 * 2);
constexpr size_t A_R = A_FD + AL((size_t)1024 * DFF * 2);
constexpr size_t R_P = A_R;
constexpr size_t R_QT = R_P + AL((size_t)MR * PW * 2);
constexpr size_t R_KT = R_QT + AL((size_t)2 * MR * 256 * 2);
constexpr size_t R_SLOC = R_KT + AL((size_t)2 * MR * 256 * 2);
constexpr size_t R_DEC = R_SLOC + AL((size_t)16 * NCH * 8192 * 4);
constexpr size_t R_SST = R_DEC + AL((size_t)16 * NCH * 64 * 4);
constexpr size_t R_CQKV = R_SST + AL((size_t)16 * NCH * 8192 * 2);
constexpr size_t R_QB = R_CQKV + AL((size_t)MR * 384 * 2);
constexpr size_t R_KB = R_QB + AL((size_t)8 * TKV * 192 * 2);
constexpr size_t R_VB = R_KB + AL((size_t)8 * TKV * 192 * 2);
constexpr size_t R_MIX = R_VB + AL((size_t)8 * TKV * 128 * 2);
constexpr size_t R_END = R_MIX + AL((size_t)MR * DM * 2);
constexpr size_t R_PART = R_SLOC;
constexpr size_t R_ACT = A_R;
static_assert(R_ACT + (size_t)MR * DFF * 2 <= R_SLOC && (size_t)11 * 512 * 1024 * 4 <= (size_t)16 * NCH * 8192 * 4, "ACT ends below SLOC; PART fits SLOC");
constexpr size_t M_EGU = 0;
constexpr size_t M_ED = M_EGU + AL((size_t)NEXP * 2 * DFE * 1024 * 2);
constexpr size_t M_HS = M_ED + AL((size_t)NEXP * 1024 * DFE * 2);
constexpr size_t M_ACT = M_HS + AL((size_t)MAXT * 256 * 1024 * 2);
constexpr size_t M_END = M_ACT + AL((size_t)MAXT * 256 * DFEH * 2);
constexpr size_t ARENA_BYTES = (R_END > M_END) ? R_END : M_END;
constexpr size_t WS_END = WS_ARENA + ARENA_BYTES;
static_assert(WS_END <= 534000000ull, "workspace map exceeds the guaranteed scratch size");

constexpr int CW_BAR = 4096;
constexpr int CW_CNT = 64;

constexpr int LDS_BYTES = 147456, MISC_OFF = LDS_BYTES - 256;

__device__ __forceinline__ unsigned f2bf(float f) { unsigned u = __builtin_bit_cast(unsigned, f); return (u + 0x7fffu + ((u >> 16) & 1u)) >> 16; }
__device__ __forceinline__ unsigned pk2(float lo, float hi) { return f2bf(lo) | (f2bf(hi) << 16); }
__device__ __forceinline__ float bf2f(unsigned b) { return __builtin_bit_cast(float, b << 16); }
__device__ __forceinline__ float bflo(unsigned w) { return __builtin_bit_cast(float, w << 16); }
__device__ __forceinline__ float bfhi(unsigned w) { return __builtin_bit_cast(float, w & 0xffff0000u); }
__device__ __forceinline__ u32x4 pack8(const float* v) { u32x4 w; w.x = pk2(v[0], v[1]); w.y = pk2(v[2], v[3]); w.z = pk2(v[4], v[5]); w.w = pk2(v[6], v[7]); return w; }
__device__ __forceinline__ void unpack8(u32x4 w, float* v) { v[0] = bflo(w.x); v[1] = bfhi(w.x); v[2] = bflo(w.y); v[3] = bfhi(w.y); v[4] = bflo(w.z); v[5] = bfhi(w.z); v[6] = bflo(w.w); v[7] = bfhi(w.w); }
__device__ __forceinline__ float wave_sum(float v) {
#pragma unroll
    for (int o = 1; o < 64; o <<= 1) v += __shfl_xor(v, o);
    return v;
}
__device__ __forceinline__ float silu_f(float x) { return x / (1.f + __expf(-x)); }
__device__ __forceinline__ float logsig_f(float x) { return fminf(x, 0.f) - __logf(1.f + __expf(-fabsf(x))); }
#define LDS_WAIT() asm volatile("s_waitcnt lgkmcnt(0)" ::: "memory")
#define VM_WAIT() asm volatile("s_waitcnt vmcnt(0)" ::: "memory")

namespace pg8 {
constexpr int BM = 256, BK = 64, HALF = 128, HTB = HALF * BK * 2, NXCD = 8, WGM = 8;
__host__ __device__ __forceinline__ int lds_byte(int r, int c) { const int st = (r >> 4) * 2 + (c >> 5), rr = r & 15, cc = c & 31, ob = rr * 64 + cc * 2; return st * 1024 + (ob ^ (((ob >> 9) & 1) << 5)); }
__host__ __device__ __forceinline__ void stage_rc(int b, int& R, int& C) { const int st = b / 1024, sb = b % 1024, swz = sb ^ (((sb >> 9) & 1) << 5); R = (st >> 1) * 16 + swz / 64; C = (st & 1) * 32 + (swz % 64) / 2; }
__host__ __device__ __forceinline__ int perm32(int rho) { const int n = rho >> 4, i = rho & 15; return 8 * (i >> 2) + 4 * n + (i & 3); }

struct Unit { int pm, pn, kc; };
struct Gemm { const bf16* A; const bf16* Bt; int K, lda, ldb; };

struct StaticOrder {
    int nM, nN, nwg, G, c;
    __device__ void init(int M, int N, int G_, int c_) { nM = M / BM; nN = N / BM; nwg = nM * nN; G = G_; c = c_; }
    __device__ bool next(int i, Unit& u) const {
        const long L = (long)i * G + c; if (L >= nwg) return false;
        int wgid = (int)L; { const int q = nwg / NXCD, r = nwg % NXCD, xcd = wgid % NXCD, off = wgid / NXCD; wgid = (xcd < r ? xcd * (q + 1) : r * (q + 1) + (xcd - r) * q) + off; }
        const int nig = WGM * nN, gid = wgid / nig, fm = gid * WGM, gsz = (nM - fm) < WGM ? (nM - fm) : WGM;
        u.pm = fm + ((wgid % nig) % gsz); u.pn = (wgid % nig) / gsz; u.kc = 0; return true;
    }
};
struct MoeOrder {
    int tb[9]; int ncol, tpe, joff, G, c;
    __device__ bool next(int i, Unit& u) const {
        const long L = (long)i * G + c; if (L >= (long)tb[8] * ncol) return false;
        const int tile = (int)(L / ncol), j = (int)(L % ncol); int e = 0;
#pragma unroll
        for (int k = 1; k < 8; ++k) e += (tile >= tb[k]) ? 1 : 0;
        u.pm = tile; u.pn = e * tpe + joff + j; u.kc = 0; return true;
    }
};

struct CtxSplitOrder {
    int nchunk, G, c;
    __device__ bool next(int i, Unit& u) const { const int L = i * G + c; if (L >= nchunk * 8) return false; const int r = L & 7; u.kc = L >> 3; u.pm = 64 + (r & 1); u.pn = r >> 1; return true; }
};
template <class Epi, class Sched>
__device__ __forceinline__ void gemm_phase(LAS unsigned char* lds, const Gemm g, const Sched& S, const Epi& E) {
    int tid = threadIdx.x; asm volatile("" : "+v"(tid));
    const int wid = __builtin_amdgcn_readfirstlane(tid >> 6), lane = tid & 63, wr = wid >> 2, wc = wid & 3, fr = lane & 15, fq = lane >> 4;
    const int K = g.K, nt = K / BK;
    unsigned voffA[2], voffB[2];
#pragma unroll
    for (int i = 0; i < 2; ++i) { int R, C; stage_rc(tid * 16 + i * 8192, R, C); const int Rb = (R & ~31) + perm32(R & 31);
        voffA[i] = (unsigned)(R * g.lda + C) * 2u; voffB[i] = (unsigned)(Rb * g.ldb + C) * 2u; }
    const size_t kstep = (size_t)(BK * 2);
    const size_t hstepA = (size_t)HALF * g.lda * 2, hstepB = (size_t)HALF * g.ldb * 2;
    const size_t tstepA = 2 * hstepA, tstepB = 2 * hstepB;
    const unsigned ldsw = (unsigned)wid * 1024u;
    const int aoff = lds_byte(wr * 64 + fr, fq * 8), boff = lds_byte(wc * 32 + fr, fq * 8);
#define PG8_SA(b, h) (((b) * 2 + (h)) * HTB)
#define PG8_SB(b, h) ((4 + (b) * 2 + (h)) * HTB)
#define PG8_STAGE(bufoff, gbase, voff) do { _Pragma("unroll") for (int _i = 0; _i < 2; ++_i) \
        __builtin_amdgcn_global_load_lds((const unsigned*)((const char*)(gbase) + (voff)[_i]), (LAS unsigned*)(lds + (bufoff) + ldsw + _i * 8192), 16, 0, 0); } while (0)
#define PG8_LDA(dst, b, h) do { _Pragma("unroll") for (int m = 0; m < 4; ++m) _Pragma("unroll") for (int k = 0; k < 2; ++k) dst[m][k] = *(const LAS bf16x8*)(lds + PG8_SA(b, h) + aoff + m * 2048 + k * 1024); } while (0)
#define PG8_LDB(dst, b, h) do { _Pragma("unroll") for (int n = 0; n < 2; ++n) _Pragma("unroll") for (int k = 0; k < 2; ++k) dst[n][k] = *(const LAS bf16x8*)(lds + PG8_SB(b, h) + boff + n * 2048 + k * 1024); } while (0)
#define PG8_MMA(ai, bj, At, Bt) do { __builtin_amdgcn_s_setprio(1); _Pragma("unroll") for (int m = 0; m < 4; ++m) _Pragma("unroll") for (int n = 0; n < 2; ++n) _Pragma("unroll") for (int k = 0; k < 2; ++k) \
        acc[ai][bj][m][n] = __builtin_amdgcn_mfma_f32_16x16x32_bf16(Bt[n][k], At[m][k], acc[ai][bj][m][n], 0, 0, 0); __builtin_amdgcn_s_setprio(0); } while (0)
#define PG8_WAIT_V(n) asm volatile("s_waitcnt vmcnt(" #n ")" ::: "memory")
#define PG8_WAIT_L(n) asm volatile("s_waitcnt lgkmcnt(" #n ")" ::: "memory")
#define PG8_BAR __builtin_amdgcn_s_barrier()
#define PG8_SCHED __builtin_amdgcn_sched_barrier(0)
    Unit cur, nxt; int ui = 0;
    if (!S.next(0, cur)) return;
    f32x4 acc[2][2][4][2];
#pragma unroll
    for (int a = 0; a < 2; ++a)
#pragma unroll
        for (int b = 0; b < 2; ++b)
#pragma unroll
            for (int m = 0; m < 4; ++m)
#pragma unroll
                for (int n = 0; n < 2; ++n) acc[a][b][m][n] = (f32x4){0.f, 0.f, 0.f, 0.f};
    bf16x8 At[4][2], B0[2][2], B1[2][2];
    const size_t cstep = (size_t)K * 2;
    const char* cA = (const char*)g.A + (size_t)cur.pm * tstepA + cur.kc * cstep; const char* cB = (const char*)g.Bt + (size_t)cur.pn * tstepB + cur.kc * cstep;
    PG8_STAGE(PG8_SB(0, 0), cB, voffB); PG8_STAGE(PG8_SB(0, 1), cB + hstepB, voffB); PG8_STAGE(PG8_SA(0, 0), cA, voffA); PG8_STAGE(PG8_SA(0, 1), cA + hstepA, voffA);
    if (wr == 1) PG8_BAR;
    PG8_WAIT_V(2); PG8_BAR;
    PG8_STAGE(PG8_SB(1, 0), cB + kstep, voffB); PG8_STAGE(PG8_SA(1, 0), cA + kstep, voffA); PG8_STAGE(PG8_SB(1, 1), cB + hstepB + kstep, voffB);
    PG8_WAIT_V(6); PG8_BAR;
    for (;;) {
        const bool has_next = S.next(ui + 1, nxt);
        const char* nA = has_next ? (const char*)g.A + (size_t)nxt.pm * tstepA + nxt.kc * cstep : cA; const char* nB = has_next ? (const char*)g.Bt + (size_t)nxt.pn * tstepB + nxt.kc * cstep : cB;
#pragma unroll 1
        for (int t = 0; t < nt; t += 2) {
            const bool last = (t == nt - 2);
            const char* a1 = cA + (size_t)(t + 1) * kstep;
            const char* a2 = last ? nA : cA + (size_t)(t + 2) * kstep; const char* b2 = last ? nB : cB + (size_t)(t + 2) * kstep;
            const char* a3 = a2 + kstep; const char* b3 = b2 + kstep;
            PG8_LDB(B0, 0, 0); PG8_LDB(B1, 0, 1); PG8_SCHED; PG8_LDA(At, 0, 0); PG8_STAGE(PG8_SA(1, 1), a1 + hstepA, voffA);
            PG8_WAIT_V(8); PG8_WAIT_L(0); PG8_BAR; PG8_MMA(0, 0, At, B0); PG8_MMA(0, 1, At, B1); PG8_BAR; PG8_SCHED;
            PG8_LDA(At, 0, 1); PG8_STAGE(PG8_SB(0, 0), b2, voffB); PG8_STAGE(PG8_SB(0, 1), b2 + hstepB, voffB); PG8_STAGE(PG8_SA(0, 0), a2, voffA);
            PG8_WAIT_V(8); PG8_WAIT_L(0); PG8_BAR; PG8_MMA(1, 0, At, B0); PG8_MMA(1, 1, At, B1); PG8_BAR; PG8_SCHED;
            PG8_LDB(B0, 1, 0); PG8_LDB(B1, 1, 1); PG8_SCHED; PG8_LDA(At, 1, 0); PG8_STAGE(PG8_SA(0, 1), a2 + hstepA, voffA);
            PG8_WAIT_V(8); PG8_WAIT_L(0); PG8_BAR; PG8_MMA(0, 0, At, B0); PG8_MMA(0, 1, At, B1); PG8_BAR; PG8_SCHED;
            PG8_LDA(At, 1, 1); PG8_STAGE(PG8_SB(1, 0), b3, voffB); PG8_STAGE(PG8_SB(1, 1), b3 + hstepB, voffB); PG8_STAGE(PG8_SA(1, 0), a3, voffA);
            PG8_WAIT_V(8); PG8_WAIT_L(0); PG8_BAR; PG8_MMA(1, 0, At, B0); PG8_MMA(1, 1, At, B1); PG8_BAR; PG8_SCHED;
        }
        if (wr == 0) PG8_BAR;
        E(acc, cur, wr, wc, fr, fq);
        if (!has_next) break;
#pragma unroll
        for (int a = 0; a < 2; ++a)
#pragma unroll
            for (int b = 0; b < 2; ++b)
#pragma unroll
                for (int m = 0; m < 4; ++m)
#pragma unroll
                    for (int n = 0; n < 2; ++n) acc[a][b][m][n] = (f32x4){0.f, 0.f, 0.f, 0.f};
        cur = nxt; cA = nA; cB = nB; ++ui;
        if (wr == 1) PG8_BAR;
    }
    PG8_WAIT_V(0);
    PG8_BAR;
#undef PG8_SA
#undef PG8_SB
#undef PG8_STAGE
#undef PG8_LDA
#undef PG8_LDB
#undef PG8_MMA
#undef PG8_WAIT_V
#undef PG8_WAIT_L
#undef PG8_BAR
#undef PG8_SCHED
}

template <class F> struct Epi8 {
    F f;
    __device__ __forceinline__ void operator()(const f32x4 (&acc)[2][2][4][2], const Unit& u, int wr, int wc, int fr, int fq) const {
        const int row0 = u.pm * BM + wr * 64 + fr, col0 = u.pn * BM + wc * 32 + 8 * fq;
#pragma unroll
        for (int ai = 0; ai < 2; ++ai)
#pragma unroll
            for (int m = 0; m < 4; ++m)
#pragma unroll
                for (int bj = 0; bj < 2; ++bj) { f(row0 + ai * HALF + m * 16, col0 + bj * HALF, acc[ai][bj][m][0], acc[ai][bj][m][1]); __builtin_amdgcn_sched_barrier(0); }
    }
};
struct EpiPart {
    float* PART;
    __device__ __forceinline__ void operator()(const f32x4 (&acc)[2][2][4][2], const Unit& u, int wr, int wc, int fr, int fq) const {
        const int row0 = (u.pm - 64) * BM + wr * 64 + fr, col0 = u.pn * BM + wc * 32 + 8 * fq; float* base = PART + (size_t)u.kc * 512 * 1024;
#pragma unroll
        for (int ai = 0; ai < 2; ++ai)
#pragma unroll
            for (int m = 0; m < 4; ++m)
#pragma unroll
                for (int bj = 0; bj < 2; ++bj) { float* d = base + (size_t)(row0 + ai * HALF + m * 16) * 1024 + col0 + bj * HALF; *(f32x4*)d = acc[ai][bj][m][0]; *(f32x4*)(d + 4) = acc[ai][bj][m][1]; }
    }
};
template <class F> struct EpiGU {
    F f; int tiles_per_mat;
    __device__ __forceinline__ void operator()(const f32x4 (&acc)[2][2][4][2], const Unit& u, int wr, int wc, int fr, int fq) const {
        const int row0 = u.pm * BM + wr * 64 + fr, col0 = (u.pn % tiles_per_mat) * HALF + wc * 32 + 8 * fq;
#pragma unroll
        for (int ai = 0; ai < 2; ++ai)
#pragma unroll
            for (int m = 0; m < 4; ++m) {
                float o[8];
#pragma unroll
                for (int n = 0; n < 2; ++n)
#pragma unroll
                    for (int q = 0; q < 4; ++q) { const float gt = acc[ai][0][m][n][q], up = acc[ai][1][m][n][q]; o[n * 4 + q] = gt / (1.f + __expf(-gt)) * up; }
                f(row0 + ai * HALF + m * 16, col0, o);
            }
    }
};
}

#define XB_TMO      128
#define XB_XCNT(j)  (256  + 64 * (j))
#define XB_XSUB(j)  (1280 + 64 * (j))
#define XB_XGEN(j)  (2304 + 64 * (j))
#define XB_TOP      3328
#define XB_TOPGEN   3392
#define XCD_BAR_WORDS 3456
#define XB_SPIN_CAP (1u << 18)
__device__ __forceinline__ unsigned xb_ld(unsigned* p)              { return __hip_atomic_load(p, __ATOMIC_RELAXED, __HIP_MEMORY_SCOPE_AGENT); }
__device__ __forceinline__ unsigned xb_add(unsigned* p, unsigned v) { return __hip_atomic_fetch_add(p, v, __ATOMIC_RELAXED, __HIP_MEMORY_SCOPE_AGENT); }
__device__ __forceinline__ unsigned xb_xcc_id() { return (unsigned)__builtin_amdgcn_s_getreg((3 << 11) | 20) & 0xFu; }
#define XB_SPIN(cond, bar) do { unsigned _sp = 0; while (cond) { __builtin_amdgcn_s_sleep(1); \
    if ((++_sp & 255u) == 0u) { if (xb_ld(&(bar)[XB_TMO])) break; if (_sp > XB_SPIN_CAP) { atomicAdd(&(bar)[XB_TMO], 1u); break; } } } } while (0)
struct XcdBarrier { unsigned* bar; unsigned x; volatile LAS unsigned* st; };
__device__ __forceinline__ XcdBarrier xcd_barrier_post(unsigned* bar, volatile LAS unsigned* st) {
    XcdBarrier b; b.bar = bar; b.x = xb_xcc_id(); b.st = st;
    if (threadIdx.x == 0) (void)xb_add(&bar[XB_XCNT(b.x)], 1u);
    return b;
}
__device__ __forceinline__ void xcd_barrier_complete(unsigned* bar, unsigned x, unsigned& nloc, unsigned& nx) {
    const unsigned G = gridDim.x * gridDim.y * gridDim.z;
    unsigned sum, cnt, mine, sp = 0u;
    for (;;) {
        sum = 0u; cnt = 0u; mine = 0u;
#pragma unroll
        for (unsigned j = 0; j < 16; ++j) { const unsigned c = xb_ld(&bar[XB_XCNT(j)]); sum += c; cnt += (c > 0u) ? 1u : 0u; mine = (j == x) ? c : mine; }
        if (sum == G) break;
        __builtin_amdgcn_s_sleep(1);
        if ((++sp & 255u) == 0u) { if (xb_ld(&bar[XB_TMO])) break; if (sp > XB_SPIN_CAP) { atomicAdd(&bar[XB_TMO], 1u); break; } }
    }
    nloc = mine > 0u ? mine : 1u; nx = cnt > 0u ? cnt : 1u;
}
__device__ __forceinline__ void xcd_barrier(const XcdBarrier& b) {
    asm volatile("s_waitcnt vmcnt(0)" ::: "memory");
    __syncthreads();
    if (threadIdx.x == 0) {
        unsigned* bar = b.bar;
        __builtin_amdgcn_s_waitcnt(0);
        unsigned nloc = b.st[0], nx = b.st[1];
        if (nloc == 0u) { xcd_barrier_complete(bar, b.x, nloc, nx); b.st[0] = nloc; b.st[1] = nx; }
        const unsigned old = xb_add(&bar[XB_XSUB(b.x)], 1u);
        const unsigned gen = old / nloc;
        if (old + 1u == (gen + 1u) * nloc) {
            __builtin_amdgcn_fence(__ATOMIC_RELEASE, "agent");
            asm volatile("s_waitcnt vmcnt(0)" ::: "memory");
            const unsigned og = xb_add(&bar[XB_TOP], 1u);
            const unsigned tg = og / nx;
            if (og + 1u == (tg + 1u) * nx) xb_add(&bar[XB_TOPGEN], 1u);
            else XB_SPIN(xb_ld(&bar[XB_TOPGEN]) == tg, bar);
            __builtin_amdgcn_fence(__ATOMIC_ACQUIRE, "agent");
            xb_add(&bar[XB_XGEN(b.x)], 1u);
            asm volatile("s_waitcnt vmcnt(0)" ::: "memory");
        } else {
            XB_SPIN(xb_ld(&bar[XB_XGEN(b.x)]) == gen, bar);
            __builtin_amdgcn_fence(__ATOMIC_ACQUIRE, "agent");
            asm volatile("s_waitcnt vmcnt(0)" ::: "memory");
        }
    }
    __syncthreads();
}

struct Args {
    const float* in[25];
    float* out; unsigned char* ws;
    int ph_lo, ph_hi;
};
enum { I_X = 0, I_C, I_CTX, I_CCTX, I_WMOD, I_BMOD, I_LN1, I_LN2, I_WIN, I_WG2, I_BG2, I_GLAG, I_QNG, I_WUQ, I_KVNG, I_WUKV, I_WOUT, I_FG, I_FU, I_FD, I_RW, I_EG, I_EU, I_ED, I_FNG };

struct Ctx {
    LAS unsigned char* lds; unsigned char* ldsg; unsigned char* ws; unsigned char* arena; const float* const* in; float* out;
    int tid, lane, wave, G, bid, vcu;
};

__device__ __forceinline__ int mod_row(int row) { return row < NLAT ? (row >> 13) : 2; }
__device__ __forceinline__ void row_bpos(int row, int& b, int& pos) { if (row < NLAT) { b = row >> 13; pos = row & (TT - 1); } else { const int r2 = row - NLAT; b = r2 >> 8; pos = TT + (r2 & 255); } }
__device__ __forceinline__ int chunk_row(int b, int a) { return a < 128 ? b * TT + a * 64 : NLAT + b * TC + (a - 128) * 64; }

template <class SrcFn>
__device__ __forceinline__ void transpose_item(const SrcFn& src, bf16* dst, int ldk, int k0, int n0, LAS float* scr, int lane) {
#pragma unroll 8
    for (int i = 0; i < 64; ++i) scr[i * 65 + lane] = src(k0 + i, n0 + lane);
    LDS_WAIT(); asm volatile("" ::: "memory");
    const int c = lane & 7;
#pragma unroll
    for (int j = 0; j < 8; ++j) { const int n = (lane >> 3) + 8 * j; const LAS float* s = scr + (8 * c) * 65 + n;
        u32x4 o; o.x = pk2(s[0 * 65], s[1 * 65]); o.y = pk2(s[2 * 65], s[3 * 65]); o.z = pk2(s[4 * 65], s[5 * 65]); o.w = pk2(s[6 * 65], s[7 * 65]);
        *(u32x4*)(dst + (size_t)(n0 + n) * ldk + k0 + 8 * c) = o; }
    LDS_WAIT(); asm volatile("" ::: "memory");
}
__device__ __forceinline__ void transpose_item_fast(const float* S, int ld, bf16* dst, int ldk, int k0, int n0, LAS float* scr, int lane) {
    f32x4 v[16];
#pragma unroll
    for (int i = 0; i < 16; ++i) v[i] = *(const f32x4*)(S + (size_t)(i * 4 + (lane >> 4)) * ld + (lane & 15) * 4);
#pragma unroll
    for (int i = 0; i < 16; ++i) { LAS float* p = scr + (i * 4 + (lane >> 4)) * 65 + (lane & 15) * 4; p[0] = v[i].x; p[1] = v[i].y; p[2] = v[i].z; p[3] = v[i].w; }
    LDS_WAIT(); asm volatile("" ::: "memory");
    const int c = lane & 7;
#pragma unroll
    for (int j = 0; j < 8; ++j) { const int n = (lane >> 3) + 8 * j; const LAS float* s = scr + (8 * c) * 65 + n;
        u32x4 o; o.x = pk2(s[0 * 65], s[1 * 65]); o.y = pk2(s[2 * 65], s[3 * 65]); o.z = pk2(s[4 * 65], s[5 * 65]); o.w = pk2(s[6 * 65], s[7 * 65]);
        *(u32x4*)(dst + (size_t)(n0 + n) * ldk + k0 + 8 * c) = o; }
    LDS_WAIT(); asm volatile("" ::: "memory");
}
__device__ __forceinline__ int rope_unperm(int jj) { const int pair = jj >> 1, which = jj & 1; return pair < 16 ? pair + 16 * which : 32 + (pair - 16) + 16 * which; }
__device__ __forceinline__ int win_src_col(int n) {
    if (n < 1024) return n;
    if (n < 1536) return 1056 + (n - 1024);
    if (n < 1792) return 1568 + (n - 1536);
    if (n < 1920) return 1824 + (n - 1792);
    if (n < 1984) return 1952 + rope_unperm(n - 1920);
    if (n < 2000) return 1024 + (n - 1984);
    if (n < 2016) return 1040 + (n - 2000);
    return -1;
}

__device__ __forceinline__ void convert_weights(const Ctx& C, bool first, int gw, int NGW) {
    LAS float* scr = (LAS float*)(C.lds + C.wave * 16640);
    for (int l = 0; l < 2; ++l) {
        if (first == (l == 0))
        {
            const float* W = C.in[I_WIN] + (size_t)l * 1024 * 2016; bf16* dst = (bf16*)(C.arena + A_WIN) + (size_t)l * 2048 * 1024;
            auto f = [=](int k, int n) -> float { const int sc = win_src_col(n); return sc < 0 ? 0.f : W[(size_t)k * 2016 + sc]; };
            for (int it = gw; it < 16 * 32; it += NGW) transpose_item(f, dst, 1024, (it >> 5) * 64, (it & 31) * 64, scr, C.lane);
        }
        if (!first)
        {
            const float* Wq = C.in[I_WUQ] + (size_t)l * 256 * 768; const float* gq = C.in[I_QNG] + l * 256; const float* Wk = C.in[I_WUKV] + (size_t)l * 128 * 1024; const float* gk = C.in[I_KVNG] + l * 128;
            bf16* dst = (bf16*)(C.arena + A_WQKV) + (size_t)l * 1792 * 384;
            auto f = [=](int k, int n) -> float {
                if (n < 768) { if (k >= 256) return 0.f; const int h = n / 192, j = n % 192; const int sc = h * 192 + (j < 128 ? j : 128 + rope_unperm(j - 128)); return gq[k] * Wq[(size_t)k * 768 + sc]; }
                if (k < 256) return 0.f; return gk[k - 256] * Wk[(size_t)(k - 256) * 1024 + (n - 768)]; };
            for (int it = gw; it < 6 * 28; it += NGW) transpose_item(f, dst, 384, (it / 28) * 64, (it % 28) * 64, scr, C.lane);
        }
        if (!first)
        {
            const float* W = C.in[I_WOUT] + (size_t)l * 1024 * 1024; bf16* dst = (bf16*)(C.arena + A_WOUT) + (size_t)l * 1024 * 1024;
            for (int it = gw; it < 16 * 16; it += NGW) { const int k0 = (it >> 4) * 64, n0 = (it & 15) * 64; transpose_item_fast(W + (size_t)k0 * 1024 + n0, 1024, dst, 1024, k0, n0, scr, C.lane); }
        }
    }
    if (!first)
    {
        bf16* dst = (bf16*)(C.arena + A_FGU);
        for (int it = gw; it < 16 * 88; it += NGW) { const int k0 = (it / 88) * 64, n0 = (it % 88) * 64; const int tj = n0 >> 8, c = n0 & 255;
            const float* W = (c < 128) ? C.in[I_FG] : C.in[I_FU]; const int sc = tj * 128 + (c & 127);
            transpose_item_fast(W + (size_t)k0 * DFF + sc, DFF, dst, 1024, k0, n0, scr, C.lane); }
    }
    if (!first)
    {
        bf16* dst = (bf16*)(C.arena + A_FD); const float* W = C.in[I_FD];
        for (int it = gw; it < 44 * 16; it += NGW) { const int k0 = (it >> 4) * 64, n0 = (it & 15) * 64; transpose_item_fast(W + (size_t)k0 * 1024 + n0, 1024, dst, DFF, k0, n0, scr, C.lane); }
    }
}
__device__ __forceinline__ void prologue(const Ctx& C) {
    convert_weights(C, true, C.vcu * 8 + C.wave, C.G * 8);
    __syncthreads();
    if (C.vcu == C.G - 1) {
        float* R = (float*)(C.ws + WS_ROPE);
        for (int i = C.tid; i < (128 + 64) * 16; i += 512) { const int j = i & 15, p = i >> 4; const int pos = p < 128 ? p : p - 128;
            const float inv = powf(10000.f, -(float)j / 16.f); const float ang = (float)pos * inv; R[2 * i] = cosf(ang); R[2 * i + 1] = sinf(ang); }
    }
    for (int item = C.vcu; item < 96; item += C.G) {
        const int l = item / 48, cg = item % 48;
        LAS float* sil = (LAS float*)C.lds; LAS float* part = sil + 3 * 1024;
        for (int i = C.tid; i < 3 * 1024; i += 512) { const int v = i >> 10, k = i & 1023; const float x = v < 2 ? C.in[I_C][v * 1024 + k] : C.in[I_CCTX][k]; sil[i] = silu_f(x); }
        __syncthreads();
        const int half = C.lane >> 5, c4 = (C.lane & 31) * 4;
        f32x4 a0 = {0, 0, 0, 0}, a1 = a0, a2 = a0;
        const float* W = C.in[I_WMOD] + (size_t)l * 1024 * 6144 + cg * 128 + c4;
#pragma unroll 8
        for (int i = 0; i < 64; ++i) { const int k = C.wave * 128 + 2 * i + half; const f32x4 w = *(const f32x4*)(W + (size_t)k * 6144);
            a0 += w * sil[k]; a1 += w * sil[1024 + k]; a2 += w * sil[2048 + k]; }
        LAS float* pp = part + (C.wave * 2 + half) * 384 + c4;
#pragma unroll
        for (int q = 0; q < 4; ++q) { pp[q] = a0[q]; pp[128 + q] = a1[q]; pp[256 + q] = a2[q]; }
        __syncthreads();
        if (C.tid < 384) { const int v = C.tid >> 7, c = C.tid & 127; float s = C.in[I_BMOD][l * 6144 + cg * 128 + c];
#pragma unroll
            for (int p = 0; p < 16; ++p) s += part[p * 384 + v * 128 + c];
            ((float*)(C.ws + WS_MOD))[(l * 3 + v) * 6144 + cg * 128 + c] = s; }
        __syncthreads();
    }
}

__device__ __forceinline__ void load_row16(const float* p, int lane, f32x4 (&v)[4]) {
#pragma unroll
    for (int j = 0; j < 4; ++j) v[j] = *(const f32x4*)(p + 256 * j + 4 * lane);
}
__device__ __forceinline__ void norm_mod_row(f32x4 (&v)[4], const float* g, const float* sc, const float* sh, int lane) {
    float ss = 0.f;
#pragma unroll
    for (int j = 0; j < 4; ++j) ss += (v[j].x * v[j].x + v[j].y * v[j].y) + (v[j].z * v[j].z + v[j].w * v[j].w);
    const float rs = 1.f / sqrtf(wave_sum(ss) * (1.f / DM) + EPS);
#pragma unroll
    for (int j = 0; j < 4; ++j) { const f32x4 gg = *(const f32x4*)(g + 256 * j + 4 * lane), s1 = *(const f32x4*)(sc + 256 * j + 4 * lane), s0 = *(const f32x4*)(sh + 256 * j + 4 * lane);
        v[j] = (v[j] * rs * gg) * (s1 + 1.f) + s0; }
}
__device__ __forceinline__ void store_row16_bf16(bf16* p, int lane, const f32x4 (&v)[4]) {
#pragma unroll
    for (int j = 0; j < 4; ++j) { u32x2 w; w.x = pk2(v[j].x, v[j].y); w.y = pk2(v[j].z, v[j].w); *(u32x2*)(p + 256 * j + 4 * lane) = w; }
}
__device__ __forceinline__ const float* xin_row(const Ctx& C, int layer, int row) {
    if (layer == 0) return row < NLAT ? C.in[I_X] + (size_t)row * DM : C.in[I_CTX] + (size_t)(row - NLAT) * DM;
    return (const float*)(C.ws + WS_XL) + (size_t)row * DM;
}

__device__ __forceinline__ void phase_norm1(const Ctx& C, int layer) {
    const int gw = C.vcu * 8 + C.wave, NGW = C.G * 8;
    const float* g = C.in[I_LN1] + layer * DM; const float* MOD = (const float*)(C.ws + WS_MOD) + (size_t)layer * 3 * 6144; bf16* H = (bf16*)(C.ws + WS_H);
    for (int row = gw; row < MR; row += NGW) {
        f32x4 v[4]; load_row16(xin_row(C, layer, row), C.lane, v);
        if (layer == 1 && row >= NLAT) {
            const float* PART = (const float*)(C.arena + R_PART) + (size_t)(row - NLAT) * 1024; const float* g2c = (const float*)(C.ws + WS_MOD) + 2 * 6144 + 5 * 1024;
#pragma unroll
            for (int j = 0; j < 4; ++j) { f32x4 acc = {0.f, 0.f, 0.f, 0.f};
                for (int c = 0; c < 11; ++c) acc += *(const f32x4*)(PART + (size_t)c * 512 * 1024 + 256 * j + 4 * C.lane);
                v[j] += *(const f32x4*)(g2c + 256 * j + 4 * C.lane) * acc; } }
        const float* m = MOD + mod_row(row) * 6144;
        norm_mod_row(v, g, m + 1024, m, C.lane);
        store_row16_bf16(H + (size_t)row * DM, C.lane, v);
    }
}

__device__ __forceinline__ void phase_norm2(const Ctx& C, int layer) {
    const int gw = C.vcu * 8 + C.wave, NGW = C.G * 8;
    const float* g = C.in[I_LN2] + layer * DM; const float* MOD = (const float*)(C.ws + WS_MOD) + (size_t)layer * 3 * 6144; bf16* H = (bf16*)(C.ws + WS_H);
    const float* XL = (const float*)(C.ws + WS_XL);
    const int nrow = layer == 0 ? MR : NLAT;
    unsigned* ctl = (unsigned*)(C.ws + WS_CTL);
    int* PE = (int*)(C.ws + WS_LIST); int* PS = PE + NLAT * 2; float* PWt = (float*)(PS + NLAT * 2);
    for (int row = gw; row < nrow; row += NGW) {
        f32x4 v[4];
        if (layer == 0 && row >= NLAT) {
            load_row16(C.in[I_CTX] + (size_t)(row - NLAT) * DM, C.lane, v);
            const float* PART = (const float*)(C.arena + R_PART) + (size_t)(row - NLAT) * 1024; const float* g1c = MOD + 2 * 6144 + 2 * 1024;
#pragma unroll
            for (int j = 0; j < 4; ++j) { f32x4 acc = {0.f, 0.f, 0.f, 0.f};
                for (int c = 0; c < 4; ++c) acc += *(const f32x4*)(PART + (size_t)c * 512 * 1024 + 256 * j + 4 * C.lane);
                v[j] += *(const f32x4*)(g1c + 256 * j + 4 * C.lane) * acc;
                *(f32x4*)((float*)(C.ws + WS_XL) + (size_t)row * DM + 256 * j + 4 * C.lane) = v[j]; }
        } else load_row16(XL + (size_t)row * DM, C.lane, v);
        const float* m = MOD + mod_row(row) * 6144;
        norm_mod_row(v, g, m + 4096, m + 3072, C.lane);
        store_row16_bf16(H + (size_t)row * DM, C.lane, v);
        if (layer == 1) {
            const float* RW = C.in[I_RW];
            float lg[8];
#pragma unroll
            for (int e = 0; e < 8; ++e) lg[e] = 0.f;
#pragma unroll
            for (int j = 0; j < 4; ++j)
#pragma unroll
                for (int q = 0; q < 4; ++q) { const int n = 256 * j + 4 * C.lane + q; const f32x4 w0 = *(const f32x4*)(RW + n * 8), w1 = *(const f32x4*)(RW + n * 8 + 4); const float x = v[j][q];
                    lg[0] += x * w0.x; lg[1] += x * w0.y; lg[2] += x * w0.z; lg[3] += x * w0.w; lg[4] += x * w1.x; lg[5] += x * w1.y; lg[6] += x * w1.z; lg[7] += x * w1.w; }
#pragma unroll
            for (int e = 0; e < 8; ++e) lg[e] = wave_sum(lg[e]);
            int e1 = 0; float v1 = lg[0];
#pragma unroll
            for (int e = 1; e < 8; ++e) if (lg[e] > v1) { v1 = lg[e]; e1 = e; }
            int e2 = -1; float v2 = -3.0e38f;
#pragma unroll
            for (int e = 0; e < 8; ++e) if (e != e1 && lg[e] > v2) { v2 = lg[e]; e2 = e; }
            if (C.lane == 0) {
                const float w1 = 1.f / (1.f + expf(v2 - v1)), w2 = 1.f - w1;
                const unsigned s1 = atomicAdd(ctl + CW_CNT + 64 * e1, 1u), s2 = atomicAdd(ctl + CW_CNT + 64 * e2, 1u);
                PE[row * 2] = e1; PE[row * 2 + 1] = e2; PS[row * 2] = (int)s1; PS[row * 2 + 1] = (int)s2; PWt[row * 2] = w1; PWt[row * 2 + 1] = w2;
            }
        }
    }
    if (layer == 1) {
        int* ENT = (int*)(C.ws + WS_LIST + AL((size_t)NLAT * 2 * 4 * 3));
        for (int i = C.vcu * 512 + C.tid; i < MAXT * 256; i += C.G * 512) ENT[i] = -1;
    }
}

__device__ __forceinline__ void phase_expert_weights(const Ctx& C) {
    const int gw = C.vcu * 8 + C.wave, NGW = C.G * 8;
    LAS float* scr = (LAS float*)(C.lds + C.wave * 16640);
    bf16* EGU = (bf16*)(C.arena + M_EGU); bf16* ED = (bf16*)(C.arena + M_ED);
    for (int it = gw; it < NEXP * 16 * 112; it += NGW) { const int e = it / (16 * 112), r = it % (16 * 112), k0 = (r / 112) * 64, n0 = (r % 112) * 64; const int tj = n0 >> 8, c = n0 & 255;
        const float* W = ((c < 128) ? C.in[I_EG] : C.in[I_EU]) + (size_t)e * 1024 * DFE; const int sc = tj * 128 + (c & 127);
        transpose_item_fast(W + (size_t)k0 * DFE + sc, DFE, EGU + (size_t)e * 2 * DFE * 1024, 1024, k0, n0, scr, C.lane); }
    for (int it = gw; it < NEXP * 56 * 16; it += NGW) { const int e = it / (56 * 16), r = it % (56 * 16), k0 = (r >> 4) * 64, n0 = (r & 15) * 64;
        const float* W = C.in[I_ED] + (size_t)e * DFE * 1024;
        transpose_item_fast(W + (size_t)k0 * 1024 + n0, 1024, ED + (size_t)e * 1024 * DFE, DFE, k0, n0, scr, C.lane); }
}

__device__ __forceinline__ void moe_tile_bases(const Ctx& C, int (&tb)[9]) {
    unsigned* ctl = (unsigned*)(C.ws + WS_CTL); int acc = 0;
#pragma unroll
    for (int e = 0; e < 8; ++e) { tb[e] = acc; const unsigned c = __hip_atomic_load(ctl + CW_CNT + 64 * e, __ATOMIC_RELAXED, __HIP_MEMORY_SCOPE_AGENT); acc += (int)((c + 255u) >> 8); }
    tb[8] = acc;
}
__device__ __forceinline__ void phase_gather(const Ctx& C) {
    const int gw = C.vcu * 8 + C.wave, NGW = C.G * 8;
    int tb[9]; moe_tile_bases(C, tb);
    const int* PE = (const int*)(C.ws + WS_LIST); const int* PS = PE + NLAT * 2; const float* PWt = (const float*)(PS + NLAT * 2);
    int* ENT = (int*)(C.ws + WS_LIST + AL((size_t)NLAT * 2 * 4 * 3)); float* WTS = (float*)(ENT + MAXT * 256);
    const bf16* H = (const bf16*)(C.ws + WS_H); bf16* HS = (bf16*)(C.arena + M_HS);
    for (int pr = gw; pr < NLAT * 2; pr += NGW) {
        const int e = PE[pr], s = PS[pr]; int base = 0;
#pragma unroll
        for (int k = 0; k < 8; ++k) base = (e == k) ? tb[k] : base;
        const int pos = base * 256 + s;
        const u32x4* srcp = (const u32x4*)(H + (size_t)(pr >> 1) * DM); u32x4* dstp = (u32x4*)(HS + (size_t)pos * DM);
        const u32x4 a = srcp[C.lane], b = srcp[64 + C.lane]; dstp[C.lane] = a; dstp[64 + C.lane] = b;
        if (C.lane == 0) { ENT[pos] = pr; WTS[pos] = PWt[pr]; }
    }
}

__device__ __forceinline__ void phase_final(const Ctx& C) {
    const int gw = C.vcu * 8 + C.wave, NGW = C.G * 8;
    const float* XL = (const float*)(C.ws + WS_XL); const bf16* Y2 = (const bf16*)(C.ws + WS_H); const float* g = C.in[I_FNG];
    for (int row = gw; row < NLAT; row += NGW) {
        f32x4 v[4]; load_row16(XL + (size_t)row * DM, C.lane, v);
        float ss = 0.f;
#pragma unroll
        for (int j = 0; j < 4; ++j) { const u32x2 y = *(const u32x2*)(Y2 + (size_t)row * DM + 256 * j + 4 * C.lane);
            v[j].x += bflo(y.x); v[j].y += bfhi(y.x); v[j].z += bflo(y.y); v[j].w += bfhi(y.y);
            ss += (v[j].x * v[j].x + v[j].y * v[j].y) + (v[j].z * v[j].z + v[j].w * v[j].w); }
        const float rs = 1.f / sqrtf(wave_sum(ss) * (1.f / DM) + EPS);
#pragma unroll
        for (int j = 0; j < 4; ++j) { const f32x4 gg = *(const f32x4*)(g + 256 * j + 4 * C.lane); *(f32x4*)(C.out + (size_t)row * DM + 256 * j + 4 * C.lane) = v[j] * rs * gg; }
    }
}

__device__ __forceinline__ void phase_mla_prep(const Ctx& C) {
    const int gw = C.vcu * 8 + C.wave, NGW = C.G * 8;
    const bf16* P = (const bf16*)(C.arena + R_P); bf16* CQKV = (bf16*)(C.arena + R_CQKV); char* KBc = (char*)(C.arena + R_KB);
    const float* ROPE = (const float*)(C.ws + WS_ROPE);
    for (int row = gw; row < MR; row += NGW) {
        const bf16* pr = P + (size_t)row * PW;
        {   const u32x2 w = *(const u32x2*)(pr + PC_CQ + 4 * C.lane); float x0 = bflo(w.x), x1 = bfhi(w.x), x2 = bflo(w.y), x3 = bfhi(w.y);
            const float rs = 1.f / sqrtf(wave_sum(x0 * x0 + x1 * x1 + x2 * x2 + x3 * x3) * (1.f / 256.f) + EPS);
            u32x2 o; o.x = pk2(x0 * rs, x1 * rs); o.y = pk2(x2 * rs, x3 * rs); *(u32x2*)(CQKV + (size_t)row * 384 + 4 * C.lane) = o; }
        {   const unsigned w = *(const unsigned*)(pr + PC_CKV + 2 * C.lane); float x0 = bflo(w), x1 = bfhi(w);
            const float rs = 1.f / sqrtf(wave_sum(x0 * x0 + x1 * x1) * (1.f / 128.f) + EPS);
            *(unsigned*)(CQKV + (size_t)row * 384 + 256 + 2 * C.lane) = pk2(x0 * rs, x1 * rs); }
        {   float x = bf2f(pr[PC_KR + C.lane]); const float xo = __shfl_xor(x, 1);
            int b, pos; row_bpos(row, b, pos);
            if (row < NLAT) { const int pair = C.lane >> 1, fi = pair & 15, axis = pair >> 4; const int pidx = axis ? (pos & 63) : (pos >> 6);
                const float* cs = ROPE + ((axis ? 128 : 0) + pidx) * 32 + fi * 2; const float c = cs[0], s = cs[1];
                x = (C.lane & 1) ? (x * c + xo * s) : (x * c - xo * s); }
            const bf16 xb = (bf16)f2bf(x);
#pragma unroll
            for (int h = 0; h < 4; ++h) *(bf16*)(KBc + ((size_t)(b * 4 + h) * 132 + (pos >> 6)) * att::KT_BYTES + (16 + (C.lane >> 3)) * 1024 + (pos & 63) * 16 + (C.lane & 7) * 2) = xb; }
    }
}

__device__ __forceinline__ f32x4 mma16(bf16x8 a, bf16x8 b, f32x4 c) { return __builtin_amdgcn_mfma_f32_16x16x32_bf16(a, b, c, 0, 0, 0); }
constexpr int LS = 72;

__device__ __forceinline__ void phase_gla_local(const Ctx& C, int layer) {
    LAS float* codes = (LAS float*)C.lds;
    LAS float* bcum = codes + 64 * 32;
    LAS float* gsum = bcum + 2 * 64 * 64;
    LAS float* tot = gsum + 2 * 4 * 64;
    LAS bf16* vT = (LAS bf16*)(tot + 128);
    LAS bf16* khT = vT + 128 * LS;
    const bf16* P = (const bf16*)(C.arena + R_P);
    bf16* QT = (bf16*)(C.arena + R_QT); bf16* KT = (bf16*)(C.arena + R_KT);
    float* SLOC = (float*)(C.arena + R_SLOC); float* DEC = (float*)(C.arena + R_DEC);
    const float* WG2 = C.in[I_WG2] + (size_t)layer * 2 * 16 * 256; const float* BG2 = C.in[I_BG2] + (size_t)layer * 2 * 256;
    const int tid = C.tid, lane = C.lane;
    for (int L = C.bid; L < NB * NCH * 4; L += C.G) {
        const int h = L & 3, a = (L >> 2) % NCH, b = L / (NCH * 4);
        const int rbase = chunk_row(b, a);
        {
            const int t = tid >> 3, j4 = (tid & 7) * 4; const u32x2 w = *(const u32x2*)(P + (size_t)(rbase + t) * PW + PC_GF + j4);
            LAS float* cp = codes + t * 32 + j4; cp[0] = bflo(w.x); cp[1] = bfhi(w.x); cp[2] = bflo(w.y); cp[3] = bfhi(w.y);
            const int e0 = (tid & 7) * 16; const bf16* vp = P + (size_t)(rbase + t) * PW + PC_V + h * 128 + e0;
            const u32x4 v0 = *(const u32x4*)vp, v1 = *(const u32x4*)(vp + 8); float vf[16]; unpack8(v0, vf); unpack8(v1, vf + 8);
#pragma unroll
            for (int i = 0; i < 16; ++i) vT[(e0 + i) * LS + t] = (bf16)f2bf(vf[i]);
        }
        __syncthreads();
        const int dir = tid >> 8, tg = (tid >> 6) & 3, d = tid & 63;
        {
            float w[16];
#pragma unroll
            for (int r = 0; r < 16; ++r) w[r] = WG2[(dir * 16 + r) * 256 + h * 64 + d];
            const float bias = BG2[dir * 256 + h * 64 + d];
            float acc = 0.f;
#pragma unroll
            for (int ii = 0; ii < 16; ++ii) { const int i = dir ? 15 - ii : ii; const int t = tg * 16 + i; float pre = bias;
#pragma unroll
                for (int r = 0; r < 16; ++r) pre += codes[t * 32 + dir * 16 + r] * w[r];
                acc += logsig_f(pre) * (1.f / 16.f); bcum[(dir * 64 + t) * 64 + d] = acc; }
            gsum[(dir * 4 + tg) * 64 + d] = acc;
        }
        __syncthreads();
        {   float off = 0.f, total = 0.f;
#pragma unroll
            for (int g2 = 0; g2 < 4; ++g2) { const float s = gsum[(dir * 4 + g2) * 64 + d]; total += s; if (dir ? (g2 > tg) : (g2 < tg)) off += s; }
#pragma unroll
            for (int i = 0; i < 16; ++i) bcum[(dir * 64 + tg * 16 + i) * 64 + d] += off;
            if (tg == 0) tot[dir * 64 + d] = total;
        }
        __syncthreads();
        {
            const int t = (tid >> 2) & 63, d0 = (tid & 3) * 16; const size_t row = (size_t)(rbase + t);
            const bf16* qp = P + row * PW + PC_Q + h * 64 + d0; const bf16* kp = P + row * PW + PC_K + h * 64 + d0;
            float q[16], k[16]; unpack8(*(const u32x4*)qp, q); unpack8(*(const u32x4*)(qp + 8), q + 8); unpack8(*(const u32x4*)kp, k); unpack8(*(const u32x4*)(kp + 8), k + 8);
            float qo[16], ko[16];
#pragma unroll
            for (int i = 0; i < 16; ++i) { const float B = bcum[(dir * 64 + t) * 64 + d0 + i], tt = tot[dir * 64 + d0 + i];
                qo[i] = q[i] * 0.125f * __expf(B); ko[i] = k[i] * __expf(-B); khT[(dir * 64 + d0 + i) * LS + t] = (bf16)f2bf(k[i] * __expf(tt - B)); }
            bf16* qd = QT + ((size_t)dir * MR + row) * 256 + h * 64 + d0; bf16* kd = KT + ((size_t)dir * MR + row) * 256 + h * 64 + d0;
            *(u32x4*)qd = pack8(qo); *(u32x4*)(qd + 8) = pack8(qo + 8); *(u32x4*)kd = pack8(ko); *(u32x4*)(kd + 8) = pack8(ko + 8);
        }
        const int pf = a < 128 ? a + 4 : a - 128, pb = 131 - a;
        if (tid < 128) { const int dd = tid >> 6, d2 = tid & 63; const int chain = dd * 8 + b * 4 + h, p = dd ? pb : pf; DEC[((size_t)chain * NCH + p) * 64 + d2] = __expf(tot[dd * 64 + d2]); }
        __syncthreads();
        {
            const int fr = lane & 15, fq = lane >> 4;
#pragma unroll 2
            for (int i = 0; i < 8; ++i) { const int id = C.wave * 8 + i, dd = id >> 5, et = (id >> 2) & 7, dt = id & 3;
                f32x4 acc = {0.f, 0.f, 0.f, 0.f};
#pragma unroll
                for (int ks = 0; ks < 2; ++ks) { const bf16x8 av = *(const LAS bf16x8*)(vT + (et * 16 + fr) * LS + ks * 32 + fq * 8); const bf16x8 bv = *(const LAS bf16x8*)(khT + (dd * 64 + dt * 16 + fr) * LS + ks * 32 + fq * 8);
                    acc = mma16(av, bv, acc); }
                const int chain = dd * 8 + b * 4 + h, p = dd ? pb : pf; float* S = SLOC + ((size_t)chain * NCH + p) * 8192;
#pragma unroll
                for (int r = 0; r < 4; ++r) S[(et * 16 + fq * 4 + r) * 64 + dt * 16 + fr] = acc[r]; }
        }
        __syncthreads();
    }
}

__device__ __forceinline__ void phase_gla_scan(const Ctx& C) {
    const float* SLOC = (const float*)(C.arena + R_SLOC); const float* DEC = (const float*)(C.arena + R_DEC); bf16* SST = (bf16*)(C.arena + R_SST);
    for (int idx = C.bid * 512 + C.tid; idx < 16 * 8192; idx += C.G * 512) {
        const int chain = idx >> 13, el = idx & 8191, d = el & 63;
        const float* sl = SLOC + (size_t)chain * NCH * 8192 + el; const float* dc = DEC + (size_t)chain * NCH * 64 + d; bf16* so = SST + (size_t)chain * NCH * 8192 + el;
        float S = 0.f;
        for (int p0 = 0; p0 < NCH; p0 += 12) {
            float x[12], g[12];
#pragma unroll
            for (int i = 0; i < 12; ++i) { x[i] = sl[(size_t)(p0 + i) * 8192]; g[i] = dc[(p0 + i) * 64]; }
#pragma unroll
            for (int i = 0; i < 12; ++i) { so[(size_t)(p0 + i) * 8192] = (bf16)f2bf(S); S = S * g[i] + x[i]; }
        }
    }
}

__device__ __forceinline__ void phase_gla_out(const Ctx& C, int layer) {
    LAS bf16* qf = (LAS bf16*)C.lds; LAS bf16* kf = qf + 64 * LS; LAS bf16* qb = kf + 64 * LS; LAS bf16* kb = qb + 64 * LS;
    LAS bf16* vT = kb + 64 * LS;
    LAS bf16* SfT = vT + 128 * LS; LAS bf16* SbT = SfT + 128 * LS;
    LAS bf16* As = SbT + 128 * LS;
    LAS float* O = (LAS float*)(As + 64 * LS);
    const bf16* P = (const bf16*)(C.arena + R_P); const bf16* QT = (const bf16*)(C.arena + R_QT); const bf16* KT = (const bf16*)(C.arena + R_KT);
    const bf16* SST = (const bf16*)(C.arena + R_SST); bf16* MIX = (bf16*)(C.arena + R_MIX);
    const float* GG = C.in[I_GLAG] + layer * 128;
    const int tid = C.tid, lane = C.lane, fr = lane & 15, fq = lane >> 4;
    const int na = layer == 0 ? NCH : 128;
    for (int L = C.bid; L < NB * na * 4; L += C.G) {
        const int h = L & 3, a = (L >> 2) % na, b = L / (na * 4);
        const int rbase = chunk_row(b, a);
        const int pf = a < 128 ? a + 4 : a - 128, pb = 131 - a;
        {
            const int which = tid >> 7, t = (tid >> 1) & 63, hf = tid & 1; const int dd = which >> 1;
            const bf16* src = ((which & 1) ? KT : QT) + ((size_t)dd * MR + rbase + t) * 256 + h * 64 + hf * 32;
            LAS bf16* dst = (which == 0 ? qf : which == 1 ? kf : which == 2 ? qb : kb) + t * LS + hf * 32;
#pragma unroll
            for (int i = 0; i < 4; ++i) *(LAS u32x4*)(dst + 8 * i) = *(const u32x4*)(src + 8 * i);
        }
        {
            const int t = tid >> 3, e0 = (tid & 7) * 16; const bf16* vp = P + (size_t)(rbase + t) * PW + PC_V + h * 128 + e0;
            const u32x4 v0 = *(const u32x4*)vp, v1 = *(const u32x4*)(vp + 8); float vf[16]; unpack8(v0, vf); unpack8(v1, vf + 8);
#pragma unroll
            for (int i = 0; i < 16; ++i) vT[(e0 + i) * LS + t] = (bf16)f2bf(vf[i]);
        }
        {
            const int dd = tid >> 8, e = (tid >> 1) & 127, hf = tid & 1; const int chain = dd * 8 + b * 4 + h, p = dd ? pb : pf;
            const bf16* src = SST + ((size_t)chain * NCH + p) * 8192 + e * 64 + hf * 32; LAS bf16* dst = (dd ? SbT : SfT) + e * LS + hf * 32;
#pragma unroll
            for (int i = 0; i < 4; ++i) *(LAS u32x4*)(dst + 8 * i) = *(const u32x4*)(src + 8 * i);
        }
        __syncthreads();
        {
#pragma unroll
            for (int i = 0; i < 2; ++i) { const int pos = C.wave * 2 + i, ti = pos >> 2, si = pos & 3;
                f32x4 af = {0.f, 0.f, 0.f, 0.f}, ab = af;
#pragma unroll
                for (int ks = 0; ks < 2; ++ks) {
                    const bf16x8 a1 = *(const LAS bf16x8*)(qf + (ti * 16 + fr) * LS + ks * 32 + fq * 8), b1 = *(const LAS bf16x8*)(kf + (si * 16 + fr) * LS + ks * 32 + fq * 8);
                    const bf16x8 a2 = *(const LAS bf16x8*)(qb + (ti * 16 + fr) * LS + ks * 32 + fq * 8), b2 = *(const LAS bf16x8*)(kb + (si * 16 + fr) * LS + ks * 32 + fq * 8);
                    af = mma16(a1, b1, af); ab = mma16(a2, b2, ab); }
#pragma unroll
                for (int r = 0; r < 4; ++r) { const int t = ti * 16 + fq * 4 + r, s = si * 16 + fr; const float val = (s <= t ? af[r] : 0.f) + (s >= t ? ab[r] : 0.f); As[t * LS + s] = (bf16)f2bf(val); } }
        }
        __syncthreads();
        {
#pragma unroll 2
            for (int i = 0; i < 4; ++i) { const int id = C.wave * 4 + i, tt = id >> 3, et = id & 7;
                f32x4 acc = {0.f, 0.f, 0.f, 0.f};
#pragma unroll
                for (int ks = 0; ks < 2; ++ks) {
                    const bf16x8 bv = *(const LAS bf16x8*)(vT + (et * 16 + fr) * LS + ks * 32 + fq * 8);
                    acc = mma16(*(const LAS bf16x8*)(As + (tt * 16 + fr) * LS + ks * 32 + fq * 8), bv, acc);
                    acc = mma16(*(const LAS bf16x8*)(qf + (tt * 16 + fr) * LS + ks * 32 + fq * 8), *(const LAS bf16x8*)(SfT + (et * 16 + fr) * LS + ks * 32 + fq * 8), acc);
                    acc = mma16(*(const LAS bf16x8*)(qb + (tt * 16 + fr) * LS + ks * 32 + fq * 8), *(const LAS bf16x8*)(SbT + (et * 16 + fr) * LS + ks * 32 + fq * 8), acc); }
#pragma unroll
                for (int r = 0; r < 4; ++r) O[(tt * 16 + fq * 4 + r) * 132 + et * 16 + fr] = acc[r]; }
        }
        __syncthreads();
        {
            const int t = tid >> 3, e0 = (tid & 7) * 16; float o[16], ss = 0.f;
#pragma unroll
            for (int i = 0; i < 16; ++i) { o[i] = O[t * 132 + e0 + i]; ss += o[i] * o[i]; }
            ss += __shfl_xor(ss, 1); ss += __shfl_xor(ss, 2); ss += __shfl_xor(ss, 4);
            const float rs = 1.f / sqrtf(ss * (1.f / 128.f) + EPS);
            const size_t row = (size_t)(rbase + t); const bf16* rp = P + row * PW + PC_R + h * 128 + e0; float rv[16]; unpack8(*(const u32x4*)rp, rv); unpack8(*(const u32x4*)(rp + 8), rv + 8);
#pragma unroll
            for (int i = 0; i < 16; ++i) o[i] = o[i] * rs * GG[e0 + i] * silu_f(rv[i]);
            bf16* mp = MIX + row * DM + h * 128 + e0; *(u32x4*)mp = pack8(o); *(u32x4*)(mp + 8) = pack8(o + 8);
        }
        __syncthreads();
    }
}

namespace att {
constexpr int NW = 8, QBLK = 32, KVBLK = 64;
constexpr float THR = 8.f;
constexpr int OFF_K = 0, OFF_V = 2 * KT_BYTES, OFF_WS = OFF_V + 3 * VT_BYTES, OFF_QR = OFF_WS + NW * 64 * 4, SHM_ATTN = OFF_QR + NW * 4096;
#define SBAR() __builtin_amdgcn_sched_barrier(0)
__device__ __forceinline__ int crow(int r, int hi) { return (r & 3) + 8 * (r >> 2) + 4 * hi; }
__device__ __forceinline__ unsigned cvtpk(float lo, float hi) { unsigned r; asm volatile("v_cvt_pk_bf16_f32 %0, %1, %2" : "=v"(r) : "v"(lo), "v"(hi)); return r; }
__device__ __forceinline__ void glds16(const void* gsrc, unsigned lds_dst) { unsigned keep;
    asm volatile("s_mov_b32 %0, m0\n\ts_mov_b32 m0, %2\n\ts_nop 0\n\tglobal_load_lds_dwordx4 %1, off\n\ts_mov_b32 m0, %0" : "=&s"(keep) : "v"(gsrc), "s"(lds_dst) : "memory"); }
__device__ __forceinline__ void partialSM(f32x16& p0, f32x16& p1, float& m_reg, float& mn, float& alpha) {
    constexpr float Cc = MLA_SCALE * 1.4426950408889634f;
    float pmax = p0[0];
#pragma unroll
    for (int r = 1; r < 16; ++r) pmax = fmaxf(pmax, p0[r]);
#pragma unroll
    for (int r = 0; r < 16; ++r) pmax = fmaxf(pmax, p1[r]);
    { auto rr = __builtin_amdgcn_permlane32_swap(__float_as_uint(pmax), __float_as_uint(pmax), false, false);
      pmax = fmaxf(__uint_as_float(rr[0]), __uint_as_float(rr[1])); }
    if (__builtin_expect(__all(pmax - m_reg <= THR / MLA_SCALE), 1)) { mn = m_reg; alpha = 1.f; }
    else { mn = fmaxf(m_reg, pmax); alpha = __builtin_amdgcn_exp2f((m_reg - mn) * Cc); m_reg = mn; }
    const float mnC = -mn * Cc;
#pragma unroll
    for (int r = 0; r < 16; ++r) p0[r] = fmaf(p0[r], Cc, mnC);
#pragma unroll
    for (int r = 0; r < 16; ++r) p1[r] = fmaf(p1[r], Cc, mnC);
#pragma unroll
    for (int r = 0; r < 16; ++r) p0[r] = __builtin_amdgcn_exp2f(p0[r]);
}
__device__ __forceinline__ void finishSM(f32x16& p0, f32x16& p1, float alpha, float& l_reg, bf16x8& pa0, bf16x8& pa1, bf16x8& pa2, bf16x8& pa3) {
#pragma unroll
    for (int r = 0; r < 16; ++r) p1[r] = __builtin_amdgcn_exp2f(p1[r]);
    float ps = 0;
#pragma unroll
    for (int r = 0; r < 16; ++r) ps += p0[r];
#pragma unroll
    for (int r = 0; r < 16; ++r) ps += p1[r];
    { auto rr = __builtin_amdgcn_permlane32_swap(__float_as_uint(ps), __float_as_uint(ps), false, false);
      ps = __uint_as_float(rr[0]) + __uint_as_float(rr[1]); }
    l_reg = l_reg * alpha + ps;
#define PK4(P, BASE, OUT) do { unsigned a0 = cvtpk(P[BASE + 0], P[BASE + 1]), a1 = cvtpk(P[BASE + 2], P[BASE + 3]);   \
    unsigned b0 = cvtpk(P[BASE + 4], P[BASE + 5]), b1 = cvtpk(P[BASE + 6], P[BASE + 7]);                              \
    auto r0 = __builtin_amdgcn_permlane32_swap(a0, b0, false, false); auto r1 = __builtin_amdgcn_permlane32_swap(a1, b1, false, false); \
    u32x4 w = {r0[0], r1[0], r0[1], r1[1]}; OUT = *reinterpret_cast<bf16x8*>(&w); } while (0)
    PK4(p0, 0, pa0); PK4(p0, 8, pa1); PK4(p1, 0, pa2); PK4(p1, 8, pa3);
#undef PK4
}
__device__ __forceinline__ void qkt(f32x16& p0, f32x16& p1, const char* kl, const bf16x8* qr, const char* qrl) {
    p0 = f32x16{}; p1 = f32x16{};
#pragma unroll
    for (int d0 = 0; d0 < 8; ++d0) {
        const bf16x8 b0 = *reinterpret_cast<const bf16x8*>(kl + d0 * 2048);
        const bf16x8 b1 = *reinterpret_cast<const bf16x8*>(kl + d0 * 2048 + 512);
        p0 = __builtin_amdgcn_mfma_f32_32x32x16_bf16(b0, qr[d0], p0, 0, 0, 0);
        p1 = __builtin_amdgcn_mfma_f32_32x32x16_bf16(b1, qr[d0], p1, 0, 0, 0); }
#pragma unroll
    for (int d0 = 8; d0 < 12; ++d0) {
        const bf16x8 b0 = *reinterpret_cast<const bf16x8*>(kl + d0 * 2048);
        const bf16x8 b1 = *reinterpret_cast<const bf16x8*>(kl + d0 * 2048 + 512);
        const bf16x8 qv = *reinterpret_cast<const bf16x8*>(qrl + (d0 - 8) * 1024);
        p0 = __builtin_amdgcn_mfma_f32_32x32x16_bf16(b0, qv, p0, 0, 0, 0);
        p1 = __builtin_amdgcn_mfma_f32_32x32x16_bf16(b1, qv, p1, 0, 0, 0); }
}
__device__ __forceinline__ int v_rd_base(int lane) { return ((lane & 3) << 3) | (((lane >> 2) & 3) << 6) | (((lane >> 4) & 1) << 5) | (((lane >> 5) & 1) << 8); }
constexpr int v_rd_off(int d0, int ks, int half) { return d0 * 512 + ks * 4096 + half * 2048; }
template <int OFF> __device__ __forceinline__ s16x4 tr_read(int vb) {
    s16x4 r; asm volatile("ds_read_b64_tr_b16 %0, %1 offset:%2" : "=&v"(r) : "v"(vb), "i"(OFF) : "memory"); return r;
}
template <int D0> __device__ __forceinline__ void pv_one(f32x16& od, int vb, bf16x8 pa0, bf16x8 pa1, bf16x8 pa2, bf16x8 pa3) {
    const s16x4 l0 = tr_read<v_rd_off(D0, 0, 0)>(vb), h0 = tr_read<v_rd_off(D0, 0, 1)>(vb), l1 = tr_read<v_rd_off(D0, 1, 0)>(vb), h1 = tr_read<v_rd_off(D0, 1, 1)>(vb);
    const s16x4 l2 = tr_read<v_rd_off(D0, 2, 0)>(vb), h2 = tr_read<v_rd_off(D0, 2, 1)>(vb), l3 = tr_read<v_rd_off(D0, 3, 0)>(vb), h3 = tr_read<v_rd_off(D0, 3, 1)>(vb);
    asm volatile("s_waitcnt lgkmcnt(0)" ::: "memory"); SBAR();
#define PKV(L, H) (bf16x8){L[0], L[1], L[2], L[3], H[0], H[1], H[2], H[3]}
    od = __builtin_amdgcn_mfma_f32_32x32x16_bf16(pa0, PKV(l0, h0), od, 0, 0, 0);
    od = __builtin_amdgcn_mfma_f32_32x32x16_bf16(pa1, PKV(l1, h1), od, 0, 0, 0);
    od = __builtin_amdgcn_mfma_f32_32x32x16_bf16(pa2, PKV(l2, h2), od, 0, 0, 0);
    od = __builtin_amdgcn_mfma_f32_32x32x16_bf16(pa3, PKV(l3, h3), od, 0, 0, 0);
#undef PKV
}
__device__ __forceinline__ void pv_d0(f32x16* o, int vb, bf16x8 pa0, bf16x8 pa1, bf16x8 pa2, bf16x8 pa3) {
    pv_one<0>(o[0], vb, pa0, pa1, pa2, pa3); pv_one<1>(o[1], vb, pa0, pa1, pa2, pa3); pv_one<2>(o[2], vb, pa0, pa1, pa2, pa3); pv_one<3>(o[3], vb, pa0, pa1, pa2, pa3);
}
__device__ __forceinline__ void attn_body(const bf16* __restrict__ Qb, const char* __restrict__ Kt, const char* __restrict__ Vt, bf16* __restrict__ Ob, int t0, int NT, char* lds, const float* __restrict__ ROPE, int qpos0) {
    int tid = threadIdx.x; asm volatile("" : "+v"(tid));
    const int wid = __builtin_amdgcn_readfirstlane(tid >> 6), lane = tid & 63, r32 = lane & 31, hi = lane >> 5;
    float* ws = (float*)(lds + OFF_WS) + wid * 64; float* li_l = ws; float* al_l = ws + 32;
    float m_reg = -1e30f, l_reg = 0; f32x16 o[4] = {}; bf16x8 qr[8];
    const bf16* Qw = Qb + (long)(wid * QBLK + r32) * 192 + hi * 8;
#pragma unroll
    for (int d0 = 0; d0 < 8; ++d0) qr[d0] = *reinterpret_cast<const bf16x8*>(Qw + d0 * 16);
    char* qrl = lds + OFF_QR + wid * 4096 + lane * 16;
#pragma unroll
    for (int d0 = 0; d0 < 4; ++d0) {
        const u32x4 w = *reinterpret_cast<const u32x4*>(Qw + 128 + d0 * 16); float v[8]; unpack8(w, v);
        if (qpos0 >= 0) { const int pos = qpos0 + wid * QBLK + r32;
#pragma unroll
            for (int q = 0; q < 4; ++q) { const int pair = d0 * 8 + hi * 4 + q, fi = pair & 15, axis = pair >> 4; const int pidx = axis ? (pos & 63) : (pos >> 6);
                const float* cs = ROPE + ((axis ? 128 : 0) + pidx) * 32 + fi * 2; const float c = cs[0], sn = cs[1]; const float x1 = v[2 * q], x2 = v[2 * q + 1];
                v[2 * q] = x1 * c - x2 * sn; v[2 * q + 1] = x2 * c + x1 * sn; } }
        *reinterpret_cast<u32x4*>(qrl + d0 * 1024) = pack8(v); }
    asm volatile("s_waitcnt vmcnt(0)" ::: "memory");
    const unsigned ldsb = (unsigned)(uintptr_t)lds;
    const char* Ktw = Kt + (size_t)t0 * KT_BYTES + lane * 16; const char* Vtw = Vt + (size_t)t0 * VT_BYTES + lane * 16;
#define ISSUE(j, ks, vs) do { _Pragma("unroll") for (int _i = 0; _i < 5; ++_i) { const int q = wid * 5 + _i; \
        if (q < 24) glds16(Ktw + (size_t)(j) * KT_BYTES + q * 1024, __builtin_amdgcn_readfirstlane(ldsb + OFF_K + (ks) * KT_BYTES + q * 1024)); \
        else glds16(Vtw + (size_t)(j) * VT_BYTES + (q - 24) * 1024, __builtin_amdgcn_readfirstlane(ldsb + OFF_V + (vs) * VT_BYTES + (q - 24) * 1024)); } } while (0)
#define RESC(a) do { if (__any((a) < 1.f)) { if (hi == 0) al_l[r32] = (a); asm volatile("s_waitcnt lgkmcnt(0)" ::: "memory"); \
    _Pragma("unroll") for (int d = 0; d < 4; ++d) _Pragma("unroll") for (int r = 0; r < 16; ++r) o[d][r] *= al_l[crow(r, hi)]; } } while (0)
    const char* kl0 = lds + OFF_K + hi * 1024 + r32 * 16;
    const int vb0 = (int)ldsb + OFF_V + v_rd_base(lane);
    f32x16 pA0, pA1, pB0, pB1; float mnA, mnB, alA, alB; bf16x8 pa0, pa1, pa2, pa3;
    ISSUE(0, 0, 0); ISSUE(1, 1, 1);
    asm volatile("s_waitcnt vmcnt(5)" ::: "memory"); __builtin_amdgcn_s_barrier(); SBAR();
    qkt(pA0, pA1, kl0, qr, qrl); partialSM(pA0, pA1, m_reg, mnA, alA);
    int vprev = 0, vcur = 1, vnext = 2;
    for (int j = 1; j < NT; j += 2) {
        asm volatile("s_waitcnt vmcnt(0)" ::: "memory"); __builtin_amdgcn_s_barrier(); SBAR();
        if (j + 1 < NT) ISSUE(j + 1, 0, vnext);
        SBAR(); qkt(pB0, pB1, kl0 + KT_BYTES, qr, qrl);
        finishSM(pA0, pA1, alA, l_reg, pa0, pa1, pa2, pa3); SBAR();
        pv_d0(o, vb0 + vprev * VT_BYTES, pa0, pa1, pa2, pa3); partialSM(pB0, pB1, m_reg, mnB, alB);
        RESC(alB);
        { const int t = vprev; vprev = vcur; vcur = vnext; vnext = t; }
        if (j + 1 < NT) {
            asm volatile("s_waitcnt vmcnt(0)" ::: "memory"); __builtin_amdgcn_s_barrier(); SBAR();
            if (j + 2 < NT) ISSUE(j + 2, 1, vnext);
            SBAR(); qkt(pA0, pA1, kl0, qr, qrl);
            finishSM(pB0, pB1, alB, l_reg, pa0, pa1, pa2, pa3); SBAR();
            pv_d0(o, vb0 + vprev * VT_BYTES, pa0, pa1, pa2, pa3); partialSM(pA0, pA1, m_reg, mnA, alA);
            RESC(alA);
            { const int t = vprev; vprev = vcur; vcur = vnext; vnext = t; }
        }
    }
    finishSM(pB0, pB1, alB, l_reg, pa0, pa1, pa2, pa3); SBAR();
    pv_d0(o, vb0 + vprev * VT_BYTES, pa0, pa1, pa2, pa3);
    if (hi == 0) li_l[r32] = l_reg; asm volatile("s_waitcnt lgkmcnt(0)" ::: "memory");
    float rli[16];
#pragma unroll
    for (int r = 0; r < 16; ++r) rli[r] = __builtin_amdgcn_rcpf(li_l[crow(r, hi)]);
    bf16* Ow = Ob + (long)(wid * QBLK) * DM;
#pragma unroll
    for (int r = 0; r < 16; ++r) { const int orow = crow(r, hi);
#pragma unroll
        for (int d0 = 0; d0 < 4; ++d0) Ow[(long)orow * DM + d0 * 32 + r32] = (bf16)f2bf(o[d0][r] * rli[r]); }
    __syncthreads();
#undef ISSUE
#undef RESC
}
}

__device__ __forceinline__ void phase_attention(const Ctx& C, int layer) {
    const bf16* QB = (const bf16*)(C.arena + R_QB); const char* KB = (const char*)(C.arena + R_KB); const char* VB = (const char*)(C.arena + R_VB); bf16* MIX = (bf16*)(C.arena + R_MIX);
    const float* ROPE = (const float*)(C.ws + WS_ROPE);
    const int nunit = layer == 0 ? 264 : 256;
    for (int L = C.bid; L < nunit; L += C.G) {
        const bool lat = L < 256; const int bh = lat ? (L & 7) : (L - 256), qb = L >> 3, b = bh >> 2, h = bh & 3;
        const int qrow = lat ? qb * 256 : TT, orow = lat ? b * TT + qb * 256 : NLAT + b * TC;
        att::attn_body(QB + ((size_t)bh * TKV + qrow) * 192, KB + (size_t)bh * 132 * att::KT_BYTES, VB + (size_t)bh * 132 * att::VT_BYTES, MIX + (size_t)orow * DM + 512 + h * 128,
                       lat ? 0 : 128, lat ? 132 : 4, (char*)C.ldsg, ROPE, lat ? qb * 256 : -1);
    }
}

struct FStoreP { bf16* P;
    __device__ __forceinline__ void operator()(int row, int col, f32x4 v0, f32x4 v1) const { u32x4 w; w.x = pk2(v0[0], v0[1]); w.y = pk2(v0[2], v0[3]); w.z = pk2(v1[0], v1[1]); w.w = pk2(v1[2], v1[3]); *(u32x4*)(P + (size_t)row * PW + col) = w; } };
struct FStoreQKV { bf16* QB; char* KB; char* VB;
    __device__ __forceinline__ void operator()(int row, int col, f32x4 v0, f32x4 v1) const {
        int b, pos; row_bpos(row, b, pos);
        u32x4 w; w.x = pk2(v0[0], v0[1]); w.y = pk2(v0[2], v0[3]); w.z = pk2(v1[0], v1[1]); w.w = pk2(v1[2], v1[3]);
        if (col < 768) { const int h = col / 192, j = col - h * 192; *(u32x4*)(QB + ((size_t)(b * 4 + h) * TKV + pos) * 192 + j) = w; }
        else { const int c2 = col - 768, h = c2 >> 8, j = c2 & 255; const size_t tile = (size_t)(b * 4 + h) * 132 + (pos >> 6); const int k = pos & 63;
            if (j < 128) *(u32x4*)(KB + tile * att::KT_BYTES + (j >> 3) * 1024 + k * 16) = w;
            else *(u32x4*)(VB + tile * att::VT_BYTES + att::v_st(k, j - 128)) = w; }
    } };
struct FResidual { const float* x; const float* ctx; float* XL; const float* gate; int layer0;
    __device__ __forceinline__ void operator()(int row, int col, f32x4 v0, f32x4 v1) const {
        const float* src = layer0 ? (row < NLAT ? x + (size_t)row * DM : ctx + (size_t)(row - NLAT) * DM) : XL + (size_t)row * DM;
        const float* g = gate + mod_row(row) * 6144 + col;
        const f32x4 s0 = *(const f32x4*)(src + col), s1 = *(const f32x4*)(src + col + 4), g0 = *(const f32x4*)g, g1 = *(const f32x4*)(g + 4);
        float* d = XL + (size_t)row * DM + col; *(f32x4*)d = s0 + g0 * v0; *(f32x4*)(d + 4) = s1 + g1 * v1;
    } };
struct FStoreAct { bf16* ACT; int ld;
    __device__ __forceinline__ void operator()(int row, int col, const float* o) const { *(u32x4*)(ACT + (size_t)row * ld + col) = pack8(o); } };
struct FMoeDown { const int* ENT; const float* WTS; float* XL; bf16* Y2; const float* gate; int accum;
    __device__ __forceinline__ void operator()(int row, int colx, f32x4 v0, f32x4 v1) const {
        const int col = colx & (DM - 1);
        const int ent = ENT[row]; if (ent < 0) return;
        const int tok = ent >> 1; const float w = WTS[row]; const float* g = gate + (tok >> 13) * 6144 + col;
        const f32x4 g0 = *(const f32x4*)g * w, g1 = *(const f32x4*)(g + 4) * w;
        if ((ent & 1) == 0) { float* d = XL + (size_t)tok * DM + col; *(f32x4*)d = *(const f32x4*)d + g0 * v0; *(f32x4*)(d + 4) = *(const f32x4*)(d + 4) + g1 * v1; }
        else { bf16* d = Y2 + (size_t)tok * DM + col; float y[8] = {0.f, 0.f, 0.f, 0.f, 0.f, 0.f, 0.f, 0.f}; if (accum) unpack8(*(const u32x4*)d, y);
            const f32x4 a0 = g0 * v0, a1 = g1 * v1; y[0] += a0[0]; y[1] += a0[1]; y[2] += a0[2]; y[3] += a0[3]; y[4] += a1[0]; y[5] += a1[1]; y[6] += a1[2]; y[7] += a1[3];
            *(u32x4*)d = pack8(y); }
    } };

constexpr int PH_PER_LAYER = 13, PH_FINAL = 1 + 2 * PH_PER_LAYER, N_PHASES = PH_FINAL + 1;
__host__ __device__ constexpr bool phase_exists(int ph) { return ph == 0 || ph == PH_FINAL || (ph >= 1 && ph < PH_FINAL && ((((ph - 1) / PH_PER_LAYER) == 1 && ((ph - 1) % PH_PER_LAYER) != 7) || (((ph - 1) / PH_PER_LAYER) == 0 && ((ph - 1) % PH_PER_LAYER) < 9))); }

#ifndef DBG_REP
#define DBG_REP(ph) 0
#endif
#ifndef DBG_STOP
#define DBG_STOP 0
#endif
#ifndef DBG_SRC
#define DBG_SRC 0
#endif
__device__ __forceinline__ void phase_dump(const Ctx& C) {
    const int gw = C.vcu * 8 + C.wave, NGW = C.G * 8;
    for (int row = gw; row < NLAT; row += NGW) {
        float* o = C.out + (size_t)row * DM;
        if (DBG_SRC == 0) { const float* s = (const float*)(C.ws + WS_XL) + (size_t)row * DM; for (int c = C.lane; c < DM; c += 64) o[c] = s[c]; }
        else { const bf16* s = DBG_SRC == 1 ? (const bf16*)(C.arena + R_MIX) + (size_t)row * DM : DBG_SRC == 2 ? (const bf16*)(C.ws + WS_H) + (size_t)row * DM
                             : DBG_SRC == 3 ? (const bf16*)(C.arena + R_P) + (size_t)row * PW : DBG_SRC == 4 ? (const bf16*)(C.arena + R_P) + (size_t)row * PW + 1024
                             : DBG_SRC == 5 ? (const bf16*)(C.arena + R_ACT) + (size_t)row * DFF : DBG_SRC == 6 ? (const bf16*)(C.arena + R_QT) + (size_t)row * 256
                             : (const bf16*)(C.arena + R_QB) + (size_t)row * 192;
            const int n = DBG_SRC == 6 ? 256 : DBG_SRC == 7 ? 192 : DM;
            for (int c = C.lane; c < DM; c += 64) o[c] = c < n ? bf2f(s[c]) : 0.f; }
    }
}
template <int PH, int SUB = 0> __device__ __forceinline__ void run_phase(const Ctx& C0) {
    Ctx C = C0; { int t = threadIdx.x; asm volatile("" : "+v"(t)); C.tid = t; C.lane = t & 63; C.wave = __builtin_amdgcn_readfirstlane(t >> 6); }
    constexpr int layer = (PH - 1) / PH_PER_LAYER, k = (PH - 1) % PH_PER_LAYER;
    const float* MODB = (const float*)(C.ws + WS_MOD);
    if constexpr (DBG_STOP > 0 && PH > DBG_STOP && PH != PH_FINAL) { }
    else if constexpr (DBG_STOP > 0 && PH == PH_FINAL) { phase_dump(C); }
    else if constexpr (PH == 0) { prologue(C); }
    else if constexpr (PH == PH_FINAL) { phase_final(C); }
    else if constexpr (k == 0) { phase_norm1(C, layer); }
    else if constexpr (k == 1) {
        pg8::Gemm g{(const bf16*)(C.ws + WS_H), (const bf16*)(C.arena + A_WIN) + (size_t)layer * 2048 * 1024, 1024, 1024, 1024};
        pg8::StaticOrder S; S.init(MR, PW, C.G, C.bid); pg8::Epi8<FStoreP> E{{(bf16*)(C.arena + R_P)}};
        pg8::gemm_phase(C.lds, g, S, E);
        if constexpr (layer == 0) { const int nfull = (MR / 256 * (PW / 256)) % C.G;
            if (C.bid >= nfull) convert_weights(C, false, (C.bid - nfull) * 8 + C.wave, (C.G - nfull) * 8); }
    } else if constexpr (k == 2) {
        if (SUB != 2) phase_gla_local(C, layer);
        if (SUB != 1) phase_mla_prep(C);
    } else if constexpr (k == 3) {
        if (SUB != 2) phase_gla_scan(C);
        if (SUB != 1)
        { pg8::Gemm g{(const bf16*)(C.arena + R_CQKV), (const bf16*)(C.arena + A_WQKV) + (size_t)layer * 1792 * 384, 384, 384, 384};
          pg8::StaticOrder S; S.init(MR, 1792, C.G, C.bid); pg8::Epi8<FStoreQKV> E{{(bf16*)(C.arena + R_QB), (char*)(C.arena + R_KB), (char*)(C.arena + R_VB)}};
          pg8::gemm_phase(C.lds, g, S, E); }
    } else if constexpr (k == 4) {
        if (SUB != 2) phase_gla_out(C, layer);
        if (SUB != 1) phase_attention(C, layer);
    } else if constexpr (k == 5) {
        pg8::Gemm g{(const bf16*)(C.arena + R_MIX), (const bf16*)(C.arena + A_WOUT) + (size_t)layer * 1024 * 1024, 1024, 1024, 1024};
        pg8::StaticOrder S; S.init(NLAT, DM, C.G, C.bid);
        pg8::Epi8<FResidual> E{{C.in[I_X], C.in[I_CTX], (float*)(C.ws + WS_XL), MODB + (size_t)layer * 3 * 6144 + 2 * 1024, layer == 0 ? 1 : 0}};
        pg8::gemm_phase(C.lds, g, S, E);
        if constexpr (layer == 0) {
            pg8::Gemm g2{(const bf16*)(C.arena + R_MIX), (const bf16*)(C.arena + A_WOUT), 256, 1024, 1024};
            pg8::CtxSplitOrder S2{4, C.G, C.bid}; pg8::EpiPart E2{(float*)(C.arena + R_PART)};
            pg8::gemm_phase(C.lds, g2, S2, E2); }
    } else if constexpr (k == 6) { phase_norm2(C, layer); if constexpr (layer == 1) phase_expert_weights(C); }
    else if constexpr (layer == 0 && k == 7) {
        pg8::Gemm g{(const bf16*)(C.ws + WS_H), (const bf16*)(C.arena + A_FGU), 1024, 1024, 1024};
        pg8::StaticOrder S; S.init(MR, 2 * DFF, C.G, C.bid); pg8::EpiGU<FStoreAct> E{{(bf16*)(C.arena + R_ACT), DFF}, 1 << 20};
        pg8::gemm_phase(C.lds, g, S, E);
    } else if constexpr (layer == 0 && k == 8) {
        pg8::Gemm g{(const bf16*)(C.arena + R_ACT), (const bf16*)(C.arena + A_FD), DFF, DFF, DFF};
        pg8::StaticOrder S; S.init(NLAT, DM, C.G, C.bid);
        pg8::Epi8<FResidual> E{{C.in[I_X], C.in[I_CTX], (float*)(C.ws + WS_XL), MODB + 5 * 1024, 0}};
        pg8::gemm_phase(C.lds, g, S, E);
        {
            pg8::Gemm g2{(const bf16*)(C.arena + R_ACT), (const bf16*)(C.arena + A_FD), 256, DFF, DFF};
            pg8::CtxSplitOrder S2{11, C.G, C.bid}; pg8::EpiPart E2{(float*)(C.arena + R_PART)};
            pg8::gemm_phase(C.lds, g2, S2, E2); }
    } else if constexpr (layer == 1 && k == 8) { phase_gather(C); }
    else if constexpr (layer == 1 && (k == 9 || k == 11)) {
        constexpr int half = (k - 9) / 2;
        pg8::MoeOrder S; moe_tile_bases(C, S.tb); S.ncol = 14; S.tpe = 28; S.joff = 14 * half; S.G = C.G; S.c = C.bid;
        pg8::Gemm g{(const bf16*)(C.arena + M_HS), (const bf16*)(C.arena + M_EGU), 1024, 1024, 1024};
        pg8::EpiGU<FStoreAct> E{{(bf16*)(C.arena + M_ACT) - (size_t)half * 14 * 128, DFEH}, 28};
        pg8::gemm_phase(C.lds, g, S, E);
    } else if constexpr (layer == 1 && (k == 10 || k == 12)) {
        constexpr int half = (k - 10) / 2;
        const int* ENT = (const int*)(C.ws + WS_LIST + AL((size_t)NLAT * 2 * 4 * 3)); const float* WTS = (const float*)(ENT + MAXT * 256);
        pg8::MoeOrder S; moe_tile_bases(C, S.tb); S.ncol = 4; S.tpe = 4; S.joff = 0; S.G = C.G; S.c = C.bid;
        pg8::Gemm g{(const bf16*)(C.arena + M_ACT), (const bf16*)(C.arena + M_ED) + (size_t)half * DFEH, DFEH, DFEH, DFE};
        pg8::Epi8<FMoeDown> E{{ENT, WTS, (float*)(C.ws + WS_XL), (bf16*)(C.ws + WS_H), MODB + (size_t)3 * 6144 + 5 * 1024, half}};
        pg8::gemm_phase(C.lds, g, S, E);
    }
}

__device__ __forceinline__ void make_ctx(Ctx& C, const Args& args, unsigned char* lds_raw) {
    C.lds = (LAS unsigned char*)lds_raw; C.ldsg = lds_raw; C.ws = args.ws; C.arena = args.ws + WS_ARENA; C.in = args.in; C.out = args.out;
    C.tid = threadIdx.x; C.lane = C.tid & 63; C.wave = __builtin_amdgcn_readfirstlane(C.tid >> 6);
    C.G = gridDim.x; C.bid = blockIdx.x; C.vcu = (C.G % 8 == 0) ? (C.bid % 8) * (C.G / 8) + C.bid / 8 : C.bid;
}

template <int PH> __device__ __forceinline__ void run_from(const Ctx& C, const XcdBarrier& bar) {
    if constexpr (PH < N_PHASES) {
        if constexpr (phase_exists(PH)) { run_phase<PH>(C); if constexpr (PH != PH_FINAL) xcd_barrier(bar);
            if constexpr (DBG_REP(PH) > 0) { run_phase<PH, DBG_REP(PH) - 1>(C); xcd_barrier(bar); } }
        run_from<PH + 1>(C, bar);
    }
}

#if !MK_PER_PHASE
__global__ void __launch_bounds__(512, 2) mega_fwd(Args args) {
    extern __shared__ __attribute__((aligned(16))) unsigned char lds_raw[];
    Ctx C; make_ctx(C, args, lds_raw);
    volatile LAS unsigned* MISC = (volatile LAS unsigned*)(C.lds + MISC_OFF);
    if (C.tid < 64) MISC[C.tid] = 0u;
    __syncthreads();
    unsigned* ctl = (unsigned*)(C.ws + WS_CTL);
    const XcdBarrier bar = xcd_barrier_post(ctl + CW_BAR, MISC + 8);
    run_from<0>(C, bar);
}
#else
template <int PH> __global__ void __launch_bounds__(512, 2) phase_kernel(Args args) {
    extern __shared__ __attribute__((aligned(16))) unsigned char lds_raw[];
    Ctx C; make_ctx(C, args, lds_raw);
    run_phase<PH>(C);
}
template <int PH> void launch_from(int grid, hipStream_t stream, const Args& a) {
    if constexpr (PH < N_PHASES) {
        if constexpr (phase_exists(PH)) {
            (void)hipFuncSetAttribute((const void*)phase_kernel<PH>, hipFuncAttributeMaxDynamicSharedMemorySize, LDS_BYTES);
            hipLaunchKernelGGL(phase_kernel<PH>, dim3(grid), dim3(512), LDS_BYTES, stream, a);
        }
        launch_from<PH + 1>(grid, stream, a);
    }
}
#endif

extern "C" void kernel_launch(void* const* d_in, const int* in_sizes, int n_in, void* d_out, int out_size, void* d_ws, size_t ws_size, hipStream_t stream) {
    static int grid = 0;
    if (grid == 0) {
        if (n_in != 25 || out_size != NLAT * DM || ws_size < WS_END) { fprintf(stderr, "kernel_launch: unexpected shapes (n_in %d, out %d, ws %zu < %zu); nothing launched\n", n_in, out_size, ws_size, (size_t)WS_END); grid = -1; return; }
        int dev = 0, cus = 0;
        if (hipGetDevice(&dev) != hipSuccess || hipDeviceGetAttribute(&cus, hipDeviceAttributeMultiprocessorCount, dev) != hipSuccess) { grid = -1; return; }
#if !MK_PER_PHASE
        if (hipFuncSetAttribute((const void*)mega_fwd, hipFuncAttributeMaxDynamicSharedMemorySize, LDS_BYTES) != hipSuccess) { fprintf(stderr, "kernel_launch: hipFuncSetAttribute failed\n"); grid = -1; return; }
        int per_cu = 0;
        if (hipOccupancyMaxActiveBlocksPerMultiprocessor(&per_cu, (const void*)mega_fwd, 512, LDS_BYTES) != hipSuccess || per_cu < 1) { fprintf(stderr, "kernel_launch: occupancy query reports %d blocks per CU\n", per_cu); }
        (void)hipGetLastError();
#endif
        grid = cus;
    }
    if (grid < 0) return;
    if (hipMemsetAsync((char*)d_ws + WS_CTL, 0, CTL_BYTES, stream) != hipSuccess) return;
    Args a{};
    for (int i = 0; i < 25; ++i) a.in[i] = (const float*)d_in[i];
    a.out = (float*)d_out; a.ws = (unsigned char*)d_ws;
#if MK_PER_PHASE
    launch_from<0>(grid, stream, a);
#else
    hipLaunchKernelGGL(mega_fwd, dim3(grid), dim3(512), LDS_BYTES, stream, a);
#endif
    const hipError_t le = hipPeekAtLastError();
    if (le != hipSuccess) fprintf(stderr, "kernel_launch: launch failed: %s\n", hipGetErrorName(le));
}
```

```cpp
#include <hip/hip_runtime.h>
#include <cstdio>
#include <cstdint>

#define LAS __attribute__((address_space(3)))
#define GAS __attribute__((address_space(1)))
typedef unsigned short bf16;
typedef short bf16x8 __attribute__((ext_vector_type(8)));
typedef short s16x4 __attribute__((ext_vector_type(4)));
typedef float f32x2 __attribute__((ext_vector_type(2)));
typedef float f32x4 __attribute__((ext_vector_type(4)));
typedef float f32x16 __attribute__((ext_vector_type(16)));
typedef unsigned u32x2 __attribute__((ext_vector_type(2)));
typedef unsigned u32x4 __attribute__((ext_vector_type(4)));

#ifndef MK_PER_PHASE
#define MK_PER_PHASE 0
#endif

constexpr int DM = 1024, NB = 2, TT = 8192, TC = 256, NLAT = NB * TT, NCTXR = NB * TC, MR = NLAT + NCTXR;
constexpr int TKV = TT + TC;
constexpr int PW = 2048;
constexpr int PC_Q = 0, PC_K = 256, PC_V = 512, PC_R = 1024, PC_CQ = 1536, PC_CKV = 1792, PC_KR = 1920, PC_GF = 1984, PC_GB = 2000;
constexpr int NCH = 132;
constexpr int DFF = 2816, DFE = 3584, NEXP = 8;
constexpr int MOE_T0 = 15, MOE_T1 = 28 - MOE_T0, MOE_K0 = MOE_T0 * 128, MOE_K1 = MOE_T1 * 128;
constexpr int MOE_MAIN = 128, MOE_C0 = 384, MOE_NC0 = 5, MOE_C1 = 128, MOE_NC1 = 13;
constexpr int MAXT = 136;
constexpr float EPS = 1e-6f;
constexpr float MLA_SCALE = 0.07216878364870322f;
namespace att {
constexpr int KT_BYTES = 24576, VT_BYTES = 16384;
__host__ __device__ __forceinline__ int v_st(int k, int c) { const int kk = (k & ~0xC) | ((k & 4) << 1) | ((k & 8) >> 1); return ((kk >> 3) * 4 + (c >> 5)) * 512 + ((kk & 7) * 32 + (c & 31)) * 2; }
}

constexpr size_t AL(size_t x) { return (x + 255) & ~(size_t)255; }
constexpr size_t WS_CTL = 0, CTL_BYTES = 65536;
constexpr size_t WS_MOD = WS_CTL + CTL_BYTES;
constexpr size_t WS_ROPE = WS_MOD + AL(2 * 3 * 6144 * 4);
constexpr size_t WS_XL = WS_ROPE + AL((128 + 64) * 32 * 4);
constexpr size_t WS_H = WS_XL + AL((size_t)MR * DM * 2);
constexpr size_t WS_LIST = WS_H + AL((size_t)MR * DM * 2);
constexpr size_t LIST_BYTES = AL((size_t)NLAT * 2 * 4 * 3) + AL((size_t)MAXT * 256 * 4 * 2) + AL((size_t)NLAT * 2 * 4);
constexpr size_t WS_Y0 = WS_LIST + LIST_BYTES;
constexpr size_t WS_ARENA = WS_Y0 + AL((size_t)NLAT * DM * 2);
constexpr size_t A_WIN = 0;
constexpr size_t A_WQKV = A_WIN + AL((size_t)2 * 2048 * 1024 * 2);
constexpr size_t A_WOUT = A_WQKV + AL((size_t)2 * 1792 * 384 * 2);
constexpr size_t A_FGU = A_WOUT + AL((size_t)2 * 1024 * 1024 * 2);
constexpr size_t A_FD = A_FGU + AL((size_t)2 * DFF * 1024 * 2);
constexpr size_t A_R = A_FD + AL((size_t)1024 * DFF * 2);
constexpr size_t R_P = A_R;
constexpr size_t R_QT = R_P + AL((size_t)MR * PW * 2);
constexpr size_t R_KT = R_QT + AL((size_t)2 * MR * 256 * 2);
constexpr size_t R_SLOC = R_KT + AL((size_t)2 * MR * 256 * 2);
constexpr size_t R_DEC = R_SLOC + AL((size_t)16 * NCH * 8192 * 4);
constexpr size_t R_SST = R_DEC + AL((size_t)16 * NCH * 64 * 4);
constexpr size_t R_CQKV = R_SST + AL((size_t)16 * NCH * 8192 * 2);
constexpr size_t R_QB = R_CQKV + AL((size_t)MR * 384 * 2);
constexpr size_t R_KB = R_QB + AL((size_t)8 * TKV * 192 * 2);
constexpr size_t R_VB = R_KB + AL((size_t)8 * TKV * 192 * 2);
constexpr size_t R_MIX = R_VB + AL((size_t)8 * TKV * 128 * 2);
constexpr size_t R_END = R_MIX + AL((size_t)MR * DM * 2);
constexpr size_t R_PART = R_SLOC;
constexpr size_t R_ACT = A_R;
static_assert(R_ACT + (size_t)MR * DFF * 2 <= R_SLOC && (size_t)11 * 512 * 1024 * 4 <= (size_t)16 * NCH * 8192 * 4, "ACT ends below SLOC; PART fits SLOC");
constexpr size_t M_EGU = 0;
constexpr size_t M_HS = M_EGU + AL((size_t)NEXP * 2 * DFE * 1024 * 2);
constexpr size_t M_LISTE = M_HS + AL((size_t)NLAT * DM * 2);
constexpr size_t M_ACT = M_HS + AL((size_t)MAXT * 256 * 1024 * 2);
constexpr size_t M_PT0 = M_ACT + AL((size_t)MAXT * 256 * MOE_K0 * 2);
constexpr size_t M_END = M_PT0 + AL((size_t)MOE_NC0 * 2048 * 1024 * 2);
constexpr size_t ARENA_BYTES = (R_END > M_END) ? R_END : M_END;
constexpr size_t WS_ED = WS_ARENA + ARENA_BYTES;
constexpr size_t WS_END = WS_ED + AL((size_t)NEXP * 1024 * DFE * 2);
static_assert(WS_END <= 534000000ull, "workspace map exceeds the guaranteed scratch size");

constexpr int CW_BAR = 4096;
constexpr int CW_CNT = 64;

constexpr int LDS_BYTES = 147456, MISC_OFF = LDS_BYTES - 256;

__device__ __forceinline__ unsigned f2bf_s(float f) { unsigned u = __builtin_bit_cast(unsigned, f); return (u + 0x7fffu + ((u >> 16) & 1u)) >> 16; }
__device__ __forceinline__ unsigned pk2s(float lo, float hi) { return f2bf_s(lo) | (f2bf_s(hi) << 16); }
typedef __bf16 bf16x2_t __attribute__((ext_vector_type(2)));
__device__ __forceinline__ unsigned pk2h(float lo, float hi) { const f32x2 v = {lo, hi}; return __builtin_bit_cast(unsigned, __builtin_convertvector(v, bf16x2_t)); }
__device__ __forceinline__ unsigned pk2(float lo, float hi) { return pk2h(lo, hi); }
__device__ __forceinline__ unsigned f2bf(float f) { return pk2h(f, 0.f) & 0xffffu; }
__device__ __forceinline__ u32x4 pack8h(const float* v) { u32x4 w; w.x = pk2h(v[0], v[1]); w.y = pk2h(v[2], v[3]); w.z = pk2h(v[4], v[5]); w.w = pk2h(v[6], v[7]); return w; }
__device__ __forceinline__ float bf2f(unsigned b) { return __builtin_bit_cast(float, b << 16); }
__device__ __forceinline__ float bflo(unsigned w) { return __builtin_bit_cast(float, w << 16); }
__device__ __forceinline__ float bfhi(unsigned w) { return __builtin_bit_cast(float, w & 0xffff0000u); }
__device__ __forceinline__ u32x4 pack8s(const float* v) { u32x4 w; w.x = pk2s(v[0], v[1]); w.y = pk2s(v[2], v[3]); w.z = pk2s(v[4], v[5]); w.w = pk2s(v[6], v[7]); return w; }
__device__ __forceinline__ u32x4 pack8(const float* v) { u32x4 w; w.x = pk2(v[0], v[1]); w.y = pk2(v[2], v[3]); w.z = pk2(v[4], v[5]); w.w = pk2(v[6], v[7]); return w; }
__device__ __forceinline__ void unpack8_raw(u32x4 w, bf16* v) { v[0] = (bf16)(w.x & 0xffffu); v[1] = (bf16)(w.x >> 16); v[2] = (bf16)(w.y & 0xffffu); v[3] = (bf16)(w.y >> 16); v[4] = (bf16)(w.z & 0xffffu); v[5] = (bf16)(w.z >> 16); v[6] = (bf16)(w.w & 0xffffu); v[7] = (bf16)(w.w >> 16); }
__device__ __forceinline__ void unpack8(u32x4 w, float* v) { v[0] = bflo(w.x); v[1] = bfhi(w.x); v[2] = bflo(w.y); v[3] = bfhi(w.y); v[4] = bflo(w.z); v[5] = bfhi(w.z); v[6] = bflo(w.w); v[7] = bfhi(w.w); }
__device__ __forceinline__ float wave_sum(float v) {
#pragma unroll
    for (int o = 1; o < 64; o <<= 1) v += __shfl_xor(v, o);
    return v;
}
__device__ __forceinline__ float silu_f(float x) { return x * __builtin_amdgcn_rcpf(1.f + __expf(-x)); }
__device__ __forceinline__ float logsig_f(float x) { return fminf(x, 0.f) - __logf(1.f + __expf(-fabsf(x))); }
#define LDS_WAIT() asm volatile("s_waitcnt lgkmcnt(0)" ::: "memory")
#define VM_WAIT() asm volatile("s_waitcnt vmcnt(0)" ::: "memory")

namespace pg8 {
constexpr int BM = 256, BK = 64, HALF = 128, HTB = HALF * BK * 2, NXCD = 8, WGM = 8;
__host__ __device__ __forceinline__ int lds_byte(int r, int c) { const int st = (r >> 4) * 2 + (c >> 5), rr = r & 15, cc = c & 31, ob = rr * 64 + cc * 2; return st * 1024 + (ob ^ (((ob >> 9) & 1) << 5)); }
__host__ __device__ __forceinline__ void stage_rc(int b, int& R, int& C) { const int st = b / 1024, sb = b % 1024, swz = sb ^ (((sb >> 9) & 1) << 5); R = (st >> 1) * 16 + swz / 64; C = (st & 1) * 32 + (swz % 64) / 2; }
__host__ __device__ __forceinline__ int perm32(int rho) { const int n = rho >> 4, i = rho & 15; return 8 * (i >> 2) + 4 * n + (i & 3); }

struct Unit { int pm, pn, kc; };
struct Gemm { const bf16* A; const bf16* Bt; int K, lda, ldb; };

struct StaticOrder {
    static constexpr bool GATHER = false;
    int nM, nN, nwg, G, c;
    __device__ void init(int M, int N, int G_, int c_) { nM = M / BM; nN = N / BM; nwg = nM * nN; G = G_; c = c_; }
    __device__ bool next(int i, Unit& u) const {
        const long L = (long)i * G + c; if (L >= nwg) return false;
        int wgid = (int)L; { const int q = nwg / NXCD, r = nwg % NXCD, xcd = wgid % NXCD, off = wgid / NXCD; wgid = (xcd < r ? xcd * (q + 1) : r * (q + 1) + (xcd - r) * q) + off; }
        const int nig = WGM * nN, gid = wgid / nig, fm = gid * WGM, gsz = (nM - fm) < WGM ? (nM - fm) : WGM;
        u.pm = fm + ((wgid % nig) % gsz); u.pn = (wgid % nig) / gsz; u.kc = 0; return true;
    }
};
struct MoeOrder {
    static constexpr bool GATHER = false;
    int tb[9]; int ncol, tpe, joff, G, c;
    __device__ bool next(int i, Unit& u) const {
        const int nM = tb[8], nwg = nM * ncol; const long L = (long)i * G + c; if (L >= nwg) return false;
        int wgid = (int)L; { const int q = nwg / NXCD, r = nwg % NXCD, xcd = wgid % NXCD, off = wgid / NXCD; wgid = (xcd < r ? xcd * (q + 1) : r * (q + 1) + (xcd - r) * q) + off; }
        const int nig = WGM * ncol, gid = wgid / nig, fm = gid * WGM, gsz = (nM - fm) < WGM ? (nM - fm) : WGM;
        const int tile = fm + ((wgid % nig) % gsz), j = (wgid % nig) / gsz; int e = 0;
#pragma unroll
        for (int k = 1; k < 8; ++k) e += (tile >= tb[k]) ? 1 : 0;
        u.pm = tile; u.pn = e * tpe + joff + j; u.kc = 0; return true;
    }
};
struct MoeTailOrder {
    static constexpr bool GATHER = false;
    int tb[9]; int nm, ntail, nchunk, G, c;
    __device__ bool next(int i, Unit& u) const {
        const int per = ntail * 4, L = i * G + c; if (L >= per * nchunk) return false;
        const int kc = L / per, r = L - kc * per, tile = nm + (r >> 2); int e = 0;
#pragma unroll
        for (int k = 1; k < 8; ++k) e += (tile >= tb[k]) ? 1 : 0;
        u.pm = tile; u.pn = e * 4 + (r & 3); u.kc = kc; return true;
    }
};
struct CtxSplitOrder {
    static constexpr bool GATHER = false;
    int nchunk, G, c;
    __device__ bool next(int i, Unit& u) const { const int L = i * G + c; if (L >= nchunk * 8) return false; const int r = L & 7; u.kc = L >> 3; u.pm = 64 + (r & 1); u.pn = r >> 1; return true; }
};
struct MoeGatherOrder : MoeOrder {
    static constexpr bool GATHER = true;
    const int* LISTE; int cnt[8];
    __device__ __forceinline__ void rows_of(const Unit& u, const int*& src, int& nvalid) const {
        int e = 0;
#pragma unroll
        for (int k = 1; k < 8; ++k) e += (u.pm >= tb[k]) ? 1 : 0;
        int tbe = 0, ce = 0;
#pragma unroll
        for (int k = 0; k < 8; ++k) { tbe = (e == k) ? tb[k] : tbe; ce = (e == k) ? cnt[k] : ce; }
        const int s0 = (u.pm - tbe) * 256; src = LISTE + e * 16384 + s0; nvalid = ce - s0;
    }
};
template <class Epi, class Sched>
__device__ __forceinline__ void gemm_phase(LAS unsigned char* lds, const Gemm g, const Sched& S, const Epi& E) {
    int tid = threadIdx.x; asm volatile("" : "+v"(tid));
    const int wid = __builtin_amdgcn_readfirstlane(tid >> 6), lane = tid & 63, wr = wid >> 2, wc = wid & 3, fr = lane & 15, fq = lane >> 4;
    const int K = g.K, nt = K / BK;
    constexpr bool GA = Sched::GATHER;
    unsigned voffA[2], voffB[2], vG[2][2]; int RA[2], CA[2];
#pragma unroll
    for (int i = 0; i < 2; ++i) { int R, C; stage_rc(tid * 16 + i * 8192, R, C); const int Rb = (R & ~31) + perm32(R & 31); RA[i] = R; CA[i] = C;
        voffA[i] = (unsigned)(R * g.lda + C) * 2u; voffB[i] = (unsigned)(Rb * g.ldb + C) * 2u; vG[0][i] = vG[1][i] = 0u; }
    const size_t kstep = (size_t)(BK * 2);
    const size_t hstepA = GA ? (size_t)0 : (size_t)HALF * g.lda * 2, hstepB = (size_t)HALF * g.ldb * 2;
    constexpr int TAB_OFF = 8 * HTB;
#define PG8_IDX_ISSUE(u, par) do { if constexpr (GA) { const int* _src; int _nv; S.rows_of(u, _src, _nv); \
        __builtin_amdgcn_global_load_lds((const unsigned*)(_src + (wid & 3) * 64 + lane), (LAS unsigned*)(lds + TAB_OFF + (par) * 1024 + (wid & 3) * 256), 4, 0, 0); } } while (0)
#define PG8_IDX_READ(u, par) do { if constexpr (GA) { const int* _src; int _nv; S.rows_of(u, _src, _nv); _Pragma("unroll") for (int _h = 0; _h < 2; ++_h) _Pragma("unroll") for (int _i = 0; _i < 2; ++_i) { \
        const int _r = _h * HALF + RA[_i]; const int _raw = *(const LAS int*)(lds + TAB_OFF + (par) * 1024 + _r * 4); const int _row = _r < _nv ? (_raw >> 1) : 0; vG[_h][_i] = (unsigned)(_row * g.lda + CA[_i]) * 2u; } } } while (0)
    const size_t tstepA = 2 * hstepA, tstepB = 2 * hstepB;
    const unsigned ldsw = (unsigned)wid * 1024u;
    const int aoff = lds_byte(wr * 64 + fr, fq * 8), boff = lds_byte(wc * 32 + fr, fq * 8);
#define PG8_SA(b, h) (((b) * 2 + (h)) * HTB)
#define PG8_SB(b, h) ((4 + (b) * 2 + (h)) * HTB)
#define PG8_STAGE(bufoff, gbase, voff) do { _Pragma("unroll") for (int _i = 0; _i < 2; ++_i) \
        __builtin_amdgcn_global_load_lds((const unsigned*)((const char*)(gbase) + (voff)[_i]), (LAS unsigned*)(lds + (bufoff) + ldsw + _i * 8192), 16, 0, 0); } while (0)
#define PG8_STAGE_A(bufoff, gbase, h) do { if constexpr (GA) PG8_STAGE(bufoff, gbase, vG[h]); else PG8_STAGE(bufoff, gbase, voffA); } while (0)
#define PG8_LDA(dst, b, h) do { _Pragma("unroll") for (int m = 0; m < 4; ++m) _Pragma("unroll") for (int k = 0; k < 2; ++k) dst[m][k] = *(const LAS bf16x8*)(lds + PG8_SA(b, h) + aoff + m * 2048 + k * 1024); } while (0)
#define PG8_LDB(dst, b, h) do { _Pragma("unroll") for (int n = 0; n < 2; ++n) _Pragma("unroll") for (int k = 0; k < 2; ++k) dst[n][k] = *(const LAS bf16x8*)(lds + PG8_SB(b, h) + boff + n * 2048 + k * 1024); } while (0)
#define PG8_MMA(ai, bj, At, Bt) do { __builtin_amdgcn_s_setprio(1); _Pragma("unroll") for (int m = 0; m < 4; ++m) _Pragma("unroll") for (int n = 0; n < 2; ++n) _Pragma("unroll") for (int k = 0; k < 2; ++k) \
        acc[ai][bj][m][n] = __builtin_amdgcn_mfma_f32_16x16x32_bf16(Bt[n][k], At[m][k], acc[ai][bj][m][n], 0, 0, 0); __builtin_amdgcn_s_setprio(0); } while (0)
#define PG8_WAIT_V(n) asm volatile("s_waitcnt vmcnt(" #n ")" ::: "memory")
#define PG8_WAIT_L(n) asm volatile("s_waitcnt lgkmcnt(" #n ")" ::: "memory")
#define PG8_BAR __builtin_amdgcn_s_barrier()
#define PG8_SCHED __builtin_amdgcn_sched_barrier(0)
    Unit cur, nxt; int ui = 0;
    if (!S.next(0, cur)) return;
    f32x4 acc[2][2][4][2];
#pragma unroll
    for (int a = 0; a < 2; ++a)
#pragma unroll
        for (int b = 0; b < 2; ++b)
#pragma unroll
            for (int m = 0; m < 4; ++m)
#pragma unroll
                for (int n = 0; n < 2; ++n) acc[a][b][m][n] = (f32x4){0.f, 0.f, 0.f, 0.f};
    bf16x8 At[4][2], B0[2][2], B1[2][2];
    const size_t cstep = (size_t)K * 2;
    const char* cA = (const char*)g.A + (GA ? (size_t)0 : (size_t)cur.pm * tstepA) + cur.kc * cstep; const char* cB = (const char*)g.Bt + (size_t)cur.pn * tstepB + cur.kc * cstep;
    if constexpr (GA) { PG8_IDX_ISSUE(cur, 0); PG8_WAIT_V(0); PG8_BAR; PG8_IDX_READ(cur, 0); }
    PG8_STAGE(PG8_SB(0, 0), cB, voffB); PG8_STAGE(PG8_SB(0, 1), cB + hstepB, voffB); PG8_STAGE_A(PG8_SA(0, 0), cA, 0); PG8_STAGE_A(PG8_SA(0, 1), cA + hstepA, 1);
    if (wr == 1) PG8_BAR;
    PG8_WAIT_V(2); PG8_BAR;
    PG8_STAGE(PG8_SB(1, 0), cB + kstep, voffB); PG8_STAGE_A(PG8_SA(1, 0), cA + kstep, 0); PG8_STAGE(PG8_SB(1, 1), cB + hstepB + kstep, voffB);
    PG8_WAIT_V(6); PG8_BAR;
    for (;;) {
        const bool has_next = S.next(ui + 1, nxt);
        if (has_next) PG8_IDX_ISSUE(nxt, (ui + 1) & 1);
        const char* nA = has_next ? (const char*)g.A + (GA ? (size_t)0 : (size_t)nxt.pm * tstepA) + nxt.kc * cstep : cA; const char* nB = has_next ? (const char*)g.Bt + (size_t)nxt.pn * tstepB + nxt.kc * cstep : cB;
#pragma unroll 1
        for (int t = 0; t < nt; t += 2) {
            const bool last = (t == nt - 2);
            const char* a1 = cA + (size_t)(t + 1) * kstep;
            const char* a2 = last ? nA : cA + (size_t)(t + 2) * kstep; const char* b2 = last ? nB : cB + (size_t)(t + 2) * kstep;
            const char* a3 = a2 + kstep; const char* b3 = b2 + kstep;
            PG8_LDB(B0, 0, 0); PG8_LDB(B1, 0, 1); PG8_SCHED; PG8_LDA(At, 0, 0); PG8_STAGE_A(PG8_SA(1, 1), a1 + hstepA, 1);
            if constexpr (GA) { if (last && has_next) PG8_IDX_READ(nxt, (ui + 1) & 1); }
            PG8_WAIT_V(8); PG8_WAIT_L(0); PG8_BAR; PG8_MMA(0, 0, At, B0); PG8_MMA(0, 1, At, B1); PG8_BAR; PG8_SCHED;
            PG8_LDA(At, 0, 1); PG8_STAGE(PG8_SB(0, 0), b2, voffB); PG8_STAGE(PG8_SB(0, 1), b2 + hstepB, voffB); PG8_STAGE_A(PG8_SA(0, 0), a2, 0);
            PG8_WAIT_V(8); PG8_WAIT_L(0); PG8_BAR; PG8_MMA(1, 0, At, B0); PG8_MMA(1, 1, At, B1); PG8_BAR; PG8_SCHED;
            PG8_LDB(B0, 1, 0); PG8_LDB(B1, 1, 1); PG8_SCHED; PG8_LDA(At, 1, 0); PG8_STAGE_A(PG8_SA(0, 1), a2 + hstepA, 1);
            PG8_WAIT_V(8); PG8_WAIT_L(0); PG8_BAR; PG8_MMA(0, 0, At, B0); PG8_MMA(0, 1, At, B1); PG8_BAR; PG8_SCHED;
            PG8_LDA(At, 1, 1); PG8_STAGE(PG8_SB(1, 0), b3, voffB); PG8_STAGE(PG8_SB(1, 1), b3 + hstepB, voffB); PG8_STAGE_A(PG8_SA(1, 0), a3, 0);
            PG8_WAIT_V(8); PG8_WAIT_L(0); PG8_BAR; PG8_MMA(1, 0, At, B0); PG8_MMA(1, 1, At, B1); PG8_BAR; PG8_SCHED;
        }
        if (wr == 0) PG8_BAR;
        E(acc, cur, wr, wc, fr, fq);
        if (!has_next) break;
#pragma unroll
        for (int a = 0; a < 2; ++a)
#pragma unroll
            for (int b = 0; b < 2; ++b)
#pragma unroll
                for (int m = 0; m < 4; ++m)
#pragma unroll
                    for (int n = 0; n < 2; ++n) acc[a][b][m][n] = (f32x4){0.f, 0.f, 0.f, 0.f};
        cur = nxt; cA = nA; cB = nB; ++ui;
        if (wr == 1) PG8_BAR;
    }
    PG8_WAIT_V(0);
    PG8_BAR;
#undef PG8_SA
#undef PG8_SB
#undef PG8_STAGE
#undef PG8_STAGE_A
#undef PG8_IDX_ISSUE
#undef PG8_IDX_READ
#undef PG8_LDA
#undef PG8_LDB
#undef PG8_MMA
#undef PG8_WAIT_V
#undef PG8_WAIT_L
#undef PG8_BAR
#undef PG8_SCHED
}

template <class F> struct Epi8 {
    F f;
    __device__ __forceinline__ void operator()(const f32x4 (&acc)[2][2][4][2], const Unit& u, int wr, int wc, int fr, int fq) const {
        const int row0 = u.pm * BM + wr * 64 + fr, col0 = u.pn * BM + wc * 32 + 8 * fq;
#pragma unroll
        for (int ai = 0; ai < 2; ++ai)
#pragma unroll
            for (int m = 0; m < 4; ++m)
#pragma unroll
                for (int bj = 0; bj < 2; ++bj) { f(row0 + ai * HALF + m * 16, col0 + bj * HALF, acc[ai][bj][m][0], acc[ai][bj][m][1]); __builtin_amdgcn_sched_barrier(0); }
    }
};
struct EpiPart {
    float* PART;
    __device__ __forceinline__ void operator()(const f32x4 (&acc)[2][2][4][2], const Unit& u, int wr, int wc, int fr, int fq) const {
        const int row0 = (u.pm - 64) * BM + wr * 64 + fr, col0 = u.pn * BM + wc * 32 + 8 * fq; float* base = PART + (size_t)u.kc * 512 * 1024;
#pragma unroll
        for (int ai = 0; ai < 2; ++ai)
#pragma unroll
            for (int m = 0; m < 4; ++m)
#pragma unroll
                for (int bj = 0; bj < 2; ++bj) { float* d = base + (size_t)(row0 + ai * HALF + m * 16) * 1024 + col0 + bj * HALF; *(f32x4*)d = acc[ai][bj][m][0]; *(f32x4*)(d + 4) = acc[ai][bj][m][1]; }
    }
};
struct EpiPartT {
    bf16* PART; int nm;
    __device__ __forceinline__ void operator()(const f32x4 (&acc)[2][2][4][2], const Unit& u, int wr, int wc, int fr, int fq) const {
        const int row0 = (u.pm - nm) * BM + wr * 64 + fr, col0 = (u.pn & 3) * BM + wc * 32 + 8 * fq; bf16* base = PART + (size_t)u.kc * 2048 * 1024;
#pragma unroll
        for (int ai = 0; ai < 2; ++ai)
#pragma unroll
            for (int m = 0; m < 4; ++m)
#pragma unroll
                for (int bj = 0; bj < 2; ++bj) { const f32x4 v0 = acc[ai][bj][m][0], v1 = acc[ai][bj][m][1]; u32x4 w; w.x = pk2s(v0[0], v0[1]); w.y = pk2s(v0[2], v0[3]); w.z = pk2s(v1[0], v1[1]); w.w = pk2s(v1[2], v1[3]);
                    *(u32x4*)(base + (size_t)(row0 + ai * HALF + m * 16) * 1024 + col0 + bj * HALF) = w; }
    }
};
template <class F> struct EpiGU {
    F f; int tiles_per_mat;
    __device__ __forceinline__ void operator()(const f32x4 (&acc)[2][2][4][2], const Unit& u, int wr, int wc, int fr, int fq) const {
        const int row0 = u.pm * BM + wr * 64 + fr, col0 = (u.pn % tiles_per_mat) * HALF + wc * 32 + 8 * fq;
#pragma unroll
        for (int ai = 0; ai < 2; ++ai)
#pragma unroll
            for (int m = 0; m < 4; ++m) {
                float o[8];
#pragma unroll
                for (int n = 0; n < 2; ++n)
#pragma unroll
                    for (int q = 0; q < 4; ++q) { const float gt = acc[ai][0][m][n][q], up = acc[ai][1][m][n][q]; o[n * 4 + q] = gt * __builtin_amdgcn_rcpf(1.f + __expf(-gt)) * up; }
                f(row0 + ai * HALF + m * 16, col0, o);
            }
    }
};
}

#define XB_TMO      128
#define XB_XCNT(j)  (256  + 64 * (j))
#define XB_XSUB(j)  (1280 + 64 * (j))
#define XB_XGEN(j)  (2304 + 64 * (j))
#define XB_TOP      3328
#define XB_TOPGEN   3392
#define XCD_BAR_WORDS 3456
#define XB_SPIN_CAP (1u << 18)
__device__ __forceinline__ unsigned xb_ld(unsigned* p)              { return __hip_atomic_load(p, __ATOMIC_RELAXED, __HIP_MEMORY_SCOPE_AGENT); }
__device__ __forceinline__ unsigned xb_add(unsigned* p, unsigned v) { return __hip_atomic_fetch_add(p, v, __ATOMIC_RELAXED, __HIP_MEMORY_SCOPE_AGENT); }
__device__ __forceinline__ unsigned xb_xcc_id() { return (unsigned)__builtin_amdgcn_s_getreg((3 << 11) | 20) & 0xFu; }
#define XB_SPIN(cond, bar) do { unsigned _sp = 0; while (cond) { __builtin_amdgcn_s_sleep(1); \
    if ((++_sp & 255u) == 0u) { if (xb_ld(&(bar)[XB_TMO])) break; if (_sp > XB_SPIN_CAP) { atomicAdd(&(bar)[XB_TMO], 1u); break; } } } } while (0)
struct XcdBarrier { unsigned* bar; unsigned x; volatile LAS unsigned* st; };
__device__ __forceinline__ XcdBarrier xcd_barrier_post(unsigned* bar, volatile LAS unsigned* st) {
    XcdBarrier b; b.bar = bar; b.x = xb_xcc_id(); b.st = st;
    if (threadIdx.x == 0) (void)xb_add(&bar[XB_XCNT(b.x)], 1u);
    return b;
}
__device__ __forceinline__ void xcd_barrier_complete(unsigned* bar, unsigned x, unsigned& nloc, unsigned& nx) {
    const unsigned G = gridDim.x * gridDim.y * gridDim.z;
    unsigned sum, cnt, mine, sp = 0u;
    for (;;) {
        sum = 0u; cnt = 0u; mine = 0u;
#pragma unroll
        for (unsigned j = 0; j < 16; ++j) { const unsigned c = xb_ld(&bar[XB_XCNT(j)]); sum += c; cnt += (c > 0u) ? 1u : 0u; mine = (j == x) ? c : mine; }
        if (sum == G) break;
        __builtin_amdgcn_s_sleep(1);
        if ((++sp & 255u) == 0u) { if (xb_ld(&bar[XB_TMO])) break; if (sp > XB_SPIN_CAP) { atomicAdd(&bar[XB_TMO], 1u); break; } }
    }
    nloc = mine > 0u ? mine : 1u; nx = cnt > 0u ? cnt : 1u;
}
__device__ __forceinline__ void xcd_barrier(const XcdBarrier& b) {
    asm volatile("s_waitcnt vmcnt(0)" ::: "memory");
    __syncthreads();
    if (threadIdx.x == 0) {
        unsigned* bar = b.bar;
        __builtin_amdgcn_s_waitcnt(0);
        unsigned nloc = b.st[0], nx = b.st[1];
        if (nloc == 0u) { xcd_barrier_complete(bar, b.x, nloc, nx); b.st[0] = nloc; b.st[1] = nx; }
        const unsigned old = xb_add(&bar[XB_XSUB(b.x)], 1u);
        const unsigned gen = old / nloc;
        if (old + 1u == (gen + 1u) * nloc) {
            __builtin_amdgcn_fence(__ATOMIC_RELEASE, "agent");
            asm volatile("s_waitcnt vmcnt(0)" ::: "memory");
            const unsigned og = xb_add(&bar[XB_TOP], 1u);
            const unsigned tg = og / nx;
            if (og + 1u == (tg + 1u) * nx) xb_add(&bar[XB_TOPGEN], 1u);
            else XB_SPIN(xb_ld(&bar[XB_TOPGEN]) == tg, bar);
            __builtin_amdgcn_fence(__ATOMIC_ACQUIRE, "agent");
            xb_add(&bar[XB_XGEN(b.x)], 1u);
            asm volatile("s_waitcnt vmcnt(0)" ::: "memory");
        } else {
            XB_SPIN(xb_ld(&bar[XB_XGEN(b.x)]) == gen, bar);
            __builtin_amdgcn_fence(__ATOMIC_ACQUIRE, "agent");
            asm volatile("s_waitcnt vmcnt(0)" ::: "memory");
        }
    }
    __syncthreads();
}

struct Args {
    const float* in[25];
    float* out; unsigned char* ws;
    int ph_lo, ph_hi;
};
enum { I_X = 0, I_C, I_CTX, I_CCTX, I_WMOD, I_BMOD, I_LN1, I_LN2, I_WIN, I_WG2, I_BG2, I_GLAG, I_QNG, I_WUQ, I_KVNG, I_WUKV, I_WOUT, I_FG, I_FU, I_FD, I_RW, I_EG, I_EU, I_ED, I_FNG };

struct Ctx {
    LAS unsigned char* lds; unsigned char* ldsg; unsigned char* ws; unsigned char* arena; const float* const* in; float* out;
    int tid, lane, wave, G, bid, vcu;
};

__device__ __forceinline__ int mod_row(int row) { return row < NLAT ? (row >> 13) : 2; }
__device__ __forceinline__ void row_bpos(int row, int& b, int& pos) { if (row < NLAT) { b = row >> 13; pos = row & (TT - 1); } else { const int r2 = row - NLAT; b = r2 >> 8; pos = TT + (r2 & 255); } }
__device__ __forceinline__ int chunk_row(int b, int a) { return a < 128 ? b * TT + a * 64 : NLAT + b * TC + (a - 128) * 64; }

template <class SrcFn>
__device__ __forceinline__ void transpose_item(const SrcFn& src, bf16* dst, int ldk, int k0, int n0, LAS float* scr, int lane) {
    float tv[64];
#pragma unroll
    for (int i = 0; i < 64; ++i) tv[i] = src(k0 + i, n0 + lane);
#pragma unroll
    for (int i = 0; i < 64; ++i) scr[i * 65 + lane] = tv[i];
    LDS_WAIT(); asm volatile("" ::: "memory");
    const int c = lane & 7;
#pragma unroll
    for (int j = 0; j < 8; ++j) { const int n = (lane >> 3) + 8 * j; const LAS float* s = scr + (8 * c) * 65 + n;
        u32x4 o; o.x = pk2(s[0 * 65], s[1 * 65]); o.y = pk2(s[2 * 65], s[3 * 65]); o.z = pk2(s[4 * 65], s[5 * 65]); o.w = pk2(s[6 * 65], s[7 * 65]);
        *(u32x4*)(dst + (size_t)(n0 + n) * ldk + k0 + 8 * c) = o; }
    LDS_WAIT(); asm volatile("" ::: "memory");
}
__device__ __forceinline__ void transpose_item_fast(const float* S, int ld, bf16* dst, int ldk, int k0, int n0, LAS float* scr, int lane, const float* rowscale = nullptr) {
    f32x4 v[16];
#pragma unroll
    for (int i = 0; i < 16; ++i) v[i] = __builtin_nontemporal_load((const f32x4*)(S + (size_t)(i * 4 + (lane >> 4)) * ld + (lane & 15) * 4));
    if (rowscale) {
#pragma unroll
        for (int i = 0; i < 16; ++i) v[i] *= rowscale[i * 4 + (lane >> 4)]; }
#pragma unroll
    for (int i = 0; i < 16; ++i) { LAS float* p = scr + (i * 4 + (lane >> 4)) * 65 + (lane & 15) * 4; p[0] = v[i].x; p[1] = v[i].y; p[2] = v[i].z; p[3] = v[i].w; }
    LDS_WAIT(); asm volatile("" ::: "memory");
    const int c = lane & 7;
#pragma unroll
    for (int j = 0; j < 8; ++j) { const int n = (lane >> 3) + 8 * j; const LAS float* s = scr + (8 * c) * 65 + n;
        u32x4 o; o.x = pk2(s[0 * 65], s[1 * 65]); o.y = pk2(s[2 * 65], s[3 * 65]); o.z = pk2(s[4 * 65], s[5 * 65]); o.w = pk2(s[6 * 65], s[7 * 65]);
        *(u32x4*)(dst + (size_t)(n0 + n) * ldk + k0 + 8 * c) = o; }
    LDS_WAIT(); asm volatile("" ::: "memory");
}
__device__ __forceinline__ int rope_unperm(int jj) { const int pair = jj >> 1, which = jj & 1; return pair < 16 ? pair + 16 * which : 32 + (pair - 16) + 16 * which; }
__device__ __forceinline__ int win_src_col(int n) {
    if (n < 1024) return n;
    if (n < 1536) return 1056 + (n - 1024);
    if (n < 1792) return 1568 + (n - 1536);
    if (n < 1920) return 1824 + (n - 1792);
    if (n < 1984) return 1952 + rope_unperm(n - 1920);
    if (n < 2000) return 1024 + (n - 1984);
    if (n < 2016) return 1040 + (n - 2000);
    return -1;
}

__device__ __forceinline__ void convert_weights(const Ctx& C, bool first, int gw, int NGW) {
    LAS float* scr = (LAS float*)(C.lds + C.wave * 16640);
    for (int l = 0; l < 2; ++l) {
        if (first == (l == 0))
        {
            const float* W = C.in[I_WIN] + (size_t)l * 1024 * 2016; bf16* dst = (bf16*)(C.arena + A_WIN) + (size_t)l * 2048 * 1024;
            auto f = [=](int k, int n) -> float { const int sc = win_src_col(n); return sc < 0 ? 0.f : W[(size_t)k * 2016 + sc]; };
            for (int it = gw; it < 16 * 32; it += NGW) { const int k0 = (it >> 5) * 64, n0 = (it & 31) * 64;
                if (n0 < 1920) transpose_item_fast(W + (size_t)k0 * 2016 + win_src_col(n0), 2016, dst, 1024, k0, n0, scr, C.lane);
                else transpose_item(f, dst, 1024, k0, n0, scr, C.lane); }
        }
        if (!first)
        {
            const float* Wq = C.in[I_WUQ] + (size_t)l * 256 * 768; const float* gq = C.in[I_QNG] + l * 256; const float* Wk = C.in[I_WUKV] + (size_t)l * 128 * 1024; const float* gk = C.in[I_KVNG] + l * 128;
            bf16* dst = (bf16*)(C.arena + A_WQKV) + (size_t)l * 1792 * 384;
            auto f = [=](int k, int n) -> float {
                if (n < 768) { if (k >= 256) return 0.f; const int h = n / 192, j = n % 192; const int sc = h * 192 + (j < 128 ? j : 128 + rope_unperm(j - 128)); return gq[k] * Wq[(size_t)k * 768 + sc]; }
                if (k < 256) return 0.f; return gk[k - 256] * Wk[(size_t)(k - 256) * 1024 + (n - 768)]; };
            for (int it = gw; it < 6 * 28; it += NGW) { const int k0 = (it % 6) * 64, n0 = (it / 6) * 64;
                const bool qcol = n0 < 768, qrow = k0 < 256;
                if (qcol != qrow) {
                    const int c = C.lane & 7;
#pragma unroll
                    for (int j = 0; j < 8; ++j) *(u32x4*)(dst + (size_t)(n0 + (C.lane >> 3) + 8 * j) * 384 + k0 + 8 * c) = (u32x4){0u, 0u, 0u, 0u};
                } else if (qcol && (n0 % 192) == 128) transpose_item(f, dst, 384, k0, n0, scr, C.lane);
                else if (qcol) transpose_item_fast(Wq + (size_t)k0 * 768 + n0, 768, dst, 384, k0, n0, scr, C.lane, gq + k0);
                else transpose_item_fast(Wk + (size_t)(k0 - 256) * 1024 + (n0 - 768), 1024, dst, 384, k0, n0, scr, C.lane, gk + (k0 - 256)); }
        }
        if (!first)
        {
            const float* W = C.in[I_WOUT] + (size_t)l * 1024 * 1024; bf16* dst = (bf16*)(C.arena + A_WOUT) + (size_t)l * 1024 * 1024;
            for (int it = gw; it < 16 * 16; it += NGW) { const int k0 = (it >> 4) * 64, n0 = (it & 15) * 64; transpose_item_fast(W + (size_t)k0 * 1024 + n0, 1024, dst, 1024, k0, n0, scr, C.lane); }
        }
    }
    if (!first)
    {
        bf16* dst = (bf16*)(C.arena + A_FGU);
        for (int it = gw; it < 16 * 88; it += NGW) { const int k0 = (it & 15) * 64, n0 = (it >> 4) * 64; const int tj = n0 >> 8, c = n0 & 255;
            const float* W = (c < 128) ? C.in[I_FG] : C.in[I_FU]; const int sc = tj * 128 + (c & 127);
            transpose_item_fast(W + (size_t)k0 * DFF + sc, DFF, dst, 1024, k0, n0, scr, C.lane); }
    }
    if (!first)
    {
        bf16* dst = (bf16*)(C.arena + A_FD); const float* W = C.in[I_FD];
        for (int it = gw; it < 44 * 16; it += NGW) { const int k0 = (it % 44) * 64, n0 = (it / 44) * 64; transpose_item_fast(W + (size_t)k0 * 1024 + n0, 1024, dst, DFF, k0, n0, scr, C.lane); }
    }
}
__device__ __forceinline__ void prologue(const Ctx& C) {
    convert_weights(C, true, C.vcu * 8 + C.wave, C.G * 8);
    __syncthreads();
    if (C.vcu < 6) {
        float* R = (float*)(C.ws + WS_ROPE);
        const int i = C.vcu * 512 + C.tid; const int j = i & 15, p = i >> 4; const int pos = p < 128 ? p : p - 128;
        const float inv = powf(10000.f, -(float)j / 16.f); const float ang = (float)pos * inv; R[2 * i] = cosf(ang); R[2 * i + 1] = sinf(ang);
    }
    for (int item = C.G - 1 - C.vcu; item < 192; item += C.G) {
        const int l = item / 96, cg = item % 96;
        LAS float* sil = (LAS float*)C.lds; LAS float* part = sil + 3 * 1024;
        for (int i = C.tid; i < 3 * 1024; i += 512) { const int v = i >> 10, k = i & 1023; const float x = v < 2 ? C.in[I_C][v * 1024 + k] : C.in[I_CCTX][k]; sil[i] = silu_f(x); }
        __syncthreads();
        const int rsub = C.lane >> 4, c4 = (C.lane & 15) * 4;
        f32x4 a0 = {0, 0, 0, 0}, a1 = a0, a2 = a0;
        const float* W = C.in[I_WMOD] + (size_t)l * 1024 * 6144 + cg * 64 + c4;
#pragma unroll 16
        for (int i = 0; i < 32; ++i) { const int k = C.wave * 128 + 4 * i + rsub; const f32x4 w = __builtin_nontemporal_load((const f32x4*)(W + (size_t)k * 6144));
            a0 += w * sil[k]; a1 += w * sil[1024 + k]; a2 += w * sil[2048 + k]; }
        LAS float* pp = part + (C.wave * 4 + rsub) * 192 + c4;
#pragma unroll
        for (int q = 0; q < 4; ++q) { pp[q] = a0[q]; pp[64 + q] = a1[q]; pp[128 + q] = a2[q]; }
        __syncthreads();
        if (C.tid < 192) { const int v = C.tid >> 6, c = C.tid & 63; float s = C.in[I_BMOD][l * 6144 + cg * 64 + c];
#pragma unroll
            for (int p = 0; p < 32; ++p) s += part[p * 192 + v * 64 + c];
            ((float*)(C.ws + WS_MOD))[(l * 3 + v) * 6144 + cg * 64 + c] = s; }
        __syncthreads();
    }
}

__device__ __forceinline__ void load_row16(const float* p, int lane, f32x4 (&v)[4]) {
#pragma unroll
    for (int j = 0; j < 4; ++j) v[j] = *(const f32x4*)(p + 256 * j + 4 * lane);
}
__device__ __forceinline__ void norm_mod_row(f32x4 (&v)[4], const float* g, const float* sc, const float* sh, int lane) {
    float ss = 0.f;
#pragma unroll
    for (int j = 0; j < 4; ++j) ss += (v[j].x * v[j].x + v[j].y * v[j].y) + (v[j].z * v[j].z + v[j].w * v[j].w);
    const float rs = 1.f / sqrtf(wave_sum(ss) * (1.f / DM) + EPS);
#pragma unroll
    for (int j = 0; j < 4; ++j) { const f32x4 gg = *(const f32x4*)(g + 256 * j + 4 * lane), s1 = *(const f32x4*)(sc + 256 * j + 4 * lane), s0 = *(const f32x4*)(sh + 256 * j + 4 * lane);
        v[j] = (v[j] * rs * gg) * (s1 + 1.f) + s0; }
}
__device__ __forceinline__ void store_row16_bf16(bf16* p, int lane, const f32x4 (&v)[4]) {
#pragma unroll
    for (int j = 0; j < 4; ++j) { u32x2 w; w.x = pk2(v[j].x, v[j].y); w.y = pk2(v[j].z, v[j].w); *(u32x2*)(p + 256 * j + 4 * lane) = w; }
}
__device__ __forceinline__ void load_row16_bf16(const bf16* p, int lane, f32x4 (&v)[4]) {
#pragma unroll
    for (int j = 0; j < 4; ++j) { const u32x2 w = *(const u32x2*)(p + 256 * j + 4 * lane); v[j] = (f32x4){bflo(w.x), bfhi(w.x), bflo(w.y), bfhi(w.y)}; }
}
__device__ __forceinline__ void load_xin_row(const Ctx& C, int layer, int row, f32x4 (&v)[4]) {
    if (layer == 0) load_row16(row < NLAT ? C.in[I_X] + (size_t)row * DM : C.in[I_CTX] + (size_t)(row - NLAT) * DM, C.lane, v);
    else load_row16_bf16((const bf16*)(C.ws + WS_XL) + (size_t)row * DM, C.lane, v);
}

__device__ __forceinline__ void phase_norm1(const Ctx& C, int layer) {
    const int gw = C.vcu * 8 + C.wave, NGW = C.G * 8;
    const float* g = C.in[I_LN1] + layer * DM; const float* MOD = (const float*)(C.ws + WS_MOD) + (size_t)layer * 3 * 6144; bf16* H = (bf16*)(C.ws + WS_H);
    for (int row = gw; row < MR; row += NGW) {
        f32x4 v[4]; load_xin_row(C, layer, row, v);
        if (layer == 1 && row >= NLAT) {
            const float* PART = (const float*)(C.arena + R_PART) + (size_t)(row - NLAT) * 1024; const float* g2c = (const float*)(C.ws + WS_MOD) + 2 * 6144 + 5 * 1024;
#pragma unroll
            for (int j = 0; j < 4; ++j) { f32x4 t[11];
#pragma unroll
                for (int c = 0; c < 11; ++c) t[c] = *(const f32x4*)(PART + (size_t)c * 512 * 1024 + 256 * j + 4 * C.lane);
                f32x4 acc = t[0];
#pragma unroll
                for (int c = 1; c < 11; ++c) acc += t[c];
                v[j] += *(const f32x4*)(g2c + 256 * j + 4 * C.lane) * acc; } }
        const float* m = MOD + mod_row(row) * 6144;
        norm_mod_row(v, g, m + 1024, m, C.lane);
        store_row16_bf16(H + (size_t)row * DM, C.lane, v);
    }
}

__device__ __forceinline__ void phase_norm2(const Ctx& C, int layer) {
    const int gw = C.vcu * 8 + C.wave, NGW = C.G * 8;
    const float* g = C.in[I_LN2] + layer * DM; const float* MOD = (const float*)(C.ws + WS_MOD) + (size_t)layer * 3 * 6144; bf16* H = layer == 0 ? (bf16*)(C.ws + WS_H) : (bf16*)(C.arena + M_HS);
    const bf16* XL = (const bf16*)(C.ws + WS_XL); int* LISTE = (int*)(C.arena + M_LISTE);
    const int nrow = layer == 0 ? MR : NLAT;
    unsigned* ctl = (unsigned*)(C.ws + WS_CTL);
    int* PE = (int*)(C.ws + WS_LIST); int* PS = PE + NLAT * 2; float* PWt = (float*)(PS + NLAT * 2);
    LAS unsigned* lcnt = (LAS unsigned*)(C.lds + 140000); LAS unsigned* gbase = lcnt + 8;
    const int maxit = (nrow + NGW - 1) / NGW;
    f32x4 rw[32];
    if (layer == 1) {
#pragma unroll
        for (int j = 0; j < 4; ++j)
#pragma unroll
            for (int q = 0; q < 4; ++q) { const float* RWp = C.in[I_RW] + (256 * j + 4 * C.lane + q) * 8; rw[(j * 4 + q) * 2] = *(const f32x4*)RWp; rw[(j * 4 + q) * 2 + 1] = *(const f32x4*)(RWp + 4); }
    }
    for (int b0 = 0; b0 < maxit; b0 += 64) {
        int my_e1 = 0, my_e2 = 0, my_row = -1; float my_d = 0.f;
        if (layer == 1) { if (C.tid < 8) lcnt[C.tid] = 0u; }
        const int b1 = (b0 + 64 < maxit) ? b0 + 64 : maxit;
        for (int it = b0; it < b1; ++it) {
            const int row = gw + it * NGW; if (row >= nrow) break;
            f32x4 v[4];
            if (layer == 0 && row >= NLAT) {
                load_row16(C.in[I_CTX] + (size_t)(row - NLAT) * DM, C.lane, v);
                const float* PART = (const float*)(C.arena + R_PART) + (size_t)(row - NLAT) * 1024; const float* g1c = MOD + 2 * 6144 + 2 * 1024;
#pragma unroll
                for (int j = 0; j < 4; ++j) { f32x4 t[4];
#pragma unroll
                    for (int c = 0; c < 4; ++c) t[c] = *(const f32x4*)(PART + (size_t)c * 512 * 1024 + 256 * j + 4 * C.lane);
                    const f32x4 acc = ((t[0] + t[1]) + t[2]) + t[3];
                    v[j] += *(const f32x4*)(g1c + 256 * j + 4 * C.lane) * acc; }
                store_row16_bf16((bf16*)(C.ws + WS_XL) + (size_t)row * DM, C.lane, v);
                load_row16_bf16(XL + (size_t)row * DM, C.lane, v);
            } else load_row16_bf16(XL + (size_t)row * DM, C.lane, v);
            const float* m = MOD + mod_row(row) * 6144;
            norm_mod_row(v, g, m + 4096, m + 3072, C.lane);
            store_row16_bf16(H + (size_t)row * DM, C.lane, v);
            if (layer == 1) {
                float lg[8];
#pragma unroll
                for (int e = 0; e < 8; ++e) lg[e] = 0.f;
#pragma unroll
                for (int j = 0; j < 4; ++j)
#pragma unroll
                    for (int q = 0; q < 4; ++q) { const f32x4 w0 = rw[(j * 4 + q) * 2], w1 = rw[(j * 4 + q) * 2 + 1]; const float x = v[j][q];
                        lg[0] += x * w0.x; lg[1] += x * w0.y; lg[2] += x * w0.z; lg[3] += x * w0.w; lg[4] += x * w1.x; lg[5] += x * w1.y; lg[6] += x * w1.z; lg[7] += x * w1.w; }
#pragma unroll
                for (int e = 0; e < 8; ++e) lg[e] = wave_sum(lg[e]);
                int e1 = 0; float v1 = lg[0];
#pragma unroll
                for (int e = 1; e < 8; ++e) if (lg[e] > v1) { v1 = lg[e]; e1 = e; }
                int e2 = -1; float v2 = -3.0e38f;
#pragma unroll
                for (int e = 0; e < 8; ++e) if (e != e1 && lg[e] > v2) { v2 = lg[e]; e2 = e; }
                if (C.lane == (it & 63)) { my_e1 = e1; my_e2 = e2; my_row = row; my_d = v2 - v1; }
            }
        }
        if (layer == 1) {
            __syncthreads();
            unsigned r1 = 0u, r2 = 0u;
            if (my_row >= 0) { r1 = __hip_atomic_fetch_add(lcnt + my_e1, 1u, __ATOMIC_RELAXED, __HIP_MEMORY_SCOPE_WORKGROUP); r2 = __hip_atomic_fetch_add(lcnt + my_e2, 1u, __ATOMIC_RELAXED, __HIP_MEMORY_SCOPE_WORKGROUP); }
            __syncthreads();
            if (C.tid < 8) { const unsigned n = lcnt[C.tid]; gbase[C.tid] = n ? atomicAdd(ctl + CW_CNT + 64 * C.tid, n) : 0u; }
            __syncthreads();
            if (my_row >= 0) {
                const float w1 = 1.f / (1.f + expf(my_d)), w2 = 1.f - w1;
                const unsigned s1 = gbase[my_e1] + r1, s2 = gbase[my_e2] + r2;
                PE[my_row * 2] = my_e1; PE[my_row * 2 + 1] = my_e2; PS[my_row * 2] = (int)s1; PS[my_row * 2 + 1] = (int)s2; PWt[my_row * 2] = w1; PWt[my_row * 2 + 1] = w2;
                LISTE[my_e1 * 16384 + (int)s1] = my_row * 2; LISTE[my_e2 * 16384 + (int)s2] = my_row * 2 + 1;
            }
            __syncthreads();
        }
    }
    if (layer == 1) {
        int* ENT = (int*)(C.ws + WS_LIST + AL((size_t)NLAT * 2 * 4 * 3));
        for (int i = C.vcu * 512 + C.tid; i < MAXT * 256; i += C.G * 512) ENT[i] = -1;
    }
}

__device__ __forceinline__ void convert_expert_gu(const Ctx& C, int gw, int NGW) {
    LAS float* scr = (LAS float*)(C.lds + C.wave * 16640); bf16* EGU = (bf16*)(C.arena + M_EGU);
    for (int it = gw; it < NEXP * 16 * 112; it += NGW) { const int e = it / (16 * 112), r = it % (16 * 112), k0 = (r & 15) * 64, n0 = (r >> 4) * 64; const int tj = n0 >> 8, c = n0 & 255;
        const float* W = ((c < 128) ? C.in[I_EG] : C.in[I_EU]) + (size_t)e * 1024 * DFE; const int sc = tj * 128 + (c & 127);
        transpose_item_fast(W + (size_t)k0 * DFE + sc, DFE, EGU + (size_t)e * 2 * DFE * 1024, 1024, k0, n0, scr, C.lane); }
}
__device__ __forceinline__ void convert_expert_down(const Ctx& C, int gw, int NGW) {
    LAS float* scr = (LAS float*)(C.lds + C.wave * 16640); bf16* ED = (bf16*)(C.ws + WS_ED);
    for (int it = gw; it < NEXP * 56 * 16; it += NGW) { const int e = it / (56 * 16), r = it % (56 * 16), k0 = (r % 56) * 64, n0 = (r / 56) * 64;
        const float* W = C.in[I_ED] + (size_t)e * DFE * 1024;
        transpose_item_fast(W + (size_t)k0 * 1024 + n0, 1024, ED + (size_t)e * 1024 * DFE, DFE, k0, n0, scr, C.lane); }
}

__device__ __forceinline__ void moe_tile_bases(const Ctx& C, int (&tb)[9]) {
    unsigned* ctl = (unsigned*)(C.ws + WS_CTL); int acc = 0;
#pragma unroll
    for (int e = 0; e < 8; ++e) { tb[e] = acc; const unsigned c = __hip_atomic_load(ctl + CW_CNT + 64 * e, __ATOMIC_RELAXED, __HIP_MEMORY_SCOPE_AGENT); acc += (int)((c + 255u) >> 8); }
    tb[8] = acc;
}
__device__ __forceinline__ void moe_fill_lists(const Ctx& C) {
    int tb[9]; moe_tile_bases(C, tb);
    const int* PE = (const int*)(C.ws + WS_LIST); const int* PS = PE + NLAT * 2; const float* PWt = (const float*)(PS + NLAT * 2);
    int* ENT = (int*)(C.ws + WS_LIST + AL((size_t)NLAT * 2 * 4 * 3)); float* WTS = (float*)(ENT + MAXT * 256); int* TAILROW = (int*)(C.ws + WS_LIST + AL((size_t)NLAT * 2 * 4 * 3) + AL((size_t)MAXT * 256 * 4 * 2));
    for (int pr = C.vcu * 512 + C.tid; pr < NLAT * 2; pr += C.G * 512) {
        const int e = PE[pr], s = PS[pr]; int base = 0;
#pragma unroll
        for (int k = 0; k < 8; ++k) base = (e == k) ? tb[k] : base;
        const int pos = base * 256 + s;
        ENT[pos] = pr; WTS[pos] = PWt[pr]; TAILROW[pr] = pos >= MOE_MAIN * 256 ? pos - MOE_MAIN * 256 : -1;
    }
}

__device__ __forceinline__ void moe_tail_reduce0(const Ctx& C) {
    const int gw = C.vcu * 8 + C.wave, NGW = C.G * 8;
    int tb[9]; moe_tile_bases(C, tb); const int ntail = tb[8] > MOE_MAIN ? tb[8] - MOE_MAIN : 0;
    const int* ENT = (const int*)(C.ws + WS_LIST + AL((size_t)NLAT * 2 * 4 * 3)); const float* WTS = (const float*)(ENT + MAXT * 256);
    const bf16* PART = (const bf16*)(C.arena + M_PT0); const float* gate = (const float*)(C.ws + WS_MOD) + (size_t)3 * 6144 + 5 * 1024;
    for (int r = gw; r < ntail * 256; r += NGW) {
        const int pos = MOE_MAIN * 256 + r, ent = ENT[pos]; const float w = WTS[pos];
        u32x2 t[4][MOE_NC0]; f32x4 gv[4];
#pragma unroll
        for (int j = 0; j < 4; ++j)
#pragma unroll
            for (int c = 0; c < MOE_NC0; ++c) t[j][c] = *(const u32x2*)(PART + ((size_t)c * 2048 + r) * 1024 + 256 * j + 4 * C.lane);
        if (ent < 0) continue;
        const int tok = ent >> 1; const float* g = gate + (tok >> 13) * 6144;
        bf16* Y = (bf16*)(C.ws + ((ent & 1) ? WS_H : WS_Y0)) + (size_t)tok * DM;
#pragma unroll
        for (int j = 0; j < 4; ++j) gv[j] = *(const f32x4*)(g + 256 * j + 4 * C.lane);
#pragma unroll
        for (int j = 0; j < 4; ++j) { f32x4 acc = {0.f, 0.f, 0.f, 0.f};
#pragma unroll
            for (int c = 0; c < MOE_NC0; ++c) acc += (f32x4){bflo(t[j][c].x), bfhi(t[j][c].x), bflo(t[j][c].y), bfhi(t[j][c].y)};
            const f32x4 y = gv[j] * w * acc; u32x2 o; o.x = pk2(y.x, y.y); o.y = pk2(y.z, y.w); *(u32x2*)(Y + 256 * j + 4 * C.lane) = o; }
    }
}
__device__ __forceinline__ void phase_final(const Ctx& C) {
    const int gw = C.vcu * 8 + C.wave, NGW = C.G * 8;
    const bf16* XL = (const bf16*)(C.ws + WS_XL); const bf16* Y2 = (const bf16*)(C.ws + WS_H); const bf16* Y0 = (const bf16*)(C.ws + WS_Y0); const float* g = C.in[I_FNG];
    const bf16* Y0b = (const bf16*)(C.arena + M_EGU); const bf16* Y2b = Y0b + (size_t)NLAT * DM;
    const int* TAILROW = (const int*)(C.ws + WS_LIST + AL((size_t)NLAT * 2 * 4 * 3) + AL((size_t)MAXT * 256 * 4 * 2)); const float* PWt = (const float*)(C.ws + WS_LIST) + NLAT * 4;
    const bf16* PART1 = (const bf16*)(C.arena + M_HS); const float* gate = (const float*)(C.ws + WS_MOD) + (size_t)3 * 6144 + 5 * 1024;
    const int maxit = (NLAT + NGW - 1) / NGW;
    for (int b0 = 0; b0 < maxit; b0 += 64) {
        int my_t0 = -1, my_t1 = -1;
        { const int r = gw + (b0 + C.lane) * NGW; if (b0 + C.lane < maxit && r < NLAT) { my_t0 = TAILROW[r * 2]; my_t1 = TAILROW[r * 2 + 1]; } }
        const int b1 = (b0 + 64 < maxit) ? b0 + 64 : maxit;
        for (int it = b0; it < b1; ++it) {
            const int row = gw + it * NGW; if (row >= NLAT) break;
            const int tr0 = __builtin_amdgcn_readlane(my_t0, it - b0), tr1 = __builtin_amdgcn_readlane(my_t1, it - b0);
            u32x2 xa[4], ya[4], za[4], pa[4], qa[4];
#pragma unroll
            for (int j = 0; j < 4; ++j) { const size_t o = (size_t)row * DM + 256 * j + 4 * C.lane;
                xa[j] = *(const u32x2*)(XL + o); ya[j] = *(const u32x2*)(Y2 + o); za[j] = *(const u32x2*)(Y0 + o);
                pa[j] = (u32x2){0u, 0u}; qa[j] = (u32x2){0u, 0u};
                if (tr0 < 0) pa[j] = *(const u32x2*)(Y0b + o);
                if (tr1 < 0) qa[j] = *(const u32x2*)(Y2b + o); }
            f32x4 v[4];
#pragma unroll
            for (int j = 0; j < 4; ++j) {
                v[j].x = bflo(xa[j].x) + (bflo(ya[j].x) + bflo(za[j].x)); v[j].y = bfhi(xa[j].x) + (bfhi(ya[j].x) + bfhi(za[j].x));
                v[j].z = bflo(xa[j].y) + (bflo(ya[j].y) + bflo(za[j].y)); v[j].w = bfhi(xa[j].y) + (bfhi(ya[j].y) + bfhi(za[j].y));
                v[j].x += bflo(pa[j].x); v[j].y += bfhi(pa[j].x); v[j].z += bflo(pa[j].y); v[j].w += bfhi(pa[j].y);
                v[j].x += bflo(qa[j].x); v[j].y += bfhi(qa[j].x); v[j].z += bflo(qa[j].y); v[j].w += bfhi(qa[j].y); }
#pragma unroll
            for (int k = 0; k < 2; ++k) { const int tr = k ? tr1 : tr0;
                if (tr >= 0) { const float w = PWt[row * 2 + k]; const float* gt = gate + (row >> 13) * 6144;
#pragma unroll
                    for (int j = 0; j < 4; ++j) { u32x2 t[MOE_NC1];
#pragma unroll
                        for (int c = 0; c < MOE_NC1; ++c) t[c] = *(const u32x2*)(PART1 + ((size_t)c * 2048 + tr) * 1024 + 256 * j + 4 * C.lane);
                        f32x4 acc = {0.f, 0.f, 0.f, 0.f};
#pragma unroll
                        for (int c = 0; c < MOE_NC1; ++c) acc += (f32x4){bflo(t[c].x), bfhi(t[c].x), bflo(t[c].y), bfhi(t[c].y)};
                        v[j] += *(const f32x4*)(gt + 256 * j + 4 * C.lane) * w * acc; } } }
            float ss = 0.f;
#pragma unroll
            for (int j = 0; j < 4; ++j) ss += (v[j].x * v[j].x + v[j].y * v[j].y) + (v[j].z * v[j].z + v[j].w * v[j].w);
            const float rs = 1.f / sqrtf(wave_sum(ss) * (1.f / DM) + EPS);
#pragma unroll
            for (int j = 0; j < 4; ++j) { const f32x4 gg = *(const f32x4*)(g + 256 * j + 4 * C.lane); *(f32x4*)(C.out + (size_t)row * DM + 256 * j + 4 * C.lane) = v[j] * rs * gg; }
        }
    }
}

__device__ __forceinline__ void phase_mla_prep(const Ctx& C, int gw, int NGW) {
    const bf16* P = (const bf16*)(C.arena + R_P); bf16* CQKV = (bf16*)(C.arena + R_CQKV); char* KBc = (char*)(C.arena + R_KB);
    const float* ROPE = (const float*)(C.ws + WS_ROPE);
    for (int row = gw; row < MR; row += NGW) {
        const bf16* pr = P + (size_t)row * PW;
        {   const u32x2 w = *(const u32x2*)(pr + PC_CQ + 4 * C.lane); float x0 = bflo(w.x), x1 = bfhi(w.x), x2 = bflo(w.y), x3 = bfhi(w.y);
            const float rs = 1.f / sqrtf(wave_sum(x0 * x0 + x1 * x1 + x2 * x2 + x3 * x3) * (1.f / 256.f) + EPS);
            u32x2 o; o.x = pk2(x0 * rs, x1 * rs); o.y = pk2(x2 * rs, x3 * rs); *(u32x2*)(CQKV + (size_t)row * 384 + 4 * C.lane) = o; }
        {   const unsigned w = *(const unsigned*)(pr + PC_CKV + 2 * C.lane); float x0 = bflo(w), x1 = bfhi(w);
            const float rs = 1.f / sqrtf(wave_sum(x0 * x0 + x1 * x1) * (1.f / 128.f) + EPS);
            *(unsigned*)(CQKV + (size_t)row * 384 + 256 + 2 * C.lane) = pk2(x0 * rs, x1 * rs); }
        {   float x = bf2f(pr[PC_KR + C.lane]); const float xo = __shfl_xor(x, 1);
            int b, pos; row_bpos(row, b, pos);
            if (row < NLAT) { const int pair = C.lane >> 1, fi = pair & 15, axis = pair >> 4; const int pidx = axis ? (pos & 63) : (pos >> 6);
                const float* cs = ROPE + ((axis ? 128 : 0) + pidx) * 32 + fi * 2; const float c = cs[0], s = cs[1];
                x = (C.lane & 1) ? (x * c + xo * s) : (x * c - xo * s); }
            const bf16 xb = (bf16)f2bf(x);
#pragma unroll
            for (int h = 0; h < 4; ++h) *(bf16*)(KBc + ((size_t)(b * 4 + h) * 132 + (pos >> 6)) * att::KT_BYTES + (16 + (C.lane >> 3)) * 1024 + (pos & 63) * 16 + (C.lane & 7) * 2) = xb; }
    }
}

__device__ __forceinline__ f32x4 mma16(bf16x8 a, bf16x8 b, f32x4 c) { return __builtin_amdgcn_mfma_f32_16x16x32_bf16(a, b, c, 0, 0, 0); }
constexpr int LS = 72;

__device__ __forceinline__ void phase_gla_local(const Ctx& C, int layer) {
    LAS float* codes = (LAS float*)C.lds;
    LAS float* bcum = codes + 64 * 32;
    LAS float* gsum = bcum + 2 * 64 * 64;
    LAS float* tot = gsum + 2 * 4 * 64;
    LAS bf16* vT = (LAS bf16*)(tot + 128);
    LAS bf16* khT = vT + 128 * LS;
    const bf16* P = (const bf16*)(C.arena + R_P);
    bf16* QT = (bf16*)(C.arena + R_QT); bf16* KT = (bf16*)(C.arena + R_KT);
    float* SLOC = (float*)(C.arena + R_SLOC); float* DEC = (float*)(C.arena + R_DEC);
    const float* WG2 = C.in[I_WG2] + (size_t)layer * 2 * 16 * 256; const float* BG2 = C.in[I_BG2] + (size_t)layer * 2 * 256;
    const int tid = C.tid, lane = C.lane;
    for (int L = C.bid; L < NB * NCH * 4; L += C.G) {
        const int h = L & 3, a = (L >> 2) % NCH, b = L / (NCH * 4);
        const int rbase = chunk_row(b, a);
        {
            const int t = tid >> 3, j4 = (tid & 7) * 4; const u32x2 w = *(const u32x2*)(P + (size_t)(rbase + t) * PW + PC_GF + j4);
            LAS float* cp = codes + t * 32 + j4; cp[0] = bflo(w.x); cp[1] = bfhi(w.x); cp[2] = bflo(w.y); cp[3] = bfhi(w.y);
            const int e0 = (tid & 7) * 16; const bf16* vp = P + (size_t)(rbase + t) * PW + PC_V + h * 128 + e0;
            const u32x4 v0 = *(const u32x4*)vp, v1 = *(const u32x4*)(vp + 8); bf16 vr[16]; unpack8_raw(v0, vr); unpack8_raw(v1, vr + 8);
#pragma unroll
            for (int i = 0; i < 16; ++i) vT[(e0 + i) * LS + t] = vr[i];
        }
        __syncthreads();
        const int dir = tid >> 8, tg = (tid >> 6) & 3, d = tid & 63;
        {
            float w[16];
#pragma unroll
            for (int r = 0; r < 16; ++r) w[r] = WG2[(dir * 16 + r) * 256 + h * 64 + d];
            const float bias = BG2[dir * 256 + h * 64 + d];
            float acc = 0.f;
#pragma unroll
            for (int ii = 0; ii < 16; ++ii) { const int i = dir ? 15 - ii : ii; const int t = tg * 16 + i; float pre = bias;
#pragma unroll
                for (int r4 = 0; r4 < 4; ++r4) { const f32x4 cv = *(const LAS f32x4*)(codes + t * 32 + dir * 16 + 4 * r4); pre += cv.x * w[4 * r4] + cv.y * w[4 * r4 + 1] + cv.z * w[4 * r4 + 2] + cv.w * w[4 * r4 + 3]; }
                acc += logsig_f(pre) * (1.f / 16.f); bcum[(dir * 64 + t) * 64 + d] = acc; }
            gsum[(dir * 4 + tg) * 64 + d] = acc;
        }
        __syncthreads();
        {   float off = 0.f, total = 0.f;
#pragma unroll
            for (int g2 = 0; g2 < 4; ++g2) { const float s = gsum[(dir * 4 + g2) * 64 + d]; total += s; if (dir ? (g2 > tg) : (g2 < tg)) off += s; }
#pragma unroll
            for (int i = 0; i < 16; ++i) bcum[(dir * 64 + tg * 16 + i) * 64 + d] += off;
            if (tg == 0) tot[dir * 64 + d] = __expf(total);
        }
        __syncthreads();
        {
            const int t = (tid >> 2) & 63, d0 = (tid & 3) * 16; const size_t row = (size_t)(rbase + t);
            const bf16* qp = P + row * PW + PC_Q + h * 64 + d0; const bf16* kp = P + row * PW + PC_K + h * 64 + d0;
            float q[16], k[16]; unpack8(*(const u32x4*)qp, q); unpack8(*(const u32x4*)(qp + 8), q + 8); unpack8(*(const u32x4*)kp, k); unpack8(*(const u32x4*)(kp + 8), k + 8);
            float qo[16], ko[16];
#pragma unroll
            for (int i = 0; i < 16; ++i) { const float eB = __expf(bcum[(dir * 64 + t) * 64 + d0 + i]), et = tot[dir * 64 + d0 + i];
                qo[i] = q[i] * 0.125f * eB; ko[i] = k[i] * __builtin_amdgcn_rcpf(eB); khT[(dir * 64 + d0 + i) * LS + t] = (bf16)f2bf(ko[i] * et); }
            bf16* qd = QT + ((size_t)dir * MR + row) * 256 + h * 64 + d0; bf16* kd = KT + ((size_t)dir * MR + row) * 256 + h * 64 + d0;
            *(u32x4*)qd = pack8h(qo); *(u32x4*)(qd + 8) = pack8h(qo + 8); *(u32x4*)kd = pack8h(ko); *(u32x4*)(kd + 8) = pack8h(ko + 8);
        }
        const int pf = a < 128 ? a + 4 : a - 128, pb = 131 - a;
        if (tid < 128) { const int dd = tid >> 6, d2 = tid & 63; const int chain = dd * 8 + b * 4 + h, p = dd ? pb : pf; DEC[((size_t)chain * NCH + p) * 64 + d2] = tot[dd * 64 + d2]; }
        __syncthreads();
        {
            const int fr = lane & 15, fq = lane >> 4;
#pragma unroll 2
            for (int i = 0; i < 8; ++i) { const int id = C.wave * 8 + i, dd = id >> 5, et = (id >> 2) & 7, dt = id & 3;
                f32x4 acc = {0.f, 0.f, 0.f, 0.f};
#pragma unroll
                for (int ks = 0; ks < 2; ++ks) { const bf16x8 av = *(const LAS bf16x8*)(vT + (et * 16 + fr) * LS + ks * 32 + fq * 8); const bf16x8 bv = *(const LAS bf16x8*)(khT + (dd * 64 + dt * 16 + fr) * LS + ks * 32 + fq * 8);
                    acc = mma16(av, bv, acc); }
                const int chain = dd * 8 + b * 4 + h, p = dd ? pb : pf; float* S = SLOC + ((size_t)chain * NCH + p) * 8192;
#pragma unroll
                for (int r = 0; r < 4; ++r) S[(et * 16 + fq * 4 + r) * 64 + dt * 16 + fr] = acc[r]; }
        }
        __syncthreads();
    }
}

__device__ __forceinline__ void phase_gla_scan(const Ctx& C) {
    const float* SLOC = (const float*)(C.arena + R_SLOC); const float* DEC = (const float*)(C.arena + R_DEC); bf16* SST = (bf16*)(C.arena + R_SST);
    for (int idx = C.bid * 512 + C.tid; idx < 16 * 8192; idx += C.G * 512) {
        const int chain = idx >> 13, el = idx & 8191, d = el & 63;
        const float* sl = SLOC + (size_t)chain * NCH * 8192 + el; const float* dc = DEC + (size_t)chain * NCH * 64 + d; bf16* so = SST + (size_t)chain * NCH * 8192 + el;
        float S = 0.f;
#pragma unroll 1
        for (int p0 = 0; p0 < NCH; p0 += 44) {
            float x[44], g[44];
#pragma unroll
            for (int i = 0; i < 44; ++i) { x[i] = sl[(size_t)(p0 + i) * 8192]; g[i] = dc[(p0 + i) * 64]; }
#pragma unroll
            for (int i = 0; i < 44; ++i) { so[(size_t)(p0 + i) * 8192] = (bf16)f2bf(S); S = S * g[i] + x[i]; }
        }
    }
}

__device__ __forceinline__ void phase_gla_out(const Ctx& C, int layer) {
    LAS bf16* qf = (LAS bf16*)C.lds; LAS bf16* kf = qf + 64 * LS; LAS bf16* qb = kf + 64 * LS; LAS bf16* kb = qb + 64 * LS;
    LAS bf16* vT = kb + 64 * LS;
    LAS bf16* SfT = vT + 128 * LS; LAS bf16* SbT = SfT + 128 * LS;
    LAS bf16* As = SbT + 128 * LS;
    LAS float* O = (LAS float*)(As + 64 * LS);
    const bf16* P = (const bf16*)(C.arena + R_P); const bf16* QT = (const bf16*)(C.arena + R_QT); const bf16* KT = (const bf16*)(C.arena + R_KT);
    const bf16* SST = (const bf16*)(C.arena + R_SST); bf16* MIX = (bf16*)(C.arena + R_MIX);
    const float* GG = C.in[I_GLAG] + layer * 128;
    const int tid = C.tid, lane = C.lane, fr = lane & 15, fq = lane >> 4;
    const int na = layer == 0 ? NCH : 128;
    const int nskip = (layer == 0 && C.G > 16) ? 8 : 0;
    if (C.bid < nskip) return;
    for (int L = C.G - 1 - C.bid; L < NB * na * 4; L += C.G - nskip) {
        const int h = L & 3, a = (L >> 2) % na, b = L / (na * 4);
        const int rbase = chunk_row(b, a);
        const int pf = a < 128 ? a + 4 : a - 128, pb = 131 - a;
        {
            const int which = tid >> 7, t = (tid >> 1) & 63, hf = tid & 1; const int dd = which >> 1;
            const bf16* src = ((which & 1) ? KT : QT) + ((size_t)dd * MR + rbase + t) * 256 + h * 64 + hf * 32;
            LAS bf16* dst = (which == 0 ? qf : which == 1 ? kf : which == 2 ? qb : kb) + t * LS + hf * 32;
#pragma unroll
            for (int i = 0; i < 4; ++i) *(LAS u32x4*)(dst + 8 * i) = *(const u32x4*)(src + 8 * i);
        }
        {
            const int t = tid >> 3, e0 = (tid & 7) * 16; const bf16* vp = P + (size_t)(rbase + t) * PW + PC_V + h * 128 + e0;
            const u32x4 v0 = *(const u32x4*)vp, v1 = *(const u32x4*)(vp + 8); bf16 vr[16]; unpack8_raw(v0, vr); unpack8_raw(v1, vr + 8);
#pragma unroll
            for (int i = 0; i < 16; ++i) vT[(e0 + i) * LS + t] = vr[i];
        }
        {
            const int dd = tid >> 8, e = (tid >> 1) & 127, hf = tid & 1; const int chain = dd * 8 + b * 4 + h, p = dd ? pb : pf;
            const bf16* src = SST + ((size_t)chain * NCH + p) * 8192 + e * 64 + hf * 32; LAS bf16* dst = (dd ? SbT : SfT) + e * LS + hf * 32;
#pragma unroll
            for (int i = 0; i < 4; ++i) *(LAS u32x4*)(dst + 8 * i) = *(const u32x4*)(src + 8 * i);
        }
        __syncthreads();
        {
#pragma unroll
            for (int i = 0; i < 2; ++i) { const int pos = C.wave * 2 + i, ti = pos >> 2, si = pos & 3;
                f32x4 af = {0.f, 0.f, 0.f, 0.f}, ab = af;
#pragma unroll
                for (int ks = 0; ks < 2; ++ks) {
                    const bf16x8 a1 = *(const LAS bf16x8*)(qf + (ti * 16 + fr) * LS + ks * 32 + fq * 8), b1 = *(const LAS bf16x8*)(kf + (si * 16 + fr) * LS + ks * 32 + fq * 8);
                    const bf16x8 a2 = *(const LAS bf16x8*)(qb + (ti * 16 + fr) * LS + ks * 32 + fq * 8), b2 = *(const LAS bf16x8*)(kb + (si * 16 + fr) * LS + ks * 32 + fq * 8);
                    af = mma16(a1, b1, af); ab = mma16(a2, b2, ab); }
#pragma unroll
                for (int r = 0; r < 4; ++r) { const int t = ti * 16 + fq * 4 + r, s = si * 16 + fr; const float val = (s <= t ? af[r] : 0.f) + (s >= t ? ab[r] : 0.f); As[t * LS + s] = (bf16)f2bf(val); } }
        }
        __syncthreads();
        {
#pragma unroll 2
            for (int i = 0; i < 4; ++i) { const int id = C.wave * 4 + i, tt = id >> 3, et = id & 7;
                f32x4 acc = {0.f, 0.f, 0.f, 0.f};
#pragma unroll
                for (int ks = 0; ks < 2; ++ks) {
                    const bf16x8 bv = *(const LAS bf16x8*)(vT + (et * 16 + fr) * LS + ks * 32 + fq * 8);
                    acc = mma16(*(const LAS bf16x8*)(As + (tt * 16 + fr) * LS + ks * 32 + fq * 8), bv, acc);
                    acc = mma16(*(const LAS bf16x8*)(qf + (tt * 16 + fr) * LS + ks * 32 + fq * 8), *(const LAS bf16x8*)(SfT + (et * 16 + fr) * LS + ks * 32 + fq * 8), acc);
                    acc = mma16(*(const LAS bf16x8*)(qb + (tt * 16 + fr) * LS + ks * 32 + fq * 8), *(const LAS bf16x8*)(SbT + (et * 16 + fr) * LS + ks * 32 + fq * 8), acc); }
#pragma unroll
                for (int r = 0; r < 4; ++r) O[(tt * 16 + fq * 4 + r) * 132 + et * 16 + fr] = acc[r]; }
        }
        __syncthreads();
        {
            const int t = tid >> 3, e0 = (tid & 7) * 16; float o[16], ss = 0.f;
#pragma unroll
            for (int i = 0; i < 16; ++i) { o[i] = O[t * 132 + e0 + i]; ss += o[i] * o[i]; }
            ss += __shfl_xor(ss, 1); ss += __shfl_xor(ss, 2); ss += __shfl_xor(ss, 4);
            const float rs = 1.f / sqrtf(ss * (1.f / 128.f) + EPS);
            const size_t row = (size_t)(rbase + t); const bf16* rp = P + row * PW + PC_R + h * 128 + e0; float rv[16]; unpack8(*(const u32x4*)rp, rv); unpack8(*(const u32x4*)(rp + 8), rv + 8);
#pragma unroll
            for (int i = 0; i < 16; ++i) o[i] = o[i] * rs * GG[e0 + i] * silu_f(rv[i]);
            bf16* mp = MIX + row * DM + h * 128 + e0; *(u32x4*)mp = pack8h(o); *(u32x4*)(mp + 8) = pack8h(o + 8);
        }
        __syncthreads();
    }
}

namespace att {
constexpr int NW = 8, QBLK = 32, KVBLK = 64;
constexpr float THR = 8.f;
constexpr int OFF_K = 0, OFF_V = 2 * KT_BYTES, OFF_WS = OFF_V + 2 * VT_BYTES, OFF_QR = OFF_WS + NW * 64 * 4, SHM_ATTN = OFF_QR + NW * 4096;
#define SBAR() __builtin_amdgcn_sched_barrier(0)
__device__ __forceinline__ int crow(int r, int hi) { return (r & 3) + 8 * (r >> 2) + 4 * hi; }
__device__ __forceinline__ unsigned cvtpk(float lo, float hi) { unsigned r; asm volatile("v_cvt_pk_bf16_f32 %0, %1, %2" : "=v"(r) : "v"(lo), "v"(hi)); return r; }
__device__ __forceinline__ void glds16(const void* gsrc, unsigned lds_dst) { unsigned keep;
    asm volatile("s_mov_b32 %0, m0\n\ts_mov_b32 m0, %2\n\ts_nop 0\n\tglobal_load_lds_dwordx4 %1, off\n\ts_mov_b32 m0, %0" : "=&s"(keep) : "v"(gsrc), "s"(lds_dst) : "memory"); }
__device__ __forceinline__ void partialSM(f32x16& p0, f32x16& p1, f32x16& negm, bool first, float& alpha) {
    constexpr float THRL = THR * 1.4426950408889634f;
    float pmax = p0[0];
#pragma unroll
    for (int r = 1; r < 16; ++r) pmax = fmaxf(pmax, p0[r]);
#pragma unroll
    for (int r = 0; r < 16; ++r) pmax = fmaxf(pmax, p1[r]);
    { auto rr = __builtin_amdgcn_permlane32_swap(__float_as_uint(pmax), __float_as_uint(pmax), false, false);
      pmax = fmaxf(__uint_as_float(rr[0]), __uint_as_float(rr[1])); }
    if (__builtin_expect(!first && __all(pmax <= THRL), 1)) { alpha = 1.f; }
    else { const float delta = first ? pmax : fmaxf(pmax, 0.f); alpha = first ? 1.f : __builtin_amdgcn_exp2f(-delta);
#pragma unroll
        for (int r = 0; r < 16; ++r) { p0[r] -= delta; p1[r] -= delta; negm[r] -= delta; } }
#pragma unroll
    for (int r = 0; r < 16; ++r) p0[r] = __builtin_amdgcn_exp2f(p0[r]);
}
__device__ __forceinline__ void finishSM(f32x16& p0, f32x16& p1, float alpha, float& l_reg, bf16x8& pa0, bf16x8& pa1, bf16x8& pa2, bf16x8& pa3) {
#pragma unroll
    for (int r = 0; r < 16; ++r) p1[r] = __builtin_amdgcn_exp2f(p1[r]);
    float ps = 0;
#pragma unroll
    for (int r = 0; r < 16; ++r) ps += p0[r];
#pragma unroll
    for (int r = 0; r < 16; ++r) ps += p1[r];
    { auto rr = __builtin_amdgcn_permlane32_swap(__float_as_uint(ps), __float_as_uint(ps), false, false);
      ps = __uint_as_float(rr[0]) + __uint_as_float(rr[1]); }
    l_reg = l_reg * alpha + ps;
#define PK4(P, BASE, OUT) do { unsigned a0 = cvtpk(P[BASE + 0], P[BASE + 1]), a1 = cvtpk(P[BASE + 2], P[BASE + 3]);   \
    unsigned b0 = cvtpk(P[BASE + 4], P[BASE + 5]), b1 = cvtpk(P[BASE + 6], P[BASE + 7]);                              \
    auto r0 = __builtin_amdgcn_permlane32_swap(a0, b0, false, false); auto r1 = __builtin_amdgcn_permlane32_swap(a1, b1, false, false); \
    u32x4 w = {r0[0], r1[0], r0[1], r1[1]}; OUT = *reinterpret_cast<bf16x8*>(&w); } while (0)
    PK4(p0, 0, pa0); PK4(p0, 8, pa1); PK4(p1, 0, pa2); PK4(p1, 8, pa3);
#undef PK4
}
__device__ __forceinline__ void qkt(f32x16& p0, f32x16& p1, const char* kl, const bf16x8* qr, const char* qrl, const f32x16& negm) {
    bf16x8 ka[8], kb[8], qv[4];
#define KLOAD(dst, g) do { _Pragma("unroll") for (int i = 0; i < 4; ++i) { dst[2 * i] = *reinterpret_cast<const bf16x8*>(kl + ((g) * 4 + i) * 2048); dst[2 * i + 1] = *reinterpret_cast<const bf16x8*>(kl + ((g) * 4 + i) * 2048 + 512); } } while (0)
    KLOAD(ka, 0); SBAR(); KLOAD(kb, 1);
#pragma unroll
    for (int i = 0; i < 4; ++i) qv[i] = *reinterpret_cast<const bf16x8*>(qrl + i * 1024);
    SBAR();
    p0 = __builtin_amdgcn_mfma_f32_32x32x16_bf16(ka[0], qr[0], negm, 0, 0, 0);
    p1 = __builtin_amdgcn_mfma_f32_32x32x16_bf16(ka[1], qr[0], negm, 0, 0, 0);
#pragma unroll
    for (int i = 1; i < 4; ++i) { p0 = __builtin_amdgcn_mfma_f32_32x32x16_bf16(ka[2 * i], qr[i], p0, 0, 0, 0); p1 = __builtin_amdgcn_mfma_f32_32x32x16_bf16(ka[2 * i + 1], qr[i], p1, 0, 0, 0); }
    SBAR(); KLOAD(ka, 2); SBAR();
#pragma unroll
    for (int i = 0; i < 4; ++i) { p0 = __builtin_amdgcn_mfma_f32_32x32x16_bf16(kb[2 * i], qr[4 + i], p0, 0, 0, 0); p1 = __builtin_amdgcn_mfma_f32_32x32x16_bf16(kb[2 * i + 1], qr[4 + i], p1, 0, 0, 0); }
    SBAR();
#pragma unroll
    for (int i = 0; i < 4; ++i) { p0 = __builtin_amdgcn_mfma_f32_32x32x16_bf16(ka[2 * i], qv[i], p0, 0, 0, 0); p1 = __builtin_amdgcn_mfma_f32_32x32x16_bf16(ka[2 * i + 1], qv[i], p1, 0, 0, 0); }
#undef KLOAD
}
__device__ __forceinline__ int v_rd_base(int lane) { return ((lane & 3) << 3) | (((lane >> 2) & 3) << 6) | (((lane >> 4) & 1) << 5) | (((lane >> 5) & 1) << 8); }
constexpr int v_rd_off(int d0, int ks, int half) { return d0 * 512 + ks * 4096 + half * 2048; }
template <int OFF> __device__ __forceinline__ s16x4 tr_read(int vb) {
    s16x4 r; asm volatile("ds_read_b64_tr_b16 %0, %1 offset:%2" : "=&v"(r) : "v"(vb), "i"(OFF) : "memory"); return r;
}
struct VFrag { s16x4 l0, h0, l1, h1, l2, h2, l3, h3; };
#define VF_WAIT(n, F) asm volatile("s_waitcnt lgkmcnt(" #n ")" : "+v"(F.l0), "+v"(F.h0), "+v"(F.l1), "+v"(F.h1), "+v"(F.l2), "+v"(F.h2), "+v"(F.l3), "+v"(F.h3) :: "memory")
template <int D0> __device__ __forceinline__ void v_reads(VFrag& f, int vb) {
    f.l0 = tr_read<v_rd_off(D0, 0, 0)>(vb); f.h0 = tr_read<v_rd_off(D0, 0, 1)>(vb); f.l1 = tr_read<v_rd_off(D0, 1, 0)>(vb); f.h1 = tr_read<v_rd_off(D0, 1, 1)>(vb);
    f.l2 = tr_read<v_rd_off(D0, 2, 0)>(vb); f.h2 = tr_read<v_rd_off(D0, 2, 1)>(vb); f.l3 = tr_read<v_rd_off(D0, 3, 0)>(vb); f.h3 = tr_read<v_rd_off(D0, 3, 1)>(vb);
}
__device__ __forceinline__ void pv_mma(f32x16& od, const VFrag& f, bf16x8 pa0, bf16x8 pa1, bf16x8 pa2, bf16x8 pa3) {
#define PKV(L, H) (bf16x8){L[0], L[1], L[2], L[3], H[0], H[1], H[2], H[3]}
    od = __builtin_amdgcn_mfma_f32_32x32x16_bf16(pa0, PKV(f.l0, f.h0), od, 0, 0, 0);
    od = __builtin_amdgcn_mfma_f32_32x32x16_bf16(pa1, PKV(f.l1, f.h1), od, 0, 0, 0);
    od = __builtin_amdgcn_mfma_f32_32x32x16_bf16(pa2, PKV(f.l2, f.h2), od, 0, 0, 0);
    od = __builtin_amdgcn_mfma_f32_32x32x16_bf16(pa3, PKV(f.l3, f.h3), od, 0, 0, 0);
#undef PKV
}
__device__ __forceinline__ void pv_d0(f32x16* o, int vb, bf16x8 pa0, bf16x8 pa1, bf16x8 pa2, bf16x8 pa3) {
    VFrag fa, fb;
    v_reads<0>(fa, vb); v_reads<1>(fb, vb);
    VF_WAIT(8, fa); SBAR(); pv_mma(o[0], fa, pa0, pa1, pa2, pa3); SBAR();
    v_reads<2>(fa, vb);
    VF_WAIT(8, fb); SBAR(); pv_mma(o[1], fb, pa0, pa1, pa2, pa3); SBAR();
    v_reads<3>(fb, vb);
    VF_WAIT(8, fa); SBAR(); pv_mma(o[2], fa, pa0, pa1, pa2, pa3); SBAR();
    VF_WAIT(0, fb); SBAR(); pv_mma(o[3], fb, pa0, pa1, pa2, pa3);
}
__device__ __forceinline__ void attn_body(const bf16* __restrict__ Qb, const char* __restrict__ Kt, const char* __restrict__ Vt, bf16* __restrict__ Ob, int t0, int NT, char* lds, const float* __restrict__ ROPE, int qpos0) {
    int tid = threadIdx.x; asm volatile("" : "+v"(tid));
    const int wid = __builtin_amdgcn_readfirstlane(tid >> 6), lane = tid & 63, r32 = lane & 31, hi = lane >> 5, grp = wid >> 2;
    float* ws = (float*)(lds + OFF_WS) + wid * 64; float* li_l = ws; float* al_l = ws + 32;
    float l_reg = 0; f32x16 o[4] = {}; f32x16 negm = {}; bf16x8 qr[8];
    const bf16* Qw = Qb + (long)(wid * QBLK + r32) * 192 + hi * 8;
#pragma unroll
    for (int d0 = 0; d0 < 8; ++d0) qr[d0] = *reinterpret_cast<const bf16x8*>(Qw + d0 * 16);
    char* qrl = lds + OFF_QR + wid * 4096 + lane * 16;
#pragma unroll
    for (int d0 = 0; d0 < 4; ++d0) {
        const u32x4 w = *reinterpret_cast<const u32x4*>(Qw + 128 + d0 * 16); float v[8]; unpack8(w, v);
        if (qpos0 >= 0) { const int pos = qpos0 + wid * QBLK + r32;
#pragma unroll
            for (int q = 0; q < 4; ++q) { const int pair = d0 * 8 + hi * 4 + q, fi = pair & 15, axis = pair >> 4; const int pidx = axis ? (pos & 63) : (pos >> 6);
                const float* cs = ROPE + ((axis ? 128 : 0) + pidx) * 32 + fi * 2; const float c = cs[0], sn = cs[1]; const float x1 = v[2 * q], x2 = v[2 * q + 1];
                v[2 * q] = x1 * c - x2 * sn; v[2 * q + 1] = x2 * c + x1 * sn; } }
        *reinterpret_cast<u32x4*>(qrl + d0 * 1024) = pack8(v); }
    asm volatile("s_waitcnt vmcnt(0)" ::: "memory");
    const unsigned ldsb = (unsigned)(uintptr_t)lds;
    const char* Ktw = Kt + (size_t)t0 * KT_BYTES + lane * 16; const char* Vtw = Vt + (size_t)t0 * VT_BYTES + lane * 16;
#define ISSUE_K(j) do { _Pragma("unroll") for (int _i = 0; _i < 3; ++_i) { const int q = wid * 3 + _i; \
        glds16(Ktw + (size_t)(j) * KT_BYTES + q * 1024, __builtin_amdgcn_readfirstlane(ldsb + OFF_K + ((j) & 1) * KT_BYTES + q * 1024)); } } while (0)
#define ISSUE_V(j) do { _Pragma("unroll") for (int _i = 0; _i < 2; ++_i) { const int q = wid * 2 + _i; \
        glds16(Vtw + (size_t)(j) * VT_BYTES + q * 1024, __builtin_amdgcn_readfirstlane(ldsb + OFF_V + ((j) & 1) * VT_BYTES + q * 1024)); } } while (0)
#define STEP_PRE(s) do { __builtin_amdgcn_s_barrier(); SBAR(); const int _s = (s), _m = _s >> 1; issued = 0; \
        if (_m + 1 < NT) { if (_s & 1) { ISSUE_V(_m + 1); issued = 2; } else { ISSUE_K(_m + 1); issued = 3; } } SBAR(); } while (0)
#define STEP_POST() do { SBAR(); if (issued == 3) asm volatile("s_waitcnt vmcnt(3)" ::: "memory"); else if (issued == 2) asm volatile("s_waitcnt vmcnt(2)" ::: "memory"); else asm volatile("s_waitcnt vmcnt(0)" ::: "memory"); } while (0)
#define RESC(a) do { if (__any((a) < 1.f)) { if (hi == 0) al_l[r32] = (a); asm volatile("s_waitcnt lgkmcnt(0)" ::: "memory"); \
    _Pragma("unroll") for (int d = 0; d < 4; ++d) _Pragma("unroll") for (int r = 0; r < 16; ++r) o[d][r] *= al_l[crow(r, hi)]; } } while (0)
    const char* kl0 = lds + OFF_K + hi * 1024 + r32 * 16;
    const int vb0 = (int)ldsb + OFF_V + v_rd_base(lane);
    f32x16 p0, p1; float al = 1.f; bf16x8 pa0, pa1, pa2, pa3;
    ISSUE_K(0); ISSUE_V(0);
    if (NT > 1) { ISSUE_K(1); ISSUE_V(1); asm volatile("s_waitcnt vmcnt(5)" ::: "memory"); } else asm volatile("s_waitcnt vmcnt(0)" ::: "memory");
    __builtin_amdgcn_s_barrier(); SBAR();
    for (int j = 0; j < NT; ++j) {
        const int sl = j & 1;
        qkt(p0, p1, kl0 + sl * KT_BYTES, qr, qrl, negm);
        partialSM(p0, p1, negm, j == 0, al);
        RESC(al);
        finishSM(p0, p1, al, l_reg, pa0, pa1, pa2, pa3); SBAR();
        pv_d0(o, vb0 + sl * VT_BYTES, pa0, pa1, pa2, pa3);
        SBAR(); asm volatile("s_waitcnt vmcnt(0)" ::: "memory"); __builtin_amdgcn_s_barrier(); SBAR();
        if (j + 2 < NT) { ISSUE_K(j + 2); ISSUE_V(j + 2); }
    }
    if (hi == 0) li_l[r32] = l_reg; asm volatile("s_waitcnt lgkmcnt(0)" ::: "memory");
    float rli[16];
#pragma unroll
    for (int r = 0; r < 16; ++r) rli[r] = __builtin_amdgcn_rcpf(li_l[crow(r, hi)]);
    bf16* Ow = Ob + (long)(wid * QBLK) * DM;
#pragma unroll
    for (int r = 0; r < 16; ++r) { const int orow = crow(r, hi);
#pragma unroll
        for (int d0 = 0; d0 < 4; ++d0) Ow[(long)orow * DM + d0 * 32 + r32] = (bf16)f2bf(o[d0][r] * rli[r]); }
    __syncthreads();
#undef ISSUE_K
#undef ISSUE_V
#undef STEP_PRE
#undef STEP_POST
#undef RESC
}
}

__device__ __forceinline__ void phase_attention(const Ctx& C, int layer) {
    const bf16* QB = (const bf16*)(C.arena + R_QB); const char* KB = (const char*)(C.arena + R_KB); const char* VB = (const char*)(C.arena + R_VB); bf16* MIX = (bf16*)(C.arena + R_MIX);
    const float* ROPE = (const float*)(C.ws + WS_ROPE);
    const int nunit = layer == 0 ? 264 : 256;
    for (int L = C.bid; L < nunit; L += C.G) {
        const bool lat = L < 256; const int bh = lat ? (L & 7) : (L - 256), qb = L >> 3, b = bh >> 2, h = bh & 3;
        const int qrow = lat ? qb * 256 : TT, orow = lat ? b * TT + qb * 256 : NLAT + b * TC;
        att::attn_body(QB + ((size_t)bh * TKV + qrow) * 192, KB + (size_t)bh * 132 * att::KT_BYTES, VB + (size_t)bh * 132 * att::VT_BYTES, MIX + (size_t)orow * DM + 512 + h * 128,
                       lat ? 0 : 128, lat ? 132 : 4, (char*)C.ldsg, ROPE, lat ? qb * 256 : -1);
    }
}

struct FStoreP { bf16* P;
    __device__ __forceinline__ void operator()(int row, int col, f32x4 v0, f32x4 v1) const { u32x4 w; w.x = pk2h(v0[0], v0[1]); w.y = pk2h(v0[2], v0[3]); w.z = pk2h(v1[0], v1[1]); w.w = pk2h(v1[2], v1[3]); *(u32x4*)(P + (size_t)row * PW + col) = w; } };
struct FStoreQKV { bf16* QB; char* KB; char* VB; int coff;
    __device__ __forceinline__ void operator()(int row, int colx, f32x4 v0, f32x4 v1) const {
        const int col = colx + coff; int b, pos; row_bpos(row, b, pos);
        if (col < 768) { constexpr float QS = MLA_SCALE * 1.4426950408889634f; v0 = v0 * QS; v1 = v1 * QS; }
        u32x4 w; w.x = pk2h(v0[0], v0[1]); w.y = pk2h(v0[2], v0[3]); w.z = pk2h(v1[0], v1[1]); w.w = pk2h(v1[2], v1[3]);
        if (col < 768) { const int h = col / 192, j = col - h * 192; *(u32x4*)(QB + ((size_t)(b * 4 + h) * TKV + pos) * 192 + j) = w; }
        else { const int c2 = col - 768, h = c2 >> 8, j = c2 & 255; const size_t tile = (size_t)(b * 4 + h) * 132 + (pos >> 6); const int k = pos & 63;
            if (j < 128) *(u32x4*)(KB + tile * att::KT_BYTES + (j >> 3) * 1024 + k * 16) = w;
            else *(u32x4*)(VB + tile * att::VT_BYTES + att::v_st(k, j - 128)) = w; }
    } };
struct FResidual { const float* x; const float* ctx; bf16* XL; const float* gate; int layer0;
    __device__ __forceinline__ void operator()(int row, int col, f32x4 v0, f32x4 v1) const {
        const float* g = gate + mod_row(row) * 6144 + col; const f32x4 g0 = *(const f32x4*)g, g1 = *(const f32x4*)(g + 4);
        float r[8];
        if (layer0) { const float* src = (row < NLAT ? x + (size_t)row * DM : ctx + (size_t)(row - NLAT) * DM) + col; const f32x4 s0 = *(const f32x4*)src, s1 = *(const f32x4*)(src + 4);
            r[0] = s0[0]; r[1] = s0[1]; r[2] = s0[2]; r[3] = s0[3]; r[4] = s1[0]; r[5] = s1[1]; r[6] = s1[2]; r[7] = s1[3]; }
        else unpack8(*(const u32x4*)(XL + (size_t)row * DM + col), r);
        r[0] += g0[0] * v0[0]; r[1] += g0[1] * v0[1]; r[2] += g0[2] * v0[2]; r[3] += g0[3] * v0[3]; r[4] += g1[0] * v1[0]; r[5] += g1[1] * v1[1]; r[6] += g1[2] * v1[2]; r[7] += g1[3] * v1[3];
        *(u32x4*)(XL + (size_t)row * DM + col) = pack8h(r);
    } };
struct FStoreAct { bf16* ACT; int ld;
    __device__ __forceinline__ void operator()(int row, int col, const float* o) const { *(u32x4*)(ACT + (size_t)row * ld + col) = pack8h(o); } };
struct FMoeDown { const int* ENT; const float* WTS; bf16* Y0; bf16* Y2; const float* gate;
    __device__ __forceinline__ void operator()(int row, int colx, f32x4 v0, f32x4 v1) const {
        const int col = colx & (DM - 1);
        const int ent = ENT[row]; if (ent < 0) return;
        const int tok = ent >> 1; const float w = WTS[row]; const float* g = gate + (tok >> 13) * 6144 + col;
        const f32x4 a0 = *(const f32x4*)g * w * v0, a1 = *(const f32x4*)(g + 4) * w * v1;
        u32x4 o; o.x = pk2h(a0[0], a0[1]); o.y = pk2h(a0[2], a0[3]); o.z = pk2h(a1[0], a1[1]); o.w = pk2h(a1[2], a1[3]);
        *(u32x4*)(((ent & 1) ? Y2 : Y0) + (size_t)tok * DM + col) = o;
    } };

constexpr int PH_PER_LAYER = 13, PH_FINAL = 1 + 2 * PH_PER_LAYER, N_PHASES = PH_FINAL + 1;
__host__ __device__ constexpr bool phase_exists(int ph) { return ph == 0 || ph == PH_FINAL || (ph >= 1 && ph < PH_FINAL && ((((ph - 1) / PH_PER_LAYER) == 1 && ((ph - 1) % PH_PER_LAYER) != 7 && ((ph - 1) % PH_PER_LAYER) != 8) || (((ph - 1) / PH_PER_LAYER) == 0 && ((ph - 1) % PH_PER_LAYER) < 9))); }

#ifndef DBG_REP
#define DBG_REP(ph) 0
#endif
#ifndef DBG_DELAY
#define DBG_DELAY(ph) 0
#endif
#ifndef DBG_STOP
#define DBG_STOP 0
#endif
#ifndef DBG_SRC
#define DBG_SRC 0
#endif
__device__ __forceinline__ void phase_dump(const Ctx& C) {
    const int gw = C.vcu * 8 + C.wave, NGW = C.G * 8;
    for (int row = gw; row < NLAT; row += NGW) {
        float* o = C.out + (size_t)row * DM;
        if (DBG_SRC == 0) { const bf16* s = (const bf16*)(C.ws + WS_XL) + (size_t)row * DM; for (int c = C.lane; c < DM; c += 64) o[c] = bf2f(s[c]); }
        else { const bf16* s = DBG_SRC == 1 ? (const bf16*)(C.arena + R_MIX) + (size_t)row * DM : DBG_SRC == 2 ? (const bf16*)(C.ws + WS_H) + (size_t)row * DM
                             : DBG_SRC == 3 ? (const bf16*)(C.arena + R_P) + (size_t)row * PW : DBG_SRC == 4 ? (const bf16*)(C.arena + R_P) + (size_t)row * PW + 1024
                             : DBG_SRC == 5 ? (const bf16*)(C.arena + R_ACT) + (size_t)row * DFF : DBG_SRC == 6 ? (const bf16*)(C.arena + R_QT) + (size_t)row * 256
                             : (const bf16*)(C.arena + R_QB) + (size_t)row * 192;
            const int n = DBG_SRC == 6 ? 256 : DBG_SRC == 7 ? 192 : DM;
            for (int c = C.lane; c < DM; c += 64) o[c] = c < n ? bf2f(s[c]) : 0.f; }
    }
}
template <int PH, int SUB = 0> __device__ __forceinline__ void run_phase(const Ctx& C0) {
    Ctx C = C0; { int t = threadIdx.x; asm volatile("" : "+v"(t)); C.tid = t; C.lane = t & 63; C.wave = __builtin_amdgcn_readfirstlane(t >> 6); }
    constexpr int layer = (PH - 1) / PH_PER_LAYER, k = (PH - 1) % PH_PER_LAYER;
    const float* MODB = (const float*)(C.ws + WS_MOD);
    if constexpr (DBG_STOP > 0 && PH > DBG_STOP && PH != PH_FINAL) { }
    else if constexpr (DBG_STOP > 0 && PH == PH_FINAL) { phase_dump(C); }
    else if constexpr (PH == 0) { prologue(C); }
    else if constexpr (PH == PH_FINAL) { phase_final(C); }
    else if constexpr (k == 0) { phase_norm1(C, layer); }
    else if constexpr (k == 1) {
        pg8::Gemm g{(const bf16*)(C.ws + WS_H), (const bf16*)(C.arena + A_WIN) + (size_t)layer * 2048 * 1024, 1024, 1024, 1024};
        pg8::StaticOrder S; S.init(MR, PW, C.G, C.bid); pg8::Epi8<FStoreP> E{{(bf16*)(C.arena + R_P)}};
        pg8::gemm_phase(C.lds, g, S, E);
        if constexpr (layer == 0) { const int nfull = (MR / 256 * (PW / 256)) % C.G;
            if (C.bid >= nfull) convert_weights(C, false, (C.bid - nfull) * 8 + C.wave, (C.G - nfull) * 8); }
        else { const int nfull = (MR / 256 * (PW / 256)) % C.G;
            if (C.bid >= nfull) convert_expert_down(C, (C.bid - nfull) * 8 + C.wave, (C.G - nfull) * 8); }
    } else if constexpr (k == 2) {
        if (SUB != 2) phase_gla_local(C, layer);
        if (SUB != 1) {
            const int r5 = (NB * NCH * 4) % C.G;
            if (r5 == 0) phase_mla_prep(C, C.vcu * 8 + C.wave, C.G * 8);
            else if (C.bid >= r5) phase_mla_prep(C, (C.bid - r5) * 8 + C.wave, (C.G - r5) * 8); }
    } else if constexpr (k == 3) {
        if (SUB != 2) phase_gla_scan(C);
        if (SUB != 1)
        {
            const bf16* W = (const bf16*)(C.arena + A_WQKV) + (size_t)layer * 1792 * 384; const bf16* A = (const bf16*)(C.arena + R_CQKV);
#pragma unroll 1
            for (int pass = 0; pass < 2; ++pass) {
                int ps = pass; asm volatile("" : "+s"(ps));
                pg8::Gemm g{A + (ps ? 256 : 0), W + (ps ? (size_t)768 * 384 + 256 : 0), ps ? 128 : 256, 384, 384};
                pg8::StaticOrder S; S.init(ps ? MR : (layer == 0 ? MR : NLAT), ps ? 1024 : 768, C.G, C.bid);
                pg8::Epi8<FStoreQKV> E{{(bf16*)(C.arena + R_QB), (char*)(C.arena + R_KB), (char*)(C.arena + R_VB), ps ? 768 : 0}};
                pg8::gemm_phase(C.lds, g, S, E); }
        }
    } else if constexpr (k == 4) {
        if (SUB != 2) phase_gla_out(C, layer);
        if (SUB != 1) phase_attention(C, layer);
    } else if constexpr (k == 5) {
        pg8::Gemm g{(const bf16*)(C.arena + R_MIX), (const bf16*)(C.arena + A_WOUT) + (size_t)layer * 1024 * 1024, 1024, 1024, 1024};
        pg8::StaticOrder S; S.init(NLAT, DM, C.G, C.bid);
        pg8::Epi8<FResidual> E{{C.in[I_X], C.in[I_CTX], (bf16*)(C.ws + WS_XL), MODB + (size_t)layer * 3 * 6144 + 2 * 1024, layer == 0 ? 1 : 0}};
        pg8::gemm_phase(C.lds, g, S, E);
        if constexpr (layer == 0) {
            pg8::Gemm g2{(const bf16*)(C.arena + R_MIX), (const bf16*)(C.arena + A_WOUT), 256, 1024, 1024};
            pg8::CtxSplitOrder S2{4, C.G, C.bid}; pg8::EpiPart E2{(float*)(C.arena + R_PART)};
            pg8::gemm_phase(C.lds, g2, S2, E2); }
    } else if constexpr (k == 6) { phase_norm2(C, layer); if constexpr (layer == 1) convert_expert_gu(C, C.vcu * 8 + C.wave, C.G * 8); }
    else if constexpr (layer == 0 && k == 7) {
        pg8::Gemm g{(const bf16*)(C.ws + WS_H), (const bf16*)(C.arena + A_FGU), 1024, 1024, 1024};
        pg8::StaticOrder S; S.init(MR, 2 * DFF, C.G, C.bid); pg8::EpiGU<FStoreAct> E{{(bf16*)(C.arena + R_ACT), DFF}, 1 << 20};
        pg8::gemm_phase(C.lds, g, S, E);
    } else if constexpr (layer == 0 && k == 8) {
        pg8::Gemm g{(const bf16*)(C.arena + R_ACT), (const bf16*)(C.arena + A_FD), DFF, DFF, DFF};
        pg8::StaticOrder S; S.init(NLAT, DM, C.G, C.bid);
        pg8::Epi8<FResidual> E{{C.in[I_X], C.in[I_CTX], (bf16*)(C.ws + WS_XL), MODB + 5 * 1024, 0}};
        pg8::gemm_phase(C.lds, g, S, E);
        {
            pg8::Gemm g2{(const bf16*)(C.arena + R_ACT), (const bf16*)(C.arena + A_FD), 256, DFF, DFF};
            pg8::CtxSplitOrder S2{11, C.G, C.bid}; pg8::EpiPart E2{(float*)(C.arena + R_PART)};
            pg8::gemm_phase(C.lds, g2, S2, E2); }
    }
    else if constexpr (layer == 1 && (k == 9 || k == 11)) {
        constexpr int half = (k - 9) / 2;
        if constexpr (half == 1) moe_tail_reduce0(C);
        pg8::MoeGatherOrder S; moe_tile_bases(C, S.tb); S.ncol = half ? MOE_T1 : MOE_T0; S.tpe = 28; S.joff = half ? MOE_T0 : 0; S.G = C.G; S.c = C.bid;
        S.LISTE = (const int*)(C.arena + M_LISTE);
        { const unsigned* ctl = (const unsigned*)(C.ws + WS_CTL);
#pragma unroll
          for (int e = 0; e < 8; ++e) S.cnt[e] = (int)__hip_atomic_load(ctl + CW_CNT + 64 * e, __ATOMIC_RELAXED, __HIP_MEMORY_SCOPE_AGENT); }
        pg8::Gemm g{(const bf16*)(C.arena + M_HS), (const bf16*)(C.arena + M_EGU), 1024, 1024, 1024};
        pg8::EpiGU<FStoreAct> E{{(bf16*)(C.arena + M_ACT) - (size_t)(half ? MOE_K0 : 0), half ? MOE_K1 : MOE_K0}, 28};
        pg8::gemm_phase(C.lds, g, S, E);
        if constexpr (half == 0) moe_fill_lists(C);
    } else if constexpr (layer == 1 && (k == 10 || k == 12)) {
        constexpr int half = (k - 10) / 2;
        const int* ENT = (const int*)(C.ws + WS_LIST + AL((size_t)NLAT * 2 * 4 * 3)); const float* WTS = (const float*)(ENT + MAXT * 256);
        pg8::MoeTailOrder ST; moe_tile_bases(C, ST.tb); const int ntot = ST.tb[8];
        pg8::MoeOrder S;
#pragma unroll
        for (int e = 0; e < 9; ++e) S.tb[e] = ST.tb[e] < MOE_MAIN ? ST.tb[e] : MOE_MAIN;
        S.ncol = 4; S.tpe = 4; S.joff = 0; S.G = C.G; S.c = C.bid;
        constexpr int KP = half ? MOE_K1 : MOE_K0;
        pg8::Gemm g{(const bf16*)(C.arena + M_ACT), (const bf16*)(C.ws + WS_ED) + (size_t)(half ? MOE_K0 : 0), KP, KP, DFE};
        pg8::Epi8<FMoeDown> E{{ENT, WTS, half ? (bf16*)(C.arena + M_EGU) : (bf16*)(C.ws + WS_Y0), half ? (bf16*)(C.arena + M_EGU) + (size_t)NLAT * DM : (bf16*)(C.ws + WS_H), MODB + (size_t)3 * 6144 + 5 * 1024}};
        pg8::gemm_phase(C.lds, g, S, E);
        if (ntot > MOE_MAIN) {
            constexpr int KC = half ? MOE_C1 : MOE_C0;
            ST.nm = MOE_MAIN; ST.ntail = ntot - MOE_MAIN; ST.nchunk = half ? MOE_NC1 : MOE_NC0; ST.G = C.G; ST.c = C.bid;
            pg8::Gemm g2{(const bf16*)(C.arena + M_ACT), (const bf16*)(C.ws + WS_ED) + (size_t)(half ? MOE_K0 : 0), KC, KP, DFE};
            pg8::EpiPartT E2{half ? (bf16*)(C.arena + M_HS) : (bf16*)(C.arena + M_PT0), MOE_MAIN};
            pg8::gemm_phase(C.lds, g2, ST, E2); }
    }
}

__device__ __forceinline__ void make_ctx(Ctx& C, const Args& args, unsigned char* lds_raw) {
    C.lds = (LAS unsigned char*)lds_raw; C.ldsg = lds_raw; C.ws = args.ws; C.arena = args.ws + WS_ARENA; C.in = args.in; C.out = args.out;
    C.tid = threadIdx.x; C.lane = C.tid & 63; C.wave = __builtin_amdgcn_readfirstlane(C.tid >> 6);
    C.G = gridDim.x; C.bid = blockIdx.x; C.vcu = (C.G % 8 == 0) ? (C.bid % 8) * (C.G / 8) + C.bid / 8 : C.bid;
}

template <int PH> __device__ __forceinline__ void run_from(const Ctx& C, const XcdBarrier& bar) {
    if constexpr (PH < N_PHASES) {
        if constexpr (phase_exists(PH)) {
            unsigned long long t0_ = 0; if constexpr (DBG_DELAY(PH) != 0) t0_ = __builtin_amdgcn_s_memrealtime();
            run_phase<PH>(C); if constexpr (PH != PH_FINAL) xcd_barrier(bar);
            if constexpr (DBG_DELAY(PH) != 0) { const unsigned long long t1_ = __builtin_amdgcn_s_memrealtime(); while (__builtin_amdgcn_s_memrealtime() - t1_ < t1_ - t0_) __builtin_amdgcn_s_sleep(8); __syncthreads(); }
            if constexpr (DBG_REP(PH) > 0) { run_phase<PH, DBG_REP(PH) - 1>(C); xcd_barrier(bar); } }
        run_from<PH + 1>(C, bar);
    }
}

#if !MK_PER_PHASE
__global__ void __launch_bounds__(512, 2) mega_fwd(Args args) {
    extern __shared__ __attribute__((aligned(16))) unsigned char lds_raw[];
    Ctx C; make_ctx(C, args, lds_raw);
    volatile LAS unsigned* MISC = (volatile LAS unsigned*)(C.lds + MISC_OFF);
    if (C.tid < 64) MISC[C.tid] = 0u;
    __syncthreads();
    unsigned* ctl = (unsigned*)(C.ws + WS_CTL);
    const XcdBarrier bar = xcd_barrier_post(ctl + CW_BAR, MISC + 8);
    run_from<0>(C, bar);
}
#else
template <int PH> __global__ void __launch_bounds__(512, 2) phase_kernel(Args args) {
    extern __shared__ __attribute__((aligned(16))) unsigned char lds_raw[];
    Ctx C; make_ctx(C, args, lds_raw);
    run_phase<PH>(C);
}
template <int PH> void launch_from(int grid, hipStream_t stream, const Args& a) {
    if constexpr (PH < N_PHASES) {
        if constexpr (phase_exists(PH)) {
            (void)hipFuncSetAttribute((const void*)phase_kernel<PH>, hipFuncAttributeMaxDynamicSharedMemorySize, LDS_BYTES);
            hipLaunchKernelGGL(phase_kernel<PH>, dim3(grid), dim3(512), LDS_BYTES, stream, a);
        }
        launch_from<PH + 1>(grid, stream, a);
    }
}
#endif

extern "C" void kernel_launch(void* const* d_in, const int* in_sizes, int n_in, void* d_out, int out_size, void* d_ws, size_t ws_size, hipStream_t stream) {
    static int grid = 0;
    if (grid == 0) {
        if (n_in != 25 || out_size != NLAT * DM || ws_size < WS_END) { fprintf(stderr, "kernel_launch: unexpected shapes (n_in %d, out %d, ws %zu < %zu); nothing launched\n", n_in, out_size, ws_size, (size_t)WS_END); grid = -1; return; }
        int dev = 0, cus = 0;
        if (hipGetDevice(&dev) != hipSuccess || hipDeviceGetAttribute(&cus, hipDeviceAttributeMultiprocessorCount, dev) != hipSuccess) { grid = -1; return; }
#if !MK_PER_PHASE
        if (hipFuncSetAttribute((const void*)mega_fwd, hipFuncAttributeMaxDynamicSharedMemorySize, LDS_BYTES) != hipSuccess) { fprintf(stderr, "kernel_launch: hipFuncSetAttribute failed\n"); grid = -1; return; }
        int per_cu = 0;
        if (hipOccupancyMaxActiveBlocksPerMultiprocessor(&per_cu, (const void*)mega_fwd, 512, LDS_BYTES) != hipSuccess || per_cu < 1) { fprintf(stderr, "kernel_launch: occupancy query reports %d blocks per CU\n", per_cu); }
        (void)hipGetLastError();
#endif
        grid = cus;
    }
    if (grid < 0) return;
    if (hipMemsetAsync((char*)d_ws + WS_CTL, 0, CTL_BYTES, stream) != hipSuccess) return;
    Args a{};
    for (int i = 0; i < 25; ++i) a.in[i] = (const float*)d_in[i];
    a.out = (float*)d_out; a.ws = (unsigned char*)d_ws;
#if MK_PER_PHASE
    launch_from<0>(grid, stream, a);
#else
    hipLaunchKernelGGL(mega_fwd, dim3(grid), dim3(512), LDS_BYTES, stream, a);
#endif
    const hipError_t le = hipPeekAtLastError();
    if (le != hipSuccess) fprintf(stderr, "kernel_launch: launch failed: %s\n", hipGetErrorName(le));
}
```

```cpp
#include <hip/hip_runtime.h>
#include <cstdio>
#include <cstdint>

#define LAS __attribute__((address_space(3)))
#define GAS __attribute__((address_space(1)))
typedef unsigned short bf16;
typedef short bf16x8 __attribute__((ext_vector_type(8)));
typedef short s16x4 __attribute__((ext_vector_type(4)));
typedef float f32x2 __attribute__((ext_vector_type(2)));
typedef float f32x4 __attribute__((ext_vector_type(4)));
typedef float f32x16 __attribute__((ext_vector_type(16)));
typedef unsigned u32x2 __attribute__((ext_vector_type(2)));
typedef unsigned u32x4 __attribute__((ext_vector_type(4)));

#ifndef MK_PER_PHASE
#define MK_PER_PHASE 0
#endif

constexpr int DM = 1024, NB = 2, TT = 8192, TC = 256, NLAT = NB * TT, NCTXR = NB * TC, MR = NLAT + NCTXR;
constexpr int TKV = TT + TC;
constexpr int PW = 2048;
constexpr int PC_Q = 0, PC_K = 256, PC_V = 512, PC_R = 1024, PC_CQ = 1536, PC_CKV = 1792, PC_KR = 1920, PC_GF = 1984, PC_GB = 2000;
constexpr int NCH = 132;
constexpr int DFF = 2816, DFE = 3584, NEXP = 8;
constexpr int MOE_T0 = 15, MOE_T1 = 28 - MOE_T0, MOE_K0 = MOE_T0 * 128, MOE_K1 = MOE_T1 * 128;
constexpr int MOE_MAIN = 128, MOE_C0 = 384, MOE_NC0 = 5, MOE_C1 = 128, MOE_NC1 = 13;
constexpr int MAXT = 136;
constexpr float EPS = 1e-6f;
constexpr float MLA_SCALE = 0.07216878364870322f;
namespace att {
constexpr int KT_BYTES = 24576, VT_BYTES = 16384;
__host__ __device__ __forceinline__ int v_st(int k, int c) { const int kk = (k & ~0xC) | ((k & 4) << 1) | ((k & 8) >> 1); return ((kk >> 3) * 4 + (c >> 5)) * 512 + ((kk & 7) * 32 + (c & 31)) * 2; }
}

constexpr size_t AL(size_t x) { return (x + 255) & ~(size_t)255; }
constexpr size_t WS_CTL = 0, CTL_BYTES = 65536;
constexpr size_t WS_MOD = WS_CTL + CTL_BYTES;
constexpr size_t WS_ROPE = WS_MOD + AL(2 * 3 * 6144 * 4);
constexpr size_t WS_XL = WS_ROPE + AL((128 + 64) * 32 * 4);
constexpr size_t WS_H = WS_XL + AL((size_t)MR * DM * 2);
constexpr size_t WS_LIST = WS_H + AL((size_t)MR * DM * 2);
constexpr size_t LIST_BYTES = AL((size_t)NLAT * 2 * 4 * 3) + AL((size_t)MAXT * 256 * 4 * 2) + AL((size_t)NLAT * 2 * 4);
constexpr size_t WS_Y0 = WS_LIST + LIST_BYTES;
constexpr size_t WS_ARENA = WS_Y0 + AL((size_t)NLAT * DM * 2);
constexpr size_t A_WIN = 0;
constexpr size_t A_WQKV = A_WIN + AL((size_t)2 * 2048 * 1024 * 2);
constexpr size_t A_WOUT = A_WQKV + AL((size_t)2 * 1792 * 384 * 2);
constexpr size_t A_FGU = A_WOUT + AL((size_t)2 * 1024 * 1024 * 2);
constexpr size_t A_FD = A_FGU + AL((size_t)2 * DFF * 1024 * 2);
constexpr size_t A_R = A_FD + AL((size_t)1024 * DFF * 2);
constexpr size_t R_P = A_R;
constexpr size_t R_QT = R_P + AL((size_t)MR * PW * 2);
constexpr size_t R_KT = R_QT + AL((size_t)2 * MR * 256 * 2);
constexpr size_t R_SLOC = R_KT + AL((size_t)2 * MR * 256 * 2);
constexpr size_t R_DEC = R_SLOC + AL((size_t)16 * NCH * 8192 * 4);
constexpr size_t R_SST = R_DEC + AL((size_t)16 * NCH * 64 * 4);
constexpr size_t R_CQKV = R_SST + AL((size_t)16 * NCH * 8192 * 2);
constexpr size_t R_QB = R_CQKV + AL((size_t)MR * 384 * 2);
constexpr size_t R_KB = R_QB + AL((size_t)8 * TKV * 192 * 2);
constexpr size_t R_VB = R_KB + AL((size_t)8 * TKV * 192 * 2);
constexpr size_t R_MIX = R_VB + AL((size_t)8 * TKV * 128 * 2);
constexpr size_t R_END = R_MIX + AL((size_t)MR * DM * 2);
constexpr size_t R_PART = R_SLOC;
constexpr size_t R_ACT = A_R;
static_assert(R_ACT + (size_t)MR * DFF * 2 <= R_SLOC && (size_t)11 * 512 * 1024 * 4 <= (size_t)16 * NCH * 8192 * 4, "ACT ends below SLOC; PART fits SLOC");
constexpr size_t M_EGU = 0;
constexpr size_t M_HS = M_EGU + AL((size_t)NEXP * 2 * DFE * 1024 * 2);
constexpr size_t M_LISTE = M_HS + AL((size_t)NLAT * DM * 2);
constexpr size_t M_ACT = M_HS + AL((size_t)MAXT * 256 * 1024 * 2);
constexpr size_t M_PT0 = M_ACT + AL((size_t)MAXT * 256 * MOE_K0 * 2);
constexpr size_t M_END = M_PT0 + AL((size_t)MOE_NC0 * 2048 * 1024 * 2);
constexpr size_t ARENA_BYTES = (R_END > M_END) ? R_END : M_END;
constexpr size_t WS_ED = WS_ARENA + ARENA_BYTES;
constexpr size_t WS_END = WS_ED + AL((size_t)NEXP * 1024 * DFE * 2);
static_assert(WS_END <= 534000000ull, "workspace map exceeds the guaranteed scratch size");

constexpr int CW_BAR = 4096;
constexpr int CW_CNT = 64;

constexpr int LDS_BYTES = 147456, MISC_OFF = LDS_BYTES - 256;

__device__ __forceinline__ unsigned f2bf_s(float f) { unsigned u = __builtin_bit_cast(unsigned, f); return (u + 0x7fffu + ((u >> 16) & 1u)) >> 16; }
__device__ __forceinline__ unsigned pk2s(float lo, float hi) { return f2bf_s(lo) | (f2bf_s(hi) << 16); }
typedef __bf16 bf16x2_t __attribute__((ext_vector_type(2)));
__device__ __forceinline__ unsigned pk2h(float lo, float hi) { const f32x2 v = {lo, hi}; return __builtin_bit_cast(unsigned, __builtin_convertvector(v, bf16x2_t)); }
__device__ __forceinline__ unsigned pk2(float lo, float hi) { return pk2h(lo, hi); }
__device__ __forceinline__ unsigned f2bf(float f) { return pk2h(f, 0.f) & 0xffffu; }
__device__ __forceinline__ u32x4 pack8h(const float* v) { u32x4 w; w.x = pk2h(v[0], v[1]); w.y = pk2h(v[2], v[3]); w.z = pk2h(v[4], v[5]); w.w = pk2h(v[6], v[7]); return w; }
__device__ __forceinline__ float bf2f(unsigned b) { return __builtin_bit_cast(float, b << 16); }
__device__ __forceinline__ float bflo(unsigned w) { return __builtin_bit_cast(float, w << 16); }
__device__ __forceinline__ float bfhi(unsigned w) { return __builtin_bit_cast(float, w & 0xffff0000u); }
__device__ __forceinline__ u32x4 pack8s(const float* v) { u32x4 w; w.x = pk2s(v[0], v[1]); w.y = pk2s(v[2], v[3]); w.z = pk2s(v[4], v[5]); w.w = pk2s(v[6], v[7]); return w; }
__device__ __forceinline__ u32x4 pack8(const float* v) { u32x4 w; w.x = pk2(v[0], v[1]); w.y = pk2(v[2], v[3]); w.z = pk2(v[4], v[5]); w.w = pk2(v[6], v[7]); return w; }
__device__ __forceinline__ void unpack8_raw(u32x4 w, bf16* v) { v[0] = (bf16)(w.x & 0xffffu); v[1] = (bf16)(w.x >> 16); v[2] = (bf16)(w.y & 0xffffu); v[3] = (bf16)(w.y >> 16); v[4] = (bf16)(w.z & 0xffffu); v[5] = (bf16)(w.z >> 16); v[6] = (bf16)(w.w & 0xffffu); v[7] = (bf16)(w.w >> 16); }
__device__ __forceinline__ void unpack8(u32x4 w, float* v) { v[0] = bflo(w.x); v[1] = bfhi(w.x); v[2] = bflo(w.y); v[3] = bfhi(w.y); v[4] = bflo(w.z); v[5] = bfhi(w.z); v[6] = bflo(w.w); v[7] = bfhi(w.w); }
__device__ __forceinline__ float wave_sum(float v) {
#pragma unroll
    for (int o = 1; o < 64; o <<= 1) v += __shfl_xor(v, o);
    return v;
}
__device__ __forceinline__ float silu_f(float x) { return x * __builtin_amdgcn_rcpf(1.f + __expf(-x)); }
__device__ __forceinline__ float logsig_f(float x) { return fminf(x, 0.f) - __logf(1.f + __expf(-fabsf(x))); }
#define LDS_WAIT() asm volatile("s_waitcnt lgkmcnt(0)" ::: "memory")
#define VM_WAIT() asm volatile("s_waitcnt vmcnt(0)" ::: "memory")

namespace pg8 {
constexpr int BM = 256, BK = 64, HALF = 128, HTB = HALF * BK * 2, NXCD = 8, WGM = 8;
__host__ __device__ __forceinline__ int lds_byte(int r, int c) { const int st = (r >> 4) * 2 + (c >> 5), rr = r & 15, cc = c & 31, ob = rr * 64 + cc * 2; return st * 1024 + (ob ^ (((ob >> 9) & 1) << 5)); }
__host__ __device__ __forceinline__ void stage_rc(int b, int& R, int& C) { const int st = b / 1024, sb = b % 1024, swz = sb ^ (((sb >> 9) & 1) << 5); R = (st >> 1) * 16 + swz / 64; C = (st & 1) * 32 + (swz % 64) / 2; }
__host__ __device__ __forceinline__ int perm32(int rho) { const int n = rho >> 4, i = rho & 15; return 8 * (i >> 2) + 4 * n + (i & 3); }

struct Unit { int pm, pn, kc; };
struct Gemm { const bf16* A; const bf16* Bt; int K, lda, ldb; };

struct StaticOrder {
    static constexpr bool GATHER = false;
    int nM, nN, nwg, G, c;
    __device__ void init(int M, int N, int G_, int c_) { nM = M / BM; nN = N / BM; nwg = nM * nN; G = G_; c = c_; }
    __device__ bool next(int i, Unit& u) const {
        const long L = (long)i * G + c; if (L >= nwg) return false;
        int wgid = (int)L; { const int q = nwg / NXCD, r = nwg % NXCD, xcd = wgid % NXCD, off = wgid / NXCD; wgid = (xcd < r ? xcd * (q + 1) : r * (q + 1) + (xcd - r) * q) + off; }
        const int nig = WGM * nN, gid = wgid / nig, fm = gid * WGM, gsz = (nM - fm) < WGM ? (nM - fm) : WGM;
        u.pm = fm + ((wgid % nig) % gsz); u.pn = (wgid % nig) / gsz; u.kc = 0; return true;
    }
};
struct MoeOrder {
    static constexpr bool GATHER = false;
    int tb[9]; int ncol, tpe, joff, G, c;
    __device__ bool next(int i, Unit& u) const {
        const int nM = tb[8], nwg = nM * ncol; const long L = (long)i * G + c; if (L >= nwg) return false;
        int wgid = (int)L; { const int q = nwg / NXCD, r = nwg % NXCD, xcd = wgid % NXCD, off = wgid / NXCD; wgid = (xcd < r ? xcd * (q + 1) : r * (q + 1) + (xcd - r) * q) + off; }
        const int nig = WGM * ncol, gid = wgid / nig, fm = gid * WGM, gsz = (nM - fm) < WGM ? (nM - fm) : WGM;
        const int tile = fm + ((wgid % nig) % gsz), j = (wgid % nig) / gsz; int e = 0;
#pragma unroll
        for (int k = 1; k < 8; ++k) e += (tile >= tb[k]) ? 1 : 0;
        u.pm = tile; u.pn = e * tpe + joff + j; u.kc = 0; return true;
    }
};
struct MoeTailOrder {
    static constexpr bool GATHER = false;
    int tb[9]; int nm, ntail, nchunk, G, c;
    __device__ bool next(int i, Unit& u) const {
        const int per = ntail * 4, L = i * G + c; if (L >= per * nchunk) return false;
        const int kc = L / per, r = L - kc * per, tile = nm + (r >> 2); int e = 0;
#pragma unroll
        for (int k = 1; k < 8; ++k) e += (tile >= tb[k]) ? 1 : 0;
        u.pm = tile; u.pn = e * 4 + (r & 3); u.kc = kc; return true;
    }
};
struct CtxSplitOrder {
    static constexpr bool GATHER = false;
    int nchunk, G, c;
    __device__ bool next(int i, Unit& u) const { const int L = i * G + c; if (L >= nchunk * 8) return false; const int r = L & 7; u.kc = L >> 3; u.pm = 64 + (r & 1); u.pn = r >> 1; return true; }
};
struct MoeGatherOrder : MoeOrder {
    static constexpr bool GATHER = true;
    const int* LISTE; int cnt[8];
    __device__ __forceinline__ void rows_of(const Unit& u, const int*& src, int& nvalid) const {
        int e = 0;
#pragma unroll
        for (int k = 1; k < 8; ++k) e += (u.pm >= tb[k]) ? 1 : 0;
        int tbe = 0, ce = 0;
#pragma unroll
        for (int k = 0; k < 8; ++k) { tbe = (e == k) ? tb[k] : tbe; ce = (e == k) ? cnt[k] : ce; }
        const int s0 = (u.pm - tbe) * 256; src = LISTE + e * 16384 + s0; nvalid = ce - s0;
    }
};
template <class Epi, class Sched>
__device__ __forceinline__ void gemm_phase(LAS unsigned char* lds, const Gemm g, const Sched& S, const Epi& E) {
    int tid = threadIdx.x; asm volatile("" : "+v"(tid));
    const int wid = __builtin_amdgcn_readfirstlane(tid >> 6), lane = tid & 63, wr = wid >> 2, wc = wid & 3, fr = lane & 15, fq = lane >> 4;
    const int K = g.K, nt = K / BK;
    constexpr bool GA = Sched::GATHER;
    unsigned voffA[2], voffB[2], vG[2][2]; int RA[2], CA[2];
#pragma unroll
    for (int i = 0; i < 2; ++i) { int R, C; stage_rc(tid * 16 + i * 8192, R, C); const int Rb = (R & ~31) + perm32(R & 31); RA[i] = R; CA[i] = C;
        voffA[i] = (unsigned)(R * g.lda + C) * 2u; voffB[i] = (unsigned)(Rb * g.ldb + C) * 2u; vG[0][i] = vG[1][i] = 0u; }
    const size_t kstep = (size_t)(BK * 2);
    const size_t hstepA = GA ? (size_t)0 : (size_t)HALF * g.lda * 2, hstepB = (size_t)HALF * g.ldb * 2;
    constexpr int TAB_OFF = 8 * HTB;
#define PG8_IDX_ISSUE(u, par) do { if constexpr (GA) { const int* _src; int _nv; S.rows_of(u, _src, _nv); \
        __builtin_amdgcn_global_load_lds((const unsigned*)(_src + (wid & 3) * 64 + lane), (LAS unsigned*)(lds + TAB_OFF + (par) * 1024 + (wid & 3) * 256), 4, 0, 0); } } while (0)
#define PG8_IDX_READ(u, par) do { if constexpr (GA) { const int* _src; int _nv; S.rows_of(u, _src, _nv); _Pragma("unroll") for (int _h = 0; _h < 2; ++_h) _Pragma("unroll") for (int _i = 0; _i < 2; ++_i) { \
        const int _r = _h * HALF + RA[_i]; const int _raw = *(const LAS int*)(lds + TAB_OFF + (par) * 1024 + _r * 4); const int _row = _r < _nv ? (_raw >> 1) : 0; vG[_h][_i] = (unsigned)(_row * g.lda + CA[_i]) * 2u; } } } while (0)
    const size_t tstepA = 2 * hstepA, tstepB = 2 * hstepB;
    const unsigned ldsw = (unsigned)wid * 1024u;
    const int aoff = lds_byte(wr * 64 + fr, fq * 8), boff = lds_byte(wc * 32 + fr, fq * 8);
#define PG8_SA(b, h) (((b) * 2 + (h)) * HTB)
#define PG8_SB(b, h) ((4 + (b) * 2 + (h)) * HTB)
#define PG8_STAGE(bufoff, gbase, voff) do { _Pragma("unroll") for (int _i = 0; _i < 2; ++_i) \
        __builtin_amdgcn_global_load_lds((const unsigned*)((const char*)(gbase) + (voff)[_i]), (LAS unsigned*)(lds + (bufoff) + ldsw + _i * 8192), 16, 0, 0); } while (0)
#define PG8_STAGE_A(bufoff, gbase, h) do { if constexpr (GA) PG8_STAGE(bufoff, gbase, vG[h]); else PG8_STAGE(bufoff, gbase, voffA); } while (0)
#define PG8_LDA(dst, b, h) do { _Pragma("unroll") for (int m = 0; m < 4; ++m) _Pragma("unroll") for (int k = 0; k < 2; ++k) dst[m][k] = *(const LAS bf16x8*)(lds + PG8_SA(b, h) + aoff + m * 2048 + k * 1024); } while (0)
#define PG8_LDB(dst, b, h) do { _Pragma("unroll") for (int n = 0; n < 2; ++n) _Pragma("unroll") for (int k = 0; k < 2; ++k) dst[n][k] = *(const LAS bf16x8*)(lds + PG8_SB(b, h) + boff + n * 2048 + k * 1024); } while (0)
#define PG8_MMA(ai, bj, At, Bt) do { __builtin_amdgcn_s_setprio(1); _Pragma("unroll") for (int m = 0; m < 4; ++m) _Pragma("unroll") for (int n = 0; n < 2; ++n) _Pragma("unroll") for (int k = 0; k < 2; ++k) \
        acc[ai][bj][m][n] = __builtin_amdgcn_mfma_f32_16x16x32_bf16(Bt[n][k], At[m][k], acc[ai][bj][m][n], 0, 0, 0); __builtin_amdgcn_s_setprio(0); } while (0)
#define PG8_WAIT_V(n) asm volatile("s_waitcnt vmcnt(" #n ")" ::: "memory")
#define PG8_WAIT_L(n) asm volatile("s_waitcnt lgkmcnt(" #n ")" ::: "memory")
#define PG8_BAR __builtin_amdgcn_s_barrier()
#define PG8_SCHED __builtin_amdgcn_sched_barrier(0)
    Unit cur, nxt; int ui = 0;
    if (!S.next(0, cur)) return;
    f32x4 acc[2][2][4][2];
#pragma unroll
    for (int a = 0; a < 2; ++a)
#pragma unroll
        for (int b = 0; b < 2; ++b)
#pragma unroll
            for (int m = 0; m < 4; ++m)
#pragma unroll
                for (int n = 0; n < 2; ++n) acc[a][b][m][n] = (f32x4){0.f, 0.f, 0.f, 0.f};
    bf16x8 At[4][2], B0[2][2], B1[2][2];
    const size_t cstep = (size_t)K * 2;
    const char* cA = (const char*)g.A + (GA ? (size_t)0 : (size_t)cur.pm * tstepA) + cur.kc * cstep; const char* cB = (const char*)g.Bt + (size_t)cur.pn * tstepB + cur.kc * cstep;
    if constexpr (GA) { PG8_IDX_ISSUE(cur, 0); PG8_WAIT_V(0); PG8_BAR; PG8_IDX_READ(cur, 0); }
    PG8_STAGE(PG8_SB(0, 0), cB, voffB); PG8_STAGE(PG8_SB(0, 1), cB + hstepB, voffB); PG8_STAGE_A(PG8_SA(0, 0), cA, 0); PG8_STAGE_A(PG8_SA(0, 1), cA + hstepA, 1);
    if (wr == 1) PG8_BAR;
    PG8_WAIT_V(2); PG8_BAR;
    PG8_STAGE(PG8_SB(1, 0), cB + kstep, voffB); PG8_STAGE_A(PG8_SA(1, 0), cA + kstep, 0); PG8_STAGE(PG8_SB(1, 1), cB + hstepB + kstep, voffB);
    PG8_WAIT_V(6); PG8_BAR;
    for (;;) {
        const bool has_next = S.next(ui + 1, nxt);
        if (has_next) PG8_IDX_ISSUE(nxt, (ui + 1) & 1);
        const char* nA = has_next ? (const char*)g.A + (GA ? (size_t)0 : (size_t)nxt.pm * tstepA) + nxt.kc * cstep : cA; const char* nB = has_next ? (const char*)g.Bt + (size_t)nxt.pn * tstepB + nxt.kc * cstep : cB;
#pragma unroll 1
        for (int t = 0; t < nt; t += 2) {
            const bool last = (t == nt - 2);
            const char* a1 = cA + (size_t)(t + 1) * kstep;
            const char* a2 = last ? nA : cA + (size_t)(t + 2) * kstep; const char* b2 = last ? nB : cB + (size_t)(t + 2) * kstep;
            const char* a3 = a2 + kstep; const char* b3 = b2 + kstep;
            PG8_LDB(B0, 0, 0); PG8_LDB(B1, 0, 1); PG8_SCHED; PG8_LDA(At, 0, 0); PG8_STAGE_A(PG8_SA(1, 1), a1 + hstepA, 1);
            if constexpr (GA) { if (last && has_next) PG8_IDX_READ(nxt, (ui + 1) & 1); }
            PG8_WAIT_V(8); PG8_WAIT_L(0); PG8_BAR; PG8_MMA(0, 0, At, B0); PG8_MMA(0, 1, At, B1); PG8_BAR; PG8_SCHED;
            PG8_LDA(At, 0, 1); PG8_STAGE(PG8_SB(0, 0), b2, voffB); PG8_STAGE(PG8_SB(0, 1), b2 + hstepB, voffB); PG8_STAGE_A(PG8_SA(0, 0), a2, 0);
            PG8_WAIT_V(8); PG8_WAIT_L(0); PG8_BAR; PG8_MMA(1, 0, At, B0); PG8_MMA(1, 1, At, B1); PG8_BAR; PG8_SCHED;
            PG8_LDB(B0, 1, 0); PG8_LDB(B1, 1, 1); PG8_SCHED; PG8_LDA(At, 1, 0); PG8_STAGE_A(PG8_SA(0, 1), a2 + hstepA, 1);
            PG8_WAIT_V(8); PG8_WAIT_L(0); PG8_BAR; PG8_MMA(0, 0, At, B0); PG8_MMA(0, 1, At, B1); PG8_BAR; PG8_SCHED;
            PG8_LDA(At, 1, 1); PG8_STAGE(PG8_SB(1, 0), b3, voffB); PG8_STAGE(PG8_SB(1, 1), b3 + hstepB, voffB); PG8_STAGE_A(PG8_SA(1, 0), a3, 0);
            PG8_WAIT_V(8); PG8_WAIT_L(0); PG8_BAR; PG8_MMA(1, 0, At, B0); PG8_MMA(1, 1, At, B1); PG8_BAR; PG8_SCHED;
        }
        if (wr == 0) PG8_BAR;
        E(acc, cur, wr, wc, fr, fq);
        if (!has_next) break;
#pragma unroll
        for (int a = 0; a < 2; ++a)
#pragma unroll
            for (int b = 0; b < 2; ++b)
#pragma unroll
                for (int m = 0; m < 4; ++m)
#pragma unroll
                    for (int n = 0; n < 2; ++n) acc[a][b][m][n] = (f32x4){0.f, 0.f, 0.f, 0.f};
        cur = nxt; cA = nA; cB = nB; ++ui;
        if (wr == 1) PG8_BAR;
    }
    PG8_WAIT_V(0);
    PG8_BAR;
#undef PG8_SA
#undef PG8_SB
#undef PG8_STAGE
#undef PG8_STAGE_A
#undef PG8_IDX_ISSUE
#undef PG8_IDX_READ
#undef PG8_LDA
#undef PG8_LDB
#undef PG8_MMA
#undef PG8_WAIT_V
#undef PG8_WAIT_L
#undef PG8_BAR
#undef PG8_SCHED
}

template <class F> struct Epi8 {
    F f;
    __device__ __forceinline__ void operator()(const f32x4 (&acc)[2][2][4][2], const Unit& u, int wr, int wc, int fr, int fq) const {
        const int row0 = u.pm * BM + wr * 64 + fr, col0 = u.pn * BM + wc * 32 + 8 * fq;
#pragma unroll
        for (int ai = 0; ai < 2; ++ai)
#pragma unroll
            for (int m = 0; m < 4; ++m)
#pragma unroll
                for (int bj = 0; bj < 2; ++bj) { f(row0 + ai * HALF + m * 16, col0 + bj * HALF, acc[ai][bj][m][0], acc[ai][bj][m][1]); __builtin_amdgcn_sched_barrier(0); }
    }
};
struct EpiPart {
    float* PART;
    __device__ __forceinline__ void operator()(const f32x4 (&acc)[2][2][4][2], const Unit& u, int wr, int wc, int fr, int fq) const {
        const int row0 = (u.pm - 64) * BM + wr * 64 + fr, col0 = u.pn * BM + wc * 32 + 8 * fq; float* base = PART + (size_t)u.kc * 512 * 1024;
#pragma unroll
        for (int ai = 0; ai < 2; ++ai)
#pragma unroll
            for (int m = 0; m < 4; ++m)
#pragma unroll
                for (int bj = 0; bj < 2; ++bj) { float* d = base + (size_t)(row0 + ai * HALF + m * 16) * 1024 + col0 + bj * HALF; *(f32x4*)d = acc[ai][bj][m][0]; *(f32x4*)(d + 4) = acc[ai][bj][m][1]; }
    }
};
struct EpiPartT {
    bf16* PART; int nm;
    __device__ __forceinline__ void operator()(const f32x4 (&acc)[2][2][4][2], const Unit& u, int wr, int wc, int fr, int fq) const {
        const int row0 = (u.pm - nm) * BM + wr * 64 + fr, col0 = (u.pn & 3) * BM + wc * 32 + 8 * fq; bf16* base = PART + (size_t)u.kc * 2048 * 1024;
#pragma unroll
        for (int ai = 0; ai < 2; ++ai)
#pragma unroll
            for (int m = 0; m < 4; ++m)
#pragma unroll
                for (int bj = 0; bj < 2; ++bj) { const f32x4 v0 = acc[ai][bj][m][0], v1 = acc[ai][bj][m][1]; u32x4 w; w.x = pk2s(v0[0], v0[1]); w.y = pk2s(v0[2], v0[3]); w.z = pk2s(v1[0], v1[1]); w.w = pk2s(v1[2], v1[3]);
                    *(u32x4*)(base + (size_t)(row0 + ai * HALF + m * 16) * 1024 + col0 + bj * HALF) = w; }
    }
};
template <class F> struct EpiGU {
    F f; int tiles_per_mat;
    __device__ __forceinline__ void operator()(const f32x4 (&acc)[2][2][4][2], const Unit& u, int wr, int wc, int fr, int fq) const {
        const int row0 = u.pm * BM + wr * 64 + fr, col0 = (u.pn % tiles_per_mat) * HALF + wc * 32 + 8 * fq;
#pragma unroll
        for (int ai = 0; ai < 2; ++ai)
#pragma unroll
            for (int m = 0; m < 4; ++m) {
                float o[8];
#pragma unroll
                for (int n = 0; n < 2; ++n)
#pragma unroll
                    for (int q = 0; q < 4; ++q) { const float gt = acc[ai][0][m][n][q], up = acc[ai][1][m][n][q]; o[n * 4 + q] = gt * __builtin_amdgcn_rcpf(1.f + __expf(-gt)) * up; }
                f(row0 + ai * HALF + m * 16, col0, o);
            }
    }
};
}

#define XB_TMO      128
#define XB_XCNT(j)  (256  + 64 * (j))
#define XB_XSUB(j)  (1280 + 64 * (j))
#define XB_XGEN(j)  (2304 + 64 * (j))
#define XB_TOP      3328
#define XB_TOPGEN   3392
#define XCD_BAR_WORDS 3456
#define XB_SPIN_CAP (1u << 18)
__device__ __forceinline__ unsigned xb_ld(unsigned* p)              { return __hip_atomic_load(p, __ATOMIC_RELAXED, __HIP_MEMORY_SCOPE_AGENT); }
__device__ __forceinline__ unsigned xb_add(unsigned* p, unsigned v) { return __hip_atomic_fetch_add(p, v, __ATOMIC_RELAXED, __HIP_MEMORY_SCOPE_AGENT); }
__device__ __forceinline__ unsigned xb_xcc_id() { return (unsigned)__builtin_amdgcn_s_getreg((3 << 11) | 20) & 0xFu; }
#define XB_SPIN(cond, bar) do { unsigned _sp = 0; while (cond) { __builtin_amdgcn_s_sleep(1); \
    if ((++_sp & 255u) == 0u) { if (xb_ld(&(bar)[XB_TMO])) break; if (_sp > XB_SPIN_CAP) { atomicAdd(&(bar)[XB_TMO], 1u); break; } } } } while (0)
struct XcdBarrier { unsigned* bar; unsigned x; volatile LAS unsigned* st; };
__device__ __forceinline__ XcdBarrier xcd_barrier_post(unsigned* bar, volatile LAS unsigned* st) {
    XcdBarrier b; b.bar = bar; b.x = xb_xcc_id(); b.st = st;
    if (threadIdx.x == 0) (void)xb_add(&bar[XB_XCNT(b.x)], 1u);
    return b;
}
__device__ __forceinline__ void xcd_barrier_complete(unsigned* bar, unsigned x, unsigned& nloc, unsigned& nx) {
    const unsigned G = gridDim.x * gridDim.y * gridDim.z;
    unsigned sum, cnt, mine, sp = 0u;
    for (;;) {
        sum = 0u; cnt = 0u; mine = 0u;
#pragma unroll
        for (unsigned j = 0; j < 16; ++j) { const unsigned c = xb_ld(&bar[XB_XCNT(j)]); sum += c; cnt += (c > 0u) ? 1u : 0u; mine = (j == x) ? c : mine; }
        if (sum == G) break;
        __builtin_amdgcn_s_sleep(1);
        if ((++sp & 255u) == 0u) { if (xb_ld(&bar[XB_TMO])) break; if (sp > XB_SPIN_CAP) { atomicAdd(&bar[XB_TMO], 1u); break; } }
    }
    nloc = mine > 0u ? mine : 1u; nx = cnt > 0u ? cnt : 1u;
}
__device__ __forceinline__ void xcd_barrier(const XcdBarrier& b) {
    asm volatile("s_waitcnt vmcnt(0)" ::: "memory");
    __syncthreads();
    if (threadIdx.x == 0) {
        unsigned* bar = b.bar;
        __builtin_amdgcn_s_waitcnt(0);
        unsigned nloc = b.st[0], nx = b.st[1];
        if (nloc == 0u) { xcd_barrier_complete(bar, b.x, nloc, nx); b.st[0] = nloc; b.st[1] = nx; }
        const unsigned old = xb_add(&bar[XB_XSUB(b.x)], 1u);
        const unsigned gen = old / nloc;
        if (old + 1u == (gen + 1u) * nloc) {
            __builtin_amdgcn_fence(__ATOMIC_RELEASE, "agent");
            asm volatile("s_waitcnt vmcnt(0)" ::: "memory");
            const unsigned og = xb_add(&bar[XB_TOP], 1u);
            const unsigned tg = og / nx;
            if (og + 1u == (tg + 1u) * nx) xb_add(&bar[XB_TOPGEN], 1u);
            else XB_SPIN(xb_ld(&bar[XB_TOPGEN]) == tg, bar);
            __builtin_amdgcn_fence(__ATOMIC_ACQUIRE, "agent");
            xb_add(&bar[XB_XGEN(b.x)], 1u);
            asm volatile("s_waitcnt vmcnt(0)" ::: "memory");
        } else {
            XB_SPIN(xb_ld(&bar[XB_XGEN(b.x)]) == gen, bar);
            __builtin_amdgcn_fence(__ATOMIC_ACQUIRE, "agent");
            asm volatile("s_waitcnt vmcnt(0)" ::: "memory");
        }
    }
    __syncthreads();
}

struct Args {
    const float* in[25];
    float* out; unsigned char* ws;
    int ph_lo, ph_hi;
};
enum { I_X = 0, I_C, I_CTX, I_CCTX, I_WMOD, I_BMOD, I_LN1, I_LN2, I_WIN, I_WG2, I_BG2, I_GLAG, I_QNG, I_WUQ, I_KVNG, I_WUKV, I_WOUT, I_FG, I_FU, I_FD, I_RW, I_EG, I_EU, I_ED, I_FNG };

struct Ctx {
    LAS unsigned char* lds; unsigned char* ldsg; unsigned char* ws; unsigned char* arena; const float* const* in; float* out;
    int tid, lane, wave, G, bid, vcu;
};

__device__ __forceinline__ int mod_row(int row) { return row < NLAT ? (row >> 13) : 2; }
__device__ __forceinline__ void row_bpos(int row, int& b, int& pos) { if (row < NLAT) { b = row >> 13; pos = row & (TT - 1); } else { const int r2 = row - NLAT; b = r2 >> 8; pos = TT + (r2 & 255); } }
__device__ __forceinline__ int chunk_row(int b, int a) { return a < 128 ? b * TT + a * 64 : NLAT + b * TC + (a - 128) * 64; }

template <class SrcFn>
__device__ __forceinline__ void transpose_item(const SrcFn& src, bf16* dst, int ldk, int k0, int n0, LAS float* scr, int lane) {
    float tv[64];
#pragma unroll
    for (int i = 0; i < 64; ++i) tv[i] = src(k0 + i, n0 + lane);
#pragma unroll
    for (int i = 0; i < 64; ++i) scr[i * 65 + lane] = tv[i];
    LDS_WAIT(); asm volatile("" ::: "memory");
    const int c = lane & 7;
#pragma unroll
    for (int j = 0; j < 8; ++j) { const int n = (lane >> 3) + 8 * j; const LAS float* s = scr + (8 * c) * 65 + n;
        u32x4 o; o.x = pk2(s[0 * 65], s[1 * 65]); o.y = pk2(s[2 * 65], s[3 * 65]); o.z = pk2(s[4 * 65], s[5 * 65]); o.w = pk2(s[6 * 65], s[7 * 65]);
        *(u32x4*)(dst + (size_t)(n0 + n) * ldk + k0 + 8 * c) = o; }
    LDS_WAIT(); asm volatile("" ::: "memory");
}
__device__ __forceinline__ void transpose_item_fast(const float* S, int ld, bf16* dst, int ldk, int k0, int n0, LAS float* scr, int lane, const float* rowscale = nullptr) {
    f32x4 v[16];
#pragma unroll
    for (int i = 0; i < 16; ++i) v[i] = __builtin_nontemporal_load((const f32x4*)(S + (size_t)(i * 4 + (lane >> 4)) * ld + (lane & 15) * 4));
    if (rowscale) {
#pragma unroll
        for (int i = 0; i < 16; ++i) v[i] *= rowscale[i * 4 + (lane >> 4)]; }
#pragma unroll
    for (int i = 0; i < 16; ++i) { LAS float* p = scr + (i * 4 + (lane >> 4)) * 65 + (lane & 15) * 4; p[0] = v[i].x; p[1] = v[i].y; p[2] = v[i].z; p[3] = v[i].w; }
    LDS_WAIT(); asm volatile("" ::: "memory");
    const int c = lane & 7;
#pragma unroll
    for (int j = 0; j < 8; ++j) { const int n = (lane >> 3) + 8 * j; const LAS float* s = scr + (8 * c) * 65 + n;
        u32x4 o; o.x = pk2(s[0 * 65], s[1 * 65]); o.y = pk2(s[2 * 65], s[3 * 65]); o.z = pk2(s[4 * 65], s[5 * 65]); o.w = pk2(s[6 * 65], s[7 * 65]);
        *(u32x4*)(dst + (size_t)(n0 + n) * ldk + k0 + 8 * c) = o; }
    LDS_WAIT(); asm volatile("" ::: "memory");
}
__device__ __forceinline__ int rope_unperm(int jj) { const int pair = jj >> 1, which = jj & 1; return pair < 16 ? pair + 16 * which : 32 + (pair - 16) + 16 * which; }
__device__ __forceinline__ int win_src_col(int n) {
    if (n < 1024) return n;
    if (n < 1536) return 1056 + (n - 1024);
    if (n < 1792) return 1568 + (n - 1536);
    if (n < 1920) return 1824 + (n - 1792);
    if (n < 1984) return 1952 + rope_unperm(n - 1920);
    if (n < 2000) return 1024 + (n - 1984);
    if (n < 2016) return 1040 + (n - 2000);
    return -1;
}

__device__ __forceinline__ void convert_weights(const Ctx& C, bool first, int gw, int NGW) {
    LAS float* scr = (LAS float*)(C.lds + C.wave * 16640);
    for (int l = 0; l < 2; ++l) {
        if (first == (l == 0))
        {
            const float* W = C.in[I_WIN] + (size_t)l * 1024 * 2016; bf16* dst = (bf16*)(C.arena + A_WIN) + (size_t)l * 2048 * 1024;
            auto f = [=](int k, int n) -> float { const int sc = win_src_col(n); return sc < 0 ? 0.f : W[(size_t)k * 2016 + sc]; };
            for (int it = gw; it < 16 * 32; it += NGW) { const int k0 = (it >> 5) * 64, n0 = (it & 31) * 64;
                if (n0 < 1920) transpose_item_fast(W + (size_t)k0 * 2016 + win_src_col(n0), 2016, dst, 1024, k0, n0, scr, C.lane);
                else transpose_item(f, dst, 1024, k0, n0, scr, C.lane); }
        }
        if (!first)
        {
            const float* Wq = C.in[I_WUQ] + (size_t)l * 256 * 768; const float* gq = C.in[I_QNG] + l * 256; const float* Wk = C.in[I_WUKV] + (size_t)l * 128 * 1024; const float* gk = C.in[I_KVNG] + l * 128;
            bf16* dst = (bf16*)(C.arena + A_WQKV) + (size_t)l * 1792 * 384;
            auto f = [=](int k, int n) -> float {
                if (n < 768) { if (k >= 256) return 0.f; const int h = n / 192, j = n % 192; const int sc = h * 192 + (j < 128 ? j : 128 + rope_unperm(j - 128)); return gq[k] * Wq[(size_t)k * 768 + sc]; }
                if (k < 256) return 0.f; return gk[k - 256] * Wk[(size_t)(k - 256) * 1024 + (n - 768)]; };
            for (int it = gw; it < 6 * 28; it += NGW) { const int k0 = (it % 6) * 64, n0 = (it / 6) * 64;
                const bool qcol = n0 < 768, qrow = k0 < 256;
                if (qcol != qrow) {
                    const int c = C.lane & 7;
#pragma unroll
                    for (int j = 0; j < 8; ++j) *(u32x4*)(dst + (size_t)(n0 + (C.lane >> 3) + 8 * j) * 384 + k0 + 8 * c) = (u32x4){0u, 0u, 0u, 0u};
                } else if (qcol && (n0 % 192) == 128) transpose_item(f, dst, 384, k0, n0, scr, C.lane);
                else if (qcol) transpose_item_fast(Wq + (size_t)k0 * 768 + n0, 768, dst, 384, k0, n0, scr, C.lane, gq + k0);
                else transpose_item_fast(Wk + (size_t)(k0 - 256) * 1024 + (n0 - 768), 1024, dst, 384, k0, n0, scr, C.lane, gk + (k0 - 256)); }
        }
        if (!first)
        {
            const float* W = C.in[I_WOUT] + (size_t)l * 1024 * 1024; bf16* dst = (bf16*)(C.arena + A_WOUT) + (size_t)l * 1024 * 1024;
            for (int it = gw; it < 16 * 16; it += NGW) { const int k0 = (it >> 4) * 64, n0 = (it & 15) * 64; transpose_item_fast(W + (size_t)k0 * 1024 + n0, 1024, dst, 1024, k0, n0, scr, C.lane); }
        }
    }
    if (!first)
    {
        bf16* dst = (bf16*)(C.arena + A_FGU);
        for (int it = gw; it < 16 * 88; it += NGW) { const int k0 = (it & 15) * 64, n0 = (it >> 4) * 64; const int tj = n0 >> 8, c = n0 & 255;
            const float* W = (c < 128) ? C.in[I_FG] : C.in[I_FU]; const int sc = tj * 128 + (c & 127);
            transpose_item_fast(W + (size_t)k0 * DFF + sc, DFF, dst, 1024, k0, n0, scr, C.lane); }
    }
    if (!first)
    {
        bf16* dst = (bf16*)(C.arena + A_FD); const float* W = C.in[I_FD];
        for (int it = gw; it < 44 * 16; it += NGW) { const int k0 = (it % 44) * 64, n0 = (it / 44) * 64; transpose_item_fast(W + (size_t)k0 * 1024 + n0, 1024, dst, DFF, k0, n0, scr, C.lane); }
    }
}
__device__ __forceinline__ void prologue(const Ctx& C) {
    convert_weights(C, true, C.vcu * 8 + C.wave, C.G * 8);
    __syncthreads();
    if (C.vcu < 6) {
        float* R = (float*)(C.ws + WS_ROPE);
        const int i = C.vcu * 512 + C.tid; const int j = i & 15, p = i >> 4; const int pos = p < 128 ? p : p - 128;
        const float inv = powf(10000.f, -(float)j / 16.f); const float ang = (float)pos * inv; R[2 * i] = cosf(ang); R[2 * i + 1] = sinf(ang);
    }
    for (int item = C.G - 1 - C.vcu; item < 192; item += C.G) {
        const int l = item / 96, cg = item % 96;
        LAS float* sil = (LAS float*)C.lds; LAS float* part = sil + 3 * 1024;
        for (int i = C.tid; i < 3 * 1024; i += 512) { const int v = i >> 10, k = i & 1023; const float x = v < 2 ? C.in[I_C][v * 1024 + k] : C.in[I_CCTX][k]; sil[i] = silu_f(x); }
        __syncthreads();
        const int rsub = C.lane >> 4, c4 = (C.lane & 15) * 4;
        f32x4 a0 = {0, 0, 0, 0}, a1 = a0, a2 = a0;
        const float* W = C.in[I_WMOD] + (size_t)l * 1024 * 6144 + cg * 64 + c4;
#pragma unroll 16
        for (int i = 0; i < 32; ++i) { const int k = C.wave * 128 + 4 * i + rsub; const f32x4 w = __builtin_nontemporal_load((const f32x4*)(W + (size_t)k * 6144));
            a0 += w * sil[k]; a1 += w * sil[1024 + k]; a2 += w * sil[2048 + k]; }
        LAS float* pp = part + (C.wave * 4 + rsub) * 192 + c4;
#pragma unroll
        for (int q = 0; q < 4; ++q) { pp[q] = a0[q]; pp[64 + q] = a1[q]; pp[128 + q] = a2[q]; }
        __syncthreads();
        if (C.tid < 192) { const int v = C.tid >> 6, c = C.tid & 63; float s = C.in[I_BMOD][l * 6144 + cg * 64 + c];
#pragma unroll
            for (int p = 0; p < 32; ++p) s += part[p * 192 + v * 64 + c];
            ((float*)(C.ws + WS_MOD))[(l * 3 + v) * 6144 + cg * 64 + c] = s; }
        __syncthreads();
    }
}

__device__ __forceinline__ void load_row16(const float* p, int lane, f32x4 (&v)[4]) {
#pragma unroll
    for (int j = 0; j < 4; ++j) v[j] = *(const f32x4*)(p + 256 * j + 4 * lane);
}
__device__ __forceinline__ void norm_mod_row(f32x4 (&v)[4], const float* g, const float* sc, const float* sh, int lane) {
    float ss = 0.f;
#pragma unroll
    for (int j = 0; j < 4; ++j) ss += (v[j].x * v[j].x + v[j].y * v[j].y) + (v[j].z * v[j].z + v[j].w * v[j].w);
    const float rs = 1.f / sqrtf(wave_sum(ss) * (1.f / DM) + EPS);
#pragma unroll
    for (int j = 0; j < 4; ++j) { const f32x4 gg = *(const f32x4*)(g + 256 * j + 4 * lane), s1 = *(const f32x4*)(sc + 256 * j + 4 * lane), s0 = *(const f32x4*)(sh + 256 * j + 4 * lane);
        v[j] = (v[j] * rs * gg) * (s1 + 1.f) + s0; }
}
__device__ __forceinline__ void store_row16_bf16(bf16* p, int lane, const f32x4 (&v)[4]) {
#pragma unroll
    for (int j = 0; j < 4; ++j) { u32x2 w; w.x = pk2(v[j].x, v[j].y); w.y = pk2(v[j].z, v[j].w); *(u32x2*)(p + 256 * j + 4 * lane) = w; }
}
__device__ __forceinline__ void load_row16_bf16(const bf16* p, int lane, f32x4 (&v)[4]) {
#pragma unroll
    for (int j = 0; j < 4; ++j) { const u32x2 w = *(const u32x2*)(p + 256 * j + 4 * lane); v[j] = (f32x4){bflo(w.x), bfhi(w.x), bflo(w.y), bfhi(w.y)}; }
}
__device__ __forceinline__ void load_xin_row(const Ctx& C, int layer, int row, f32x4 (&v)[4]) {
    if (layer == 0) load_row16(row < NLAT ? C.in[I_X] + (size_t)row * DM : C.in[I_CTX] + (size_t)(row - NLAT) * DM, C.lane, v);
    else load_row16_bf16((const bf16*)(C.ws + WS_XL) + (size_t)row * DM, C.lane, v);
}

__device__ __forceinline__ void phase_norm1(const Ctx& C, int layer) {
    const int gw = C.vcu * 8 + C.wave, NGW = C.G * 8;
    const float* g = C.in[I_LN1] + layer * DM; const float* MOD = (const float*)(C.ws + WS_MOD) + (size_t)layer * 3 * 6144; bf16* H = (bf16*)(C.ws + WS_H);
    for (int row = gw; row < MR; row += NGW) {
        f32x4 v[4]; load_xin_row(C, layer, row, v);
        if (layer == 1 && row >= NLAT) {
            const float* PART = (const float*)(C.arena + R_PART) + (size_t)(row - NLAT) * 1024; const float* g2c = (const float*)(C.ws + WS_MOD) + 2 * 6144 + 5 * 1024;
#pragma unroll
            for (int j = 0; j < 4; ++j) { f32x4 t[11];
#pragma unroll
                for (int c = 0; c < 11; ++c) t[c] = *(const f32x4*)(PART + (size_t)c * 512 * 1024 + 256 * j + 4 * C.lane);
                f32x4 acc = t[0];
#pragma unroll
                for (int c = 1; c < 11; ++c) acc += t[c];
                v[j] += *(const f32x4*)(g2c + 256 * j + 4 * C.lane) * acc; } }
        const float* m = MOD + mod_row(row) * 6144;
        norm_mod_row(v, g, m + 1024, m, C.lane);
        store_row16_bf16(H + (size_t)row * DM, C.lane, v);
    }
}

__device__ __forceinline__ void phase_norm2(const Ctx& C, int layer) {
    const int gw = C.vcu * 8 + C.wave, NGW = C.G * 8;
    const float* g = C.in[I_LN2] + layer * DM; const float* MOD = (const float*)(C.ws + WS_MOD) + (size_t)layer * 3 * 6144; bf16* H = layer == 0 ? (bf16*)(C.ws + WS_H) : (bf16*)(C.arena + M_HS);
    const bf16* XL = (const bf16*)(C.ws + WS_XL); int* LISTE = (int*)(C.arena + M_LISTE);
    const int nrow = layer == 0 ? MR : NLAT;
    unsigned* ctl = (unsigned*)(C.ws + WS_CTL);
    int* PE = (int*)(C.ws + WS_LIST); int* PS = PE + NLAT * 2; float* PWt = (float*)(PS + NLAT * 2);
    LAS unsigned* lcnt = (LAS unsigned*)(C.lds + 140000); LAS unsigned* gbase = lcnt + 8;
    const int maxit = (nrow + NGW - 1) / NGW;
    f32x4 rw[32];
    if (layer == 1) {
#pragma unroll
        for (int j = 0; j < 4; ++j)
#pragma unroll
            for (int q = 0; q < 4; ++q) { const float* RWp = C.in[I_RW] + (256 * j + 4 * C.lane + q) * 8; rw[(j * 4 + q) * 2] = *(const f32x4*)RWp; rw[(j * 4 + q) * 2 + 1] = *(const f32x4*)(RWp + 4); }
    }
    for (int b0 = 0; b0 < maxit; b0 += 64) {
        int my_e1 = 0, my_e2 = 0, my_row = -1; float my_d = 0.f;
        if (layer == 1) { if (C.tid < 8) lcnt[C.tid] = 0u; }
        const int b1 = (b0 + 64 < maxit) ? b0 + 64 : maxit;
        for (int it = b0; it < b1; ++it) {
            const int row = gw + it * NGW; if (row >= nrow) break;
            f32x4 v[4];
            if (layer == 0 && row >= NLAT) {
                load_row16(C.in[I_CTX] + (size_t)(row - NLAT) * DM, C.lane, v);
                const float* PART = (const float*)(C.arena + R_PART) + (size_t)(row - NLAT) * 1024; const float* g1c = MOD + 2 * 6144 + 2 * 1024;
#pragma unroll
                for (int j = 0; j < 4; ++j) { f32x4 t[4];
#pragma unroll
                    for (int c = 0; c < 4; ++c) t[c] = *(const f32x4*)(PART + (size_t)c * 512 * 1024 + 256 * j + 4 * C.lane);
                    const f32x4 acc = ((t[0] + t[1]) + t[2]) + t[3];
                    v[j] += *(const f32x4*)(g1c + 256 * j + 4 * C.lane) * acc; }
                store_row16_bf16((bf16*)(C.ws + WS_XL) + (size_t)row * DM, C.lane, v);
                load_row16_bf16(XL + (size_t)row * DM, C.lane, v);
            } else load_row16_bf16(XL + (size_t)row * DM, C.lane, v);
            const float* m = MOD + mod_row(row) * 6144;
            norm_mod_row(v, g, m + 4096, m + 3072, C.lane);
            store_row16_bf16(H + (size_t)row * DM, C.lane, v);
            if (layer == 1) {
                float lg[8];
#pragma unroll
                for (int e = 0; e < 8; ++e) lg[e] = 0.f;
#pragma unroll
                for (int j = 0; j < 4; ++j)
#pragma unroll
                    for (int q = 0; q < 4; ++q) { const f32x4 w0 = rw[(j * 4 + q) * 2], w1 = rw[(j * 4 + q) * 2 + 1]; const float x = v[j][q];
                        lg[0] += x * w0.x; lg[1] += x * w0.y; lg[2] += x * w0.z; lg[3] += x * w0.w; lg[4] += x * w1.x; lg[5] += x * w1.y; lg[6] += x * w1.z; lg[7] += x * w1.w; }
#pragma unroll
                for (int e = 0; e < 8; ++e) lg[e] = wave_sum(lg[e]);
                int e1 = 0; float v1 = lg[0];
#pragma unroll
                for (int e = 1; e < 8; ++e) if (lg[e] > v1) { v1 = lg[e]; e1 = e; }
                int e2 = -1; float v2 = -3.0e38f;
#pragma unroll
                for (int e = 0; e < 8; ++e) if (e != e1 && lg[e] > v2) { v2 = lg[e]; e2 = e; }
                if (C.lane == (it & 63)) { my_e1 = e1; my_e2 = e2; my_row = row; my_d = v2 - v1; }
            }
        }
        if (layer == 1) {
            __syncthreads();
            unsigned r1 = 0u, r2 = 0u;
            if (my_row >= 0) { r1 = __hip_atomic_fetch_add(lcnt + my_e1, 1u, __ATOMIC_RELAXED, __HIP_MEMORY_SCOPE_WORKGROUP); r2 = __hip_atomic_fetch_add(lcnt + my_e2, 1u, __ATOMIC_RELAXED, __HIP_MEMORY_SCOPE_WORKGROUP); }
            __syncthreads();
            if (C.tid < 8) { const unsigned n = lcnt[C.tid]; gbase[C.tid] = n ? atomicAdd(ctl + CW_CNT + 64 * C.tid, n) : 0u; }
            __syncthreads();
            if (my_row >= 0) {
                const float w1 = 1.f / (1.f + expf(my_d)), w2 = 1.f - w1;
                const unsigned s1 = gbase[my_e1] + r1, s2 = gbase[my_e2] + r2;
                PE[my_row * 2] = my_e1; PE[my_row * 2 + 1] = my_e2; PS[my_row * 2] = (int)s1; PS[my_row * 2 + 1] = (int)s2; PWt[my_row * 2] = w1; PWt[my_row * 2 + 1] = w2;
                LISTE[my_e1 * 16384 + (int)s1] = my_row * 2; LISTE[my_e2 * 16384 + (int)s2] = my_row * 2 + 1;
            }
            __syncthreads();
        }
    }
    if (layer == 1) {
        int* ENT = (int*)(C.ws + WS_LIST + AL((size_t)NLAT * 2 * 4 * 3));
        for (int i = C.vcu * 512 + C.tid; i < MAXT * 256; i += C.G * 512) ENT[i] = -1;
    }
}

__device__ __forceinline__ void convert_expert_gu(const Ctx& C, int gw, int NGW) {
    LAS float* scr = (LAS float*)(C.lds + C.wave * 16640); bf16* EGU = (bf16*)(C.arena + M_EGU);
    for (int it = gw; it < NEXP * 16 * 112; it += NGW) { const int e = it / (16 * 112), r = it % (16 * 112), k0 = (r & 15) * 64, n0 = (r >> 4) * 64; const int tj = n0 >> 8, c = n0 & 255;
        const float* W = ((c < 128) ? C.in[I_EG] : C.in[I_EU]) + (size_t)e * 1024 * DFE; const int sc = tj * 128 + (c & 127);
        transpose_item_fast(W + (size_t)k0 * DFE + sc, DFE, EGU + (size_t)e * 2 * DFE * 1024, 1024, k0, n0, scr, C.lane); }
}
__device__ __forceinline__ void convert_expert_down(const Ctx& C, int gw, int NGW) {
    LAS float* scr = (LAS float*)(C.lds + C.wave * 16640); bf16* ED = (bf16*)(C.ws + WS_ED);
    for (int it = gw; it < NEXP * 56 * 16; it += NGW) { const int e = it / (56 * 16), r = it % (56 * 16), k0 = (r % 56) * 64, n0 = (r / 56) * 64;
        const float* W = C.in[I_ED] + (size_t)e * DFE * 1024;
        transpose_item_fast(W + (size_t)k0 * 1024 + n0, 1024, ED + (size_t)e * 1024 * DFE, DFE, k0, n0, scr, C.lane); }
}

__device__ __forceinline__ void moe_tile_bases(const Ctx& C, int (&tb)[9]) {
    unsigned* ctl = (unsigned*)(C.ws + WS_CTL); int acc = 0;
#pragma unroll
    for (int e = 0; e < 8; ++e) { tb[e] = acc; const unsigned c = __hip_atomic_load(ctl + CW_CNT + 64 * e, __ATOMIC_RELAXED, __HIP_MEMORY_SCOPE_AGENT); acc += (int)((c + 255u) >> 8); }
    tb[8] = acc;
}
__device__ __forceinline__ void moe_fill_lists(const Ctx& C) {
    int tb[9]; moe_tile_bases(C, tb);
    const int* PE = (const int*)(C.ws + WS_LIST); const int* PS = PE + NLAT * 2; const float* PWt = (const float*)(PS + NLAT * 2);
    int* ENT = (int*)(C.ws + WS_LIST + AL((size_t)NLAT * 2 * 4 * 3)); float* WTS = (float*)(ENT + MAXT * 256); int* TAILROW = (int*)(C.ws + WS_LIST + AL((size_t)NLAT * 2 * 4 * 3) + AL((size_t)MAXT * 256 * 4 * 2));
    for (int pr = C.vcu * 512 + C.tid; pr < NLAT * 2; pr += C.G * 512) {
        const int e = PE[pr], s = PS[pr]; int base = 0;
#pragma unroll
        for (int k = 0; k < 8; ++k) base = (e == k) ? tb[k] : base;
        const int pos = base * 256 + s;
        ENT[pos] = pr; WTS[pos] = PWt[pr]; TAILROW[pr] = pos >= MOE_MAIN * 256 ? pos - MOE_MAIN * 256 : -1;
    }
}

__device__ __forceinline__ void moe_tail_reduce0(const Ctx& C) {
    const int gw = C.vcu * 8 + C.wave, NGW = C.G * 8;
    int tb[9]; moe_tile_bases(C, tb); const int ntail = tb[8] > MOE_MAIN ? tb[8] - MOE_MAIN : 0;
    const int* ENT = (const int*)(C.ws + WS_LIST + AL((size_t)NLAT * 2 * 4 * 3)); const float* WTS = (const float*)(ENT + MAXT * 256);
    const bf16* PART = (const bf16*)(C.arena + M_PT0); const float* gate = (const float*)(C.ws + WS_MOD) + (size_t)3 * 6144 + 5 * 1024;
    for (int r = gw; r < ntail * 256; r += NGW) {
        const int pos = MOE_MAIN * 256 + r, ent = ENT[pos]; const float w = WTS[pos];
        u32x2 t[4][MOE_NC0]; f32x4 gv[4];
#pragma unroll
        for (int j = 0; j < 4; ++j)
#pragma unroll
            for (int c = 0; c < MOE_NC0; ++c) t[j][c] = *(const u32x2*)(PART + ((size_t)c * 2048 + r) * 1024 + 256 * j + 4 * C.lane);
        if (ent < 0) continue;
        const int tok = ent >> 1; const float* g = gate + (tok >> 13) * 6144;
        bf16* Y = (bf16*)(C.ws + ((ent & 1) ? WS_H : WS_Y0)) + (size_t)tok * DM;
#pragma unroll
        for (int j = 0; j < 4; ++j) gv[j] = *(const f32x4*)(g + 256 * j + 4 * C.lane);
#pragma unroll
        for (int j = 0; j < 4; ++j) { f32x4 acc = {0.f, 0.f, 0.f, 0.f};
#pragma unroll
            for (int c = 0; c < MOE_NC0; ++c) acc += (f32x4){bflo(t[j][c].x), bfhi(t[j][c].x), bflo(t[j][c].y), bfhi(t[j][c].y)};
            const f32x4 y = gv[j] * w * acc; u32x2 o; o.x = pk2(y.x, y.y); o.y = pk2(y.z, y.w); *(u32x2*)(Y + 256 * j + 4 * C.lane) = o; }
    }
}
__device__ __forceinline__ void phase_final(const Ctx& C) {
    const int gw = C.vcu * 8 + C.wave, NGW = C.G * 8;
    const bf16* XL = (const bf16*)(C.ws + WS_XL); const bf16* Y2 = (const bf16*)(C.ws + WS_H); const bf16* Y0 = (const bf16*)(C.ws + WS_Y0); const float* g = C.in[I_FNG];
    const bf16* Y0b = (const bf16*)(C.arena + M_EGU); const bf16* Y2b = Y0b + (size_t)NLAT * DM;
    const int* TAILROW = (const int*)(C.ws + WS_LIST + AL((size_t)NLAT * 2 * 4 * 3) + AL((size_t)MAXT * 256 * 4 * 2)); const float* PWt = (const float*)(C.ws + WS_LIST) + NLAT * 4;
    const bf16* PART1 = (const bf16*)(C.arena + M_HS); const float* gate = (const float*)(C.ws + WS_MOD) + (size_t)3 * 6144 + 5 * 1024;
    const int maxit = (NLAT + NGW - 1) / NGW;
    for (int b0 = 0; b0 < maxit; b0 += 64) {
        int my_t0 = -1, my_t1 = -1;
        { const int r = gw + (b0 + C.lane) * NGW; if (b0 + C.lane < maxit && r < NLAT) { my_t0 = TAILROW[r * 2]; my_t1 = TAILROW[r * 2 + 1]; } }
        const int b1 = (b0 + 64 < maxit) ? b0 + 64 : maxit;
        for (int it = b0; it < b1; ++it) {
            const int row = gw + it * NGW; if (row >= NLAT) break;
            const int tr0 = __builtin_amdgcn_readlane(my_t0, it - b0), tr1 = __builtin_amdgcn_readlane(my_t1, it - b0);
            u32x2 xa[4], ya[4], za[4], pa[4], qa[4];
#pragma unroll
            for (int j = 0; j < 4; ++j) { const size_t o = (size_t)row * DM + 256 * j + 4 * C.lane;
                xa[j] = *(const u32x2*)(XL + o); ya[j] = *(const u32x2*)(Y2 + o); za[j] = *(const u32x2*)(Y0 + o);
                pa[j] = (u32x2){0u, 0u}; qa[j] = (u32x2){0u, 0u};
                if (tr0 < 0) pa[j] = *(const u32x2*)(Y0b + o);
                if (tr1 < 0) qa[j] = *(const u32x2*)(Y2b + o); }
            f32x4 v[4];
#pragma unroll
            for (int j = 0; j < 4; ++j) {
                v[j].x = bflo(xa[j].x) + (bflo(ya[j].x) + bflo(za[j].x)); v[j].y = bfhi(xa[j].x) + (bfhi(ya[j].x) + bfhi(za[j].x));
                v[j].z = bflo(xa[j].y) + (bflo(ya[j].y) + bflo(za[j].y)); v[j].w = bfhi(xa[j].y) + (bfhi(ya[j].y) + bfhi(za[j].y));
                v[j].x += bflo(pa[j].x); v[j].y += bfhi(pa[j].x); v[j].z += bflo(pa[j].y); v[j].w += bfhi(pa[j].y);
                v[j].x += bflo(qa[j].x); v[j].y += bfhi(qa[j].x); v[j].z += bflo(qa[j].y); v[j].w += bfhi(qa[j].y); }
#pragma unroll
            for (int k = 0; k < 2; ++k) { const int tr = k ? tr1 : tr0;
                if (tr >= 0) { const float w = PWt[row * 2 + k]; const float* gt = gate + (row >> 13) * 6144;
#pragma unroll
                    for (int j = 0; j < 4; ++j) { u32x2 t[MOE_NC1];
#pragma unroll
                        for (int c = 0; c < MOE_NC1; ++c) t[c] = *(const u32x2*)(PART1 + ((size_t)c * 2048 + tr) * 1024 + 256 * j + 4 * C.lane);
                        f32x4 acc = {0.f, 0.f, 0.f, 0.f};
#pragma unroll
                        for (int c = 0; c < MOE_NC1; ++c) acc += (f32x4){bflo(t[c].x), bfhi(t[c].x), bflo(t[c].y), bfhi(t[c].y)};
                        v[j] += *(const f32x4*)(gt + 256 * j + 4 * C.lane) * w * acc; } } }
            float ss = 0.f;
#pragma unroll
            for (int j = 0; j < 4; ++j) ss += (v[j].x * v[j].x + v[j].y * v[j].y) + (v[j].z * v[j].z + v[j].w * v[j].w);
            const float rs = 1.f / sqrtf(wave_sum(ss) * (1.f / DM) + EPS);
#pragma unroll
            for (int j = 0; j < 4; ++j) { const f32x4 gg = *(const f32x4*)(g + 256 * j + 4 * C.lane); *(f32x4*)(C.out + (size_t)row * DM + 256 * j + 4 * C.lane) = v[j] * rs * gg; }
        }
    }
}

__device__ __forceinline__ void phase_mla_prep(const Ctx& C, int gw, int NGW) {
    const bf16* P = (const bf16*)(C.arena + R_P); bf16* CQKV = (bf16*)(C.arena + R_CQKV); char* KBc = (char*)(C.arena + R_KB);
    const float* ROPE = (const float*)(C.ws + WS_ROPE);
    for (int row = gw; row < MR; row += NGW) {
        const bf16* pr = P + (size_t)row * PW;
        {   const u32x2 w = *(const u32x2*)(pr + PC_CQ + 4 * C.lane); float x0 = bflo(w.x), x1 = bfhi(w.x), x2 = bflo(w.y), x3 = bfhi(w.y);
            const float rs = 1.f / sqrtf(wave_sum(x0 * x0 + x1 * x1 + x2 * x2 + x3 * x3) * (1.f / 256.f) + EPS);
            u32x2 o; o.x = pk2(x0 * rs, x1 * rs); o.y = pk2(x2 * rs, x3 * rs); *(u32x2*)(CQKV + (size_t)row * 384 + 4 * C.lane) = o; }
        {   const unsigned w = *(const unsigned*)(pr + PC_CKV + 2 * C.lane); float x0 = bflo(w), x1 = bfhi(w);
            const float rs = 1.f / sqrtf(wave_sum(x0 * x0 + x1 * x1) * (1.f / 128.f) + EPS);
            *(unsigned*)(CQKV + (size_t)row * 384 + 256 + 2 * C.lane) = pk2(x0 * rs, x1 * rs); }
        {   float x = bf2f(pr[PC_KR + C.lane]); const float xo = __shfl_xor(x, 1);
            int b, pos; row_bpos(row, b, pos);
            if (row < NLAT) { const int pair = C.lane >> 1, fi = pair & 15, axis = pair >> 4; const int pidx = axis ? (pos & 63) : (pos >> 6);
                const float* cs = ROPE + ((axis ? 128 : 0) + pidx) * 32 + fi * 2; const float c = cs[0], s = cs[1];
                x = (C.lane & 1) ? (x * c + xo * s) : (x * c - xo * s); }
            const bf16 xb = (bf16)f2bf(x);
#pragma unroll
            for (int h = 0; h < 4; ++h) *(bf16*)(KBc + ((size_t)(b * 4 + h) * 132 + (pos >> 6)) * att::KT_BYTES + (16 + (C.lane >> 3)) * 1024 + (pos & 63) * 16 + (C.lane & 7) * 2) = xb; }
    }
}

__device__ __forceinline__ f32x4 mma16(bf16x8 a, bf16x8 b, f32x4 c) { return __builtin_amdgcn_mfma_f32_16x16x32_bf16(a, b, c, 0, 0, 0); }
constexpr int LS = 72;

__device__ __forceinline__ void phase_gla_local(const Ctx& C, int layer) {
    LAS float* codes = (LAS float*)C.lds;
    LAS float* bcum = codes + 64 * 32;
    LAS float* gsum = bcum + 2 * 64 * 64;
    LAS float* tot = gsum + 2 * 4 * 64;
    LAS bf16* vT = (LAS bf16*)(tot + 128);
    LAS bf16* khT = vT + 128 * LS;
    const bf16* P = (const bf16*)(C.arena + R_P);
    bf16* QT = (bf16*)(C.arena + R_QT); bf16* KT = (bf16*)(C.arena + R_KT);
    float* SLOC = (float*)(C.arena + R_SLOC); float* DEC = (float*)(C.arena + R_DEC);
    const float* WG2 = C.in[I_WG2] + (size_t)layer * 2 * 16 * 256; const float* BG2 = C.in[I_BG2] + (size_t)layer * 2 * 256;
    const int tid = C.tid, lane = C.lane;
    for (int L = C.bid; L < NB * NCH * 4; L += C.G) {
        const int h = L & 3, a = (L >> 2) % NCH, b = L / (NCH * 4);
        const int rbase = chunk_row(b, a);
        {
            const int t = tid >> 3, j4 = (tid & 7) * 4; const u32x2 w = *(const u32x2*)(P + (size_t)(rbase + t) * PW + PC_GF + j4);
            LAS float* cp = codes + t * 32 + j4; cp[0] = bflo(w.x); cp[1] = bfhi(w.x); cp[2] = bflo(w.y); cp[3] = bfhi(w.y);
            const int e0 = (tid & 7) * 16; const bf16* vp = P + (size_t)(rbase + t) * PW + PC_V + h * 128 + e0;
            const u32x4 v0 = *(const u32x4*)vp, v1 = *(const u32x4*)(vp + 8); bf16 vr[16]; unpack8_raw(v0, vr); unpack8_raw(v1, vr + 8);
#pragma unroll
            for (int i = 0; i < 16; ++i) vT[(e0 + i) * LS + t] = vr[i];
        }
        __syncthreads();
        const int dir = tid >> 8, tg = (tid >> 6) & 3, d = tid & 63;
        {
            float w[16];
#pragma unroll
            for (int r = 0; r < 16; ++r) w[r] = WG2[(dir * 16 + r) * 256 + h * 64 + d];
            const float bias = BG2[dir * 256 + h * 64 + d];
            float acc = 0.f;
#pragma unroll
            for (int ii = 0; ii < 16; ++ii) { const int i = dir ? 15 - ii : ii; const int t = tg * 16 + i; float pre = bias;
#pragma unroll
                for (int r4 = 0; r4 < 4; ++r4) { const f32x4 cv = *(const LAS f32x4*)(codes + t * 32 + dir * 16 + 4 * r4); pre += cv.x * w[4 * r4] + cv.y * w[4 * r4 + 1] + cv.z * w[4 * r4 + 2] + cv.w * w[4 * r4 + 3]; }
                acc += logsig_f(pre) * (1.f / 16.f); bcum[(dir * 64 + t) * 64 + d] = acc; }
            gsum[(dir * 4 + tg) * 64 + d] = acc;
        }
        __syncthreads();
        {   float off = 0.f, total = 0.f;
#pragma unroll
            for (int g2 = 0; g2 < 4; ++g2) { const float s = gsum[(dir * 4 + g2) * 64 + d]; total += s; if (dir ? (g2 > tg) : (g2 < tg)) off += s; }
#pragma unroll
            for (int i = 0; i < 16; ++i) bcum[(dir * 64 + tg * 16 + i) * 64 + d] += off;
            if (tg == 0) tot[dir * 64 + d] = __expf(total);
        }
        __syncthreads();
        {
            const int t = (tid >> 2) & 63, d0 = (tid & 3) * 16; const size_t row = (size_t)(rbase + t);
            const bf16* qp = P + row * PW + PC_Q + h * 64 + d0; const bf16* kp = P + row * PW + PC_K + h * 64 + d0;
            float q[16], k[16]; unpack8(*(const u32x4*)qp, q); unpack8(*(const u32x4*)(qp + 8), q + 8); unpack8(*(const u32x4*)kp, k); unpack8(*(const u32x4*)(kp + 8), k + 8);
            float qo[16], ko[16];
#pragma unroll
            for (int i = 0; i < 16; ++i) { const float eB = __expf(bcum[(dir * 64 + t) * 64 + d0 + i]), et = tot[dir * 64 + d0 + i];
                qo[i] = q[i] * 0.125f * eB; ko[i] = k[i] * __builtin_amdgcn_rcpf(eB); khT[(dir * 64 + d0 + i) * LS + t] = (bf16)f2bf(ko[i] * et); }
            bf16* qd = QT + ((size_t)dir * MR + row) * 256 + h * 64 + d0; bf16* kd = KT + ((size_t)dir * MR + row) * 256 + h * 64 + d0;
            *(u32x4*)qd = pack8h(qo); *(u32x4*)(qd + 8) = pack8h(qo + 8); *(u32x4*)kd = pack8h(ko); *(u32x4*)(kd + 8) = pack8h(ko + 8);
        }
        const int pf = a < 128 ? a + 4 : a - 128, pb = 131 - a;
        if (tid < 128) { const int dd = tid >> 6, d2 = tid & 63; const int chain = dd * 8 + b * 4 + h, p = dd ? pb : pf; DEC[((size_t)chain * NCH + p) * 64 + d2] = tot[dd * 64 + d2]; }
        __syncthreads();
        {
            const int fr = lane & 15, fq = lane >> 4;
#pragma unroll 2
            for (int i = 0; i < 8; ++i) { const int id = C.wave * 8 + i, dd = id >> 5, et = (id >> 2) & 7, dt = id & 3;
                f32x4 acc = {0.f, 0.f, 0.f, 0.f};
#pragma unroll
                for (int ks = 0; ks < 2; ++ks) { const bf16x8 av = *(const LAS bf16x8*)(vT + (et * 16 + fr) * LS + ks * 32 + fq * 8); const bf16x8 bv = *(const LAS bf16x8*)(khT + (dd * 64 + dt * 16 + fr) * LS + ks * 32 + fq * 8);
                    acc = mma16(av, bv, acc); }
                const int chain = dd * 8 + b * 4 + h, p = dd ? pb : pf; float* S = SLOC + ((size_t)chain * NCH + p) * 8192;
#pragma unroll
                for (int r = 0; r < 4; ++r) S[(et * 16 + fq * 4 + r) * 64 + dt * 16 + fr] = acc[r]; }
        }
        __syncthreads();
    }
}

__device__ __forceinline__ void phase_gla_scan(const Ctx& C) {
    const float* SLOC = (const float*)(C.arena + R_SLOC); const float* DEC = (const float*)(C.arena + R_DEC); bf16* SST = (bf16*)(C.arena + R_SST);
    for (int idx = C.bid * 512 + C.tid; idx < 16 * 8192; idx += C.G * 512) {
        const int chain = idx >> 13, el = idx & 8191, d = el & 63;
        const float* sl = SLOC + (size_t)chain * NCH * 8192 + el; const float* dc = DEC + (size_t)chain * NCH * 64 + d; bf16* so = SST + (size_t)chain * NCH * 8192 + el;
        float S = 0.f;
#pragma unroll 1
        for (int p0 = 0; p0 < NCH; p0 += 44) {
            float x[44], g[44];
#pragma unroll
            for (int i = 0; i < 44; ++i) { x[i] = sl[(size_t)(p0 + i) * 8192]; g[i] = dc[(p0 + i) * 64]; }
#pragma unroll
            for (int i = 0; i < 44; ++i) { so[(size_t)(p0 + i) * 8192] = (bf16)f2bf(S); S = S * g[i] + x[i]; }
        }
    }
}

__device__ __forceinline__ void phase_gla_out(const Ctx& C, int layer) {
    LAS bf16* qf = (LAS bf16*)C.lds; LAS bf16* kf = qf + 64 * LS; LAS bf16* qb = kf + 64 * LS; LAS bf16* kb = qb + 64 * LS;
    LAS bf16* vT = kb + 64 * LS;
    LAS bf16* SfT = vT + 128 * LS; LAS bf16* SbT = SfT + 128 * LS;
    LAS bf16* As = SbT + 128 * LS;
    LAS float* O = (LAS float*)(As + 64 * LS);
    const bf16* P = (const bf16*)(C.arena + R_P); const bf16* QT = (const bf16*)(C.arena + R_QT); const bf16* KT = (const bf16*)(C.arena + R_KT);
    const bf16* SST = (const bf16*)(C.arena + R_SST); bf16* MIX = (bf16*)(C.arena + R_MIX);
    const float* GG = C.in[I_GLAG] + layer * 128;
    const int tid = C.tid, lane = C.lane, fr = lane & 15, fq = lane >> 4;
    const int na = layer == 0 ? NCH : 128;
    const int nskip = (layer == 0 && C.G > 16) ? 8 : 0;
    if (C.bid < nskip) return;
    for (int L = C.G - 1 - C.bid; L < NB * na * 4; L += C.G - nskip) {
        const int h = L & 3, a = (L >> 2) % na, b = L / (na * 4);
        const int rbase = chunk_row(b, a);
        const int pf = a < 128 ? a + 4 : a - 128, pb = 131 - a;
        {
            const int which = tid >> 7, t = (tid >> 1) & 63, hf = tid & 1; const int dd = which >> 1;
            const bf16* src = ((which & 1) ? KT : QT) + ((size_t)dd * MR + rbase + t) * 256 + h * 64 + hf * 32;
            LAS bf16* dst = (which == 0 ? qf : which == 1 ? kf : which == 2 ? qb : kb) + t * LS + hf * 32;
#pragma unroll
            for (int i = 0; i < 4; ++i) *(LAS u32x4*)(dst + 8 * i) = *(const u32x4*)(src + 8 * i);
        }
        {
            const int t = tid >> 3, e0 = (tid & 7) * 16; const bf16* vp = P + (size_t)(rbase + t) * PW + PC_V + h * 128 + e0;
            const u32x4 v0 = *(const u32x4*)vp, v1 = *(const u32x4*)(vp + 8); bf16 vr[16]; unpack8_raw(v0, vr); unpack8_raw(v1, vr + 8);
#pragma unroll
            for (int i = 0; i < 16; ++i) vT[(e0 + i) * LS + t] = vr[i];
        }
        {
            const int dd = tid >> 8, e = (tid >> 1) & 127, hf = tid & 1; const int chain = dd * 8 + b * 4 + h, p = dd ? pb : pf;
            const bf16* src = SST + ((size_t)chain * NCH + p) * 8192 + e * 64 + hf * 32; LAS bf16* dst = (dd ? SbT : SfT) + e * LS + hf * 32;
#pragma unroll
            for (int i = 0; i < 4; ++i) *(LAS u32x4*)(dst + 8 * i) = *(const u32x4*)(src + 8 * i);
        }
        __syncthreads();
        {
#pragma unroll
            for (int i = 0; i < 2; ++i) { const int pos = C.wave * 2 + i, ti = pos >> 2, si = pos & 3;
                f32x4 af = {0.f, 0.f, 0.f, 0.f}, ab = af;
#pragma unroll
                for (int ks = 0; ks < 2; ++ks) {
                    const bf16x8 a1 = *(const LAS bf16x8*)(qf + (ti * 16 + fr) * LS + ks * 32 + fq * 8), b1 = *(const LAS bf16x8*)(kf + (si * 16 + fr) * LS + ks * 32 + fq * 8);
                    const bf16x8 a2 = *(const LAS bf16x8*)(qb + (ti * 16 + fr) * LS + ks * 32 + fq * 8), b2 = *(const LAS bf16x8*)(kb + (si * 16 + fr) * LS + ks * 32 + fq * 8);
                    af = mma16(a1, b1, af); ab = mma16(a2, b2, ab); }
#pragma unroll
                for (int r = 0; r < 4; ++r) { const int t = ti * 16 + fq * 4 + r, s = si * 16 + fr; const float val = (s <= t ? af[r] : 0.f) + (s >= t ? ab[r] : 0.f); As[t * LS + s] = (bf16)f2bf(val); } }
        }
        __syncthreads();
        {
#pragma unroll 2
            for (int i = 0; i < 4; ++i) { const int id = C.wave * 4 + i, tt = id >> 3, et = id & 7;
                f32x4 acc = {0.f, 0.f, 0.f, 0.f};
#pragma unroll
                for (int ks = 0; ks < 2; ++ks) {
                    const bf16x8 bv = *(const LAS bf16x8*)(vT + (et * 16 + fr) * LS + ks * 32 + fq * 8);
                    acc = mma16(*(const LAS bf16x8*)(As + (tt * 16 + fr) * LS + ks * 32 + fq * 8), bv, acc);
                    acc = mma16(*(const LAS bf16x8*)(qf + (tt * 16 + fr) * LS + ks * 32 + fq * 8), *(const LAS bf16x8*)(SfT + (et * 16 + fr) * LS + ks * 32 + fq * 8), acc);
                    acc = mma16(*(const LAS bf16x8*)(qb + (tt * 16 + fr) * LS + ks * 32 + fq * 8), *(const LAS bf16x8*)(SbT + (et * 16 + fr) * LS + ks * 32 + fq * 8), acc); }
#pragma unroll
                for (int r = 0; r < 4; ++r) O[(tt * 16 + fq * 4 + r) * 132 + et * 16 + fr] = acc[r]; }
        }
        __syncthreads();
        {
            const int t = tid >> 3, e0 = (tid & 7) * 16; float o[16], ss = 0.f;
#pragma unroll
            for (int i = 0; i < 16; ++i) { o[i] = O[t * 132 + e0 + i]; ss += o[i] * o[i]; }
            ss += __shfl_xor(ss, 1); ss += __shfl_xor(ss, 2); ss += __shfl_xor(ss, 4);
            const float rs = 1.f / sqrtf(ss * (1.f / 128.f) + EPS);
            const size_t row = (size_t)(rbase + t); const bf16* rp = P + row * PW + PC_R + h * 128 + e0; float rv[16]; unpack8(*(const u32x4*)rp, rv); unpack8(*(const u32x4*)(rp + 8), rv + 8);
#pragma unroll
            for (int i = 0; i < 16; ++i) o[i] = o[i] * rs * GG[e0 + i] * silu_f(rv[i]);
            bf16* mp = MIX + row * DM + h * 128 + e0; *(u32x4*)mp = pack8h(o); *(u32x4*)(mp + 8) = pack8h(o + 8);
        }
        __syncthreads();
    }
}

namespace att {
constexpr int NW = 8, QBLK = 32, KVBLK = 64;
constexpr float THR = 8.f;
constexpr int OFF_K = 0, OFF_V = 2 * KT_BYTES, OFF_WS = OFF_V + 2 * VT_BYTES, OFF_QR = OFF_WS + NW * 64 * 4, SHM_ATTN = OFF_QR + NW * 4096;
#define SBAR() __builtin_amdgcn_sched_barrier(0)
__device__ __forceinline__ int crow(int r, int hi) { return (r & 3) + 8 * (r >> 2) + 4 * hi; }
__device__ __forceinline__ unsigned cvtpk(float lo, float hi) { unsigned r; asm volatile("v_cvt_pk_bf16_f32 %0, %1, %2" : "=v"(r) : "v"(lo), "v"(hi)); return r; }
__device__ __forceinline__ void glds16(const void* gsrc, unsigned lds_dst) { unsigned keep;
    asm volatile("s_mov_b32 %0, m0\n\ts_mov_b32 m0, %2\n\ts_nop 0\n\tglobal_load_lds_dwordx4 %1, off\n\ts_mov_b32 m0, %0" : "=&s"(keep) : "v"(gsrc), "s"(lds_dst) : "memory"); }
__device__ __forceinline__ void partialSM(f32x16& p0, f32x16& p1, f32x16& negm, bool first, float& alpha) {
    constexpr float THRL = THR * 1.4426950408889634f;
    float pmax = p0[0];
#pragma unroll
    for (int r = 1; r < 16; ++r) pmax = fmaxf(pmax, p0[r]);
#pragma unroll
    for (int r = 0; r < 16; ++r) pmax = fmaxf(pmax, p1[r]);
    { auto rr = __builtin_amdgcn_permlane32_swap(__float_as_uint(pmax), __float_as_uint(pmax), false, false);
      pmax = fmaxf(__uint_as_float(rr[0]), __uint_as_float(rr[1])); }
    if (__builtin_expect(!first && __all(pmax <= THRL), 1)) { alpha = 1.f; }
    else { const float delta = first ? pmax : fmaxf(pmax, 0.f); alpha = first ? 1.f : __builtin_amdgcn_exp2f(-delta);
#pragma unroll
        for (int r = 0; r < 16; ++r) { p0[r] -= delta; p1[r] -= delta; negm[r] -= delta; } }
#pragma unroll
    for (int r = 0; r < 16; ++r) p0[r] = __builtin_amdgcn_exp2f(p0[r]);
}
__device__ __forceinline__ void finishSM(f32x16& p0, f32x16& p1, float alpha, float& l_reg, bf16x8& pa0, bf16x8& pa1, bf16x8& pa2, bf16x8& pa3) {
#pragma unroll
    for (int r = 0; r < 16; ++r) p1[r] = __builtin_amdgcn_exp2f(p1[r]);
    float ps = 0;
#pragma unroll
    for (int r = 0; r < 16; ++r) ps += p0[r];
#pragma unroll
    for (int r = 0; r < 16; ++r) ps += p1[r];
    { auto rr = __builtin_amdgcn_permlane32_swap(__float_as_uint(ps), __float_as_uint(ps), false, false);
      ps = __uint_as_float(rr[0]) + __uint_as_float(rr[1]); }
    l_reg = l_reg * alpha + ps;
#define PK4(P, BASE, OUT) do { unsigned a0 = cvtpk(P[BASE + 0], P[BASE + 1]), a1 = cvtpk(P[BASE + 2], P[BASE + 3]);   \
    unsigned b0 = cvtpk(P[BASE + 4], P[BASE + 5]), b1 = cvtpk(P[BASE + 6], P[BASE + 7]);                              \
    auto r0 = __builtin_amdgcn_permlane32_swap(a0, b0, false, false); auto r1 = __builtin_amdgcn_permlane32_swap(a1, b1, false, false); \
    u32x4 w = {r0[0], r1[0], r0[1], r1[1]}; OUT = *reinterpret_cast<bf16x8*>(&w); } while (0)
    PK4(p0, 0, pa0); PK4(p0, 8, pa1); PK4(p1, 0, pa2); PK4(p1, 8, pa3);
#undef PK4
}
__device__ __forceinline__ void qkt(f32x16& p0, f32x16& p1, const char* kl, const bf16x8* qr, const char* qrl, const f32x16& negm) {
    bf16x8 ka[8], kb[8], qv[4];
#define KLOAD(dst, g) do { _Pragma("unroll") for (int i = 0; i < 4; ++i) { dst[2 * i] = *reinterpret_cast<const bf16x8*>(kl + ((g) * 4 + i) * 2048); dst[2 * i + 1] = *reinterpret_cast<const bf16x8*>(kl + ((g) * 4 + i) * 2048 + 512); } } while (0)
    KLOAD(ka, 0); SBAR(); KLOAD(kb, 1);
#pragma unroll
    for (int i = 0; i < 4; ++i) qv[i] = *reinterpret_cast<const bf16x8*>(qrl + i * 1024);
    SBAR();
    p0 = __builtin_amdgcn_mfma_f32_32x32x16_bf16(ka[0], qr[0], negm, 0, 0, 0);
    p1 = __builtin_amdgcn_mfma_f32_32x32x16_bf16(ka[1], qr[0], negm, 0, 0, 0);
#pragma unroll
    for (int i = 1; i < 4; ++i) { p0 = __builtin_amdgcn_mfma_f32_32x32x16_bf16(ka[2 * i], qr[i], p0, 0, 0, 0); p1 = __builtin_amdgcn_mfma_f32_32x32x16_bf16(ka[2 * i + 1], qr[i], p1, 0, 0, 0); }
    SBAR(); KLOAD(ka, 2); SBAR();
#pragma unroll
    for (int i = 0; i < 4; ++i) { p0 = __builtin_amdgcn_mfma_f32_32x32x16_bf16(kb[2 * i], qr[4 + i], p0, 0, 0, 0); p1 = __builtin_amdgcn_mfma_f32_32x32x16_bf16(kb[2 * i + 1], qr[4 + i], p1, 0, 0, 0); }
    SBAR();
#pragma unroll
    for (int i = 0; i < 4; ++i) { p0 = __builtin_amdgcn_mfma_f32_32x32x16_bf16(ka[2 * i], qv[i], p0, 0, 0, 0); p1 = __builtin_amdgcn_mfma_f32_32x32x16_bf16(ka[2 * i + 1], qv[i], p1, 0, 0, 0); }
#undef KLOAD
}
__device__ __forceinline__ int v_rd_base(int lane) { return ((lane & 3) << 3) | (((lane >> 2) & 3) << 6) | (((lane >> 4) & 1) << 5) | (((lane >> 5) & 1) << 8); }
constexpr int v_rd_off(int d0, int ks, int half) { return d0 * 512 + ks * 4096 + half * 2048; }
template <int OFF> __device__ __forceinline__ s16x4 tr_read(int vb) {
    return __builtin_amdgcn_ds_read_tr16_b64_v4i16((LAS s16x4*)(uintptr_t)(unsigned)(vb + OFF));
}
struct VFrag { s16x4 l0, h0, l1, h1, l2, h2, l3, h3; };
template <int D0> __device__ __forceinline__ void v_reads(VFrag& f, int vb) {
    f.l0 = tr_read<v_rd_off(D0, 0, 0)>(vb); f.h0 = tr_read<v_rd_off(D0, 0, 1)>(vb); f.l1 = tr_read<v_rd_off(D0, 1, 0)>(vb); f.h1 = tr_read<v_rd_off(D0, 1, 1)>(vb);
    f.l2 = tr_read<v_rd_off(D0, 2, 0)>(vb); f.h2 = tr_read<v_rd_off(D0, 2, 1)>(vb); f.l3 = tr_read<v_rd_off(D0, 3, 0)>(vb); f.h3 = tr_read<v_rd_off(D0, 3, 1)>(vb);
}
__device__ __forceinline__ void pv_mma(f32x16& od, const VFrag& f, bf16x8 pa0, bf16x8 pa1, bf16x8 pa2, bf16x8 pa3) {
#define PKV(L, H) (bf16x8){L[0], L[1], L[2], L[3], H[0], H[1], H[2], H[3]}
    od = __builtin_amdgcn_mfma_f32_32x32x16_bf16(pa0, PKV(f.l0, f.h0), od, 0, 0, 0);
    od = __builtin_amdgcn_mfma_f32_32x32x16_bf16(pa1, PKV(f.l1, f.h1), od, 0, 0, 0);
    od = __builtin_amdgcn_mfma_f32_32x32x16_bf16(pa2, PKV(f.l2, f.h2), od, 0, 0, 0);
    od = __builtin_amdgcn_mfma_f32_32x32x16_bf16(pa3, PKV(f.l3, f.h3), od, 0, 0, 0);
#undef PKV
}
__device__ __forceinline__ void pv_d0(f32x16* o, int vb, bf16x8 pa0, bf16x8 pa1, bf16x8 pa2, bf16x8 pa3) {
    VFrag fa, fb;
    v_reads<0>(fa, vb); v_reads<1>(fb, vb);
    SBAR(); pv_mma(o[0], fa, pa0, pa1, pa2, pa3); SBAR();
    v_reads<2>(fa, vb);
    SBAR(); pv_mma(o[1], fb, pa0, pa1, pa2, pa3); SBAR();
    v_reads<3>(fb, vb);
    SBAR(); pv_mma(o[2], fa, pa0, pa1, pa2, pa3); SBAR();
    pv_mma(o[3], fb, pa0, pa1, pa2, pa3);
}
__device__ __forceinline__ void attn_body(const bf16* __restrict__ Qb, const char* __restrict__ Kt, const char* __restrict__ Vt, bf16* __restrict__ Ob, int t0, int NT, char* lds, const float* __restrict__ ROPE, int qpos0) {
    int tid = threadIdx.x; asm volatile("" : "+v"(tid));
    const int wid = __builtin_amdgcn_readfirstlane(tid >> 6), lane = tid & 63, r32 = lane & 31, hi = lane >> 5, grp = wid >> 2;
    float* ws = (float*)(lds + OFF_WS) + wid * 64; float* li_l = ws; float* al_l = ws + 32;
    float l_reg = 0; f32x16 o[4] = {}; f32x16 negm = {}; bf16x8 qr[8];
    const bf16* Qw = Qb + (long)(wid * QBLK + r32) * 192 + hi * 8;
#pragma unroll
    for (int d0 = 0; d0 < 8; ++d0) qr[d0] = *reinterpret_cast<const bf16x8*>(Qw + d0 * 16);
    char* qrl = lds + OFF_QR + wid * 4096 + lane * 16;
#pragma unroll
    for (int d0 = 0; d0 < 4; ++d0) {
        const u32x4 w = *reinterpret_cast<const u32x4*>(Qw + 128 + d0 * 16); float v[8]; unpack8(w, v);
        if (qpos0 >= 0) { const int pos = qpos0 + wid * QBLK + r32;
#pragma unroll
            for (int q = 0; q < 4; ++q) { const int pair = d0 * 8 + hi * 4 + q, fi = pair & 15, axis = pair >> 4; const int pidx = axis ? (pos & 63) : (pos >> 6);
                const float* cs = ROPE + ((axis ? 128 : 0) + pidx) * 32 + fi * 2; const float c = cs[0], sn = cs[1]; const float x1 = v[2 * q], x2 = v[2 * q + 1];
                v[2 * q] = x1 * c - x2 * sn; v[2 * q + 1] = x2 * c + x1 * sn; } }
        *reinterpret_cast<u32x4*>(qrl + d0 * 1024) = pack8(v); }
    asm volatile("s_waitcnt vmcnt(0)" ::: "memory");
    const unsigned ldsb = (unsigned)(uintptr_t)lds;
    const char* Ktw = Kt + (size_t)t0 * KT_BYTES + lane * 16; const char* Vtw = Vt + (size_t)t0 * VT_BYTES + lane * 16;
#define ISSUE_K(j) do { _Pragma("unroll") for (int _i = 0; _i < 3; ++_i) { const int q = wid * 3 + _i; \
        glds16(Ktw + (size_t)(j) * KT_BYTES + q * 1024, __builtin_amdgcn_readfirstlane(ldsb + OFF_K + ((j) & 1) * KT_BYTES + q * 1024)); } } while (0)
#define ISSUE_V(j) do { _Pragma("unroll") for (int _i = 0; _i < 2; ++_i) { const int q = wid * 2 + _i; \
        glds16(Vtw + (size_t)(j) * VT_BYTES + q * 1024, __builtin_amdgcn_readfirstlane(ldsb + OFF_V + ((j) & 1) * VT_BYTES + q * 1024)); } } while (0)
#define STEP_PRE(s) do { __builtin_amdgcn_s_barrier(); SBAR(); const int _s = (s), _m = _s >> 1; issued = 0; \
        if (_m + 1 < NT) { if (_s & 1) { ISSUE_V(_m + 1); issued = 2; } else { ISSUE_K(_m + 1); issued = 3; } } SBAR(); } while (0)
#define STEP_POST() do { SBAR(); if (issued == 3) asm volatile("s_waitcnt vmcnt(3)" ::: "memory"); else if (issued == 2) asm volatile("s_waitcnt vmcnt(2)" ::: "memory"); else asm volatile("s_waitcnt vmcnt(0)" ::: "memory"); } while (0)
#define RESC(a) do { if (__any((a) < 1.f)) { if (hi == 0) al_l[r32] = (a); asm volatile("s_waitcnt lgkmcnt(0)" ::: "memory"); \
    _Pragma("unroll") for (int d = 0; d < 4; ++d) _Pragma("unroll") for (int r = 0; r < 16; ++r) o[d][r] *= al_l[crow(r, hi)]; } } while (0)
    const char* kl0 = lds + OFF_K + hi * 1024 + r32 * 16;
    const int vb0 = (int)ldsb + OFF_V + v_rd_base(lane);
    f32x16 p0, p1; float al = 1.f; bf16x8 pa0, pa1, pa2, pa3;
    ISSUE_K(0); ISSUE_V(0);
    if (NT > 1) { ISSUE_K(1); ISSUE_V(1); asm volatile("s_waitcnt vmcnt(5)" ::: "memory"); } else asm volatile("s_waitcnt vmcnt(0)" ::: "memory");
    __builtin_amdgcn_s_barrier(); SBAR();
    for (int j = 0; j < NT; ++j) {
        const int sl = j & 1;
        qkt(p0, p1, kl0 + sl * KT_BYTES, qr, qrl, negm);
        partialSM(p0, p1, negm, j == 0, al);
        RESC(al);
        finishSM(p0, p1, al, l_reg, pa0, pa1, pa2, pa3); SBAR();
        pv_d0(o, vb0 + sl * VT_BYTES, pa0, pa1, pa2, pa3);
        SBAR(); asm volatile("s_waitcnt vmcnt(0)" ::: "memory"); __builtin_amdgcn_s_barrier(); SBAR();
        if (j + 2 < NT) { ISSUE_K(j + 2); ISSUE_V(j + 2); }
    }
    if (hi == 0) li_l[r32] = l_reg; asm volatile("s_waitcnt lgkmcnt(0)" ::: "memory");
    float rli[16];
#pragma unroll
    for (int r = 0; r < 16; ++r) rli[r] = __builtin_amdgcn_rcpf(li_l[crow(r, hi)]);
    bf16* Ow = Ob + (long)(wid * QBLK) * DM;
#pragma unroll
    for (int r = 0; r < 16; ++r) { const int orow = crow(r, hi);
#pragma unroll
        for (int d0 = 0; d0 < 4; ++d0) Ow[(long)orow * DM + d0 * 32 + r32] = (bf16)f2bf(o[d0][r] * rli[r]); }
    __syncthreads();
#undef ISSUE_K
#undef ISSUE_V
#undef STEP_PRE
#undef STEP_POST
#undef RESC
}
}

__device__ __forceinline__ void phase_attention(const Ctx& C, int layer) {
    const bf16* QB = (const bf16*)(C.arena + R_QB); const char* KB = (const char*)(C.arena + R_KB); const char* VB = (const char*)(C.arena + R_VB); bf16* MIX = (bf16*)(C.arena + R_MIX);
    const float* ROPE = (const float*)(C.ws + WS_ROPE);
    const int nunit = layer == 0 ? 264 : 256;
    for (int L = C.bid; L < nunit; L += C.G) {
        const bool lat = L < 256; const int bh = lat ? (L & 7) : (L - 256), qb = L >> 3, b = bh >> 2, h = bh & 3;
        const int qrow = lat ? qb * 256 : TT, orow = lat ? b * TT + qb * 256 : NLAT + b * TC;
        att::attn_body(QB + ((size_t)bh * TKV + qrow) * 192, KB + (size_t)bh * 132 * att::KT_BYTES, VB + (size_t)bh * 132 * att::VT_BYTES, MIX + (size_t)orow * DM + 512 + h * 128,
                       lat ? 0 : 128, lat ? 132 : 4, (char*)C.ldsg, ROPE, lat ? qb * 256 : -1);
    }
}

struct FStoreP { bf16* P;
    __device__ __forceinline__ void operator()(int row, int col, f32x4 v0, f32x4 v1) const { u32x4 w; w.x = pk2h(v0[0], v0[1]); w.y = pk2h(v0[2], v0[3]); w.z = pk2h(v1[0], v1[1]); w.w = pk2h(v1[2], v1[3]); *(u32x4*)(P + (size_t)row * PW + col) = w; } };
struct FStoreQKV { bf16* QB; char* KB; char* VB; int coff;
    __device__ __forceinline__ void operator()(int row, int colx, f32x4 v0, f32x4 v1) const {
        const int col = colx + coff; int b, pos; row_bpos(row, b, pos);
        if (col < 768) { constexpr float QS = MLA_SCALE * 1.4426950408889634f; v0 = v0 * QS; v1 = v1 * QS; }
        u32x4 w; w.x = pk2h(v0[0], v0[1]); w.y = pk2h(v0[2], v0[3]); w.z = pk2h(v1[0], v1[1]); w.w = pk2h(v1[2], v1[3]);
        if (col < 768) { const int h = col / 192, j = col - h * 192; *(u32x4*)(QB + ((size_t)(b * 4 + h) * TKV + pos) * 192 + j) = w; }
        else { const int c2 = col - 768, h = c2 >> 8, j = c2 & 255; const size_t tile = (size_t)(b * 4 + h) * 132 + (pos >> 6); const int k = pos & 63;
            if (j < 128) *(u32x4*)(KB + tile * att::KT_BYTES + (j >> 3) * 1024 + k * 16) = w;
            else *(u32x4*)(VB + tile * att::VT_BYTES + att::v_st(k, j - 128)) = w; }
    } };
struct FResidual { const float* x; const float* ctx; bf16* XL; const float* gate; int layer0;
    __device__ __forceinline__ void operator()(int row, int col, f32x4 v0, f32x4 v1) const {
        const float* g = gate + mod_row(row) * 6144 + col; const f32x4 g0 = *(const f32x4*)g, g1 = *(const f32x4*)(g + 4);
        float r[8];
        if (layer0) { const float* src = (row < NLAT ? x + (size_t)row * DM : ctx + (size_t)(row - NLAT) * DM) + col; const f32x4 s0 = *(const f32x4*)src, s1 = *(const f32x4*)(src + 4);
            r[0] = s0[0]; r[1] = s0[1]; r[2] = s0[2]; r[3] = s0[3]; r[4] = s1[0]; r[5] = s1[1]; r[6] = s1[2]; r[7] = s1[3]; }
        else unpack8(*(const u32x4*)(XL + (size_t)row * DM + col), r);
        r[0] += g0[0] * v0[0]; r[1] += g0[1] * v0[1]; r[2] += g0[2] * v0[2]; r[3] += g0[3] * v0[3]; r[4] += g1[0] * v1[0]; r[5] += g1[1] * v1[1]; r[6] += g1[2] * v1[2]; r[7] += g1[3] * v1[3];
        *(u32x4*)(XL + (size_t)row * DM + col) = pack8h(r);
    } };
struct FStoreAct { bf16* ACT; int ld;
    __device__ __forceinline__ void operator()(int row, int col, const float* o) const { *(u32x4*)(ACT + (size_t)row * ld + col) = pack8h(o); } };
struct FMoeDown { const int* ENT; const float* WTS; bf16* Y0; bf16* Y2; const float* gate;
    __device__ __forceinline__ void operator()(int row, int colx, f32x4 v0, f32x4 v1) const {
        const int col = colx & (DM - 1);
        const int ent = ENT[row]; if (ent < 0) return;
        const int tok = ent >> 1; const float w = WTS[row]; const float* g = gate + (tok >> 13) * 6144 + col;
        const f32x4 a0 = *(const f32x4*)g * w * v0, a1 = *(const f32x4*)(g + 4) * w * v1;
        u32x4 o; o.x = pk2h(a0[0], a0[1]); o.y = pk2h(a0[2], a0[3]); o.z = pk2h(a1[0], a1[1]); o.w = pk2h(a1[2], a1[3]);
        *(u32x4*)(((ent & 1) ? Y2 : Y0) + (size_t)tok * DM + col) = o;
    } };

constexpr int PH_PER_LAYER = 13, PH_FINAL = 1 + 2 * PH_PER_LAYER, N_PHASES = PH_FINAL + 1;
__host__ __device__ constexpr bool phase_exists(int ph) { return ph == 0 || ph == PH_FINAL || (ph >= 1 && ph < PH_FINAL && ((((ph - 1) / PH_PER_LAYER) == 1 && ((ph - 1) % PH_PER_LAYER) != 7 && ((ph - 1) % PH_PER_LAYER) != 8) || (((ph - 1) / PH_PER_LAYER) == 0 && ((ph - 1) % PH_PER_LAYER) < 9))); }

#ifndef DBG_REP
#define DBG_REP(ph) 0
#endif
#ifndef DBG_DELAY
#define DBG_DELAY(ph) 0
#endif
#ifndef DBG_STOP
#define DBG_STOP 0
#endif
#ifndef DBG_SRC
#define DBG_SRC 0
#endif
__device__ __forceinline__ void phase_dump(const Ctx& C) {
    const int gw = C.vcu * 8 + C.wave, NGW = C.G * 8;
    for (int row = gw; row < NLAT; row += NGW) {
        float* o = C.out + (size_t)row * DM;
        if (DBG_SRC == 0) { const bf16* s = (const bf16*)(C.ws + WS_XL) + (size_t)row * DM; for (int c = C.lane; c < DM; c += 64) o[c] = bf2f(s[c]); }
        else { const bf16* s = DBG_SRC == 1 ? (const bf16*)(C.arena + R_MIX) + (size_t)row * DM : DBG_SRC == 2 ? (const bf16*)(C.ws + WS_H) + (size_t)row * DM
                             : DBG_SRC == 3 ? (const bf16*)(C.arena + R_P) + (size_t)row * PW : DBG_SRC == 4 ? (const bf16*)(C.arena + R_P) + (size_t)row * PW + 1024
                             : DBG_SRC == 5 ? (const bf16*)(C.arena + R_ACT) + (size_t)row * DFF : DBG_SRC == 6 ? (const bf16*)(C.arena + R_QT) + (size_t)row * 256
                             : (const bf16*)(C.arena + R_QB) + (size_t)row * 192;
            const int n = DBG_SRC == 6 ? 256 : DBG_SRC == 7 ? 192 : DM;
            for (int c = C.lane; c < DM; c += 64) o[c] = c < n ? bf2f(s[c]) : 0.f; }
    }
}
template <int PH, int SUB = 0> __device__ __forceinline__ void run_phase(const Ctx& C0) {
    Ctx C = C0; { int t = threadIdx.x; asm volatile("" : "+v"(t)); C.tid = t; C.lane = t & 63; C.wave = __builtin_amdgcn_readfirstlane(t >> 6); }
    constexpr int layer = (PH - 1) / PH_PER_LAYER, k = (PH - 1) % PH_PER_LAYER;
    const float* MODB = (const float*)(C.ws + WS_MOD);
    if constexpr (DBG_STOP > 0 && PH > DBG_STOP && PH != PH_FINAL) { }
    else if constexpr (DBG_STOP > 0 && PH == PH_FINAL) { phase_dump(C); }
    else if constexpr (PH == 0) { prologue(C); }
    else if constexpr (PH == PH_FINAL) { phase_final(C); }
    else if constexpr (k == 0) { phase_norm1(C, layer); }
    else if constexpr (k == 1) {
        pg8::Gemm g{(const bf16*)(C.ws + WS_H), (const bf16*)(C.arena + A_WIN) + (size_t)layer * 2048 * 1024, 1024, 1024, 1024};
        pg8::StaticOrder S; S.init(MR, PW, C.G, C.bid); pg8::Epi8<FStoreP> E{{(bf16*)(C.arena + R_P)}};
        pg8::gemm_phase(C.lds, g, S, E);
        if constexpr (layer == 0) { const int nfull = (MR / 256 * (PW / 256)) % C.G;
            if (C.bid >= nfull) convert_weights(C, false, (C.bid - nfull) * 8 + C.wave, (C.G - nfull) * 8); }
        else { const int nfull = (MR / 256 * (PW / 256)) % C.G;
            if (C.bid >= nfull) convert_expert_down(C, (C.bid - nfull) * 8 + C.wave, (C.G - nfull) * 8); }
    } else if constexpr (k == 2) {
        if (SUB != 2) phase_gla_local(C, layer);
        if (SUB != 1) {
            const int r5 = (NB * NCH * 4) % C.G;
            if (r5 == 0) phase_mla_prep(C, C.vcu * 8 + C.wave, C.G * 8);
            else if (C.bid >= r5) phase_mla_prep(C, (C.bid - r5) * 8 + C.wave, (C.G - r5) * 8); }
    } else if constexpr (k == 3) {
        if (SUB != 2) phase_gla_scan(C);
        if (SUB != 1)
        {
            const bf16* W = (const bf16*)(C.arena + A_WQKV) + (size_t)layer * 1792 * 384; const bf16* A = (const bf16*)(C.arena + R_CQKV);
#pragma unroll 1
            for (int pass = 0; pass < 2; ++pass) {
                int ps = pass; asm volatile("" : "+s"(ps));
                pg8::Gemm g{A + (ps ? 256 : 0), W + (ps ? (size_t)768 * 384 + 256 : 0), ps ? 128 : 256, 384, 384};
                pg8::StaticOrder S; S.init(ps ? MR : (layer == 0 ? MR : NLAT), ps ? 1024 : 768, C.G, C.bid);
                pg8::Epi8<FStoreQKV> E{{(bf16*)(C.arena + R_QB), (char*)(C.arena + R_KB), (char*)(C.arena + R_VB), ps ? 768 : 0}};
                pg8::gemm_phase(C.lds, g, S, E); }
        }
    } else if constexpr (k == 4) {
        if (SUB != 2) phase_gla_out(C, layer);
        if (SUB != 1) phase_attention(C, layer);
    } else if constexpr (k == 5) {
        pg8::Gemm g{(const bf16*)(C.arena + R_MIX), (const bf16*)(C.arena + A_WOUT) + (size_t)layer * 1024 * 1024, 1024, 1024, 1024};
        pg8::StaticOrder S; S.init(NLAT, DM, C.G, C.bid);
        pg8::Epi8<FResidual> E{{C.in[I_X], C.in[I_CTX], (bf16*)(C.ws + WS_XL), MODB + (size_t)layer * 3 * 6144 + 2 * 1024, layer == 0 ? 1 : 0}};
        pg8::gemm_phase(C.lds, g, S, E);
        if constexpr (layer == 0) {
            pg8::Gemm g2{(const bf16*)(C.arena + R_MIX), (const bf16*)(C.arena + A_WOUT), 256, 1024, 1024};
            pg8::CtxSplitOrder S2{4, C.G, C.bid}; pg8::EpiPart E2{(float*)(C.arena + R_PART)};
            pg8::gemm_phase(C.lds, g2, S2, E2); }
    } else if constexpr (k == 6) { phase_norm2(C, layer); if constexpr (layer == 1) convert_expert_gu(C, C.vcu * 8 + C.wave, C.G * 8); }
    else if constexpr (layer == 0 && k == 7) {
        pg8::Gemm g{(const bf16*)(C.ws + WS_H), (const bf16*)(C.arena + A_FGU), 1024, 1024, 1024};
        pg8::StaticOrder S; S.init(MR, 2 * DFF, C.G, C.bid); pg8::EpiGU<FStoreAct> E{{(bf16*)(C.arena + R_ACT), DFF}, 1 << 20};
        pg8::gemm_phase(C.lds, g, S, E);
    } else if constexpr (layer == 0 && k == 8) {
        pg8::Gemm g{(const bf16*)(C.arena + R_ACT), (const bf16*)(C.arena + A_FD), DFF, DFF, DFF};
        pg8::StaticOrder S; S.init(NLAT, DM, C.G, C.bid);
        pg8::Epi8<FResidual> E{{C.in[I_X], C.in[I_CTX], (bf16*)(C.ws + WS_XL), MODB + 5 * 1024, 0}};
        pg8::gemm_phase(C.lds, g, S, E);
        {
            pg8::Gemm g2{(const bf16*)(C.arena + R_ACT), (const bf16*)(C.arena + A_FD), 256, DFF, DFF};
            pg8::CtxSplitOrder S2{11, C.G, C.bid}; pg8::EpiPart E2{(float*)(C.arena + R_PART)};
            pg8::gemm_phase(C.lds, g2, S2, E2); }
    }
    else if constexpr (layer == 1 && (k == 9 || k == 11)) {
        constexpr int half = (k - 9) / 2;
        if constexpr (half == 1) moe_tail_reduce0(C);
        pg8::MoeGatherOrder S; moe_tile_bases(C, S.tb); S.ncol = half ? MOE_T1 : MOE_T0; S.tpe = 28; S.joff = half ? MOE_T0 : 0; S.G = C.G; S.c = C.bid;
        S.LISTE = (const int*)(C.arena + M_LISTE);
        { const unsigned* ctl = (const unsigned*)(C.ws + WS_CTL);
#pragma unroll
          for (int e = 0; e < 8; ++e) S.cnt[e] = (int)__hip_atomic_load(ctl + CW_CNT + 64 * e, __ATOMIC_RELAXED, __HIP_MEMORY_SCOPE_AGENT); }
        pg8::Gemm g{(const bf16*)(C.arena + M_HS), (const bf16*)(C.arena + M_EGU), 1024, 1024, 1024};
        pg8::EpiGU<FStoreAct> E{{(bf16*)(C.arena + M_ACT) - (size_t)(half ? MOE_K0 : 0), half ? MOE_K1 : MOE_K0}, 28};
        pg8::gemm_phase(C.lds, g, S, E);
        if constexpr (half == 0) moe_fill_lists(C);
    } else if constexpr (layer == 1 && (k == 10 || k == 12)) {
        constexpr int half = (k - 10) / 2;
        const int* ENT = (const int*)(C.ws + WS_LIST + AL((size_t)NLAT * 2 * 4 * 3)); const float* WTS = (const float*)(ENT + MAXT * 256);
        pg8::MoeTailOrder ST; moe_tile_bases(C, ST.tb); const int ntot = ST.tb[8];
        pg8::MoeOrder S;
#pragma unroll
        for (int e = 0; e < 9; ++e) S.tb[e] = ST.tb[e] < MOE_MAIN ? ST.tb[e] : MOE_MAIN;
        S.ncol = 4; S.tpe = 4; S.joff = 0; S.G = C.G; S.c = C.bid;
        constexpr int KP = half ? MOE_K1 : MOE_K0;
        pg8::Gemm g{(const bf16*)(C.arena + M_ACT), (const bf16*)(C.ws + WS_ED) + (size_t)(half ? MOE_K0 : 0), KP, KP, DFE};
        pg8::Epi8<FMoeDown> E{{ENT, WTS, half ? (bf16*)(C.arena + M_EGU) : (bf16*)(C.ws + WS_Y0), half ? (bf16*)(C.arena + M_EGU) + (size_t)NLAT * DM : (bf16*)(C.ws + WS_H), MODB + (size_t)3 * 6144 + 5 * 1024}};
        pg8::gemm_phase(C.lds, g, S, E);
        if (ntot > MOE_MAIN) {
            constexpr int KC = half ? MOE_C1 : MOE_C0;
            ST.nm = MOE_MAIN; ST.ntail = ntot - MOE_MAIN; ST.nchunk = half ? MOE_NC1 : MOE_NC0; ST.G = C.G; ST.c = C.bid;
            pg8::Gemm g2{(const bf16*)(C.arena + M_ACT), (const bf16*)(C.ws + WS_ED) + (size_t)(half ? MOE_K0 : 0), KC, KP, DFE};
            pg8::EpiPartT E2{half ? (bf16*)(C.arena + M_HS) : (bf16*)(C.arena + M_PT0), MOE_MAIN};
            pg8::gemm_phase(C.lds, g2, ST, E2); }
    }
}

__device__ __forceinline__ void make_ctx(Ctx& C, const Args& args, unsigned char* lds_raw) {
    C.lds = (LAS unsigned char*)lds_raw; C.ldsg = lds_raw; C.ws = args.ws; C.arena = args.ws + WS_ARENA; C.in = args.in; C.out = args.out;
    C.tid = threadIdx.x; C.lane = C.tid & 63; C.wave = __builtin_amdgcn_readfirstlane(C.tid >> 6);
    C.G = gridDim.x; C.bid = blockIdx.x; C.vcu = (C.G % 8 == 0) ? (C.bid % 8) * (C.G / 8) + C.bid / 8 : C.bid;
}

template <int PH> __device__ __forceinline__ void run_from(const Ctx& C, const XcdBarrier& bar) {
    if constexpr (PH < N_PHASES) {
        if constexpr (phase_exists(PH)) {
            unsigned long long t0_ = 0; if constexpr (DBG_DELAY(PH) != 0) t0_ = __builtin_amdgcn_s_memrealtime();
            run_phase<PH>(C); if constexpr (PH != PH_FINAL) xcd_barrier(bar);
            if constexpr (DBG_DELAY(PH) != 0) { const unsigned long long t1_ = __builtin_amdgcn_s_memrealtime(); while (__builtin_amdgcn_s_memrealtime() - t1_ < t1_ - t0_) __builtin_amdgcn_s_sleep(8); __syncthreads(); }
            if constexpr (DBG_REP(PH) > 0) { run_phase<PH, DBG_REP(PH) - 1>(C); xcd_barrier(bar); } }
        run_from<PH + 1>(C, bar);
    }
}

#if !MK_PER_PHASE
__global__ void __launch_bounds__(512, 2) mega_fwd(Args args) {
    extern __shared__ __attribute__((aligned(16))) unsigned char lds_raw[];
    Ctx C; make_ctx(C, args, lds_raw);
    volatile LAS unsigned* MISC = (volatile LAS unsigned*)(C.lds + MISC_OFF);
    if (C.tid < 64) MISC[C.tid] = 0u;
    __syncthreads();
    unsigned* ctl = (unsigned*)(C.ws + WS_CTL);
    const XcdBarrier bar = xcd_barrier_post(ctl + CW_BAR, MISC + 8);
    run_from<0>(C, bar);
}
#else
template <int PH> __global__ void __launch_bounds__(512, 2) phase_kernel(Args args) {
    extern __shared__ __attribute__((aligned(16))) unsigned char lds_raw[];
    Ctx C; make_ctx(C, args, lds_raw);
    run_phase<PH>(C);
}
template <int PH> void launch_from(int grid, hipStream_t stream, const Args& a) {
    if constexpr (PH < N_PHASES) {
        if constexpr (phase_exists(PH)) {
            (void)hipFuncSetAttribute((const void*)phase_kernel<PH>, hipFuncAttributeMaxDynamicSharedMemorySize, LDS_BYTES);
            hipLaunchKernelGGL(phase_kernel<PH>, dim3(grid), dim3(512), LDS_BYTES, stream, a);
        }
        launch_from<PH + 1>(grid, stream, a);
    }
}
#endif

extern "C" void kernel_launch(void* const* d_in, const int* in_sizes, int n_in, void* d_out, int out_size, void* d_ws, size_t ws_size, hipStream_t stream) {
    static int grid = 0;
    if (grid == 0) {
        if (n_in != 25 || out_size != NLAT * DM || ws_size < WS_END) { fprintf(stderr, "kernel_launch: unexpected shapes (n_in %d, out %d, ws %zu < %zu); nothing launched\n", n_in, out_size, ws_size, (size_t)WS_END); grid = -1; return; }
        int dev = 0, cus = 0;
        if (hipGetDevice(&dev) != hipSuccess || hipDeviceGetAttribute(&cus, hipDeviceAttributeMultiprocessorCount, dev) != hipSuccess) { grid = -1; return; }
#if !MK_PER_PHASE
        if (hipFuncSetAttribute((const void*)mega_fwd, hipFuncAttributeMaxDynamicSharedMemorySize, LDS_BYTES) != hipSuccess) { fprintf(stderr, "kernel_launch: hipFuncSetAttribute failed\n"); grid = -1; return; }
        int per_cu = 0;
        if (hipOccupancyMaxActiveBlocksPerMultiprocessor(&per_cu, (const void*)mega_fwd, 512, LDS_BYTES) != hipSuccess || per_cu < 1) { fprintf(stderr, "kernel_launch: occupancy query reports %d blocks per CU\n", per_cu); }
        (void)hipGetLastError();
#endif
        grid = cus;
    }
    if (grid < 0) return;
    if (hipMemsetAsync((char*)d_ws + WS_CTL, 0, CTL_BYTES, stream) != hipSuccess) return;
    Args a{};
    for (int i = 0; i < 25; ++i) a.in[i] = (const float*)d_in[i];
    a.out = (float*)d_out; a.ws = (unsigned char*)d_ws;
#if MK_PER_PHASE
    launch_from<0>(grid, stream, a);
#else
    hipLaunchKernelGGL(mega_fwd, dim3(grid), dim3(512), LDS_BYTES, stream, a);
#endif
    const hipError_t le = hipPeekAtLastError();
    if (le != hipSuccess) fprintf(stderr, "kernel_launch: launch failed: %s\n", hipGetErrorName(le));
}
```

```cpp
#include <hip/hip_runtime.h>
#include <cstdio>
#include <cstdint>

#define LAS __attribute__((address_space(3)))
#define GAS __attribute__((address_space(1)))
typedef unsigned short bf16;
typedef short bf16x8 __attribute__((ext_vector_type(8)));
typedef short s16x4 __attribute__((ext_vector_type(4)));
typedef float f32x2 __attribute__((ext_vector_type(2)));
typedef float f32x4 __attribute__((ext_vector_type(4)));
typedef float f32x16 __attribute__((ext_vector_type(16)));
typedef unsigned u32x2 __attribute__((ext_vector_type(2)));
typedef unsigned u32x4 __attribute__((ext_vector_type(4)));

#ifndef MK_PER_PHASE
#define MK_PER_PHASE 0
#endif

constexpr int DM = 1024, NB = 2, TT = 8192, TC = 256, NLAT = NB * TT, NCTXR = NB * TC, MR = NLAT + NCTXR;
constexpr int TKV = TT + TC;
constexpr int PW = 2048;
constexpr int PC_Q = 0, PC_K = 256, PC_V = 512, PC_R = 1024, PC_CQ = 1536, PC_CKV = 1792, PC_KR = 1920, PC_GF = 1984, PC_GB = 2000;
constexpr int NCH = 132;
constexpr int DFF = 2816, DFE = 3584, NEXP = 8;
constexpr int MOE_T0 = 15, MOE_T1 = 28 - MOE_T0, MOE_K0 = MOE_T0 * 128, MOE_K1 = MOE_T1 * 128;
constexpr int MOE_MAIN = 128, MOE_C0 = 384, MOE_NC0 = 5, MOE_C1 = 128, MOE_NC1 = 13;
constexpr int MAXT = 136;
constexpr float EPS = 1e-6f;
constexpr float MLA_SCALE = 0.07216878364870322f;
namespace att {
constexpr int KT_BYTES = 24576, VT_BYTES = 16384;
__host__ __device__ __forceinline__ int v_st(int k, int c) { const int kk = (k & ~0xC) | ((k & 4) << 1) | ((k & 8) >> 1); return ((kk >> 3) * 4 + (c >> 5)) * 512 + ((kk & 7) * 32 + (c & 31)) * 2; }
}

constexpr size_t AL(size_t x) { return (x + 255) & ~(size_t)255; }
constexpr size_t WS_CTL = 0, CTL_BYTES = 65536;
constexpr size_t WS_MOD = WS_CTL + CTL_BYTES;
constexpr size_t WS_ROPE = WS_MOD + AL(2 * 3 * 6144 * 4);
constexpr size_t WS_XL = WS_ROPE + AL((128 + 64) * 32 * 4);
constexpr size_t WS_H = WS_XL + AL((size_t)MR * DM * 2);
constexpr size_t WS_LIST = WS_H + AL((size_t)MR * DM * 2);
constexpr size_t LIST_BYTES = AL((size_t)NLAT * 2 * 4 * 3) + AL((size_t)MAXT * 256 * 4 * 2) + AL((size_t)NLAT * 2 * 4);
constexpr size_t WS_Y0 = WS_LIST + LIST_BYTES;
constexpr size_t WS_ARENA = WS_Y0 + AL((size_t)NLAT * DM * 2);
constexpr size_t A_WIN = 0;
constexpr size_t A_WQKV = A_WIN + AL((size_t)2 * 2048 * 1024 * 2);
constexpr size_t A_WOUT = A_WQKV + AL((size_t)2 * 1792 * 384 * 2);
constexpr size_t A_FGU = A_WOUT + AL((size_t)2 * 1024 * 1024 * 2);
constexpr size_t A_FD = A_FGU + AL((size_t)2 * DFF * 1024 * 2);
constexpr size_t A_R = A_FD + AL((size_t)1024 * DFF * 2);
constexpr size_t R_P = A_R;
constexpr size_t R_QT = R_P + AL((size_t)MR * PW * 2);
constexpr size_t R_KT = R_QT + AL((size_t)2 * MR * 256 * 2);
constexpr size_t R_SLOC = R_KT + AL((size_t)2 * MR * 256 * 2);
constexpr size_t R_DEC = R_SLOC + AL((size_t)16 * NCH * 8192 * 4);
constexpr size_t R_SST = R_DEC + AL((size_t)16 * NCH * 64 * 4);
constexpr size_t R_CQKV = R_SST + AL((size_t)16 * NCH * 8192 * 2);
constexpr size_t R_QB = R_CQKV + AL((size_t)MR * 384 * 2);
constexpr size_t R_KB = R_QB + AL((size_t)8 * TKV * 192 * 2);
constexpr size_t R_VB = R_KB + AL((size_t)8 * TKV * 192 * 2);
constexpr size_t R_MIX = R_VB + AL((size_t)8 * TKV * 128 * 2);
constexpr size_t R_END = R_MIX + AL((size_t)MR * DM * 2);
constexpr size_t R_PART = R_SLOC;
constexpr size_t R_ACT = A_R;
static_assert(R_ACT + (size_t)MR * DFF * 2 <= R_SLOC && (size_t)11 * 512 * 1024 * 4 <= (size_t)16 * NCH * 8192 * 4, "ACT ends below SLOC; PART fits SLOC");
constexpr size_t M_EGU = 0;
constexpr size_t M_HS = M_EGU + AL((size_t)NEXP * 2 * DFE * 1024 * 2);
constexpr size_t M_LISTE = M_HS + AL((size_t)NLAT * DM * 2);
constexpr size_t M_ACT = M_HS + AL((size_t)MAXT * 256 * 1024 * 2);
constexpr size_t M_PT0 = M_ACT + AL((size_t)MAXT * 256 * MOE_K0 * 2);
constexpr size_t M_END = M_PT0 + AL((size_t)MOE_NC0 * 2048 * 1024 * 2);
constexpr size_t ARENA_BYTES = (R_END > M_END) ? R_END : M_END;
constexpr size_t WS_ED = WS_ARENA + ARENA_BYTES;
constexpr size_t WS_END = WS_ED + AL((size_t)NEXP * 1024 * DFE * 2);
static_assert(WS_END <= 534000000ull, "workspace map exceeds the guaranteed scratch size");

constexpr int CW_BAR = 4096;
constexpr int CW_CNT = 64;

constexpr int LDS_BYTES = 147456, MISC_OFF = LDS_BYTES - 256;

__device__ __forceinline__ unsigned f2bf_s(float f) { unsigned u = __builtin_bit_cast(unsigned, f); return (u + 0x7fffu + ((u >> 16) & 1u)) >> 16; }
__device__ __forceinline__ unsigned pk2s(float lo, float hi) { return f2bf_s(lo) | (f2bf_s(hi) << 16); }
typedef __bf16 bf16x2_t __attribute__((ext_vector_type(2)));
__device__ __forceinline__ unsigned pk2h(float lo, float hi) { const f32x2 v = {lo, hi}; return __builtin_bit_cast(unsigned, __builtin_convertvector(v, bf16x2_t)); }
__device__ __forceinline__ unsigned pk2(float lo, float hi) { return pk2h(lo, hi); }
__device__ __forceinline__ unsigned f2bf(float f) { return pk2h(f, 0.f) & 0xffffu; }
__device__ __forceinline__ u32x4 pack8h(const float* v) { u32x4 w; w.x = pk2h(v[0], v[1]); w.y = pk2h(v[2], v[3]); w.z = pk2h(v[4], v[5]); w.w = pk2h(v[6], v[7]); return w; }
__device__ __forceinline__ float bf2f(unsigned b) { return __builtin_bit_cast(float, b << 16); }
__device__ __forceinline__ float bflo(unsigned w) { return __builtin_bit_cast(float, w << 16); }
__device__ __forceinline__ float bfhi(unsigned w) { return __builtin_bit_cast(float, w & 0xffff0000u); }
__device__ __forceinline__ u32x4 pack8s(const float* v) { u32x4 w; w.x = pk2s(v[0], v[1]); w.y = pk2s(v[2], v[3]); w.z = pk2s(v[4], v[5]); w.w = pk2s(v[6], v[7]); return w; }
__device__ __forceinline__ u32x4 pack8(const float* v) { u32x4 w; w.x = pk2(v[0], v[1]); w.y = pk2(v[2], v[3]); w.z = pk2(v[4], v[5]); w.w = pk2(v[6], v[7]); return w; }
__device__ __forceinline__ void unpack8_raw(u32x4 w, bf16* v) { v[0] = (bf16)(w.x & 0xffffu); v[1] = (bf16)(w.x >> 16); v[2] = (bf16)(w.y & 0xffffu); v[3] = (bf16)(w.y >> 16); v[4] = (bf16)(w.z & 0xffffu); v[5] = (bf16)(w.z >> 16); v[6] = (bf16)(w.w & 0xffffu); v[7] = (bf16)(w.w >> 16); }
__device__ __forceinline__ void unpack8(u32x4 w, float* v) { v[0] = bflo(w.x); v[1] = bfhi(w.x); v[2] = bflo(w.y); v[3] = bfhi(w.y); v[4] = bflo(w.z); v[5] = bfhi(w.z); v[6] = bflo(w.w); v[7] = bfhi(w.w); }
__device__ __forceinline__ float wave_sum(float v) {
#pragma unroll
    for (int o = 1; o < 64; o <<= 1) v += __shfl_xor(v, o);
    return v;
}
__device__ __forceinline__ float silu_f(float x) { return x * __builtin_amdgcn_rcpf(1.f + __expf(-x)); }
__device__ __forceinline__ float logsig_f(float x) { return fminf(x, 0.f) - __logf(1.f + __expf(-fabsf(x))); }
#define LDS_WAIT() asm volatile("s_waitcnt lgkmcnt(0)" ::: "memory")
#define VM_WAIT() asm volatile("s_waitcnt vmcnt(0)" ::: "memory")

namespace pg8 {
constexpr int BM = 256, BK = 64, HALF = 128, HTB = HALF * BK * 2, NXCD = 8, WGM = 8;
__host__ __device__ __forceinline__ int lds_byte(int r, int c) { const int st = (r >> 4) * 2 + (c >> 5), rr = r & 15, cc = c & 31, ob = rr * 64 + cc * 2; return st * 1024 + (ob ^ (((ob >> 9) & 1) << 5)); }
__host__ __device__ __forceinline__ void stage_rc(int b, int& R, int& C) { const int st = b / 1024, sb = b % 1024, swz = sb ^ (((sb >> 9) & 1) << 5); R = (st >> 1) * 16 + swz / 64; C = (st & 1) * 32 + (swz % 64) / 2; }
__host__ __device__ __forceinline__ int perm32(int rho) { const int n = rho >> 4, i = rho & 15; return 8 * (i >> 2) + 4 * n + (i & 3); }

struct Unit { int pm, pn, kc; };
struct Gemm { const bf16* A; const bf16* Bt; int K, lda, ldb; };

struct StaticOrder {
    static constexpr bool GATHER = false;
    int nM, nN, nwg, G, c;
    __device__ void init(int M, int N, int G_, int c_) { nM = M / BM; nN = N / BM; nwg = nM * nN; G = G_; c = c_; }
    __device__ bool next(int i, Unit& u) const {
        const long L = (long)i * G + c; if (L >= nwg) return false;
        int wgid = (int)L; { const int q = nwg / NXCD, r = nwg % NXCD, xcd = wgid % NXCD, off = wgid / NXCD; wgid = (xcd < r ? xcd * (q + 1) : r * (q + 1) + (xcd - r) * q) + off; }
        const int nig = WGM * nN, gid = wgid / nig, fm = gid * WGM, gsz = (nM - fm) < WGM ? (nM - fm) : WGM;
        u.pm = fm + ((wgid % nig) % gsz); u.pn = (wgid % nig) / gsz; u.kc = 0; return true;
    }
};
struct MoeOrder {
    static constexpr bool GATHER = false;
    int tb[9]; int ncol, tpe, joff, G, c;
    __device__ bool next(int i, Unit& u) const {
        const int nM = tb[8], nwg = nM * ncol; const long L = (long)i * G + c; if (L >= nwg) return false;
        int wgid = (int)L; { const int q = nwg / NXCD, r = nwg % NXCD, xcd = wgid % NXCD, off = wgid / NXCD; wgid = (xcd < r ? xcd * (q + 1) : r * (q + 1) + (xcd - r) * q) + off; }
        const int nig = WGM * ncol, gid = wgid / nig, fm = gid * WGM, gsz = (nM - fm) < WGM ? (nM - fm) : WGM;
        const int tile = fm + ((wgid % nig) % gsz), j = (wgid % nig) / gsz; int e = 0;
#pragma unroll
        for (int k = 1; k < 8; ++k) e += (tile >= tb[k]) ? 1 : 0;
        u.pm = tile; u.pn = e * tpe + joff + j; u.kc = 0; return true;
    }
};
struct MoeTailOrder {
    static constexpr bool GATHER = false;
    int tb[9]; int nm, ntail, nchunk, G, c;
    __device__ bool next(int i, Unit& u) const {
        const int per = ntail * 4, L = i * G + c; if (L >= per * nchunk) return false;
        const int kc = L / per, r = L - kc * per, tile = nm + (r >> 2); int e = 0;
#pragma unroll
        for (int k = 1; k < 8; ++k) e += (tile >= tb[k]) ? 1 : 0;
        u.pm = tile; u.pn = e * 4 + (r & 3); u.kc = kc; return true;
    }
};
struct CtxSplitOrder {
    static constexpr bool GATHER = false;
    int nchunk, G, c;
    __device__ bool next(int i, Unit& u) const { const int L = i * G + c; if (L >= nchunk * 8) return false; const int r = L & 7; u.kc = L >> 3; u.pm = 64 + (r & 1); u.pn = r >> 1; return true; }
};
struct MoeGatherOrder : MoeOrder {
    static constexpr bool GATHER = true;
    const int* LISTE; int cnt[8];
    __device__ __forceinline__ void rows_of(const Unit& u, const int*& src, int& nvalid) const {
        int e = 0;
#pragma unroll
        for (int k = 1; k < 8; ++k) e += (u.pm >= tb[k]) ? 1 : 0;
        int tbe = 0, ce = 0;
#pragma unroll
        for (int k = 0; k < 8; ++k) { tbe = (e == k) ? tb[k] : tbe; ce = (e == k) ? cnt[k] : ce; }
        const int s0 = (u.pm - tbe) * 256; src = LISTE + e * 16384 + s0; nvalid = ce - s0;
    }
};
template <class Epi, class Sched>
__device__ __forceinline__ void gemm_phase(LAS unsigned char* lds, const Gemm g, const Sched& S, const Epi& E) {
    int tid = threadIdx.x; asm volatile("" : "+v"(tid));
    const int wid = __builtin_amdgcn_readfirstlane(tid >> 6), lane = tid & 63, wr = wid >> 2, wc = wid & 3, fr = lane & 15, fq = lane >> 4;
    const int K = g.K, nt = K / BK;
    constexpr bool GA = Sched::GATHER;
    unsigned voffA[2], voffB[2], vG[2][2]; int RA[2], CA[2];
#pragma unroll
    for (int i = 0; i < 2; ++i) { int R, C; stage_rc(tid * 16 + i * 8192, R, C); const int Rb = (R & ~31) + perm32(R & 31); RA[i] = R; CA[i] = C;
        voffA[i] = (unsigned)(R * g.lda + C) * 2u; voffB[i] = (unsigned)(Rb * g.ldb + C) * 2u; vG[0][i] = vG[1][i] = 0u; }
    const size_t kstep = (size_t)(BK * 2);
    const size_t hstepA = GA ? (size_t)0 : (size_t)HALF * g.lda * 2, hstepB = (size_t)HALF * g.ldb * 2;
    constexpr int TAB_OFF = 8 * HTB;
#define PG8_IDX_ISSUE(u, par) do { if constexpr (GA) { const int* _src; int _nv; S.rows_of(u, _src, _nv); \
        __builtin_amdgcn_global_load_lds((const unsigned*)(_src + (wid & 3) * 64 + lane), (LAS unsigned*)(lds + TAB_OFF + (par) * 1024 + (wid & 3) * 256), 4, 0, 0); } } while (0)
#define PG8_IDX_READ(u, par) do { if constexpr (GA) { const int* _src; int _nv; S.rows_of(u, _src, _nv); _Pragma("unroll") for (int _h = 0; _h < 2; ++_h) _Pragma("unroll") for (int _i = 0; _i < 2; ++_i) { \
        const int _r = _h * HALF + RA[_i]; const int _raw = *(const LAS int*)(lds + TAB_OFF + (par) * 1024 + _r * 4); const int _row = _r < _nv ? (_raw >> 1) : 0; vG[_h][_i] = (unsigned)(_row * g.lda + CA[_i]) * 2u; } } } while (0)
    const size_t tstepA = 2 * hstepA, tstepB = 2 * hstepB;
    const unsigned ldsw = (unsigned)wid * 1024u;
    const int aoff = lds_byte(wr * 64 + fr, fq * 8), boff = lds_byte(wc * 32 + fr, fq * 8);
#define PG8_SA(b, h) (((b) * 2 + (h)) * HTB)
#define PG8_SB(b, h) ((4 + (b) * 2 + (h)) * HTB)
#define PG8_STAGE(bufoff, gbase, voff) do { _Pragma("unroll") for (int _i = 0; _i < 2; ++_i) \
        __builtin_amdgcn_global_load_lds((const unsigned*)((const char*)(gbase) + (voff)[_i]), (LAS unsigned*)(lds + (bufoff) + ldsw + _i * 8192), 16, 0, 0); } while (0)
#define PG8_STAGE_A(bufoff, gbase, h) do { if constexpr (GA) PG8_STAGE(bufoff, gbase, vG[h]); else PG8_STAGE(bufoff, gbase, voffA); } while (0)
#define PG8_LDA(dst, b, h) do { _Pragma("unroll") for (int m = 0; m < 4; ++m) _Pragma("unroll") for (int k = 0; k < 2; ++k) dst[m][k] = *(const LAS bf16x8*)(lds + PG8_SA(b, h) + aoff + m * 2048 + k * 1024); } while (0)
#define PG8_LDB(dst, b, h) do { _Pragma("unroll") for (int n = 0; n < 2; ++n) _Pragma("unroll") for (int k = 0; k < 2; ++k) dst[n][k] = *(const LAS bf16x8*)(lds + PG8_SB(b, h) + boff + n * 2048 + k * 1024); } while (0)
#define PG8_MMA(ai, bj, At, Bt) do { __builtin_amdgcn_s_setprio(1); _Pragma("unroll") for (int m = 0; m < 4; ++m) _Pragma("unroll") for (int n = 0; n < 2; ++n) _Pragma("unroll") for (int k = 0; k < 2; ++k) \
        acc[ai][bj][m][n] = __builtin_amdgcn_mfma_f32_16x16x32_bf16(Bt[n][k], At[m][k], acc[ai][bj][m][n], 0, 0, 0); __builtin_amdgcn_s_setprio(0); } while (0)
#define PG8_WAIT_V(n) asm volatile("s_waitcnt vmcnt(" #n ")" ::: "memory")
#define PG8_WAIT_L(n) asm volatile("s_waitcnt lgkmcnt(" #n ")" ::: "memory")
#define PG8_BAR __builtin_amdgcn_s_barrier()
#define PG8_SCHED __builtin_amdgcn_sched_barrier(0)
    Unit cur, nxt; int ui = 0;
    if (!S.next(0, cur)) return;
    f32x4 acc[2][2][4][2];
#pragma unroll
    for (int a = 0; a < 2; ++a)
#pragma unroll
        for (int b = 0; b < 2; ++b)
#pragma unroll
            for (int m = 0; m < 4; ++m)
#pragma unroll
                for (int n = 0; n < 2; ++n) acc[a][b][m][n] = (f32x4){0.f, 0.f, 0.f, 0.f};
    bf16x8 At[4][2], B0[2][2], B1[2][2];
    const size_t cstep = (size_t)K * 2;
    const char* cA = (const char*)g.A + (GA ? (size_t)0 : (size_t)cur.pm * tstepA) + cur.kc * cstep; const char* cB = (const char*)g.Bt + (size_t)cur.pn * tstepB + cur.kc * cstep;
    if constexpr (GA) { PG8_IDX_ISSUE(cur, 0); PG8_WAIT_V(0); PG8_BAR; PG8_IDX_READ(cur, 0); }
    PG8_STAGE(PG8_SB(0, 0), cB, voffB); PG8_STAGE(PG8_SB(0, 1), cB + hstepB, voffB); PG8_STAGE_A(PG8_SA(0, 0), cA, 0); PG8_STAGE_A(PG8_SA(0, 1), cA + hstepA, 1);
    if (wr == 1) PG8_BAR;
    PG8_WAIT_V(2); PG8_BAR;
    PG8_STAGE(PG8_SB(1, 0), cB + kstep, voffB); PG8_STAGE_A(PG8_SA(1, 0), cA + kstep, 0); PG8_STAGE(PG8_SB(1, 1), cB + hstepB + kstep, voffB);
    PG8_WAIT_V(6); PG8_BAR;
    for (;;) {
        const bool has_next = S.next(ui + 1, nxt);
        if (has_next) PG8_IDX_ISSUE(nxt, (ui + 1) & 1);
        const char* nA = has_next ? (const char*)g.A + (GA ? (size_t)0 : (size_t)nxt.pm * tstepA) + nxt.kc * cstep : cA; const char* nB = has_next ? (const char*)g.Bt + (size_t)nxt.pn * tstepB + nxt.kc * cstep : cB;
#pragma unroll 1
        for (int t = 0; t < nt; t += 2) {
            const bool last = (t == nt - 2);
            const char* a1 = cA + (size_t)(t + 1) * kstep;
            const char* a2 = last ? nA : cA + (size_t)(t + 2) * kstep; const char* b2 = last ? nB : cB + (size_t)(t + 2) * kstep;
            const char* a3 = a2 + kstep; const char* b3 = b2 + kstep;
            PG8_LDB(B0, 0, 0); PG8_LDB(B1, 0, 1); PG8_SCHED; PG8_LDA(At, 0, 0); PG8_STAGE_A(PG8_SA(1, 1), a1 + hstepA, 1);
            if constexpr (GA) { if (last && has_next) PG8_IDX_READ(nxt, (ui + 1) & 1); }
            PG8_WAIT_V(8); PG8_WAIT_L(0); PG8_BAR; PG8_MMA(0, 0, At, B0); PG8_MMA(0, 1, At, B1); PG8_BAR; PG8_SCHED;
            PG8_LDA(At, 0, 1); PG8_STAGE(PG8_SB(0, 0), b2, voffB); PG8_STAGE(PG8_SB(0, 1), b2 + hstepB, voffB); PG8_STAGE_A(PG8_SA(0, 0), a2, 0);
            PG8_WAIT_V(8); PG8_WAIT_L(0); PG8_BAR; PG8_MMA(1, 0, At, B0); PG8_MMA(1, 1, At, B1); PG8_BAR; PG8_SCHED;
            PG8_LDB(B0, 1, 0); PG8_LDB(B1, 1, 1); PG8_SCHED; PG8_LDA(At, 1, 0); PG8_STAGE_A(PG8_SA(0, 1), a2 + hstepA, 1);
            PG8_WAIT_V(8); PG8_WAIT_L(0); PG8_BAR; PG8_MMA(0, 0, At, B0); PG8_MMA(0, 1, At, B1); PG8_BAR; PG8_SCHED;
            PG8_LDA(At, 1, 1); PG8_STAGE(PG8_SB(1, 0), b3, voffB); PG8_STAGE(PG8_SB(1, 1), b3 + hstepB, voffB); PG8_STAGE_A(PG8_SA(1, 0), a3, 0);
            PG8_WAIT_V(8); PG8_WAIT_L(0); PG8_BAR; PG8_MMA(1, 0, At, B0); PG8_MMA(1, 1, At, B1); PG8_BAR; PG8_SCHED;
        }
        if (wr == 0) PG8_BAR;
        E(acc, cur, wr, wc, fr, fq);
        if (!has_next) break;
#pragma unroll
        for (int a = 0; a < 2; ++a)
#pragma unroll
            for (int b = 0; b < 2; ++b)
#pragma unroll
                for (int m = 0; m < 4; ++m)
#pragma unroll
                    for (int n = 0; n < 2; ++n) acc[a][b][m][n] = (f32x4){0.f, 0.f, 0.f, 0.f};
        cur = nxt; cA = nA; cB = nB; ++ui;
        if (wr == 1) PG8_BAR;
    }
    PG8_WAIT_V(0);
    PG8_BAR;
#undef PG8_SA
#undef PG8_SB
#undef PG8_STAGE
#undef PG8_STAGE_A
#undef PG8_IDX_ISSUE
#undef PG8_IDX_READ
#undef PG8_LDA
#undef PG8_LDB
#undef PG8_MMA
#undef PG8_WAIT_V
#undef PG8_WAIT_L
#undef PG8_BAR
#undef PG8_SCHED
}

template <class F> struct Epi8 {
    F f;
    __device__ __forceinline__ void operator()(const f32x4 (&acc)[2][2][4][2], const Unit& u, int wr, int wc, int fr, int fq) const {
        const int row0 = u.pm * BM + wr * 64 + fr, col0 = u.pn * BM + wc * 32 + 8 * fq;
#pragma unroll
        for (int ai = 0; ai < 2; ++ai)
#pragma unroll
            for (int m = 0; m < 4; ++m)
#pragma unroll
                for (int bj = 0; bj < 2; ++bj) { f(row0 + ai * HALF + m * 16, col0 + bj * HALF, acc[ai][bj][m][0], acc[ai][bj][m][1]); __builtin_amdgcn_sched_barrier(0); }
    }
};
struct EpiPart {
    float* PART;
    __device__ __forceinline__ void operator()(const f32x4 (&acc)[2][2][4][2], const Unit& u, int wr, int wc, int fr, int fq) const {
        const int row0 = (u.pm - 64) * BM + wr * 64 + fr, col0 = u.pn * BM + wc * 32 + 8 * fq; float* base = PART + (size_t)u.kc * 512 * 1024;
#pragma unroll
        for (int ai = 0; ai < 2; ++ai)
#pragma unroll
            for (int m = 0; m < 4; ++m)
#pragma unroll
                for (int bj = 0; bj < 2; ++bj) { float* d = base + (size_t)(row0 + ai * HALF + m * 16) * 1024 + col0 + bj * HALF; *(f32x4*)d = acc[ai][bj][m][0]; *(f32x4*)(d + 4) = acc[ai][bj][m][1]; }
    }
};
struct EpiPartT {
    bf16* PART; int nm;
    __device__ __forceinline__ void operator()(const f32x4 (&acc)[2][2][4][2], const Unit& u, int wr, int wc, int fr, int fq) const {
        const int row0 = (u.pm - nm) * BM + wr * 64 + fr, col0 = (u.pn & 3) * BM + wc * 32 + 8 * fq; bf16* base = PART + (size_t)u.kc * 2048 * 1024;
#pragma unroll
        for (int ai = 0; ai < 2; ++ai)
#pragma unroll
            for (int m = 0; m < 4; ++m)
#pragma unroll
                for (int bj = 0; bj < 2; ++bj) { const f32x4 v0 = acc[ai][bj][m][0], v1 = acc[ai][bj][m][1]; u32x4 w; w.x = pk2s(v0[0], v0[1]); w.y = pk2s(v0[2], v0[3]); w.z = pk2s(v1[0], v1[1]); w.w = pk2s(v1[2], v1[3]);
                    *(u32x4*)(base + (size_t)(row0 + ai * HALF + m * 16) * 1024 + col0 + bj * HALF) = w; }
    }
};
template <class F> struct EpiGU {
    F f; int tiles_per_mat;
    __device__ __forceinline__ void operator()(const f32x4 (&acc)[2][2][4][2], const Unit& u, int wr, int wc, int fr, int fq) const {
        const int row0 = u.pm * BM + wr * 64 + fr, col0 = (u.pn % tiles_per_mat) * HALF + wc * 32 + 8 * fq;
#pragma unroll
        for (int ai = 0; ai < 2; ++ai)
#pragma unroll
            for (int m = 0; m < 4; ++m) {
                float o[8];
#pragma unroll
                for (int n = 0; n < 2; ++n)
#pragma unroll
                    for (int q = 0; q < 4; ++q) { const float gt = acc[ai][0][m][n][q], up = acc[ai][1][m][n][q]; o[n * 4 + q] = gt * __builtin_amdgcn_rcpf(1.f + __expf(-gt)) * up; }
                f(row0 + ai * HALF + m * 16, col0, o);
            }
    }
};
}

#define XB_TMO      128
#define XB_XCNT(j)  (256  + 64 * (j))
#define XB_XSUB(j)  (1280 + 64 * (j))
#define XB_XGEN(j)  (2304 + 64 * (j))
#define XB_TOP      3328
#define XB_TOPGEN   3392
#define XCD_BAR_WORDS 3456
#define XB_SPIN_CAP (1u << 18)
__device__ __forceinline__ unsigned xb_ld(unsigned* p)              { return __hip_atomic_load(p, __ATOMIC_RELAXED, __HIP_MEMORY_SCOPE_AGENT); }
__device__ __forceinline__ unsigned xb_add(unsigned* p, unsigned v) { return __hip_atomic_fetch_add(p, v, __ATOMIC_RELAXED, __HIP_MEMORY_SCOPE_AGENT); }
__device__ __forceinline__ unsigned xb_xcc_id() { return (unsigned)__builtin_amdgcn_s_getreg((3 << 11) | 20) & 0xFu; }
#define XB_SPIN(cond, bar) do { unsigned _sp = 0; while (cond) { __builtin_amdgcn_s_sleep(1); \
    if ((++_sp & 255u) == 0u) { if (xb_ld(&(bar)[XB_TMO])) break; if (_sp > XB_SPIN_CAP) { atomicAdd(&(bar)[XB_TMO], 1u); break; } } } } while (0)
struct XcdBarrier { unsigned* bar; unsigned x; volatile LAS unsigned* st; };
__device__ __forceinline__ XcdBarrier xcd_barrier_post(unsigned* bar, volatile LAS unsigned* st) {
    XcdBarrier b; b.bar = bar; b.x = xb_xcc_id(); b.st = st;
    if (threadIdx.x == 0) (void)xb_add(&bar[XB_XCNT(b.x)], 1u);
    return b;
}
__device__ __forceinline__ void xcd_barrier_complete(unsigned* bar, unsigned x, unsigned& nloc, unsigned& nx) {
    const unsigned G = gridDim.x * gridDim.y * gridDim.z;
    unsigned sum, cnt, mine, sp = 0u;
    for (;;) {
        sum = 0u; cnt = 0u; mine = 0u;
#pragma unroll
        for (unsigned j = 0; j < 16; ++j) { const unsigned c = xb_ld(&bar[XB_XCNT(j)]); sum += c; cnt += (c > 0u) ? 1u : 0u; mine = (j == x) ? c : mine; }
        if (sum == G) break;
        __builtin_amdgcn_s_sleep(1);
        if ((++sp & 255u) == 0u) { if (xb_ld(&bar[XB_TMO])) break; if (sp > XB_SPIN_CAP) { atomicAdd(&bar[XB_TMO], 1u); break; } }
    }
    nloc = mine > 0u ? mine : 1u; nx = cnt > 0u ? cnt : 1u;
}
__device__ __forceinline__ void xcd_barrier(const XcdBarrier& b) {
    asm volatile("s_waitcnt vmcnt(0)" ::: "memory");
    __syncthreads();
    if (threadIdx.x == 0) {
        unsigned* bar = b.bar;
        __builtin_amdgcn_s_waitcnt(0);
        unsigned nloc = b.st[0], nx = b.st[1];
        if (nloc == 0u) { xcd_barrier_complete(bar, b.x, nloc, nx); b.st[0] = nloc; b.st[1] = nx; }
        const unsigned old = xb_add(&bar[XB_XSUB(b.x)], 1u);
        const unsigned gen = old / nloc;
        if (old + 1u == (gen + 1u) * nloc) {
            __builtin_amdgcn_fence(__ATOMIC_RELEASE, "agent");
            asm volatile("s_waitcnt vmcnt(0)" ::: "memory");
            const unsigned og = xb_add(&bar[XB_TOP], 1u);
            const unsigned tg = og / nx;
            if (og + 1u == (tg + 1u) * nx) xb_add(&bar[XB_TOPGEN], 1u);
            else XB_SPIN(xb_ld(&bar[XB_TOPGEN]) == tg, bar);
            __builtin_amdgcn_fence(__ATOMIC_ACQUIRE, "agent");
            xb_add(&bar[XB_XGEN(b.x)], 1u);
            asm volatile("s_waitcnt vmcnt(0)" ::: "memory");
        } else {
            XB_SPIN(xb_ld(&bar[XB_XGEN(b.x)]) == gen, bar);
            __builtin_amdgcn_fence(__ATOMIC_ACQUIRE, "agent");
            asm volatile("s_waitcnt vmcnt(0)" ::: "memory");
        }
    }
    __syncthreads();
}

struct Args {
    const float* in[25];
    float* out; unsigned char* ws;
    int ph_lo, ph_hi;
};
enum { I_X = 0, I_C, I_CTX, I_CCTX, I_WMOD, I_BMOD, I_LN1, I_LN2, I_WIN, I_WG2, I_BG2, I_GLAG, I_QNG, I_WUQ, I_KVNG, I_WUKV, I_WOUT, I_FG, I_FU, I_FD, I_RW, I_EG, I_EU, I_ED, I_FNG };

struct Ctx {
    LAS unsigned char* lds; unsigned char* ldsg; unsigned char* ws; unsigned char* arena; const float* const* in; float* out;
    int tid, lane, wave, G, bid, vcu;
};

__device__ __forceinline__ int mod_row(int row) { return row < NLAT ? (row >> 13) : 2; }
__device__ __forceinline__ void row_bpos(int row, int& b, int& pos) { if (row < NLAT) { b = row >> 13; pos = row & (TT - 1); } else { const int r2 = row - NLAT; b = r2 >> 8; pos = TT + (r2 & 255); } }
__device__ __forceinline__ int chunk_row(int b, int a) { return a < 128 ? b * TT + a * 64 : NLAT + b * TC + (a - 128) * 64; }

template <class SrcFn>
__device__ __forceinline__ void transpose_item(const SrcFn& src, bf16* dst, int ldk, int k0, int n0, LAS float* scr, int lane) {
    float tv[64];
#pragma unroll
    for (int i = 0; i < 64; ++i) tv[i] = src(k0 + i, n0 + lane);
#pragma unroll
    for (int i = 0; i < 64; ++i) scr[i * 65 + lane] = tv[i];
    LDS_WAIT(); asm volatile("" ::: "memory");
    const int c = lane & 7;
#pragma unroll
    for (int j = 0; j < 8; ++j) { const int n = (lane >> 3) + 8 * j; const LAS float* s = scr + (8 * c) * 65 + n;
        u32x4 o; o.x = pk2(s[0 * 65], s[1 * 65]); o.y = pk2(s[2 * 65], s[3 * 65]); o.z = pk2(s[4 * 65], s[5 * 65]); o.w = pk2(s[6 * 65], s[7 * 65]);
        *(u32x4*)(dst + (size_t)(n0 + n) * ldk + k0 + 8 * c) = o; }
    LDS_WAIT(); asm volatile("" ::: "memory");
}
__device__ __forceinline__ void transpose_item_fast(const float* S, int ld, bf16* dst, int ldk, int k0, int n0, LAS float* scr, int lane, const float* rowscale = nullptr) {
    f32x4 v[16];
#pragma unroll
    for (int i = 0; i < 16; ++i) v[i] = __builtin_nontemporal_load((const f32x4*)(S + (size_t)(i * 4 + (lane >> 4)) * ld + (lane & 15) * 4));
    if (rowscale) {
#pragma unroll
        for (int i = 0; i < 16; ++i) v[i] *= rowscale[i * 4 + (lane >> 4)]; }
#pragma unroll
    for (int i = 0; i < 16; ++i) { LAS float* p = scr + (i * 4 + (lane >> 4)) * 65 + (lane & 15) * 4; p[0] = v[i].x; p[1] = v[i].y; p[2] = v[i].z; p[3] = v[i].w; }
    LDS_WAIT(); asm volatile("" ::: "memory");
    const int c = lane & 7;
#pragma unroll
    for (int j = 0; j < 8; ++j) { const int n = (lane >> 3) + 8 * j; const LAS float* s = scr + (8 * c) * 65 + n;
        u32x4 o; o.x = pk2(s[0 * 65], s[1 * 65]); o.y = pk2(s[2 * 65], s[3 * 65]); o.z = pk2(s[4 * 65], s[5 * 65]); o.w = pk2(s[6 * 65], s[7 * 65]);
        *(u32x4*)(dst + (size_t)(n0 + n) * ldk + k0 + 8 * c) = o; }
    LDS_WAIT(); asm volatile("" ::: "memory");
}
__device__ __forceinline__ int rope_unperm(int jj) { const int pair = jj >> 1, which = jj & 1; return pair < 16 ? pair + 16 * which : 32 + (pair - 16) + 16 * which; }
__device__ __forceinline__ int win_src_col(int n) {
    if (n < 1024) return n;
    if (n < 1536) return 1056 + (n - 1024);
    if (n < 1792) return 1568 + (n - 1536);
    if (n < 1920) return 1824 + (n - 1792);
    if (n < 1984) return 1952 + rope_unperm(n - 1920);
    if (n < 2000) return 1024 + (n - 1984);
    if (n < 2016) return 1040 + (n - 2000);
    return -1;
}

__device__ __forceinline__ void convert_weights(const Ctx& C, bool first, int gw, int NGW) {
    LAS float* scr = (LAS float*)(C.lds + C.wave * 16640);
    for (int l = 0; l < 2; ++l) {
        if (first == (l == 0))
        {
            const float* W = C.in[I_WIN] + (size_t)l * 1024 * 2016; bf16* dst = (bf16*)(C.arena + A_WIN) + (size_t)l * 2048 * 1024;
            auto f = [=](int k, int n) -> float { const int sc = win_src_col(n); return sc < 0 ? 0.f : W[(size_t)k * 2016 + sc]; };
            for (int it = gw; it < 16 * 32; it += NGW) { const int k0 = (it >> 5) * 64, n0 = (it & 31) * 64;
                if (n0 < 1920) transpose_item_fast(W + (size_t)k0 * 2016 + win_src_col(n0), 2016, dst, 1024, k0, n0, scr, C.lane);
                else transpose_item(f, dst, 1024, k0, n0, scr, C.lane); }
        }
        if (!first)
        {
            const float* Wq = C.in[I_WUQ] + (size_t)l * 256 * 768; const float* gq = C.in[I_QNG] + l * 256; const float* Wk = C.in[I_WUKV] + (size_t)l * 128 * 1024; const float* gk = C.in[I_KVNG] + l * 128;
            bf16* dst = (bf16*)(C.arena + A_WQKV) + (size_t)l * 1792 * 384;
            auto f = [=](int k, int n) -> float {
                if (n < 768) { if (k >= 256) return 0.f; const int h = n / 192, j = n % 192; const int sc = h * 192 + (j < 128 ? j : 128 + rope_unperm(j - 128)); return gq[k] * Wq[(size_t)k * 768 + sc]; }
                if (k < 256) return 0.f; return gk[k - 256] * Wk[(size_t)(k - 256) * 1024 + (n - 768)]; };
            for (int it = gw; it < 6 * 28; it += NGW) { const int k0 = (it % 6) * 64, n0 = (it / 6) * 64;
                const bool qcol = n0 < 768, qrow = k0 < 256;
                if (qcol != qrow) {
                    const int c = C.lane & 7;
#pragma unroll
                    for (int j = 0; j < 8; ++j) *(u32x4*)(dst + (size_t)(n0 + (C.lane >> 3) + 8 * j) * 384 + k0 + 8 * c) = (u32x4){0u, 0u, 0u, 0u};
                } else if (qcol && (n0 % 192) == 128) transpose_item(f, dst, 384, k0, n0, scr, C.lane);
                else if (qcol) transpose_item_fast(Wq + (size_t)k0 * 768 + n0, 768, dst, 384, k0, n0, scr, C.lane, gq + k0);
                else transpose_item_fast(Wk + (size_t)(k0 - 256) * 1024 + (n0 - 768), 1024, dst, 384, k0, n0, scr, C.lane, gk + (k0 - 256)); }
        }
        if (!first)
        {
            const float* W = C.in[I_WOUT] + (size_t)l * 1024 * 1024; bf16* dst = (bf16*)(C.arena + A_WOUT) + (size_t)l * 1024 * 1024;
            for (int it = gw; it < 16 * 16; it += NGW) { const int k0 = (it >> 4) * 64, n0 = (it & 15) * 64; transpose_item_fast(W + (size_t)k0 * 1024 + n0, 1024, dst, 1024, k0, n0, scr, C.lane); }
        }
    }
    if (!first)
    {
        bf16* dst = (bf16*)(C.arena + A_FGU);
        for (int it = gw; it < 16 * 88; it += NGW) { const int k0 = (it & 15) * 64, n0 = (it >> 4) * 64; const int tj = n0 >> 8, c = n0 & 255;
            const float* W = (c < 128) ? C.in[I_FG] : C.in[I_FU]; const int sc = tj * 128 + (c & 127);
            transpose_item_fast(W + (size_t)k0 * DFF + sc, DFF, dst, 1024, k0, n0, scr, C.lane); }
    }
    if (!first)
    {
        bf16* dst = (bf16*)(C.arena + A_FD); const float* W = C.in[I_FD];
        for (int it = gw; it < 44 * 16; it += NGW) { const int k0 = (it % 44) * 64, n0 = (it / 44) * 64; transpose_item_fast(W + (size_t)k0 * 1024 + n0, 1024, dst, DFF, k0, n0, scr, C.lane); }
    }
}
__device__ __forceinline__ void prologue(const Ctx& C) {
    convert_weights(C, true, C.vcu * 8 + C.wave, C.G * 8);
    __syncthreads();
    if (C.vcu < 6) {
        float* R = (float*)(C.ws + WS_ROPE);
        const int i = C.vcu * 512 + C.tid; const int j = i & 15, p = i >> 4; const int pos = p < 128 ? p : p - 128;
        const float inv = powf(10000.f, -(float)j / 16.f); const float ang = (float)pos * inv; R[2 * i] = cosf(ang); R[2 * i + 1] = sinf(ang);
    }
    for (int item = C.G - 1 - C.vcu; item < 192; item += C.G) {
        const int l = item / 96, cg = item % 96;
        LAS float* sil = (LAS float*)C.lds; LAS float* part = sil + 3 * 1024;
        for (int i = C.tid; i < 3 * 1024; i += 512) { const int v = i >> 10, k = i & 1023; const float x = v < 2 ? C.in[I_C][v * 1024 + k] : C.in[I_CCTX][k]; sil[i] = silu_f(x); }
        __syncthreads();
        const int rsub = C.lane >> 4, c4 = (C.lane & 15) * 4;
        f32x4 a0 = {0, 0, 0, 0}, a1 = a0, a2 = a0;
        const float* W = C.in[I_WMOD] + (size_t)l * 1024 * 6144 + cg * 64 + c4;
#pragma unroll 16
        for (int i = 0; i < 32; ++i) { const int k = C.wave * 128 + 4 * i + rsub; const f32x4 w = __builtin_nontemporal_load((const f32x4*)(W + (size_t)k * 6144));
            a0 += w * sil[k]; a1 += w * sil[1024 + k]; a2 += w * sil[2048 + k]; }
        LAS float* pp = part + (C.wave * 4 + rsub) * 192 + c4;
#pragma unroll
        for (int q = 0; q < 4; ++q) { pp[q] = a0[q]; pp[64 + q] = a1[q]; pp[128 + q] = a2[q]; }
        __syncthreads();
        if (C.tid < 192) { const int v = C.tid >> 6, c = C.tid & 63; float s = C.in[I_BMOD][l * 6144 + cg * 64 + c];
#pragma unroll
            for (int p = 0; p < 32; ++p) s += part[p * 192 + v * 64 + c];
            ((float*)(C.ws + WS_MOD))[(l * 3 + v) * 6144 + cg * 64 + c] = s; }
        __syncthreads();
    }
}

__device__ __forceinline__ void load_row16(const float* p, int lane, f32x4 (&v)[4]) {
#pragma unroll
    for (int j = 0; j < 4; ++j) v[j] = *(const f32x4*)(p + 256 * j + 4 * lane);
}
__device__ __forceinline__ void norm_mod_row(f32x4 (&v)[4], const float* g, const float* sc, const float* sh, int lane) {
    float ss = 0.f;
#pragma unroll
    for (int j = 0; j < 4; ++j) ss += (v[j].x * v[j].x + v[j].y * v[j].y) + (v[j].z * v[j].z + v[j].w * v[j].w);
    const float rs = 1.f / sqrtf(wave_sum(ss) * (1.f / DM) + EPS);
#pragma unroll
    for (int j = 0; j < 4; ++j) { const f32x4 gg = *(const f32x4*)(g + 256 * j + 4 * lane), s1 = *(const f32x4*)(sc + 256 * j + 4 * lane), s0 = *(const f32x4*)(sh + 256 * j + 4 * lane);
        v[j] = (v[j] * rs * gg) * (s1 + 1.f) + s0; }
}
__device__ __forceinline__ void store_row16_bf16(bf16* p, int lane, const f32x4 (&v)[4]) {
#pragma unroll
    for (int j = 0; j < 4; ++j) { u32x2 w; w.x = pk2(v[j].x, v[j].y); w.y = pk2(v[j].z, v[j].w); *(u32x2*)(p + 256 * j + 4 * lane) = w; }
}
__device__ __forceinline__ void load_row16_bf16(const bf16* p, int lane, f32x4 (&v)[4]) {
#pragma unroll
    for (int j = 0; j < 4; ++j) { const u32x2 w = *(const u32x2*)(p + 256 * j + 4 * lane); v[j] = (f32x4){bflo(w.x), bfhi(w.x), bflo(w.y), bfhi(w.y)}; }
}
__device__ __forceinline__ void load_xin_row(const Ctx& C, int layer, int row, f32x4 (&v)[4]) {
    if (layer == 0) load_row16(row < NLAT ? C.in[I_X] + (size_t)row * DM : C.in[I_CTX] + (size_t)(row - NLAT) * DM, C.lane, v);
    else load_row16_bf16((const bf16*)(C.ws + WS_XL) + (size_t)row * DM, C.lane, v);
}

__device__ __forceinline__ void phase_norm1(const Ctx& C, int layer) {
    const int gw = C.vcu * 8 + C.wave, NGW = C.G * 8;
    const float* g = C.in[I_LN1] + layer * DM; const float* MOD = (const float*)(C.ws + WS_MOD) + (size_t)layer * 3 * 6144; bf16* H = (bf16*)(C.ws + WS_H);
    for (int row = gw; row < MR; row += NGW) {
        f32x4 v[4]; load_xin_row(C, layer, row, v);
        if (layer == 1 && row >= NLAT) {
            const float* PART = (const float*)(C.arena + R_PART) + (size_t)(row - NLAT) * 1024; const float* g2c = (const float*)(C.ws + WS_MOD) + 2 * 6144 + 5 * 1024;
#pragma unroll
            for (int j = 0; j < 4; ++j) { f32x4 t[11];
#pragma unroll
                for (int c = 0; c < 11; ++c) t[c] = *(const f32x4*)(PART + (size_t)c * 512 * 1024 + 256 * j + 4 * C.lane);
                f32x4 acc = t[0];
#pragma unroll
                for (int c = 1; c < 11; ++c) acc += t[c];
                v[j] += *(const f32x4*)(g2c + 256 * j + 4 * C.lane) * acc; } }
        const float* m = MOD + mod_row(row) * 6144;
        norm_mod_row(v, g, m + 1024, m, C.lane);
        store_row16_bf16(H + (size_t)row * DM, C.lane, v);
    }
}

__device__ __forceinline__ void phase_norm2(const Ctx& C, int layer) {
    const int gw = C.vcu * 8 + C.wave, NGW = C.G * 8;
    const float* g = C.in[I_LN2] + layer * DM; const float* MOD = (const float*)(C.ws + WS_MOD) + (size_t)layer * 3 * 6144; bf16* H = layer == 0 ? (bf16*)(C.ws + WS_H) : (bf16*)(C.arena + M_HS);
    const bf16* XL = (const bf16*)(C.ws + WS_XL); int* LISTE = (int*)(C.arena + M_LISTE);
    const int nrow = layer == 0 ? MR : NLAT;
    unsigned* ctl = (unsigned*)(C.ws + WS_CTL);
    int* PE = (int*)(C.ws + WS_LIST); int* PS = PE + NLAT * 2; float* PWt = (float*)(PS + NLAT * 2);
    LAS unsigned* lcnt = (LAS unsigned*)(C.lds + 140000); LAS unsigned* gbase = lcnt + 8;
    const int maxit = (nrow + NGW - 1) / NGW;
    f32x4 rw[32];
    if (layer == 1) {
#pragma unroll
        for (int j = 0; j < 4; ++j)
#pragma unroll
            for (int q = 0; q < 4; ++q) { const float* RWp = C.in[I_RW] + (256 * j + 4 * C.lane + q) * 8; rw[(j * 4 + q) * 2] = *(const f32x4*)RWp; rw[(j * 4 + q) * 2 + 1] = *(const f32x4*)(RWp + 4); }
    }
    for (int b0 = 0; b0 < maxit; b0 += 64) {
        int my_e1 = 0, my_e2 = 0, my_row = -1; float my_d = 0.f;
        if (layer == 1) { if (C.tid < 8) lcnt[C.tid] = 0u; }
        const int b1 = (b0 + 64 < maxit) ? b0 + 64 : maxit;
        for (int it = b0; it < b1; ++it) {
            const int row = gw + it * NGW; if (row >= nrow) break;
            f32x4 v[4];
            if (layer == 0 && row >= NLAT) {
                load_row16(C.in[I_CTX] + (size_t)(row - NLAT) * DM, C.lane, v);
                const float* PART = (const float*)(C.arena + R_PART) + (size_t)(row - NLAT) * 1024; const float* g1c = MOD + 2 * 6144 + 2 * 1024;
#pragma unroll
                for (int j = 0; j < 4; ++j) { f32x4 t[4];
#pragma unroll
                    for (int c = 0; c < 4; ++c) t[c] = *(const f32x4*)(PART + (size_t)c * 512 * 1024 + 256 * j + 4 * C.lane);
                    const f32x4 acc = ((t[0] + t[1]) + t[2]) + t[3];
                    v[j] += *(const f32x4*)(g1c + 256 * j + 4 * C.lane) * acc; }
                store_row16_bf16((bf16*)(C.ws + WS_XL) + (size_t)row * DM, C.lane, v);
                load_row16_bf16(XL + (size_t)row * DM, C.lane, v);
            } else load_row16_bf16(XL + (size_t)row * DM, C.lane, v);
            const float* m = MOD + mod_row(row) * 6144;
            norm_mod_row(v, g, m + 4096, m + 3072, C.lane);
            store_row16_bf16(H + (size_t)row * DM, C.lane, v);
            if (layer == 1) {
                float lg[8];
#pragma unroll
                for (int e = 0; e < 8; ++e) lg[e] = 0.f;
#pragma unroll
                for (int j = 0; j < 4; ++j)
#pragma unroll
                    for (int q = 0; q < 4; ++q) { const f32x4 w0 = rw[(j * 4 + q) * 2], w1 = rw[(j * 4 + q) * 2 + 1]; const float x = v[j][q];
                        lg[0] += x * w0.x; lg[1] += x * w0.y; lg[2] += x * w0.z; lg[3] += x * w0.w; lg[4] += x * w1.x; lg[5] += x * w1.y; lg[6] += x * w1.z; lg[7] += x * w1.w; }
#pragma unroll
                for (int e = 0; e < 8; ++e) lg[e] = wave_sum(lg[e]);
                int e1 = 0; float v1 = lg[0];
#pragma unroll
                for (int e = 1; e < 8; ++e) if (lg[e] > v1) { v1 = lg[e]; e1 = e; }
                int e2 = -1; float v2 = -3.0e38f;
#pragma unroll
                for (int e = 0; e < 8; ++e) if (e != e1 && lg[e] > v2) { v2 = lg[e]; e2 = e; }
                if (C.lane == (it & 63)) { my_e1 = e1; my_e2 = e2; my_row = row; my_d = v2 - v1; }
            }
        }
        if (layer == 1) {
            __syncthreads();
            unsigned r1 = 0u, r2 = 0u;
            if (my_row >= 0) { r1 = __hip_atomic_fetch_add(lcnt + my_e1, 1u, __ATOMIC_RELAXED, __HIP_MEMORY_SCOPE_WORKGROUP); r2 = __hip_atomic_fetch_add(lcnt + my_e2, 1u, __ATOMIC_RELAXED, __HIP_MEMORY_SCOPE_WORKGROUP); }
            __syncthreads();
            if (C.tid < 8) { const unsigned n = lcnt[C.tid]; gbase[C.tid] = n ? atomicAdd(ctl + CW_CNT + 64 * C.tid, n) : 0u; }
            __syncthreads();
            if (my_row >= 0) {
                const float w1 = 1.f / (1.f + expf(my_d)), w2 = 1.f - w1;
                const unsigned s1 = gbase[my_e1] + r1, s2 = gbase[my_e2] + r2;
                PE[my_row * 2] = my_e1; PE[my_row * 2 + 1] = my_e2; PS[my_row * 2] = (int)s1; PS[my_row * 2 + 1] = (int)s2; PWt[my_row * 2] = w1; PWt[my_row * 2 + 1] = w2;
                LISTE[my_e1 * 16384 + (int)s1] = my_row * 2; LISTE[my_e2 * 16384 + (int)s2] = my_row * 2 + 1;
            }
            __syncthreads();
        }
    }
    if (layer == 1) {
        int* ENT = (int*)(C.ws + WS_LIST + AL((size_t)NLAT * 2 * 4 * 3));
        for (int i = C.vcu * 512 + C.tid; i < MAXT * 256; i += C.G * 512) ENT[i] = -1;
    }
}

__device__ __forceinline__ void convert_expert_gu(const Ctx& C, int gw, int NGW) {
    LAS float* scr = (LAS float*)(C.lds + C.wave * 16640); bf16* EGU = (bf16*)(C.arena + M_EGU);
    for (int it = gw; it < NEXP * 16 * 112; it += NGW) { const int e = it / (16 * 112), r = it % (16 * 112), k0 = (r & 15) * 64, n0 = (r >> 4) * 64; const int tj = n0 >> 8, c = n0 & 255;
        const float* W = ((c < 128) ? C.in[I_EG] : C.in[I_EU]) + (size_t)e * 1024 * DFE; const int sc = tj * 128 + (c & 127);
        transpose_item_fast(W + (size_t)k0 * DFE + sc, DFE, EGU + (size_t)e * 2 * DFE * 1024, 1024, k0, n0, scr, C.lane); }
}
__device__ __forceinline__ void convert_expert_down(const Ctx& C, int gw, int NGW) {
    LAS float* scr = (LAS float*)(C.lds + C.wave * 16640); bf16* ED = (bf16*)(C.ws + WS_ED);
    for (int it = gw; it < NEXP * 56 * 16; it += NGW) { const int e = it / (56 * 16), r = it % (56 * 16), k0 = (r % 56) * 64, n0 = (r / 56) * 64;
        const float* W = C.in[I_ED] + (size_t)e * DFE * 1024;
        transpose_item_fast(W + (size_t)k0 * 1024 + n0, 1024, ED + (size_t)e * 1024 * DFE, DFE, k0, n0, scr, C.lane); }
}

__device__ __forceinline__ void moe_tile_bases(const Ctx& C, int (&tb)[9]) {
    unsigned* ctl = (unsigned*)(C.ws + WS_CTL); int acc = 0;
#pragma unroll
    for (int e = 0; e < 8; ++e) { tb[e] = acc; const unsigned c = __hip_atomic_load(ctl + CW_CNT + 64 * e, __ATOMIC_RELAXED, __HIP_MEMORY_SCOPE_AGENT); acc += (int)((c + 255u) >> 8); }
    tb[8] = acc;
}
__device__ __forceinline__ void moe_fill_lists(const Ctx& C) {
    int tb[9]; moe_tile_bases(C, tb);
    const int* PE = (const int*)(C.ws + WS_LIST); const int* PS = PE + NLAT * 2; const float* PWt = (const float*)(PS + NLAT * 2);
    int* ENT = (int*)(C.ws + WS_LIST + AL((size_t)NLAT * 2 * 4 * 3)); float* WTS = (float*)(ENT + MAXT * 256); int* TAILROW = (int*)(C.ws + WS_LIST + AL((size_t)NLAT * 2 * 4 * 3) + AL((size_t)MAXT * 256 * 4 * 2));
    for (int pr = C.vcu * 512 + C.tid; pr < NLAT * 2; pr += C.G * 512) {
        const int e = PE[pr], s = PS[pr]; int base = 0;
#pragma unroll
        for (int k = 0; k < 8; ++k) base = (e == k) ? tb[k] : base;
        const int pos = base * 256 + s;
        ENT[pos] = pr; WTS[pos] = PWt[pr]; TAILROW[pr] = pos >= MOE_MAIN * 256 ? pos - MOE_MAIN * 256 : -1;
    }
}

__device__ __forceinline__ void moe_tail_reduce0(const Ctx& C) {
    const int gw = C.vcu * 8 + C.wave, NGW = C.G * 8;
    int tb[9]; moe_tile_bases(C, tb); const int ntail = tb[8] > MOE_MAIN ? tb[8] - MOE_MAIN : 0;
    const int* ENT = (const int*)(C.ws + WS_LIST + AL((size_t)NLAT * 2 * 4 * 3)); const float* WTS = (const float*)(ENT + MAXT * 256);
    const bf16* PART = (const bf16*)(C.arena + M_PT0); const float* gate = (const float*)(C.ws + WS_MOD) + (size_t)3 * 6144 + 5 * 1024;
    for (int r = gw; r < ntail * 256; r += NGW) {
        const int pos = MOE_MAIN * 256 + r, ent = ENT[pos]; const float w = WTS[pos];
        u32x2 t[4][MOE_NC0]; f32x4 gv[4];
#pragma unroll
        for (int j = 0; j < 4; ++j)
#pragma unroll
            for (int c = 0; c < MOE_NC0; ++c) t[j][c] = *(const u32x2*)(PART + ((size_t)c * 2048 + r) * 1024 + 256 * j + 4 * C.lane);
        if (ent < 0) continue;
        const int tok = ent >> 1; const float* g = gate + (tok >> 13) * 6144;
        bf16* Y = (bf16*)(C.ws + ((ent & 1) ? WS_H : WS_Y0)) + (size_t)tok * DM;
#pragma unroll
        for (int j = 0; j < 4; ++j) gv[j] = *(const f32x4*)(g + 256 * j + 4 * C.lane);
#pragma unroll
        for (int j = 0; j < 4; ++j) { f32x4 acc = {0.f, 0.f, 0.f, 0.f};
#pragma unroll
            for (int c = 0; c < MOE_NC0; ++c) acc += (f32x4){bflo(t[j][c].x), bfhi(t[j][c].x), bflo(t[j][c].y), bfhi(t[j][c].y)};
            const f32x4 y = gv[j] * w * acc; u32x2 o; o.x = pk2(y.x, y.y); o.y = pk2(y.z, y.w); *(u32x2*)(Y + 256 * j + 4 * C.lane) = o; }
    }
}
__device__ __forceinline__ void phase_final(const Ctx& C) {
    const int gw = C.vcu * 8 + C.wave, NGW = C.G * 8;
    const bf16* XL = (const bf16*)(C.ws + WS_XL); const bf16* Y2 = (const bf16*)(C.ws + WS_H); const bf16* Y0 = (const bf16*)(C.ws + WS_Y0); const float* g = C.in[I_FNG];
    const bf16* Y0b = (const bf16*)(C.arena + M_EGU); const bf16* Y2b = Y0b + (size_t)NLAT * DM;
    const int* TAILROW = (const int*)(C.ws + WS_LIST + AL((size_t)NLAT * 2 * 4 * 3) + AL((size_t)MAXT * 256 * 4 * 2)); const float* PWt = (const float*)(C.ws + WS_LIST) + NLAT * 4;
    const bf16* PART1 = (const bf16*)(C.arena + M_HS); const float* gate = (const float*)(C.ws + WS_MOD) + (size_t)3 * 6144 + 5 * 1024;
    const int maxit = (NLAT + NGW - 1) / NGW;
    for (int b0 = 0; b0 < maxit; b0 += 64) {
        int my_t0 = -1, my_t1 = -1;
        { const int r = gw + (b0 + C.lane) * NGW; if (b0 + C.lane < maxit && r < NLAT) { my_t0 = TAILROW[r * 2]; my_t1 = TAILROW[r * 2 + 1]; } }
        const int b1 = (b0 + 64 < maxit) ? b0 + 64 : maxit;
        for (int it = b0; it < b1; ++it) {
            const int row = gw + it * NGW; if (row >= NLAT) break;
            const int tr0 = __builtin_amdgcn_readlane(my_t0, it - b0), tr1 = __builtin_amdgcn_readlane(my_t1, it - b0);
            u32x2 xa[4], ya[4], za[4], pa[4], qa[4];
#pragma unroll
            for (int j = 0; j < 4; ++j) { const size_t o = (size_t)row * DM + 256 * j + 4 * C.lane;
                xa[j] = *(const u32x2*)(XL + o); ya[j] = *(const u32x2*)(Y2 + o); za[j] = *(const u32x2*)(Y0 + o);
                pa[j] = (u32x2){0u, 0u}; qa[j] = (u32x2){0u, 0u};
                if (tr0 < 0) pa[j] = *(const u32x2*)(Y0b + o);
                if (tr1 < 0) qa[j] = *(const u32x2*)(Y2b + o); }
            f32x4 v[4];
#pragma unroll
            for (int j = 0; j < 4; ++j) {
                v[j].x = bflo(xa[j].x) + (bflo(ya[j].x) + bflo(za[j].x)); v[j].y = bfhi(xa[j].x) + (bfhi(ya[j].x) + bfhi(za[j].x));
                v[j].z = bflo(xa[j].y) + (bflo(ya[j].y) + bflo(za[j].y)); v[j].w = bfhi(xa[j].y) + (bfhi(ya[j].y) + bfhi(za[j].y));
                v[j].x += bflo(pa[j].x); v[j].y += bfhi(pa[j].x); v[j].z += bflo(pa[j].y); v[j].w += bfhi(pa[j].y);
                v[j].x += bflo(qa[j].x); v[j].y += bfhi(qa[j].x); v[j].z += bflo(qa[j].y); v[j].w += bfhi(qa[j].y); }
#pragma unroll
            for (int k = 0; k < 2; ++k) { const int tr = k ? tr1 : tr0;
                if (tr >= 0) { const float w = PWt[row * 2 + k]; const float* gt = gate + (row >> 13) * 6144;
#pragma unroll
                    for (int j = 0; j < 4; ++j) { u32x2 t[MOE_NC1];
#pragma unroll
                        for (int c = 0; c < MOE_NC1; ++c) t[c] = *(const u32x2*)(PART1 + ((size_t)c * 2048 + tr) * 1024 + 256 * j + 4 * C.lane);
                        f32x4 acc = {0.f, 0.f, 0.f, 0.f};
#pragma unroll
                        for (int c = 0; c < MOE_NC1; ++c) acc += (f32x4){bflo(t[c].x), bfhi(t[c].x), bflo(t[c].y), bfhi(t[c].y)};
                        v[j] += *(const f32x4*)(gt + 256 * j + 4 * C.lane) * w * acc; } } }
            float ss = 0.f;
#pragma unroll
            for (int j = 0; j < 4; ++j) ss += (v[j].x * v[j].x + v[j].y * v[j].y) + (v[j].z * v[j].z + v[j].w * v[j].w);
            const float rs = 1.f / sqrtf(wave_sum(ss) * (1.f / DM) + EPS);
#pragma unroll
            for (int j = 0; j < 4; ++j) { const f32x4 gg = *(const f32x4*)(g + 256 * j + 4 * C.lane); *(f32x4*)(C.out + (size_t)row * DM + 256 * j + 4 * C.lane) = v[j] * rs * gg; }
        }
    }
}

__device__ __forceinline__ void phase_mla_prep(const Ctx& C, int gw, int NGW) {
    const bf16* P = (const bf16*)(C.arena + R_P); bf16* CQKV = (bf16*)(C.arena + R_CQKV); char* KBc = (char*)(C.arena + R_KB);
    const float* ROPE = (const float*)(C.ws + WS_ROPE);
    for (int row = gw; row < MR; row += NGW) {
        const bf16* pr = P + (size_t)row * PW;
        {   const u32x2 w = *(const u32x2*)(pr + PC_CQ + 4 * C.lane); float x0 = bflo(w.x), x1 = bfhi(w.x), x2 = bflo(w.y), x3 = bfhi(w.y);
            const float rs = 1.f / sqrtf(wave_sum(x0 * x0 + x1 * x1 + x2 * x2 + x3 * x3) * (1.f / 256.f) + EPS);
            u32x2 o; o.x = pk2(x0 * rs, x1 * rs); o.y = pk2(x2 * rs, x3 * rs); *(u32x2*)(CQKV + (size_t)row * 384 + 4 * C.lane) = o; }
        {   const unsigned w = *(const unsigned*)(pr + PC_CKV + 2 * C.lane); float x0 = bflo(w), x1 = bfhi(w);
            const float rs = 1.f / sqrtf(wave_sum(x0 * x0 + x1 * x1) * (1.f / 128.f) + EPS);
            *(unsigned*)(CQKV + (size_t)row * 384 + 256 + 2 * C.lane) = pk2(x0 * rs, x1 * rs); }
        {   float x = bf2f(pr[PC_KR + C.lane]); const float xo = __shfl_xor(x, 1);
            int b, pos; row_bpos(row, b, pos);
            if (row < NLAT) { const int pair = C.lane >> 1, fi = pair & 15, axis = pair >> 4; const int pidx = axis ? (pos & 63) : (pos >> 6);
                const float* cs = ROPE + ((axis ? 128 : 0) + pidx) * 32 + fi * 2; const float c = cs[0], s = cs[1];
                x = (C.lane & 1) ? (x * c + xo * s) : (x * c - xo * s); }
            const bf16 xb = (bf16)f2bf(x);
#pragma unroll
            for (int h = 0; h < 4; ++h) *(bf16*)(KBc + ((size_t)(b * 4 + h) * 132 + (pos >> 6)) * att::KT_BYTES + (16 + (C.lane >> 3)) * 1024 + (pos & 63) * 16 + (C.lane & 7) * 2) = xb; }
    }
}

__device__ __forceinline__ f32x4 mma16(bf16x8 a, bf16x8 b, f32x4 c) { return __builtin_amdgcn_mfma_f32_16x16x32_bf16(a, b, c, 0, 0, 0); }
constexpr int LS = 72;

__device__ __forceinline__ void phase_gla_local(const Ctx& C, int layer) {
    LAS float* codes = (LAS float*)C.lds;
    LAS float* bcum = codes + 64 * 32;
    LAS float* gsum = bcum + 2 * 64 * 64;
    LAS float* tot = gsum + 2 * 4 * 64;
    LAS bf16* vT = (LAS bf16*)(tot + 128);
    LAS bf16* khT = vT + 128 * LS;
    const bf16* P = (const bf16*)(C.arena + R_P);
    bf16* QT = (bf16*)(C.arena + R_QT); bf16* KT = (bf16*)(C.arena + R_KT);
    float* SLOC = (float*)(C.arena + R_SLOC); float* DEC = (float*)(C.arena + R_DEC);
    const float* WG2 = C.in[I_WG2] + (size_t)layer * 2 * 16 * 256; const float* BG2 = C.in[I_BG2] + (size_t)layer * 2 * 256;
    const int tid = C.tid, lane = C.lane;
    for (int L = C.bid; L < NB * NCH * 4; L += C.G) {
        const int h = L & 3, a = (L >> 2) % NCH, b = L / (NCH * 4);
        const int rbase = chunk_row(b, a);
        {
            const int t = tid >> 3, j4 = (tid & 7) * 4; const u32x2 w = *(const u32x2*)(P + (size_t)(rbase + t) * PW + PC_GF + j4);
            LAS float* cp = codes + t * 32 + j4; cp[0] = bflo(w.x); cp[1] = bfhi(w.x); cp[2] = bflo(w.y); cp[3] = bfhi(w.y);
            const int e0 = (tid & 7) * 16; const bf16* vp = P + (size_t)(rbase + t) * PW + PC_V + h * 128 + e0;
            const u32x4 v0 = *(const u32x4*)vp, v1 = *(const u32x4*)(vp + 8); bf16 vr[16]; unpack8_raw(v0, vr); unpack8_raw(v1, vr + 8);
#pragma unroll
            for (int i = 0; i < 16; ++i) vT[(e0 + i) * LS + t] = vr[i];
        }
        __syncthreads();
        const int dir = tid >> 8, tg = (tid >> 6) & 3, d = tid & 63;
        {
            float w[16];
#pragma unroll
            for (int r = 0; r < 16; ++r) w[r] = WG2[(dir * 16 + r) * 256 + h * 64 + d];
            const float bias = BG2[dir * 256 + h * 64 + d];
            float acc = 0.f;
#pragma unroll
            for (int ii = 0; ii < 16; ++ii) { const int i = dir ? 15 - ii : ii; const int t = tg * 16 + i; float pre = bias;
#pragma unroll
                for (int r4 = 0; r4 < 4; ++r4) { const f32x4 cv = *(const LAS f32x4*)(codes + t * 32 + dir * 16 + 4 * r4); pre += cv.x * w[4 * r4] + cv.y * w[4 * r4 + 1] + cv.z * w[4 * r4 + 2] + cv.w * w[4 * r4 + 3]; }
                acc += logsig_f(pre) * (1.f / 16.f); bcum[(dir * 64 + t) * 64 + d] = acc; }
            gsum[(dir * 4 + tg) * 64 + d] = acc;
        }
        __syncthreads();
        {   float off = 0.f, total = 0.f;
#pragma unroll
            for (int g2 = 0; g2 < 4; ++g2) { const float s = gsum[(dir * 4 + g2) * 64 + d]; total += s; if (dir ? (g2 > tg) : (g2 < tg)) off += s; }
#pragma unroll
            for (int i = 0; i < 16; ++i) bcum[(dir * 64 + tg * 16 + i) * 64 + d] += off;
            if (tg == 0) tot[dir * 64 + d] = __expf(total);
        }
        __syncthreads();
        {
            const int t = (tid >> 2) & 63, d0 = (tid & 3) * 16; const size_t row = (size_t)(rbase + t);
            const bf16* qp = P + row * PW + PC_Q + h * 64 + d0; const bf16* kp = P + row * PW + PC_K + h * 64 + d0;
            float q[16], k[16]; unpack8(*(const u32x4*)qp, q); unpack8(*(const u32x4*)(qp + 8), q + 8); unpack8(*(const u32x4*)kp, k); unpack8(*(const u32x4*)(kp + 8), k + 8);
            float qo[16], ko[16];
#pragma unroll
            for (int i = 0; i < 16; ++i) { const float eB = __expf(bcum[(dir * 64 + t) * 64 + d0 + i]), et = tot[dir * 64 + d0 + i];
                qo[i] = q[i] * 0.125f * eB; ko[i] = k[i] * __builtin_amdgcn_rcpf(eB); khT[(dir * 64 + d0 + i) * LS + t] = (bf16)f2bf(ko[i] * et); }
            bf16* qd = QT + ((size_t)dir * MR + row) * 256 + h * 64 + d0; bf16* kd = KT + ((size_t)dir * MR + row) * 256 + h * 64 + d0;
            *(u32x4*)qd = pack8h(qo); *(u32x4*)(qd + 8) = pack8h(qo + 8); *(u32x4*)kd = pack8h(ko); *(u32x4*)(kd + 8) = pack8h(ko + 8);
        }
        const int pf = a < 128 ? a + 4 : a - 128, pb = 131 - a;
        if (tid < 128) { const int dd = tid >> 6, d2 = tid & 63; const int chain = dd * 8 + b * 4 + h, p = dd ? pb : pf; DEC[((size_t)chain * NCH + p) * 64 + d2] = tot[dd * 64 + d2]; }
        __syncthreads();
        {
            const int fr = lane & 15, fq = lane >> 4;
#pragma unroll 2
            for (int i = 0; i < 8; ++i) { const int id = C.wave * 8 + i, dd = id >> 5, et = (id >> 2) & 7, dt = id & 3;
                f32x4 acc = {0.f, 0.f, 0.f, 0.f};
#pragma unroll
                for (int ks = 0; ks < 2; ++ks) { const bf16x8 av = *(const LAS bf16x8*)(vT + (et * 16 + fr) * LS + ks * 32 + fq * 8); const bf16x8 bv = *(const LAS bf16x8*)(khT + (dd * 64 + dt * 16 + fr) * LS + ks * 32 + fq * 8);
                    acc = mma16(av, bv, acc); }
                const int chain = dd * 8 + b * 4 + h, p = dd ? pb : pf; float* S = SLOC + ((size_t)chain * NCH + p) * 8192;
#pragma unroll
                for (int r = 0; r < 4; ++r) S[(et * 16 + fq * 4 + r) * 64 + dt * 16 + fr] = acc[r]; }
        }
        __syncthreads();
    }
}

__device__ __forceinline__ void phase_gla_scan(const Ctx& C) {
    const float* SLOC = (const float*)(C.arena + R_SLOC); const float* DEC = (const float*)(C.arena + R_DEC); bf16* SST = (bf16*)(C.arena + R_SST);
    for (int idx = C.bid * 512 + C.tid; idx < 16 * 8192; idx += C.G * 512) {
        const int chain = idx >> 13, el = idx & 8191, d = el & 63;
        const float* sl = SLOC + (size_t)chain * NCH * 8192 + el; const float* dc = DEC + (size_t)chain * NCH * 64 + d; bf16* so = SST + (size_t)chain * NCH * 8192 + el;
        float S = 0.f;
#pragma unroll 1
        for (int p0 = 0; p0 < NCH; p0 += 44) {
            float x[44], g[44];
#pragma unroll
            for (int i = 0; i < 44; ++i) { x[i] = sl[(size_t)(p0 + i) * 8192]; g[i] = dc[(p0 + i) * 64]; }
#pragma unroll
            for (int i = 0; i < 44; ++i) { so[(size_t)(p0 + i) * 8192] = (bf16)f2bf(S); S = S * g[i] + x[i]; }
        }
    }
}

__device__ __forceinline__ void phase_gla_out(const Ctx& C, int layer) {
    LAS bf16* qf = (LAS bf16*)C.lds; LAS bf16* kf = qf + 64 * LS; LAS bf16* qb = kf + 64 * LS; LAS bf16* kb = qb + 64 * LS;
    LAS bf16* vT = kb + 64 * LS;
    LAS bf16* SfT = vT + 128 * LS; LAS bf16* SbT = SfT + 128 * LS;
    LAS bf16* As = SbT + 128 * LS;
    LAS float* O = (LAS float*)(As + 64 * LS);
    const bf16* P = (const bf16*)(C.arena + R_P); const bf16* QT = (const bf16*)(C.arena + R_QT); const bf16* KT = (const bf16*)(C.arena + R_KT);
    const bf16* SST = (const bf16*)(C.arena + R_SST); bf16* MIX = (bf16*)(C.arena + R_MIX);
    const float* GG = C.in[I_GLAG] + layer * 128;
    const int tid = C.tid, lane = C.lane, fr = lane & 15, fq = lane >> 4;
    const int na = layer == 0 ? NCH : 128;
    const int nskip = (layer == 0 && C.G > 16) ? 8 : 0;
    if (C.bid < nskip) return;
    for (int L = C.G - 1 - C.bid; L < NB * na * 4; L += C.G - nskip) {
        const int h = L & 3, a = (L >> 2) % na, b = L / (na * 4);
        const int rbase = chunk_row(b, a);
        const int pf = a < 128 ? a + 4 : a - 128, pb = 131 - a;
        {
            const int which = tid >> 7, t = (tid >> 1) & 63, hf = tid & 1; const int dd = which >> 1;
            const bf16* src = ((which & 1) ? KT : QT) + ((size_t)dd * MR + rbase + t) * 256 + h * 64 + hf * 32;
            LAS bf16* dst = (which == 0 ? qf : which == 1 ? kf : which == 2 ? qb : kb) + t * LS + hf * 32;
#pragma unroll
            for (int i = 0; i < 4; ++i) *(LAS u32x4*)(dst + 8 * i) = *(const u32x4*)(src + 8 * i);
        }
        {
            const int t = tid >> 3, e0 = (tid & 7) * 16; const bf16* vp = P + (size_t)(rbase + t) * PW + PC_V + h * 128 + e0;
            const u32x4 v0 = *(const u32x4*)vp, v1 = *(const u32x4*)(vp + 8); bf16 vr[16]; unpack8_raw(v0, vr); unpack8_raw(v1, vr + 8);
#pragma unroll
            for (int i = 0; i < 16; ++i) vT[(e0 + i) * LS + t] = vr[i];
        }
        {
            const int dd = tid >> 8, e = (tid >> 1) & 127, hf = tid & 1; const int chain = dd * 8 + b * 4 + h, p = dd ? pb : pf;
            const bf16* src = SST + ((size_t)chain * NCH + p) * 8192 + e * 64 + hf * 32; LAS bf16* dst = (dd ? SbT : SfT) + e * LS + hf * 32;
#pragma unroll
            for (int i = 0; i < 4; ++i) *(LAS u32x4*)(dst + 8 * i) = *(const u32x4*)(src + 8 * i);
        }
        __syncthreads();
        {
#pragma unroll
            for (int i = 0; i < 2; ++i) { const int pos = C.wave * 2 + i, ti = pos >> 2, si = pos & 3;
                f32x4 af = {0.f, 0.f, 0.f, 0.f}, ab = af;
#pragma unroll
                for (int ks = 0; ks < 2; ++ks) {
                    const bf16x8 a1 = *(const LAS bf16x8*)(qf + (ti * 16 + fr) * LS + ks * 32 + fq * 8), b1 = *(const LAS bf16x8*)(kf + (si * 16 + fr) * LS + ks * 32 + fq * 8);
                    const bf16x8 a2 = *(const LAS bf16x8*)(qb + (ti * 16 + fr) * LS + ks * 32 + fq * 8), b2 = *(const LAS bf16x8*)(kb + (si * 16 + fr) * LS + ks * 32 + fq * 8);
                    af = mma16(a1, b1, af); ab = mma16(a2, b2, ab); }
#pragma unroll
                for (int r = 0; r < 4; ++r) { const int t = ti * 16 + fq * 4 + r, s = si * 16 + fr; const float val = (s <= t ? af[r] : 0.f) + (s >= t ? ab[r] : 0.f); As[t * LS + s] = (bf16)f2bf(val); } }
        }
        __syncthreads();
        {
#pragma unroll 2
            for (int i = 0; i < 4; ++i) { const int id = C.wave * 4 + i, tt = id >> 3, et = id & 7;
                f32x4 acc = {0.f, 0.f, 0.f, 0.f};
#pragma unroll
                for (int ks = 0; ks < 2; ++ks) {
                    const bf16x8 bv = *(const LAS bf16x8*)(vT + (et * 16 + fr) * LS + ks * 32 + fq * 8);
                    acc = mma16(*(const LAS bf16x8*)(As + (tt * 16 + fr) * LS + ks * 32 + fq * 8), bv, acc);
                    acc = mma16(*(const LAS bf16x8*)(qf + (tt * 16 + fr) * LS + ks * 32 + fq * 8), *(const LAS bf16x8*)(SfT + (et * 16 + fr) * LS + ks * 32 + fq * 8), acc);
                    acc = mma16(*(const LAS bf16x8*)(qb + (tt * 16 + fr) * LS + ks * 32 + fq * 8), *(const LAS bf16x8*)(SbT + (et * 16 + fr) * LS + ks * 32 + fq * 8), acc); }
#pragma unroll
                for (int r = 0; r < 4; ++r) O[(tt * 16 + fq * 4 + r) * 132 + et * 16 + fr] = acc[r]; }
        }
        __syncthreads();
        {
            const int t = tid >> 3, e0 = (tid & 7) * 16; float o[16], ss = 0.f;
#pragma unroll
            for (int i = 0; i < 16; ++i) { o[i] = O[t * 132 + e0 + i]; ss += o[i] * o[i]; }
            ss += __shfl_xor(ss, 1); ss += __shfl_xor(ss, 2); ss += __shfl_xor(ss, 4);
            const float rs = 1.f / sqrtf(ss * (1.f / 128.f) + EPS);
            const size_t row = (size_t)(rbase + t); const bf16* rp = P + row * PW + PC_R + h * 128 + e0; float rv[16]; unpack8(*(const u32x4*)rp, rv); unpack8(*(const u32x4*)(rp + 8), rv + 8);
#pragma unroll
            for (int i = 0; i < 16; ++i) o[i] = o[i] * rs * GG[e0 + i] * silu_f(rv[i]);
            bf16* mp = MIX + row * DM + h * 128 + e0; *(u32x4*)mp = pack8h(o); *(u32x4*)(mp + 8) = pack8h(o + 8);
        }
        __syncthreads();
    }
}

namespace att {
constexpr int NW = 8, QBLK = 32, KVBLK = 64;
constexpr float THR = 8.f;
constexpr int OFF_K = 0, OFF_V = 2 * KT_BYTES, OFF_WS = OFF_V + 2 * VT_BYTES, OFF_QR = OFF_WS + NW * 64 * 4, SHM_ATTN = OFF_QR + NW * 4096;
#define SBAR() __builtin_amdgcn_sched_barrier(0)
__device__ __forceinline__ int crow(int r, int hi) { return (r & 3) + 8 * (r >> 2) + 4 * hi; }
__device__ __forceinline__ unsigned cvtpk(float lo, float hi) { unsigned r; asm volatile("v_cvt_pk_bf16_f32 %0, %1, %2" : "=v"(r) : "v"(lo), "v"(hi)); return r; }
__device__ __forceinline__ void glds16(const void* gsrc, unsigned lds_dst) { unsigned keep;
    asm volatile("s_mov_b32 %0, m0\n\ts_mov_b32 m0, %2\n\ts_nop 0\n\tglobal_load_lds_dwordx4 %1, off\n\ts_mov_b32 m0, %0" : "=&s"(keep) : "v"(gsrc), "s"(lds_dst) : "memory"); }
__device__ __forceinline__ void partialSM(f32x16& p0, f32x16& p1, f32x16& negm, bool first, float& alpha) {
    constexpr float THRL = THR * 1.4426950408889634f;
    float ma = fmaxf(fmaxf(p0[0], p0[1]), p0[2]), mb = fmaxf(fmaxf(p0[8], p0[9]), p0[10]), mc = fmaxf(fmaxf(p1[0], p1[1]), p1[2]), md = fmaxf(fmaxf(p1[8], p1[9]), p1[10]);
    ma = fmaxf(fmaxf(ma, p0[3]), p0[4]); mb = fmaxf(fmaxf(mb, p0[11]), p0[12]); mc = fmaxf(fmaxf(mc, p1[3]), p1[4]); md = fmaxf(fmaxf(md, p1[11]), p1[12]);
    ma = fmaxf(fmaxf(ma, p0[5]), p0[6]); mb = fmaxf(fmaxf(mb, p0[13]), p0[14]); mc = fmaxf(fmaxf(mc, p1[5]), p1[6]); md = fmaxf(fmaxf(md, p1[13]), p1[14]);
    ma = fmaxf(ma, p0[7]); mb = fmaxf(mb, p0[15]); mc = fmaxf(mc, p1[7]); md = fmaxf(md, p1[15]);
    float pmax = fmaxf(fmaxf(ma, mb), fmaxf(mc, md));
    { auto rr = __builtin_amdgcn_permlane32_swap(__float_as_uint(pmax), __float_as_uint(pmax), false, false);
      pmax = fmaxf(__uint_as_float(rr[0]), __uint_as_float(rr[1])); }
    if (__builtin_expect(!first && __all(pmax <= THRL), 1)) { alpha = 1.f; }
    else { const float delta = first ? pmax : fmaxf(pmax, 0.f); alpha = first ? 1.f : __builtin_amdgcn_exp2f(-delta);
#pragma unroll
        for (int r = 0; r < 16; ++r) { p0[r] -= delta; p1[r] -= delta; negm[r] -= delta; } }
#pragma unroll
    for (int r = 0; r < 16; ++r) p0[r] = __builtin_amdgcn_exp2f(p0[r]);
}
__device__ __forceinline__ void finishSM(f32x16& p0, f32x16& p1, float alpha, float& l_reg, bf16x8& pa0, bf16x8& pa1, bf16x8& pa2, bf16x8& pa3) {
#pragma unroll
    for (int r = 0; r < 16; ++r) p1[r] = __builtin_amdgcn_exp2f(p1[r]);
    float sa = p0[0] + p0[1], sb = p0[8] + p0[9], sc = p1[0] + p1[1], sd = p1[8] + p1[9];
#pragma unroll
    for (int r = 2; r < 8; ++r) { sa += p0[r]; sb += p0[8 + r]; sc += p1[r]; sd += p1[8 + r]; }
    float ps = (sa + sb) + (sc + sd);
    { auto rr = __builtin_amdgcn_permlane32_swap(__float_as_uint(ps), __float_as_uint(ps), false, false);
      ps = __uint_as_float(rr[0]) + __uint_as_float(rr[1]); }
    l_reg = l_reg * alpha + ps;
#define PK4(P, BASE, OUT) do { unsigned a0 = cvtpk(P[BASE + 0], P[BASE + 1]), a1 = cvtpk(P[BASE + 2], P[BASE + 3]);   \
    unsigned b0 = cvtpk(P[BASE + 4], P[BASE + 5]), b1 = cvtpk(P[BASE + 6], P[BASE + 7]);                              \
    auto r0 = __builtin_amdgcn_permlane32_swap(a0, b0, false, false); auto r1 = __builtin_amdgcn_permlane32_swap(a1, b1, false, false); \
    u32x4 w = {r0[0], r1[0], r0[1], r1[1]}; OUT = *reinterpret_cast<bf16x8*>(&w); } while (0)
    PK4(p0, 0, pa0); PK4(p0, 8, pa1); PK4(p1, 0, pa2); PK4(p1, 8, pa3);
#undef PK4
}
__device__ __forceinline__ void qkt(f32x16& p0, f32x16& p1, const char* kl, const bf16x8* qr, const char* qrl, const f32x16& negm) {
    bf16x8 ka[8], kb[8], qv[4];
#define KLOAD(dst, g) do { _Pragma("unroll") for (int i = 0; i < 4; ++i) { dst[2 * i] = *reinterpret_cast<const bf16x8*>(kl + ((g) * 4 + i) * 2048); dst[2 * i + 1] = *reinterpret_cast<const bf16x8*>(kl + ((g) * 4 + i) * 2048 + 512); } } while (0)
    KLOAD(ka, 0); SBAR(); KLOAD(kb, 1);
#pragma unroll
    for (int i = 0; i < 4; ++i) qv[i] = *reinterpret_cast<const bf16x8*>(qrl + i * 1024);
    SBAR();
    p0 = __builtin_amdgcn_mfma_f32_32x32x16_bf16(ka[0], qr[0], negm, 0, 0, 0);
    p1 = __builtin_amdgcn_mfma_f32_32x32x16_bf16(ka[1], qr[0], negm, 0, 0, 0);
#pragma unroll
    for (int i = 1; i < 4; ++i) { p0 = __builtin_amdgcn_mfma_f32_32x32x16_bf16(ka[2 * i], qr[i], p0, 0, 0, 0); p1 = __builtin_amdgcn_mfma_f32_32x32x16_bf16(ka[2 * i + 1], qr[i], p1, 0, 0, 0); }
    SBAR(); KLOAD(ka, 2); SBAR();
#pragma unroll
    for (int i = 0; i < 4; ++i) { p0 = __builtin_amdgcn_mfma_f32_32x32x16_bf16(kb[2 * i], qr[4 + i], p0, 0, 0, 0); p1 = __builtin_amdgcn_mfma_f32_32x32x16_bf16(kb[2 * i + 1], qr[4 + i], p1, 0, 0, 0); }
    SBAR();
#pragma unroll
    for (int i = 0; i < 4; ++i) { p0 = __builtin_amdgcn_mfma_f32_32x32x16_bf16(ka[2 * i], qv[i], p0, 0, 0, 0); p1 = __builtin_amdgcn_mfma_f32_32x32x16_bf16(ka[2 * i + 1], qv[i], p1, 0, 0, 0); }
#undef KLOAD
}
__device__ __forceinline__ int v_rd_base(int lane) { return ((lane & 3) << 3) | (((lane >> 2) & 3) << 6) | (((lane >> 4) & 1) << 5) | (((lane >> 5) & 1) << 8); }
constexpr int v_rd_off(int d0, int ks, int half) { return d0 * 512 + ks * 4096 + half * 2048; }
template <int OFF> __device__ __forceinline__ s16x4 tr_read(int vb) {
    return __builtin_amdgcn_ds_read_tr16_b64_v4i16((LAS s16x4*)(uintptr_t)(unsigned)(vb + OFF));
}
struct VFrag { s16x4 l0, h0, l1, h1, l2, h2, l3, h3; };
template <int D0> __device__ __forceinline__ void v_reads(VFrag& f, int vb) {
    f.l0 = tr_read<v_rd_off(D0, 0, 0)>(vb); f.h0 = tr_read<v_rd_off(D0, 0, 1)>(vb); f.l1 = tr_read<v_rd_off(D0, 1, 0)>(vb); f.h1 = tr_read<v_rd_off(D0, 1, 1)>(vb);
    f.l2 = tr_read<v_rd_off(D0, 2, 0)>(vb); f.h2 = tr_read<v_rd_off(D0, 2, 1)>(vb); f.l3 = tr_read<v_rd_off(D0, 3, 0)>(vb); f.h3 = tr_read<v_rd_off(D0, 3, 1)>(vb);
}
__device__ __forceinline__ void pv_mma(f32x16& od, const VFrag& f, bf16x8 pa0, bf16x8 pa1, bf16x8 pa2, bf16x8 pa3) {
#define PKV(L, H) (bf16x8){L[0], L[1], L[2], L[3], H[0], H[1], H[2], H[3]}
    od = __builtin_amdgcn_mfma_f32_32x32x16_bf16(pa0, PKV(f.l0, f.h0), od, 0, 0, 0);
    od = __builtin_amdgcn_mfma_f32_32x32x16_bf16(pa1, PKV(f.l1, f.h1), od, 0, 0, 0);
    od = __builtin_amdgcn_mfma_f32_32x32x16_bf16(pa2, PKV(f.l2, f.h2), od, 0, 0, 0);
    od = __builtin_amdgcn_mfma_f32_32x32x16_bf16(pa3, PKV(f.l3, f.h3), od, 0, 0, 0);
#undef PKV
}
__device__ __forceinline__ void pv_d0(f32x16* o, int vb, bf16x8 pa0, bf16x8 pa1, bf16x8 pa2, bf16x8 pa3) {
    VFrag fa, fb;
    v_reads<0>(fa, vb); v_reads<1>(fb, vb);
    SBAR(); pv_mma(o[0], fa, pa0, pa1, pa2, pa3); SBAR();
    v_reads<2>(fa, vb);
    SBAR(); pv_mma(o[1], fb, pa0, pa1, pa2, pa3); SBAR();
    v_reads<3>(fb, vb);
    SBAR(); pv_mma(o[2], fa, pa0, pa1, pa2, pa3); SBAR();
    pv_mma(o[3], fb, pa0, pa1, pa2, pa3);
}
__device__ __forceinline__ void attn_body(const bf16* __restrict__ Qb, const char* __restrict__ Kt, const char* __restrict__ Vt, bf16* __restrict__ Ob, int t0, int NT, char* lds, const float* __restrict__ ROPE, int qpos0) {
    int tid = threadIdx.x; asm volatile("" : "+v"(tid));
    const int wid = __builtin_amdgcn_readfirstlane(tid >> 6), lane = tid & 63, r32 = lane & 31, hi = lane >> 5, grp = wid >> 2;
    float* ws = (float*)(lds + OFF_WS) + wid * 64; float* li_l = ws; float* al_l = ws + 32;
    float l_reg = 0; f32x16 o[4] = {}; f32x16 negm = {}; bf16x8 qr[8];
    const bf16* Qw = Qb + (long)(wid * QBLK + r32) * 192 + hi * 8;
#pragma unroll
    for (int d0 = 0; d0 < 8; ++d0) qr[d0] = *reinterpret_cast<const bf16x8*>(Qw + d0 * 16);
    char* qrl = lds + OFF_QR + wid * 4096 + lane * 16;
#pragma unroll
    for (int d0 = 0; d0 < 4; ++d0) {
        const u32x4 w = *reinterpret_cast<const u32x4*>(Qw + 128 + d0 * 16); float v[8]; unpack8(w, v);
        if (qpos0 >= 0) { const int pos = qpos0 + wid * QBLK + r32;
#pragma unroll
            for (int q = 0; q < 4; ++q) { const int pair = d0 * 8 + hi * 4 + q, fi = pair & 15, axis = pair >> 4; const int pidx = axis ? (pos & 63) : (pos >> 6);
                const float* cs = ROPE + ((axis ? 128 : 0) + pidx) * 32 + fi * 2; const float c = cs[0], sn = cs[1]; const float x1 = v[2 * q], x2 = v[2 * q + 1];
                v[2 * q] = x1 * c - x2 * sn; v[2 * q + 1] = x2 * c + x1 * sn; } }
        *reinterpret_cast<u32x4*>(qrl + d0 * 1024) = pack8(v); }
    asm volatile("s_waitcnt vmcnt(0)" ::: "memory");
    const unsigned ldsb = (unsigned)(uintptr_t)lds;
    const char* Ktw = Kt + (size_t)t0 * KT_BYTES + lane * 16; const char* Vtw = Vt + (size_t)t0 * VT_BYTES + lane * 16;
#define ISSUE_K(j) do { _Pragma("unroll") for (int _i = 0; _i < 3; ++_i) { const int q = wid * 3 + _i; \
        glds16(Ktw + (size_t)(j) * KT_BYTES + q * 1024, __builtin_amdgcn_readfirstlane(ldsb + OFF_K + ((j) & 1) * KT_BYTES + q * 1024)); } } while (0)
#define ISSUE_V(j) do { _Pragma("unroll") for (int _i = 0; _i < 2; ++_i) { const int q = wid * 2 + _i; \
        glds16(Vtw + (size_t)(j) * VT_BYTES + q * 1024, __builtin_amdgcn_readfirstlane(ldsb + OFF_V + ((j) & 1) * VT_BYTES + q * 1024)); } } while (0)
#define STEP_PRE(s) do { __builtin_amdgcn_s_barrier(); SBAR(); const int _s = (s), _m = _s >> 1; issued = 0; \
        if (_m + 1 < NT) { if (_s & 1) { ISSUE_V(_m + 1); issued = 2; } else { ISSUE_K(_m + 1); issued = 3; } } SBAR(); } while (0)
#define STEP_POST() do { SBAR(); if (issued == 3) asm volatile("s_waitcnt vmcnt(3)" ::: "memory"); else if (issued == 2) asm volatile("s_waitcnt vmcnt(2)" ::: "memory"); else asm volatile("s_waitcnt vmcnt(0)" ::: "memory"); } while (0)
#define RESC(a) do { if (__any((a) < 1.f)) { if (hi == 0) al_l[r32] = (a); asm volatile("s_waitcnt lgkmcnt(0)" ::: "memory"); \
    _Pragma("unroll") for (int d = 0; d < 4; ++d) _Pragma("unroll") for (int r = 0; r < 16; ++r) o[d][r] *= al_l[crow(r, hi)]; } } while (0)
    const char* kl0 = lds + OFF_K + hi * 1024 + r32 * 16;
    const int vb0 = (int)ldsb + OFF_V + v_rd_base(lane);
    f32x16 p0, p1; float al = 1.f; bf16x8 pa0, pa1, pa2, pa3;
    ISSUE_K(0); ISSUE_V(0);
    if (NT > 1) { ISSUE_K(1); ISSUE_V(1); asm volatile("s_waitcnt vmcnt(5)" ::: "memory"); } else asm volatile("s_waitcnt vmcnt(0)" ::: "memory");
    __builtin_amdgcn_s_barrier(); SBAR();
    for (int j = 0; j < NT; ++j) {
        const int sl = j & 1;
        qkt(p0, p1, kl0 + sl * KT_BYTES, qr, qrl, negm);
        partialSM(p0, p1, negm, j == 0, al);
        RESC(al);
        finishSM(p0, p1, al, l_reg, pa0, pa1, pa2, pa3); SBAR();
        pv_d0(o, vb0 + sl * VT_BYTES, pa0, pa1, pa2, pa3);
        SBAR(); asm volatile("s_waitcnt vmcnt(0)" ::: "memory"); __builtin_amdgcn_s_barrier(); SBAR();
        if (j + 2 < NT) { ISSUE_K(j + 2); ISSUE_V(j + 2); }
    }
    if (hi == 0) li_l[r32] = l_reg; asm volatile("s_waitcnt lgkmcnt(0)" ::: "memory");
    float rli[16];
#pragma unroll
    for (int r = 0; r < 16; ++r) rli[r] = __builtin_amdgcn_rcpf(li_l[crow(r, hi)]);
    bf16* Ow = Ob + (long)(wid * QBLK) * DM;
#pragma unroll
    for (int r = 0; r < 16; ++r) { const int orow = crow(r, hi);
#pragma unroll
        for (int d0 = 0; d0 < 4; ++d0) Ow[(long)orow * DM + d0 * 32 + r32] = (bf16)f2bf(o[d0][r] * rli[r]); }
    __syncthreads();
#undef ISSUE_K
#undef ISSUE_V
#undef STEP_PRE
#undef STEP_POST
#undef RESC
}
}

__device__ __forceinline__ void phase_attention(const Ctx& C, int layer) {
    const bf16* QB = (const bf16*)(C.arena + R_QB); const char* KB = (const char*)(C.arena + R_KB); const char* VB = (const char*)(C.arena + R_VB); bf16* MIX = (bf16*)(C.arena + R_MIX);
    const float* ROPE = (const float*)(C.ws + WS_ROPE);
    const int nunit = layer == 0 ? 264 : 256;
    for (int L = C.bid; L < nunit; L += C.G) {
        const bool lat = L < 256; const int bh = lat ? (L & 7) : (L - 256), qb = L >> 3, b = bh >> 2, h = bh & 3;
        const int qrow = lat ? qb * 256 : TT, orow = lat ? b * TT + qb * 256 : NLAT + b * TC;
        att::attn_body(QB + ((size_t)bh * TKV + qrow) * 192, KB + (size_t)bh * 132 * att::KT_BYTES, VB + (size_t)bh * 132 * att::VT_BYTES, MIX + (size_t)orow * DM + 512 + h * 128,
                       lat ? 0 : 128, lat ? 132 : 4, (char*)C.ldsg, ROPE, lat ? qb * 256 : -1);
    }
}

struct FStoreP { bf16* P;
    __device__ __forceinline__ void operator()(int row, int col, f32x4 v0, f32x4 v1) const { u32x4 w; w.x = pk2h(v0[0], v0[1]); w.y = pk2h(v0[2], v0[3]); w.z = pk2h(v1[0], v1[1]); w.w = pk2h(v1[2], v1[3]); *(u32x4*)(P + (size_t)row * PW + col) = w; } };
struct FStoreQKV { bf16* QB; char* KB; char* VB; int coff;
    __device__ __forceinline__ void operator()(int row, int colx, f32x4 v0, f32x4 v1) const {
        const int col = colx + coff; int b, pos; row_bpos(row, b, pos);
        if (col < 768) { constexpr float QS = MLA_SCALE * 1.4426950408889634f; v0 = v0 * QS; v1 = v1 * QS; }
        u32x4 w; w.x = pk2h(v0[0], v0[1]); w.y = pk2h(v0[2], v0[3]); w.z = pk2h(v1[0], v1[1]); w.w = pk2h(v1[2], v1[3]);
        if (col < 768) { const int h = col / 192, j = col - h * 192; *(u32x4*)(QB + ((size_t)(b * 4 + h) * TKV + pos) * 192 + j) = w; }
        else { const int c2 = col - 768, h = c2 >> 8, j = c2 & 255; const size_t tile = (size_t)(b * 4 + h) * 132 + (pos >> 6); const int k = pos & 63;
            if (j < 128) *(u32x4*)(KB + tile * att::KT_BYTES + (j >> 3) * 1024 + k * 16) = w;
            else *(u32x4*)(VB + tile * att::VT_BYTES + att::v_st(k, j - 128)) = w; }
    } };
struct FResidual { const float* x; const float* ctx; bf16* XL; const float* gate; int layer0;
    __device__ __forceinline__ void operator()(int row, int col, f32x4 v0, f32x4 v1) const {
        const float* g = gate + mod_row(row) * 6144 + col; const f32x4 g0 = *(const f32x4*)g, g1 = *(const f32x4*)(g + 4);
        float r[8];
        if (layer0) { const float* src = (row < NLAT ? x + (size_t)row * DM : ctx + (size_t)(row - NLAT) * DM) + col; const f32x4 s0 = *(const f32x4*)src, s1 = *(const f32x4*)(src + 4);
            r[0] = s0[0]; r[1] = s0[1]; r[2] = s0[2]; r[3] = s0[3]; r[4] = s1[0]; r[5] = s1[1]; r[6] = s1[2]; r[7] = s1[3]; }
        else unpack8(*(const u32x4*)(XL + (size_t)row * DM + col), r);
        r[0] += g0[0] * v0[0]; r[1] += g0[1] * v0[1]; r[2] += g0[2] * v0[2]; r[3] += g0[3] * v0[3]; r[4] += g1[0] * v1[0]; r[5] += g1[1] * v1[1]; r[6] += g1[2] * v1[2]; r[7] += g1[3] * v1[3];
        *(u32x4*)(XL + (size_t)row * DM + col) = pack8h(r);
    } };
struct FStoreAct { bf16* ACT; int ld;
    __device__ __forceinline__ void operator()(int row, int col, const float* o) const { *(u32x4*)(ACT + (size_t)row * ld + col) = pack8h(o); } };
struct FMoeDown { const int* ENT; const float* WTS; bf16* Y0; bf16* Y2; const float* gate;
    __device__ __forceinline__ void operator()(int row, int colx, f32x4 v0, f32x4 v1) const {
        const int col = colx & (DM - 1);
        const int ent = ENT[row]; if (ent < 0) return;
        const int tok = ent >> 1; const float w = WTS[row]; const float* g = gate + (tok >> 13) * 6144 + col;
        const f32x4 a0 = *(const f32x4*)g * w * v0, a1 = *(const f32x4*)(g + 4) * w * v1;
        u32x4 o; o.x = pk2h(a0[0], a0[1]); o.y = pk2h(a0[2], a0[3]); o.z = pk2h(a1[0], a1[1]); o.w = pk2h(a1[2], a1[3]);
        *(u32x4*)(((ent & 1) ? Y2 : Y0) + (size_t)tok * DM + col) = o;
    } };

constexpr int PH_PER_LAYER = 13, PH_FINAL = 1 + 2 * PH_PER_LAYER, N_PHASES = PH_FINAL + 1;
__host__ __device__ constexpr bool phase_exists(int ph) { return ph == 0 || ph == PH_FINAL || (ph >= 1 && ph < PH_FINAL && ((((ph - 1) / PH_PER_LAYER) == 1 && ((ph - 1) % PH_PER_LAYER) != 7 && ((ph - 1) % PH_PER_LAYER) != 8) || (((ph - 1) / PH_PER_LAYER) == 0 && ((ph - 1) % PH_PER_LAYER) < 9))); }

#ifndef DBG_REP
#define DBG_REP(ph) 0
#endif
#ifndef DBG_DELAY
#define DBG_DELAY(ph) 0
#endif
#ifndef DBG_STOP
#define DBG_STOP 0
#endif
#ifndef DBG_SRC
#define DBG_SRC 0
#endif
__device__ __forceinline__ void phase_dump(const Ctx& C) {
    const int gw = C.vcu * 8 + C.wave, NGW = C.G * 8;
    for (int row = gw; row < NLAT; row += NGW) {
        float* o = C.out + (size_t)row * DM;
        if (DBG_SRC == 0) { const bf16* s = (const bf16*)(C.ws + WS_XL) + (size_t)row * DM; for (int c = C.lane; c < DM; c += 64) o[c] = bf2f(s[c]); }
        else { const bf16* s = DBG_SRC == 1 ? (const bf16*)(C.arena + R_MIX) + (size_t)row * DM : DBG_SRC == 2 ? (const bf16*)(C.ws + WS_H) + (size_t)row * DM
                             : DBG_SRC == 3 ? (const bf16*)(C.arena + R_P) + (size_t)row * PW : DBG_SRC == 4 ? (const bf16*)(C.arena + R_P) + (size_t)row * PW + 1024
                             : DBG_SRC == 5 ? (const bf16*)(C.arena + R_ACT) + (size_t)row * DFF : DBG_SRC == 6 ? (const bf16*)(C.arena + R_QT) + (size_t)row * 256
                             : (const bf16*)(C.arena + R_QB) + (size_t)row * 192;
            const int n = DBG_SRC == 6 ? 256 : DBG_SRC == 7 ? 192 : DM;
            for (int c = C.lane; c < DM; c += 64) o[c] = c < n ? bf2f(s[c]) : 0.f; }
    }
}
template <int PH, int SUB = 0> __device__ __forceinline__ void run_phase(const Ctx& C0) {
    Ctx C = C0; { int t = threadIdx.x; asm volatile("" : "+v"(t)); C.tid = t; C.lane = t & 63; C.wave = __builtin_amdgcn_readfirstlane(t >> 6); }
    constexpr int layer = (PH - 1) / PH_PER_LAYER, k = (PH - 1) % PH_PER_LAYER;
    const float* MODB = (const float*)(C.ws + WS_MOD);
    if constexpr (DBG_STOP > 0 && PH > DBG_STOP && PH != PH_FINAL) { }
    else if constexpr (DBG_STOP > 0 && PH == PH_FINAL) { phase_dump(C); }
    else if constexpr (PH == 0) { prologue(C); }
    else if constexpr (PH == PH_FINAL) { phase_final(C); }
    else if constexpr (k == 0) { phase_norm1(C, layer); }
    else if constexpr (k == 1) {
        pg8::Gemm g{(const bf16*)(C.ws + WS_H), (const bf16*)(C.arena + A_WIN) + (size_t)layer * 2048 * 1024, 1024, 1024, 1024};
        pg8::StaticOrder S; S.init(MR, PW, C.G, C.bid); pg8::Epi8<FStoreP> E{{(bf16*)(C.arena + R_P)}};
        pg8::gemm_phase(C.lds, g, S, E);
        if constexpr (layer == 0) { const int nfull = (MR / 256 * (PW / 256)) % C.G;
            if (C.bid >= nfull) convert_weights(C, false, (C.bid - nfull) * 8 + C.wave, (C.G - nfull) * 8); }
        else { const int nfull = (MR / 256 * (PW / 256)) % C.G;
            if (C.bid >= nfull) convert_expert_down(C, (C.bid - nfull) * 8 + C.wave, (C.G - nfull) * 8); }
    } else if constexpr (k == 2) {
        if (SUB != 2) phase_gla_local(C, layer);
        if (SUB != 1) {
            const int r5 = (NB * NCH * 4) % C.G;
            if (r5 == 0) phase_mla_prep(C, C.vcu * 8 + C.wave, C.G * 8);
            else if (C.bid >= r5) phase_mla_prep(C, (C.bid - r5) * 8 + C.wave, (C.G - r5) * 8); }
    } else if constexpr (k == 3) {
        if (SUB != 2) phase_gla_scan(C);
        if (SUB != 1)
        {
            const bf16* W = (const bf16*)(C.arena + A_WQKV) + (size_t)layer * 1792 * 384; const bf16* A = (const bf16*)(C.arena + R_CQKV);
#pragma unroll 1
            for (int pass = 0; pass < 2; ++pass) {
                int ps = pass; asm volatile("" : "+s"(ps));
                pg8::Gemm g{A + (ps ? 256 : 0), W + (ps ? (size_t)768 * 384 + 256 : 0), ps ? 128 : 256, 384, 384};
                pg8::StaticOrder S; S.init(ps ? MR : (layer == 0 ? MR : NLAT), ps ? 1024 : 768, C.G, C.bid);
                pg8::Epi8<FStoreQKV> E{{(bf16*)(C.arena + R_QB), (char*)(C.arena + R_KB), (char*)(C.arena + R_VB), ps ? 768 : 0}};
                pg8::gemm_phase(C.lds, g, S, E); }
        }
    } else if constexpr (k == 4) {
        if (SUB != 2) phase_gla_out(C, layer);
        if (SUB != 1) phase_attention(C, layer);
    } else if constexpr (k == 5) {
        pg8::Gemm g{(const bf16*)(C.arena + R_MIX), (const bf16*)(C.arena + A_WOUT) + (size_t)layer * 1024 * 1024, 1024, 1024, 1024};
        pg8::StaticOrder S; S.init(NLAT, DM, C.G, C.bid);
        pg8::Epi8<FResidual> E{{C.in[I_X], C.in[I_CTX], (bf16*)(C.ws + WS_XL), MODB + (size_t)layer * 3 * 6144 + 2 * 1024, layer == 0 ? 1 : 0}};
        pg8::gemm_phase(C.lds, g, S, E);
        if constexpr (layer == 0) {
            pg8::Gemm g2{(const bf16*)(C.arena + R_MIX), (const bf16*)(C.arena + A_WOUT), 256, 1024, 1024};
            pg8::CtxSplitOrder S2{4, C.G, C.bid}; pg8::EpiPart E2{(float*)(C.arena + R_PART)};
            pg8::gemm_phase(C.lds, g2, S2, E2); }
    } else if constexpr (k == 6) { phase_norm2(C, layer); if constexpr (layer == 1) convert_expert_gu(C, C.vcu * 8 + C.wave, C.G * 8); }
    else if constexpr (layer == 0 && k == 7) {
        pg8::Gemm g{(const bf16*)(C.ws + WS_H), (const bf16*)(C.arena + A_FGU), 1024, 1024, 1024};
        pg8::StaticOrder S; S.init(MR, 2 * DFF, C.G, C.bid); pg8::EpiGU<FStoreAct> E{{(bf16*)(C.arena + R_ACT), DFF}, 1 << 20};
        pg8::gemm_phase(C.lds, g, S, E);
    } else if constexpr (layer == 0 && k == 8) {
        pg8::Gemm g{(const bf16*)(C.arena + R_ACT), (const bf16*)(C.arena + A_FD), DFF, DFF, DFF};
        pg8::StaticOrder S; S.init(NLAT, DM, C.G, C.bid);
        pg8::Epi8<FResidual> E{{C.in[I_X], C.in[I_CTX], (bf16*)(C.ws + WS_XL), MODB + 5 * 1024, 0}};
        pg8::gemm_phase(C.lds, g, S, E);
        {
            pg8::Gemm g2{(const bf16*)(C.arena + R_ACT), (const bf16*)(C.arena + A_FD), 256, DFF, DFF};
            pg8::CtxSplitOrder S2{11, C.G, C.bid}; pg8::EpiPart E2{(float*)(C.arena + R_PART)};
            pg8::gemm_phase(C.lds, g2, S2, E2); }
    }
    else if constexpr (layer == 1 && (k == 9 || k == 11)) {
        constexpr int half = (k - 9) / 2;
        if constexpr (half == 1) moe_tail_reduce0(C);
        pg8::MoeGatherOrder S; moe_tile_bases(C, S.tb); S.ncol = half ? MOE_T1 : MOE_T0; S.tpe = 28; S.joff = half ? MOE_T0 : 0; S.G = C.G; S.c = C.bid;
        S.LISTE = (const int*)(C.arena + M_LISTE);
        { const unsigned* ctl = (const unsigned*)(C.ws + WS_CTL);
#pragma unroll
          for (int e = 0; e < 8; ++e) S.cnt[e] = (int)__hip_atomic_load(ctl + CW_CNT + 64 * e, __ATOMIC_RELAXED, __HIP_MEMORY_SCOPE_AGENT); }
        pg8::Gemm g{(const bf16*)(C.arena + M_HS), (const bf16*)(C.arena + M_EGU), 1024, 1024, 1024};
        pg8::EpiGU<FStoreAct> E{{(bf16*)(C.arena + M_ACT) - (size_t)(half ? MOE_K0 : 0), half ? MOE_K1 : MOE_K0}, 28};
        pg8::gemm_phase(C.lds, g, S, E);
        if constexpr (half == 0) moe_fill_lists(C);
    } else if constexpr (layer == 1 && (k == 10 || k == 12)) {
        constexpr int half = (k - 10) / 2;
        const int* ENT = (const int*)(C.ws + WS_LIST + AL((size_t)NLAT * 2 * 4 * 3)); const float* WTS = (const float*)(ENT + MAXT * 256);
        pg8::MoeTailOrder ST; moe_tile_bases(C, ST.tb); const int ntot = ST.tb[8];
        pg8::MoeOrder S;
#pragma unroll
        for (int e = 0; e < 9; ++e) S.tb[e] = ST.tb[e] < MOE_MAIN ? ST.tb[e] : MOE_MAIN;
        S.ncol = 4; S.tpe = 4; S.joff = 0; S.G = C.G; S.c = C.bid;
        constexpr int KP = half ? MOE_K1 : MOE_K0;
        pg8::Gemm g{(const bf16*)(C.arena + M_ACT), (const bf16*)(C.ws + WS_ED) + (size_t)(half ? MOE_K0 : 0), KP, KP, DFE};
        pg8::Epi8<FMoeDown> E{{ENT, WTS, half ? (bf16*)(C.arena + M_EGU) : (bf16*)(C.ws + WS_Y0), half ? (bf16*)(C.arena + M_EGU) + (size_t)NLAT * DM : (bf16*)(C.ws + WS_H), MODB + (size_t)3 * 6144 + 5 * 1024}};
        pg8::gemm_phase(C.lds, g, S, E);
        if (ntot > MOE_MAIN) {
            constexpr int KC = half ? MOE_C1 : MOE_C0;
            ST.nm = MOE_MAIN; ST.ntail = ntot - MOE_MAIN; ST.nchunk = half ? MOE_NC1 : MOE_NC0; ST.G = C.G; ST.c = C.bid;
            pg8::Gemm g2{(const bf16*)(C.arena + M_ACT), (const bf16*)(C.ws + WS_ED) + (size_t)(half ? MOE_K0 : 0), KC, KP, DFE};
            pg8::EpiPartT E2{half ? (bf16*)(C.arena + M_HS) : (bf16*)(C.arena + M_PT0), MOE_MAIN};
            pg8::gemm_phase(C.lds, g2, ST, E2); }
    }
}

__device__ __forceinline__ void make_ctx(Ctx& C, const Args& args, unsigned char* lds_raw) {
    C.lds = (LAS unsigned char*)lds_raw; C.ldsg = lds_raw; C.ws = args.ws; C.arena = args.ws + WS_ARENA; C.in = args.in; C.out = args.out;
    C.tid = threadIdx.x; C.lane = C.tid & 63; C.wave = __builtin_amdgcn_readfirstlane(C.tid >> 6);
    C.G = gridDim.x; C.bid = blockIdx.x; C.vcu = (C.G % 8 == 0) ? (C.bid % 8) * (C.G / 8) + C.bid / 8 : C.bid;
}

template <int PH> __device__ __forceinline__ void run_from(const Ctx& C, const XcdBarrier& bar) {
    if constexpr (PH < N_PHASES) {
        if constexpr (phase_exists(PH)) {
            unsigned long long t0_ = 0; if constexpr (DBG_DELAY(PH) != 0) t0_ = __builtin_amdgcn_s_memrealtime();
            run_phase<PH>(C); if constexpr (PH != PH_FINAL) xcd_barrier(bar);
            if constexpr (DBG_DELAY(PH) != 0) { const unsigned long long t1_ = __builtin_amdgcn_s_memrealtime(); while (__builtin_amdgcn_s_memrealtime() - t1_ < t1_ - t0_) __builtin_amdgcn_s_sleep(8); __syncthreads(); }
            if constexpr (DBG_REP(PH) > 0) { run_phase<PH, DBG_REP(PH) - 1>(C); xcd_barrier(bar); } }
        run_from<PH + 1>(C, bar);
    }
}

#if !MK_PER_PHASE
__global__ void __launch_bounds__(512, 2) mega_fwd(Args args) {
    extern __shared__ __attribute__((aligned(16))) unsigned char lds_raw[];
    Ctx C; make_ctx(C, args, lds_raw);
    volatile LAS unsigned* MISC = (volatile LAS unsigned*)(C.lds + MISC_OFF);
    if (C.tid < 64) MISC[C.tid] = 0u;
    __syncthreads();
    unsigned* ctl = (unsigned*)(C.ws + WS_CTL);
    const XcdBarrier bar = xcd_barrier_post(ctl + CW_BAR, MISC + 8);
    run_from<0>(C, bar);
}
#else
template <int PH> __global__ void __launch_bounds__(512, 2) phase_kernel(Args args) {
    extern __shared__ __attribute__((aligned(16))) unsigned char lds_raw[];
    Ctx C; make_ctx(C, args, lds_raw);
    run_phase<PH>(C);
}
template <int PH> void launch_from(int grid, hipStream_t stream, const Args& a) {
    if constexpr (PH < N_PHASES) {
        if constexpr (phase_exists(PH)) {
            (void)hipFuncSetAttribute((const void*)phase_kernel<PH>, hipFuncAttributeMaxDynamicSharedMemorySize, LDS_BYTES);
            hipLaunchKernelGGL(phase_kernel<PH>, dim3(grid), dim3(512), LDS_BYTES, stream, a);
        }
        launch_from<PH + 1>(grid, stream, a);
    }
}
#endif

extern "C" void kernel_launch(void* const* d_in, const int* in_sizes, int n_in, void* d_out, int out_size, void* d_ws, size_t ws_size, hipStream_t stream) {
    static int grid = 0;
    if (grid == 0) {
        if (n_in != 25 || out_size != NLAT * DM || ws_size < WS_END) { fprintf(stderr, "kernel_launch: unexpected shapes (n_in %d, out %d, ws %zu < %zu); nothing launched\n", n_in, out_size, ws_size, (size_t)WS_END); grid = -1; return; }
        int dev = 0, cus = 0;
        if (hipGetDevice(&dev) != hipSuccess || hipDeviceGetAttribute(&cus, hipDeviceAttributeMultiprocessorCount, dev) != hipSuccess) { grid = -1; return; }
#if !MK_PER_PHASE
        if (hipFuncSetAttribute((const void*)mega_fwd, hipFuncAttributeMaxDynamicSharedMemorySize, LDS_BYTES) != hipSuccess) { fprintf(stderr, "kernel_launch: hipFuncSetAttribute failed\n"); grid = -1; return; }
        int per_cu = 0;
        if (hipOccupancyMaxActiveBlocksPerMultiprocessor(&per_cu, (const void*)mega_fwd, 512, LDS_BYTES) != hipSuccess || per_cu < 1) { fprintf(stderr, "kernel_launch: occupancy query reports %d blocks per CU\n", per_cu); }
        (void)hipGetLastError();
#endif
        grid = cus;
    }
    if (grid < 0) return;
    if (hipMemsetAsync((char*)d_ws + WS_CTL, 0, CTL_BYTES, stream) != hipSuccess) return;
    Args a{};
    for (int i = 0; i < 25; ++i) a.in[i] = (const float*)d_in[i];
    a.out = (float*)d_out; a.ws = (unsigned char*)d_ws;
#if MK_PER_PHASE
    launch_from<0>(grid, stream, a);
#else
    hipLaunchKernelGGL(mega_fwd, dim3(grid), dim3(512), LDS_BYTES, stream, a);
#endif
    const hipError_t le = hipPeekAtLastError();
    if (le != hipSuccess) fprintf(stderr, "kernel_launch: launch failed: %s\n", hipGetErrorName(le));
}
```

```cpp
#include <hip/hip_runtime.h>
#include <cstdio>
#include <cstdint>

#define LAS __attribute__((address_space(3)))
#define GAS __attribute__((address_space(1)))
typedef unsigned short bf16;
typedef short bf16x8 __attribute__((ext_vector_type(8)));
typedef short s16x4 __attribute__((ext_vector_type(4)));
typedef float f32x2 __attribute__((ext_vector_type(2)));
typedef float f32x4 __attribute__((ext_vector_type(4)));
typedef float f32x16 __attribute__((ext_vector_type(16)));
typedef unsigned u32x2 __attribute__((ext_vector_type(2)));
typedef unsigned u32x4 __attribute__((ext_vector_type(4)));

#ifndef MK_PER_PHASE
#define MK_PER_PHASE 0
#endif

constexpr int DM = 1024, NB = 2, TT = 8192, TC = 256, NLAT = NB * TT, NCTXR = NB * TC, MR = NLAT + NCTXR;
constexpr int TKV = TT + TC;
constexpr int PW = 2048;
constexpr int PC_Q = 0, PC_K = 256, PC_V = 512, PC_R = 1024, PC_CQ = 1536, PC_CKV = 1792, PC_KR = 1920, PC_GF = 1984, PC_GB = 2000;
constexpr int NCH = 132;
constexpr int DFF = 2816, DFE = 3584, NEXP = 8;
constexpr int MOE_T0 = 15, MOE_T1 = 28 - MOE_T0, MOE_K0 = MOE_T0 * 128, MOE_K1 = MOE_T1 * 128;
constexpr int MOE_MAIN = 128, MOE_C0 = 384, MOE_NC0 = 5, MOE_C1 = 128, MOE_NC1 = 13;
constexpr int MAXT = 136;
constexpr float EPS = 1e-6f;
constexpr float MLA_SCALE = 0.07216878364870322f;
namespace att {
constexpr int KT_BYTES = 24576, VT_BYTES = 16384;
__host__ __device__ __forceinline__ int v_st(int k, int c) { const int kk = (k & ~0xC) | ((k & 4) << 1) | ((k & 8) >> 1); return ((kk >> 3) * 4 + (c >> 5)) * 512 + ((kk & 7) * 32 + (c & 31)) * 2; }
}

constexpr size_t AL(size_t x) { return (x + 255) & ~(size_t)255; }
constexpr size_t WS_CTL = 0, CTL_BYTES = 65536;
constexpr size_t WS_MOD = WS_CTL + CTL_BYTES;
constexpr size_t WS_ROPE = WS_MOD + AL(2 * 3 * 6144 * 4);
constexpr size_t WS_XL = WS_ROPE + AL((128 + 64) * 32 * 4);
constexpr size_t WS_H = WS_XL + AL((size_t)MR * DM * 2);
constexpr size_t WS_LIST = WS_H + AL((size_t)MR * DM * 2);
constexpr size_t LIST_BYTES = AL((size_t)NLAT * 2 * 4 * 3) + AL((size_t)MAXT * 256 * 4 * 2) + AL((size_t)NLAT * 2 * 4);
constexpr size_t WS_Y0 = WS_LIST + LIST_BYTES;
constexpr size_t WS_ARENA = WS_Y0 + AL((size_t)NLAT * DM * 2);
constexpr size_t A_WIN = 0;
constexpr size_t A_WQKV = A_WIN + AL((size_t)2 * 2048 * 1024 * 2);
constexpr size_t A_WOUT = A_WQKV + AL((size_t)2 * 1792 * 384 * 2);
constexpr size_t A_FGU = A_WOUT + AL((size_t)2 * 1024 * 1024 * 2);
constexpr size_t A_FD = A_FGU + AL((size_t)2 * DFF * 1024 * 2);
constexpr size_t A_R = A_FD + AL((size_t)1024 * DFF * 2);
constexpr size_t R_P = A_R;
constexpr size_t R_QT = R_P + AL((size_t)MR * PW * 2);
constexpr size_t R_KT = R_QT + AL((size_t)2 * MR * 256 * 2);
constexpr size_t R_SLOC = R_KT + AL((size_t)2 * MR * 256 * 2);
constexpr size_t R_DEC = R_SLOC + AL((size_t)16 * NCH * 8192 * 4);
constexpr size_t R_SST = R_DEC + AL((size_t)16 * NCH * 64 * 4);
constexpr size_t R_CQKV = R_SST + AL((size_t)16 * NCH * 8192 * 2);
constexpr size_t R_QB = R_CQKV + AL((size_t)MR * 384 * 2);
constexpr size_t R_KB = R_QB + AL((size_t)8 * TKV * 192 * 2);
constexpr size_t R_VB = R_KB + AL((size_t)8 * TKV * 192 * 2);
constexpr size_t R_MIX = R_VB + AL((size_t)8 * TKV * 128 * 2);
constexpr size_t R_END = R_MIX + AL((size_t)MR * DM * 2);
constexpr size_t R_PART = R_SLOC;
constexpr size_t R_ACT = A_R;
static_assert(R_ACT + (size_t)MR * DFF * 2 <= R_SLOC && (size_t)11 * 512 * 1024 * 4 <= (size_t)16 * NCH * 8192 * 4, "ACT ends below SLOC; PART fits SLOC");
constexpr size_t M_EGU = 0;
constexpr size_t M_HS = M_EGU + AL((size_t)NEXP * 2 * DFE * 1024 * 2);
constexpr size_t M_LISTE = M_HS + AL((size_t)NLAT * DM * 2);
constexpr size_t M_ACT = M_HS + AL((size_t)MAXT * 256 * 1024 * 2);
constexpr size_t M_PT0 = M_ACT + AL((size_t)MAXT * 256 * MOE_K0 * 2);
constexpr size_t M_END = M_PT0 + AL((size_t)MOE_NC0 * 2048 * 1024 * 2);
constexpr size_t ARENA_BYTES = (R_END > M_END) ? R_END : M_END;
constexpr size_t WS_ED = WS_ARENA + ARENA_BYTES;
constexpr size_t WS_END = WS_ED + AL((size_t)NEXP * 1024 * DFE * 2);
static_assert(WS_END <= 534000000ull, "workspace map exceeds the guaranteed scratch size");

constexpr int CW_BAR = 4096;
constexpr int CW_CNT = 64;

constexpr int LDS_BYTES = 147456, MISC_OFF = LDS_BYTES - 256;

__device__ __forceinline__ unsigned f2bf_s(float f) { unsigned u = __builtin_bit_cast(unsigned, f); return (u + 0x7fffu + ((u >> 16) & 1u)) >> 16; }
__device__ __forceinline__ unsigned pk2s(float lo, float hi) { return f2bf_s(lo) | (f2bf_s(hi) << 16); }
typedef __bf16 bf16x2_t __attribute__((ext_vector_type(2)));
__device__ __forceinline__ unsigned pk2h(float lo, float hi) { const f32x2 v = {lo, hi}; return __builtin_bit_cast(unsigned, __builtin_convertvector(v, bf16x2_t)); }
__device__ __forceinline__ unsigned pk2(float lo, float hi) { return pk2h(lo, hi); }
__device__ __forceinline__ unsigned f2bf(float f) { return pk2h(f, 0.f) & 0xffffu; }
__device__ __forceinline__ u32x4 pack8h(const float* v) { u32x4 w; w.x = pk2h(v[0], v[1]); w.y = pk2h(v[2], v[3]); w.z = pk2h(v[4], v[5]); w.w = pk2h(v[6], v[7]); return w; }
__device__ __forceinline__ float bf2f(unsigned b) { return __builtin_bit_cast(float, b << 16); }
__device__ __forceinline__ float bflo(unsigned w) { return __builtin_bit_cast(float, w << 16); }
__device__ __forceinline__ float bfhi(unsigned w) { return __builtin_bit_cast(float, w & 0xffff0000u); }
__device__ __forceinline__ u32x4 pack8s(const float* v) { u32x4 w; w.x = pk2s(v[0], v[1]); w.y = pk2s(v[2], v[3]); w.z = pk2s(v[4], v[5]); w.w = pk2s(v[6], v[7]); return w; }
__device__ __forceinline__ u32x4 pack8(const float* v) { u32x4 w; w.x = pk2(v[0], v[1]); w.y = pk2(v[2], v[3]); w.z = pk2(v[4], v[5]); w.w = pk2(v[6], v[7]); return w; }
__device__ __forceinline__ void unpack8_raw(u32x4 w, bf16* v) { v[0] = (bf16)(w.x & 0xffffu); v[1] = (bf16)(w.x >> 16); v[2] = (bf16)(w.y & 0xffffu); v[3] = (bf16)(w.y >> 16); v[4] = (bf16)(w.z & 0xffffu); v[5] = (bf16)(w.z >> 16); v[6] = (bf16)(w.w & 0xffffu); v[7] = (bf16)(w.w >> 16); }
__device__ __forceinline__ void unpack8(u32x4 w, float* v) { v[0] = bflo(w.x); v[1] = bfhi(w.x); v[2] = bflo(w.y); v[3] = bfhi(w.y); v[4] = bflo(w.z); v[5] = bfhi(w.z); v[6] = bflo(w.w); v[7] = bfhi(w.w); }
__device__ __forceinline__ float wave_sum(float v) {
#pragma unroll
    for (int o = 1; o < 64; o <<= 1) v += __shfl_xor(v, o);
    return v;
}
__device__ __forceinline__ float silu_f(float x) { return x * __builtin_amdgcn_rcpf(1.f + __expf(-x)); }
__device__ __forceinline__ float logsig_f(float x) { return fminf(x, 0.f) - __logf(1.f + __expf(-fabsf(x))); }
#define LDS_WAIT() asm volatile("s_waitcnt lgkmcnt(0)" ::: "memory")
#define VM_WAIT() asm volatile("s_waitcnt vmcnt(0)" ::: "memory")

namespace pg8 {
constexpr int BM = 256, BK = 64, HALF = 128, HTB = HALF * BK * 2, NXCD = 8, WGM = 8;
__host__ __device__ __forceinline__ int lds_byte(int r, int c) { const int st = (r >> 4) * 2 + (c >> 5), rr = r & 15, cc = c & 31, ob = rr * 64 + cc * 2; return st * 1024 + (ob ^ (((ob >> 9) & 1) << 5)); }
__host__ __device__ __forceinline__ void stage_rc(int b, int& R, int& C) { const int st = b / 1024, sb = b % 1024, swz = sb ^ (((sb >> 9) & 1) << 5); R = (st >> 1) * 16 + swz / 64; C = (st & 1) * 32 + (swz % 64) / 2; }
__host__ __device__ __forceinline__ int perm32(int rho) { const int n = rho >> 4, i = rho & 15; return 8 * (i >> 2) + 4 * n + (i & 3); }

struct Unit { int pm, pn, kc; };
struct Gemm { const bf16* A; const bf16* Bt; int K, lda, ldb; };

struct StaticOrder {
    static constexpr bool GATHER = false;
    int nM, nN, nwg, G, c;
    __device__ void init(int M, int N, int G_, int c_) { nM = M / BM; nN = N / BM; nwg = nM * nN; G = G_; c = c_; }
    __device__ bool next(int i, Unit& u) const {
        const long L = (long)i * G + c; if (L >= nwg) return false;
        int wgid = (int)L; { const int q = nwg / NXCD, r = nwg % NXCD, xcd = wgid % NXCD, off = wgid / NXCD; wgid = (xcd < r ? xcd * (q + 1) : r * (q + 1) + (xcd - r) * q) + off; }
        const int nig = WGM * nN, gid = wgid / nig, fm = gid * WGM, gsz = (nM - fm) < WGM ? (nM - fm) : WGM;
        u.pm = fm + ((wgid % nig) % gsz); u.pn = (wgid % nig) / gsz; u.kc = 0; return true;
    }
};
struct MoeOrder {
    static constexpr bool GATHER = false;
    int tb[9]; int ncol, tpe, joff, G, c;
    __device__ bool next(int i, Unit& u) const {
        const int nM = tb[8], nwg = nM * ncol; const long L = (long)i * G + c; if (L >= nwg) return false;
        int wgid = (int)L; { const int q = nwg / NXCD, r = nwg % NXCD, xcd = wgid % NXCD, off = wgid / NXCD; wgid = (xcd < r ? xcd * (q + 1) : r * (q + 1) + (xcd - r) * q) + off; }
        const int nig = WGM * ncol, gid = wgid / nig, fm = gid * WGM, gsz = (nM - fm) < WGM ? (nM - fm) : WGM;
        const int tile = fm + ((wgid % nig) % gsz), j = (wgid % nig) / gsz; int e = 0;
#pragma unroll
        for (int k = 1; k < 8; ++k) e += (tile >= tb[k]) ? 1 : 0;
        u.pm = tile; u.pn = e * tpe + joff + j; u.kc = 0; return true;
    }
};
struct MoeTailOrder {
    static constexpr bool GATHER = false;
    int tb[9]; int nm, ntail, nchunk, G, c;
    __device__ bool next(int i, Unit& u) const {
        const int per = ntail * 4, L = i * G + c; if (L >= per * nchunk) return false;
        const int kc = L / per, r = L - kc * per, tile = nm + (r >> 2); int e = 0;
#pragma unroll
        for (int k = 1; k < 8; ++k) e += (tile >= tb[k]) ? 1 : 0;
        u.pm = tile; u.pn = e * 4 + (r & 3); u.kc = kc; return true;
    }
};
struct CtxSplitOrder {
    static constexpr bool GATHER = false;
    int nchunk, G, c;
    __device__ bool next(int i, Unit& u) const { const int L = i * G + c; if (L >= nchunk * 8) return false; const int r = L & 7; u.kc = L >> 3; u.pm = 64 + (r & 1); u.pn = r >> 1; return true; }
};
struct MoeGatherOrder : MoeOrder {
    static constexpr bool GATHER = true;
    const int* LISTE; int cnt[8];
    __device__ __forceinline__ void rows_of(const Unit& u, const int*& src, int& nvalid) const {
        int e = 0;
#pragma unroll
        for (int k = 1; k < 8; ++k) e += (u.pm >= tb[k]) ? 1 : 0;
        int tbe = 0, ce = 0;
#pragma unroll
        for (int k = 0; k < 8; ++k) { tbe = (e == k) ? tb[k] : tbe; ce = (e == k) ? cnt[k] : ce; }
        const int s0 = (u.pm - tbe) * 256; src = LISTE + e * 16384 + s0; nvalid = ce - s0;
    }
};
template <class Epi, class Sched>
__device__ __forceinline__ void gemm_phase(LAS unsigned char* lds, const Gemm g, const Sched& S, const Epi& E) {
    int tid = threadIdx.x; asm volatile("" : "+v"(tid));
    const int wid = __builtin_amdgcn_readfirstlane(tid >> 6), lane = tid & 63, wr = wid >> 2, wc = wid & 3, fr = lane & 15, fq = lane >> 4;
    const int K = g.K, nt = K / BK;
    constexpr bool GA = Sched::GATHER;
    unsigned voffA[2], voffB[2], vG[2][2]; int RA[2], CA[2];
#pragma unroll
    for (int i = 0; i < 2; ++i) { int R, C; stage_rc(tid * 16 + i * 8192, R, C); const int Rb = (R & ~31) + perm32(R & 31); RA[i] = R; CA[i] = C;
        voffA[i] = (unsigned)(R * g.lda + C) * 2u; voffB[i] = (unsigned)(Rb * g.ldb + C) * 2u; vG[0][i] = vG[1][i] = 0u; }
    const size_t kstep = (size_t)(BK * 2);
    const size_t hstepA = GA ? (size_t)0 : (size_t)HALF * g.lda * 2, hstepB = (size_t)HALF * g.ldb * 2;
    constexpr int TAB_OFF = 8 * HTB;
#define PG8_IDX_ISSUE(u, par) do { if constexpr (GA) { const int* _src; int _nv; S.rows_of(u, _src, _nv); \
        __builtin_amdgcn_global_load_lds((const unsigned*)(_src + (wid & 3) * 64 + lane), (LAS unsigned*)(lds + TAB_OFF + (par) * 1024 + (wid & 3) * 256), 4, 0, 0); } } while (0)
#define PG8_IDX_READ(u, par) do { if constexpr (GA) { const int* _src; int _nv; S.rows_of(u, _src, _nv); _Pragma("unroll") for (int _h = 0; _h < 2; ++_h) _Pragma("unroll") for (int _i = 0; _i < 2; ++_i) { \
        const int _r = _h * HALF + RA[_i]; const int _raw = *(const LAS int*)(lds + TAB_OFF + (par) * 1024 + _r * 4); const int _row = _r < _nv ? (_raw >> 1) : 0; vG[_h][_i] = (unsigned)(_row * g.lda + CA[_i]) * 2u; } } } while (0)
    const size_t tstepA = 2 * hstepA, tstepB = 2 * hstepB;
    const unsigned ldsw = (unsigned)wid * 1024u;
    const int aoff = lds_byte(wr * 64 + fr, fq * 8), boff = lds_byte(wc * 32 + fr, fq * 8);
#define PG8_SA(b, h) (((b) * 2 + (h)) * HTB)
#define PG8_SB(b, h) ((4 + (b) * 2 + (h)) * HTB)
#define PG8_STAGE(bufoff, gbase, voff) do { _Pragma("unroll") for (int _i = 0; _i < 2; ++_i) \
        __builtin_amdgcn_global_load_lds((const unsigned*)((const char*)(gbase) + (voff)[_i]), (LAS unsigned*)(lds + (bufoff) + ldsw + _i * 8192), 16, 0, 0); } while (0)
#define PG8_STAGE_A(bufoff, gbase, h) do { if constexpr (GA) PG8_STAGE(bufoff, gbase, vG[h]); else PG8_STAGE(bufoff, gbase, voffA); } while (0)
#define PG8_LDA(dst, b, h) do { _Pragma("unroll") for (int m = 0; m < 4; ++m) _Pragma("unroll") for (int k = 0; k < 2; ++k) dst[m][k] = *(const LAS bf16x8*)(lds + PG8_SA(b, h) + aoff + m * 2048 + k * 1024); } while (0)
#define PG8_LDB(dst, b, h) do { _Pragma("unroll") for (int n = 0; n < 2; ++n) _Pragma("unroll") for (int k = 0; k < 2; ++k) dst[n][k] = *(const LAS bf16x8*)(lds + PG8_SB(b, h) + boff + n * 2048 + k * 1024); } while (0)
#define PG8_MMA(ai, bj, At, Bt) do { __builtin_amdgcn_s_setprio(1); _Pragma("unroll") for (int m = 0; m < 4; ++m) _Pragma("unroll") for (int n = 0; n < 2; ++n) _Pragma("unroll") for (int k = 0; k < 2; ++k) \
        acc[ai][bj][m][n] = __builtin_amdgcn_mfma_f32_16x16x32_bf16(Bt[n][k], At[m][k], acc[ai][bj][m][n], 0, 0, 0); __builtin_amdgcn_s_setprio(0); } while (0)
#define PG8_WAIT_V(n) asm volatile("s_waitcnt vmcnt(" #n ")" ::: "memory")
#define PG8_WAIT_L(n) asm volatile("s_waitcnt lgkmcnt(" #n ")" ::: "memory")
#define PG8_BAR __builtin_amdgcn_s_barrier()
#define PG8_SCHED __builtin_amdgcn_sched_barrier(0)
    Unit cur, nxt; int ui = 0;
    if (!S.next(0, cur)) return;
    f32x4 acc[2][2][4][2];
#pragma unroll
    for (int a = 0; a < 2; ++a)
#pragma unroll
        for (int b = 0; b < 2; ++b)
#pragma unroll
            for (int m = 0; m < 4; ++m)
#pragma unroll
                for (int n = 0; n < 2; ++n) acc[a][b][m][n] = (f32x4){0.f, 0.f, 0.f, 0.f};
    bf16x8 At[4][2], B0[2][2], B1[2][2];
    const size_t cstep = (size_t)K * 2;
    const char* cA = (const char*)g.A + (GA ? (size_t)0 : (size_t)cur.pm * tstepA) + cur.kc * cstep; const char* cB = (const char*)g.Bt + (size_t)cur.pn * tstepB + cur.kc * cstep;
    if constexpr (GA) { PG8_IDX_ISSUE(cur, 0); PG8_WAIT_V(0); PG8_BAR; PG8_IDX_READ(cur, 0); }
    PG8_STAGE(PG8_SB(0, 0), cB, voffB); PG8_STAGE(PG8_SB(0, 1), cB + hstepB, voffB); PG8_STAGE_A(PG8_SA(0, 0), cA, 0); PG8_STAGE_A(PG8_SA(0, 1), cA + hstepA, 1);
    if (wr == 1) PG8_BAR;
    PG8_WAIT_V(2); PG8_BAR;
    PG8_STAGE(PG8_SB(1, 0), cB + kstep, voffB); PG8_STAGE_A(PG8_SA(1, 0), cA + kstep, 0); PG8_STAGE(PG8_SB(1, 1), cB + hstepB + kstep, voffB);
    PG8_WAIT_V(6); PG8_BAR;
    for (;;) {
        const bool has_next = S.next(ui + 1, nxt);
        if (has_next) PG8_IDX_ISSUE(nxt, (ui + 1) & 1);
        const char* nA = has_next ? (const char*)g.A + (GA ? (size_t)0 : (size_t)nxt.pm * tstepA) + nxt.kc * cstep : cA; const char* nB = has_next ? (const char*)g.Bt + (size_t)nxt.pn * tstepB + nxt.kc * cstep : cB;
#pragma unroll 1
        for (int t = 0; t < nt; t += 2) {
            const bool last = (t == nt - 2);
            const char* a1 = cA + (size_t)(t + 1) * kstep;
            const char* a2 = last ? nA : cA + (size_t)(t + 2) * kstep; const char* b2 = last ? nB : cB + (size_t)(t + 2) * kstep;
            const char* a3 = a2 + kstep; const char* b3 = b2 + kstep;
            PG8_LDB(B0, 0, 0); PG8_LDB(B1, 0, 1); PG8_SCHED; PG8_LDA(At, 0, 0); PG8_STAGE_A(PG8_SA(1, 1), a1 + hstepA, 1);
            if constexpr (GA) { if (last && has_next) PG8_IDX_READ(nxt, (ui + 1) & 1); }
            PG8_WAIT_V(8); PG8_WAIT_L(0); PG8_BAR; PG8_MMA(0, 0, At, B0); PG8_MMA(0, 1, At, B1); PG8_BAR; PG8_SCHED;
            PG8_LDA(At, 0, 1); PG8_STAGE(PG8_SB(0, 0), b2, voffB); PG8_STAGE(PG8_SB(0, 1), b2 + hstepB, voffB); PG8_STAGE_A(PG8_SA(0, 0), a2, 0);
            PG8_WAIT_V(8); PG8_WAIT_L(0); PG8_BAR; PG8_MMA(1, 0, At, B0); PG8_MMA(1, 1, At, B1); PG8_BAR; PG8_SCHED;
            PG8_LDB(B0, 1, 0); PG8_LDB(B1, 1, 1); PG8_SCHED; PG8_LDA(At, 1, 0); PG8_STAGE_A(PG8_SA(0, 1), a2 + hstepA, 1);
            PG8_WAIT_V(8); PG8_WAIT_L(0); PG8_BAR; PG8_MMA(0, 0, At, B0); PG8_MMA(0, 1, At, B1); PG8_BAR; PG8_SCHED;
            PG8_LDA(At, 1, 1); PG8_STAGE(PG8_SB(1, 0), b3, voffB); PG8_STAGE(PG8_SB(1, 1), b3 + hstepB, voffB); PG8_STAGE_A(PG8_SA(1, 0), a3, 0);
            PG8_WAIT_V(8); PG8_WAIT_L(0); PG8_BAR; PG8_MMA(1, 0, At, B0); PG8_MMA(1, 1, At, B1); PG8_BAR; PG8_SCHED;
        }
        if (wr == 0) PG8_BAR;
        E(acc, cur, wr, wc, fr, fq);
        if (!has_next) break;
#pragma unroll
        for (int a = 0; a < 2; ++a)
#pragma unroll
            for (int b = 0; b < 2; ++b)
#pragma unroll
                for (int m = 0; m < 4; ++m)
#pragma unroll
                    for (int n = 0; n < 2; ++n) acc[a][b][m][n] = (f32x4){0.f, 0.f, 0.f, 0.f};
        cur = nxt; cA = nA; cB = nB; ++ui;
        if (wr == 1) PG8_BAR;
    }
    PG8_WAIT_V(0);
    PG8_BAR;
#undef PG8_SA
#undef PG8_SB
#undef PG8_STAGE
#undef PG8_STAGE_A
#undef PG8_IDX_ISSUE
#undef PG8_IDX_READ
#undef PG8_LDA
#undef PG8_LDB
#undef PG8_MMA
#undef PG8_WAIT_V
#undef PG8_WAIT_L
#undef PG8_BAR
#undef PG8_SCHED
}

template <class F> struct Epi8 {
    F f;
    __device__ __forceinline__ void operator()(const f32x4 (&acc)[2][2][4][2], const Unit& u, int wr, int wc, int fr, int fq) const {
        const int row0 = u.pm * BM + wr * 64 + fr, col0 = u.pn * BM + wc * 32 + 8 * fq;
#pragma unroll
        for (int ai = 0; ai < 2; ++ai)
#pragma unroll
            for (int m = 0; m < 4; ++m)
#pragma unroll
                for (int bj = 0; bj < 2; ++bj) { f(row0 + ai * HALF + m * 16, col0 + bj * HALF, acc[ai][bj][m][0], acc[ai][bj][m][1]); __builtin_amdgcn_sched_barrier(0); }
    }
};
template <class F> struct Epi8P {
    F f;
    __device__ __forceinline__ void operator()(const f32x4 (&acc)[2][2][4][2], const Unit& u, int wr, int wc, int fr, int fq) const {
        const int row0 = u.pm * BM + wr * 64 + fr, col0 = u.pn * BM + wc * 32 + 8 * fq;
        typename F::UnitV uv; f.unit(uv, row0, col0);
#pragma unroll
        for (int ai = 0; ai < 2; ++ai) {
            typename F::Pre pre[4][2];
#pragma unroll
            for (int m = 0; m < 4; ++m)
#pragma unroll
                for (int bj = 0; bj < 2; ++bj) f.load(pre[m][bj], row0 + ai * HALF + m * 16, col0 + bj * HALF);
#pragma unroll
            for (int m = 0; m < 4; ++m)
#pragma unroll
                for (int bj = 0; bj < 2; ++bj) f.apply(uv, pre[m][bj], bj, row0 + ai * HALF + m * 16, col0 + bj * HALF, acc[ai][bj][m][0], acc[ai][bj][m][1]);
            __builtin_amdgcn_sched_barrier(0);
        }
    }
};
struct EpiPart {
    float* PART;
    __device__ __forceinline__ void operator()(const f32x4 (&acc)[2][2][4][2], const Unit& u, int wr, int wc, int fr, int fq) const {
        const int row0 = (u.pm - 64) * BM + wr * 64 + fr, col0 = u.pn * BM + wc * 32 + 8 * fq; float* base = PART + (size_t)u.kc * 512 * 1024;
#pragma unroll
        for (int ai = 0; ai < 2; ++ai)
#pragma unroll
            for (int m = 0; m < 4; ++m)
#pragma unroll
                for (int bj = 0; bj < 2; ++bj) { float* d = base + (size_t)(row0 + ai * HALF + m * 16) * 1024 + col0 + bj * HALF; *(f32x4*)d = acc[ai][bj][m][0]; *(f32x4*)(d + 4) = acc[ai][bj][m][1]; }
    }
};
struct EpiPartT {
    bf16* PART; int nm;
    __device__ __forceinline__ void operator()(const f32x4 (&acc)[2][2][4][2], const Unit& u, int wr, int wc, int fr, int fq) const {
        const int row0 = (u.pm - nm) * BM + wr * 64 + fr, col0 = (u.pn & 3) * BM + wc * 32 + 8 * fq; bf16* base = PART + (size_t)u.kc * 2048 * 1024;
#pragma unroll
        for (int ai = 0; ai < 2; ++ai)
#pragma unroll
            for (int m = 0; m < 4; ++m)
#pragma unroll
                for (int bj = 0; bj < 2; ++bj) { const f32x4 v0 = acc[ai][bj][m][0], v1 = acc[ai][bj][m][1]; u32x4 w; w.x = pk2s(v0[0], v0[1]); w.y = pk2s(v0[2], v0[3]); w.z = pk2s(v1[0], v1[1]); w.w = pk2s(v1[2], v1[3]);
                    *(u32x4*)(base + (size_t)(row0 + ai * HALF + m * 16) * 1024 + col0 + bj * HALF) = w; }
    }
};
template <class F> struct EpiGU {
    F f; int tiles_per_mat;
    __device__ __forceinline__ void operator()(const f32x4 (&acc)[2][2][4][2], const Unit& u, int wr, int wc, int fr, int fq) const {
        const int row0 = u.pm * BM + wr * 64 + fr, col0 = (u.pn % tiles_per_mat) * HALF + wc * 32 + 8 * fq;
#pragma unroll
        for (int ai = 0; ai < 2; ++ai)
#pragma unroll
            for (int m = 0; m < 4; ++m) {
                float o[8];
#pragma unroll
                for (int n = 0; n < 2; ++n)
#pragma unroll
                    for (int q = 0; q < 4; ++q) { const float gt = acc[ai][0][m][n][q], up = acc[ai][1][m][n][q]; o[n * 4 + q] = gt * __builtin_amdgcn_rcpf(1.f + __expf(-gt)) * up; }
                f(row0 + ai * HALF + m * 16, col0, o);
            }
    }
};
}

#define XB_TMO      128
#define XB_XCNT(j)  (256  + 64 * (j))
#define XB_XSUB(j)  (1280 + 64 * (j))
#define XB_XGEN(j)  (2304 + 64 * (j))
#define XB_TOP      3328
#define XB_TOPGEN   3392
#define XCD_BAR_WORDS 3456
#define XB_SPIN_CAP (1u << 18)
__device__ __forceinline__ unsigned xb_ld(unsigned* p)              { return __hip_atomic_load(p, __ATOMIC_RELAXED, __HIP_MEMORY_SCOPE_AGENT); }
__device__ __forceinline__ unsigned xb_add(unsigned* p, unsigned v) { return __hip_atomic_fetch_add(p, v, __ATOMIC_RELAXED, __HIP_MEMORY_SCOPE_AGENT); }
__device__ __forceinline__ unsigned xb_xcc_id() { return (unsigned)__builtin_amdgcn_s_getreg((3 << 11) | 20) & 0xFu; }
#define XB_SPIN(cond, bar) do { unsigned _sp = 0; while (cond) { __builtin_amdgcn_s_sleep(1); \
    if ((++_sp & 255u) == 0u) { if (xb_ld(&(bar)[XB_TMO])) break; if (_sp > XB_SPIN_CAP) { atomicAdd(&(bar)[XB_TMO], 1u); break; } } } } while (0)
struct XcdBarrier { unsigned* bar; unsigned x; volatile LAS unsigned* st; };
__device__ __forceinline__ XcdBarrier xcd_barrier_post(unsigned* bar, volatile LAS unsigned* st) {
    XcdBarrier b; b.bar = bar; b.x = xb_xcc_id(); b.st = st;
    if (threadIdx.x == 0) (void)xb_add(&bar[XB_XCNT(b.x)], 1u);
    return b;
}
__device__ __forceinline__ void xcd_barrier_complete(unsigned* bar, unsigned x, unsigned& nloc, unsigned& nx) {
    const unsigned G = gridDim.x * gridDim.y * gridDim.z;
    unsigned sum, cnt, mine, sp = 0u;
    for (;;) {
        sum = 0u; cnt = 0u; mine = 0u;
#pragma unroll
        for (unsigned j = 0; j < 16; ++j) { const unsigned c = xb_ld(&bar[XB_XCNT(j)]); sum += c; cnt += (c > 0u) ? 1u : 0u; mine = (j == x) ? c : mine; }
        if (sum == G) break;
        __builtin_amdgcn_s_sleep(1);
        if ((++sp & 255u) == 0u) { if (xb_ld(&bar[XB_TMO])) break; if (sp > XB_SPIN_CAP) { atomicAdd(&bar[XB_TMO], 1u); break; } }
    }
    nloc = mine > 0u ? mine : 1u; nx = cnt > 0u ? cnt : 1u;
}
__device__ __forceinline__ void xcd_barrier(const XcdBarrier& b) {
    asm volatile("s_waitcnt vmcnt(0)" ::: "memory");
    __syncthreads();
    if (threadIdx.x == 0) {
        unsigned* bar = b.bar;
        __builtin_amdgcn_s_waitcnt(0);
        unsigned nloc = b.st[0], nx = b.st[1];
        if (nloc == 0u) { xcd_barrier_complete(bar, b.x, nloc, nx); b.st[0] = nloc; b.st[1] = nx; }
        const unsigned old = xb_add(&bar[XB_XSUB(b.x)], 1u);
        const unsigned gen = old / nloc;
        if (old + 1u == (gen + 1u) * nloc) {
            __builtin_amdgcn_fence(__ATOMIC_RELEASE, "agent");
            asm volatile("s_waitcnt vmcnt(0)" ::: "memory");
            const unsigned og = xb_add(&bar[XB_TOP], 1u);
            const unsigned tg = og / nx;
            if (og + 1u == (tg + 1u) * nx) xb_add(&bar[XB_TOPGEN], 1u);
            else XB_SPIN(xb_ld(&bar[XB_TOPGEN]) == tg, bar);
            __builtin_amdgcn_fence(__ATOMIC_ACQUIRE, "agent");
            xb_add(&bar[XB_XGEN(b.x)], 1u);
            asm volatile("s_waitcnt vmcnt(0)" ::: "memory");
        } else {
            XB_SPIN(xb_ld(&bar[XB_XGEN(b.x)]) == gen, bar);
            __builtin_amdgcn_fence(__ATOMIC_ACQUIRE, "agent");
            asm volatile("s_waitcnt vmcnt(0)" ::: "memory");
        }
    }
    __syncthreads();
}

struct Args {
    const float* in[25];
    float* out; unsigned char* ws;
    int ph_lo, ph_hi;
};
enum { I_X = 0, I_C, I_CTX, I_CCTX, I_WMOD, I_BMOD, I_LN1, I_LN2, I_WIN, I_WG2, I_BG2, I_GLAG, I_QNG, I_WUQ, I_KVNG, I_WUKV, I_WOUT, I_FG, I_FU, I_FD, I_RW, I_EG, I_EU, I_ED, I_FNG };

struct Ctx {
    LAS unsigned char* lds; unsigned char* ldsg; unsigned char* ws; unsigned char* arena; const float* const* in; float* out;
    int tid, lane, wave, G, bid, vcu;
};

__device__ __forceinline__ int mod_row(int row) { return row < NLAT ? (row >> 13) : 2; }
__device__ __forceinline__ void row_bpos(int row, int& b, int& pos) { if (row < NLAT) { b = row >> 13; pos = row & (TT - 1); } else { const int r2 = row - NLAT; b = r2 >> 8; pos = TT + (r2 & 255); } }
__device__ __forceinline__ int chunk_row(int b, int a) { return a < 128 ? b * TT + a * 64 : NLAT + b * TC + (a - 128) * 64; }

template <class SrcFn>
__device__ __forceinline__ void transpose_item(const SrcFn& src, bf16* dst, int ldk, int k0, int n0, LAS float* scr, int lane) {
    float tv[64];
#pragma unroll
    for (int i = 0; i < 64; ++i) tv[i] = src(k0 + i, n0 + lane);
#pragma unroll
    for (int i = 0; i < 64; ++i) scr[i * 65 + lane] = tv[i];
    LDS_WAIT(); asm volatile("" ::: "memory");
    const int c = lane & 7;
#pragma unroll
    for (int j = 0; j < 8; ++j) { const int n = (lane >> 3) + 8 * j; const LAS float* s = scr + (8 * c) * 65 + n;
        u32x4 o; o.x = pk2(s[0 * 65], s[1 * 65]); o.y = pk2(s[2 * 65], s[3 * 65]); o.z = pk2(s[4 * 65], s[5 * 65]); o.w = pk2(s[6 * 65], s[7 * 65]);
        *(u32x4*)(dst + (size_t)(n0 + n) * ldk + k0 + 8 * c) = o; }
    LDS_WAIT(); asm volatile("" ::: "memory");
}
__device__ __forceinline__ void transpose_item_fast(const float* S, int ld, bf16* dst, int ldk, int k0, int n0, LAS float* scr, int lane, const float* rowscale = nullptr) {
    f32x4 v[16];
#pragma unroll
    for (int i = 0; i < 16; ++i) v[i] = __builtin_nontemporal_load((const f32x4*)(S + (size_t)(i * 4 + (lane >> 4)) * ld + (lane & 15) * 4));
    if (rowscale) {
#pragma unroll
        for (int i = 0; i < 16; ++i) v[i] *= rowscale[i * 4 + (lane >> 4)]; }
#pragma unroll
    for (int i = 0; i < 16; ++i) { LAS float* p = scr + (i * 4 + (lane >> 4)) * 65 + (lane & 15) * 4; p[0] = v[i].x; p[1] = v[i].y; p[2] = v[i].z; p[3] = v[i].w; }
    LDS_WAIT(); asm volatile("" ::: "memory");
    const int c = lane & 7;
#pragma unroll
    for (int j = 0; j < 8; ++j) { const int n = (lane >> 3) + 8 * j; const LAS float* s = scr + (8 * c) * 65 + n;
        u32x4 o; o.x = pk2(s[0 * 65], s[1 * 65]); o.y = pk2(s[2 * 65], s[3 * 65]); o.z = pk2(s[4 * 65], s[5 * 65]); o.w = pk2(s[6 * 65], s[7 * 65]);
        *(u32x4*)(dst + (size_t)(n0 + n) * ldk + k0 + 8 * c) = o; }
    LDS_WAIT(); asm volatile("" ::: "memory");
}
__device__ __forceinline__ int rope_unperm(int jj) { const int pair = jj >> 1, which = jj & 1; return pair < 16 ? pair + 16 * which : 32 + (pair - 16) + 16 * which; }
__device__ __forceinline__ int win_src_col(int n) {
    if (n < 1024) return n;
    if (n < 1536) return 1056 + (n - 1024);
    if (n < 1792) return 1568 + (n - 1536);
    if (n < 1920) return 1824 + (n - 1792);
    if (n < 1984) return 1952 + rope_unperm(n - 1920);
    if (n < 2000) return 1024 + (n - 1984);
    if (n < 2016) return 1040 + (n - 2000);
    return -1;
}

__device__ __forceinline__ void convert_weights(const Ctx& C, bool first, int gw, int NGW) {
    LAS float* scr = (LAS float*)(C.lds + C.wave * 16640);
    for (int l = 0; l < 2; ++l) {
        if (first == (l == 0))
        {
            const float* W = C.in[I_WIN] + (size_t)l * 1024 * 2016; bf16* dst = (bf16*)(C.arena + A_WIN) + (size_t)l * 2048 * 1024;
            auto f = [=](int k, int n) -> float { const int sc = win_src_col(n); return sc < 0 ? 0.f : W[(size_t)k * 2016 + sc]; };
            for (int it = gw; it < 16 * 32; it += NGW) { const int k0 = (it >> 5) * 64, n0 = (it & 31) * 64;
                if (n0 < 1920) transpose_item_fast(W + (size_t)k0 * 2016 + win_src_col(n0), 2016, dst, 1024, k0, n0, scr, C.lane);
                else transpose_item(f, dst, 1024, k0, n0, scr, C.lane); }
        }
        if (!first)
        {
            const float* Wq = C.in[I_WUQ] + (size_t)l * 256 * 768; const float* gq = C.in[I_QNG] + l * 256; const float* Wk = C.in[I_WUKV] + (size_t)l * 128 * 1024; const float* gk = C.in[I_KVNG] + l * 128;
            bf16* dst = (bf16*)(C.arena + A_WQKV) + (size_t)l * 1792 * 384;
            auto f = [=](int k, int n) -> float {
                if (n < 768) { if (k >= 256) return 0.f; const int h = n / 192, j = n % 192; const int sc = h * 192 + (j < 128 ? j : 128 + rope_unperm(j - 128)); return gq[k] * Wq[(size_t)k * 768 + sc]; }
                if (k < 256) return 0.f; return gk[k - 256] * Wk[(size_t)(k - 256) * 1024 + (n - 768)]; };
            for (int it = gw; it < 6 * 28; it += NGW) { const int k0 = (it % 6) * 64, n0 = (it / 6) * 64;
                const bool qcol = n0 < 768, qrow = k0 < 256;
                if (qcol != qrow) {
                    const int c = C.lane & 7;
#pragma unroll
                    for (int j = 0; j < 8; ++j) *(u32x4*)(dst + (size_t)(n0 + (C.lane >> 3) + 8 * j) * 384 + k0 + 8 * c) = (u32x4){0u, 0u, 0u, 0u};
                } else if (qcol && (n0 % 192) == 128) transpose_item(f, dst, 384, k0, n0, scr, C.lane);
                else if (qcol) transpose_item_fast(Wq + (size_t)k0 * 768 + n0, 768, dst, 384, k0, n0, scr, C.lane, gq + k0);
                else transpose_item_fast(Wk + (size_t)(k0 - 256) * 1024 + (n0 - 768), 1024, dst, 384, k0, n0, scr, C.lane, gk + (k0 - 256)); }
        }
        if (!first)
        {
            const float* W = C.in[I_WOUT] + (size_t)l * 1024 * 1024; bf16* dst = (bf16*)(C.arena + A_WOUT) + (size_t)l * 1024 * 1024;
            for (int it = gw; it < 16 * 16; it += NGW) { const int k0 = (it >> 4) * 64, n0 = (it & 15) * 64; transpose_item_fast(W + (size_t)k0 * 1024 + n0, 1024, dst, 1024, k0, n0, scr, C.lane); }
        }
    }
    if (!first)
    {
        bf16* dst = (bf16*)(C.arena + A_FGU);
        for (int it = gw; it < 16 * 88; it += NGW) { const int k0 = (it & 15) * 64, n0 = (it >> 4) * 64; const int tj = n0 >> 8, c = n0 & 255;
            const float* W = (c < 128) ? C.in[I_FG] : C.in[I_FU]; const int sc = tj * 128 + (c & 127);
            transpose_item_fast(W + (size_t)k0 * DFF + sc, DFF, dst, 1024, k0, n0, scr, C.lane); }
    }
    if (!first)
    {
        bf16* dst = (bf16*)(C.arena + A_FD); const float* W = C.in[I_FD];
        for (int it = gw; it < 44 * 16; it += NGW) { const int k0 = (it % 44) * 64, n0 = (it / 44) * 64; transpose_item_fast(W + (size_t)k0 * 1024 + n0, 1024, dst, DFF, k0, n0, scr, C.lane); }
    }
}
__device__ __forceinline__ void prologue(const Ctx& C) {
    convert_weights(C, true, C.vcu * 8 + C.wave, C.G * 8);
    __syncthreads();
    if (C.vcu < 6) {
        float* R = (float*)(C.ws + WS_ROPE);
        const int i = C.vcu * 512 + C.tid; const int j = i & 15, p = i >> 4; const int pos = p < 128 ? p : p - 128;
        const float inv = powf(10000.f, -(float)j / 16.f); const float ang = (float)pos * inv; R[2 * i] = cosf(ang); R[2 * i + 1] = sinf(ang);
    }
    for (int item = C.G - 1 - C.vcu; item < 192; item += C.G) {
        const int l = item / 96, cg = item % 96;
        LAS float* sil = (LAS float*)C.lds; LAS float* part = sil + 3 * 1024;
        for (int i = C.tid; i < 3 * 1024; i += 512) { const int v = i >> 10, k = i & 1023; const float x = v < 2 ? C.in[I_C][v * 1024 + k] : C.in[I_CCTX][k]; sil[i] = silu_f(x); }
        __syncthreads();
        const int rsub = C.lane >> 4, c4 = (C.lane & 15) * 4;
        f32x4 a0 = {0, 0, 0, 0}, a1 = a0, a2 = a0;
        const float* W = C.in[I_WMOD] + (size_t)l * 1024 * 6144 + cg * 64 + c4;
#pragma unroll 16
        for (int i = 0; i < 32; ++i) { const int k = C.wave * 128 + 4 * i + rsub; const f32x4 w = __builtin_nontemporal_load((const f32x4*)(W + (size_t)k * 6144));
            a0 += w * sil[k]; a1 += w * sil[1024 + k]; a2 += w * sil[2048 + k]; }
        LAS float* pp = part + (C.wave * 4 + rsub) * 192 + c4;
#pragma unroll
        for (int q = 0; q < 4; ++q) { pp[q] = a0[q]; pp[64 + q] = a1[q]; pp[128 + q] = a2[q]; }
        __syncthreads();
        if (C.tid < 192) { const int v = C.tid >> 6, c = C.tid & 63; float s = C.in[I_BMOD][l * 6144 + cg * 64 + c];
#pragma unroll
            for (int p = 0; p < 32; ++p) s += part[p * 192 + v * 64 + c];
            ((float*)(C.ws + WS_MOD))[(l * 3 + v) * 6144 + cg * 64 + c] = s; }
        __syncthreads();
    }
}

__device__ __forceinline__ void load_row16(const float* p, int lane, f32x4 (&v)[4]) {
#pragma unroll
    for (int j = 0; j < 4; ++j) v[j] = *(const f32x4*)(p + 256 * j + 4 * lane);
}
__device__ __forceinline__ void norm_mod_row(f32x4 (&v)[4], const float* g, const float* sc, const float* sh, int lane) {
    float ss = 0.f;
#pragma unroll
    for (int j = 0; j < 4; ++j) ss += (v[j].x * v[j].x + v[j].y * v[j].y) + (v[j].z * v[j].z + v[j].w * v[j].w);
    const float rs = 1.f / sqrtf(wave_sum(ss) * (1.f / DM) + EPS);
#pragma unroll
    for (int j = 0; j < 4; ++j) { const f32x4 gg = *(const f32x4*)(g + 256 * j + 4 * lane), s1 = *(const f32x4*)(sc + 256 * j + 4 * lane), s0 = *(const f32x4*)(sh + 256 * j + 4 * lane);
        v[j] = (v[j] * rs * gg) * (s1 + 1.f) + s0; }
}
__device__ __forceinline__ void store_row16_bf16(bf16* p, int lane, const f32x4 (&v)[4]) {
#pragma unroll
    for (int j = 0; j < 4; ++j) { u32x2 w; w.x = pk2(v[j].x, v[j].y); w.y = pk2(v[j].z, v[j].w); *(u32x2*)(p + 256 * j + 4 * lane) = w; }
}
__device__ __forceinline__ void load_row16_bf16(const bf16* p, int lane, f32x4 (&v)[4]) {
#pragma unroll
    for (int j = 0; j < 4; ++j) { const u32x2 w = *(const u32x2*)(p + 256 * j + 4 * lane); v[j] = (f32x4){bflo(w.x), bfhi(w.x), bflo(w.y), bfhi(w.y)}; }
}
__device__ __forceinline__ void load_xin_row(const Ctx& C, int layer, int row, f32x4 (&v)[4]) {
    if (layer == 0) load_row16(row < NLAT ? C.in[I_X] + (size_t)row * DM : C.in[I_CTX] + (size_t)(row - NLAT) * DM, C.lane, v);
    else load_row16_bf16((const bf16*)(C.ws + WS_XL) + (size_t)row * DM, C.lane, v);
}

__device__ __forceinline__ void phase_norm1(const Ctx& C, int layer) {
    const int gw = C.vcu * 8 + C.wave, NGW = C.G * 8;
    const float* g = C.in[I_LN1] + layer * DM; const float* MOD = (const float*)(C.ws + WS_MOD) + (size_t)layer * 3 * 6144; bf16* H = (bf16*)(C.ws + WS_H);
    for (int row = gw; row < MR; row += NGW) {
        f32x4 v[4]; load_xin_row(C, layer, row, v);
        if (layer == 1 && row >= NLAT) {
            const float* PART = (const float*)(C.arena + R_PART) + (size_t)(row - NLAT) * 1024; const float* g2c = (const float*)(C.ws + WS_MOD) + 2 * 6144 + 5 * 1024;
#pragma unroll
            for (int j = 0; j < 4; ++j) { f32x4 t[11];
#pragma unroll
                for (int c = 0; c < 11; ++c) t[c] = *(const f32x4*)(PART + (size_t)c * 512 * 1024 + 256 * j + 4 * C.lane);
                f32x4 acc = t[0];
#pragma unroll
                for (int c = 1; c < 11; ++c) acc += t[c];
                v[j] += *(const f32x4*)(g2c + 256 * j + 4 * C.lane) * acc; } }
        const float* m = MOD + mod_row(row) * 6144;
        norm_mod_row(v, g, m + 1024, m, C.lane);
        store_row16_bf16(H + (size_t)row * DM, C.lane, v);
    }
}

__device__ __forceinline__ void phase_norm2(const Ctx& C, int layer) {
    const int gw = C.vcu * 8 + C.wave, NGW = C.G * 8;
    const float* g = C.in[I_LN2] + layer * DM; const float* MOD = (const float*)(C.ws + WS_MOD) + (size_t)layer * 3 * 6144; bf16* H = layer == 0 ? (bf16*)(C.ws + WS_H) : (bf16*)(C.arena + M_HS);
    const bf16* XL = (const bf16*)(C.ws + WS_XL); int* LISTE = (int*)(C.arena + M_LISTE);
    const int nrow = layer == 0 ? MR : NLAT;
    unsigned* ctl = (unsigned*)(C.ws + WS_CTL);
    int* PE = (int*)(C.ws + WS_LIST); int* PS = PE + NLAT * 2; float* PWt = (float*)(PS + NLAT * 2);
    LAS unsigned* lcnt = (LAS unsigned*)(C.lds + 140000); LAS unsigned* gbase = lcnt + 8;
    const int maxit = (nrow + NGW - 1) / NGW;
    f32x4 rw[32];
    if (layer == 1) {
#pragma unroll
        for (int j = 0; j < 4; ++j)
#pragma unroll
            for (int q = 0; q < 4; ++q) { const float* RWp = C.in[I_RW] + (256 * j + 4 * C.lane + q) * 8; rw[(j * 4 + q) * 2] = *(const f32x4*)RWp; rw[(j * 4 + q) * 2 + 1] = *(const f32x4*)(RWp + 4); }
    }
    for (int b0 = 0; b0 < maxit; b0 += 64) {
        int my_e1 = 0, my_e2 = 0, my_row = -1; float my_d = 0.f;
        if (layer == 1) { if (C.tid < 8) lcnt[C.tid] = 0u; }
        const int b1 = (b0 + 64 < maxit) ? b0 + 64 : maxit;
        for (int it = b0; it < b1; ++it) {
            const int row = gw + it * NGW; if (row >= nrow) break;
            f32x4 v[4];
            if (layer == 0 && row >= NLAT) {
                load_row16(C.in[I_CTX] + (size_t)(row - NLAT) * DM, C.lane, v);
                const float* PART = (const float*)(C.arena + R_PART) + (size_t)(row - NLAT) * 1024; const float* g1c = MOD + 2 * 6144 + 2 * 1024;
#pragma unroll
                for (int j = 0; j < 4; ++j) { f32x4 t[4];
#pragma unroll
                    for (int c = 0; c < 4; ++c) t[c] = *(const f32x4*)(PART + (size_t)c * 512 * 1024 + 256 * j + 4 * C.lane);
                    const f32x4 acc = ((t[0] + t[1]) + t[2]) + t[3];
                    v[j] += *(const f32x4*)(g1c + 256 * j + 4 * C.lane) * acc; }
                store_row16_bf16((bf16*)(C.ws + WS_XL) + (size_t)row * DM, C.lane, v);
                load_row16_bf16(XL + (size_t)row * DM, C.lane, v);
            } else load_row16_bf16(XL + (size_t)row * DM, C.lane, v);
            const float* m = MOD + mod_row(row) * 6144;
            norm_mod_row(v, g, m + 4096, m + 3072, C.lane);
            store_row16_bf16(H + (size_t)row * DM, C.lane, v);
            if (layer == 1) {
                float lg[8];
#pragma unroll
                for (int e = 0; e < 8; ++e) lg[e] = 0.f;
#pragma unroll
                for (int j = 0; j < 4; ++j)
#pragma unroll
                    for (int q = 0; q < 4; ++q) { const f32x4 w0 = rw[(j * 4 + q) * 2], w1 = rw[(j * 4 + q) * 2 + 1]; const float x = v[j][q];
                        lg[0] += x * w0.x; lg[1] += x * w0.y; lg[2] += x * w0.z; lg[3] += x * w0.w; lg[4] += x * w1.x; lg[5] += x * w1.y; lg[6] += x * w1.z; lg[7] += x * w1.w; }
#pragma unroll
                for (int e = 0; e < 8; ++e) lg[e] = wave_sum(lg[e]);
                int e1 = 0; float v1 = lg[0];
#pragma unroll
                for (int e = 1; e < 8; ++e) if (lg[e] > v1) { v1 = lg[e]; e1 = e; }
                int e2 = -1; float v2 = -3.0e38f;
#pragma unroll
                for (int e = 0; e < 8; ++e) if (e != e1 && lg[e] > v2) { v2 = lg[e]; e2 = e; }
                if (C.lane == (it & 63)) { my_e1 = e1; my_e2 = e2; my_row = row; my_d = v2 - v1; }
            }
        }
        if (layer == 1) {
            __syncthreads();
            unsigned r1 = 0u, r2 = 0u;
            if (my_row >= 0) { r1 = __hip_atomic_fetch_add(lcnt + my_e1, 1u, __ATOMIC_RELAXED, __HIP_MEMORY_SCOPE_WORKGROUP); r2 = __hip_atomic_fetch_add(lcnt + my_e2, 1u, __ATOMIC_RELAXED, __HIP_MEMORY_SCOPE_WORKGROUP); }
            __syncthreads();
            if (C.tid < 8) { const unsigned n = lcnt[C.tid]; gbase[C.tid] = n ? atomicAdd(ctl + CW_CNT + 64 * C.tid, n) : 0u; }
            __syncthreads();
            if (my_row >= 0) {
                const float w1 = 1.f / (1.f + expf(my_d)), w2 = 1.f - w1;
                const unsigned s1 = gbase[my_e1] + r1, s2 = gbase[my_e2] + r2;
                PE[my_row * 2] = my_e1; PE[my_row * 2 + 1] = my_e2; PS[my_row * 2] = (int)s1; PS[my_row * 2 + 1] = (int)s2; PWt[my_row * 2] = w1; PWt[my_row * 2 + 1] = w2;
                LISTE[my_e1 * 16384 + (int)s1] = my_row * 2; LISTE[my_e2 * 16384 + (int)s2] = my_row * 2 + 1;
            }
            __syncthreads();
        }
    }
    if (layer == 1) {
        int* ENT = (int*)(C.ws + WS_LIST + AL((size_t)NLAT * 2 * 4 * 3));
        for (int i = C.vcu * 512 + C.tid; i < MAXT * 256; i += C.G * 512) ENT[i] = -1;
    }
}

__device__ __forceinline__ void convert_expert_gu(const Ctx& C, int gw, int NGW) {
    LAS float* scr = (LAS float*)(C.lds + C.wave * 16640); bf16* EGU = (bf16*)(C.arena + M_EGU);
    for (int it = gw; it < NEXP * 16 * 112; it += NGW) { const int e = it / (16 * 112), r = it % (16 * 112), k0 = (r & 15) * 64, n0 = (r >> 4) * 64; const int tj = n0 >> 8, c = n0 & 255;
        const float* W = ((c < 128) ? C.in[I_EG] : C.in[I_EU]) + (size_t)e * 1024 * DFE; const int sc = tj * 128 + (c & 127);
        transpose_item_fast(W + (size_t)k0 * DFE + sc, DFE, EGU + (size_t)e * 2 * DFE * 1024, 1024, k0, n0, scr, C.lane); }
}
__device__ __forceinline__ void convert_expert_down(const Ctx& C, int gw, int NGW) {
    LAS float* scr = (LAS float*)(C.lds + C.wave * 16640); bf16* ED = (bf16*)(C.ws + WS_ED);
    for (int it = gw; it < NEXP * 56 * 16; it += NGW) { const int e = it / (56 * 16), r = it % (56 * 16), k0 = (r % 56) * 64, n0 = (r / 56) * 64;
        const float* W = C.in[I_ED] + (size_t)e * DFE * 1024;
        transpose_item_fast(W + (size_t)k0 * 1024 + n0, 1024, ED + (size_t)e * 1024 * DFE, DFE, k0, n0, scr, C.lane); }
}

__device__ __forceinline__ void moe_tile_bases(const Ctx& C, int (&tb)[9]) {
    unsigned* ctl = (unsigned*)(C.ws + WS_CTL); int acc = 0;
#pragma unroll
    for (int e = 0; e < 8; ++e) { tb[e] = acc; const unsigned c = __hip_atomic_load(ctl + CW_CNT + 64 * e, __ATOMIC_RELAXED, __HIP_MEMORY_SCOPE_AGENT); acc += (int)((c + 255u) >> 8); }
    tb[8] = acc;
}
__device__ __forceinline__ void moe_fill_lists(const Ctx& C) {
    int tb[9]; moe_tile_bases(C, tb);
    const int* PE = (const int*)(C.ws + WS_LIST); const int* PS = PE + NLAT * 2; const float* PWt = (const float*)(PS + NLAT * 2);
    int* ENT = (int*)(C.ws + WS_LIST + AL((size_t)NLAT * 2 * 4 * 3)); float* WTS = (float*)(ENT + MAXT * 256); int* TAILROW = (int*)(C.ws + WS_LIST + AL((size_t)NLAT * 2 * 4 * 3) + AL((size_t)MAXT * 256 * 4 * 2));
    for (int pr = C.vcu * 512 + C.tid; pr < NLAT * 2; pr += C.G * 512) {
        const int e = PE[pr], s = PS[pr]; int base = 0;
#pragma unroll
        for (int k = 0; k < 8; ++k) base = (e == k) ? tb[k] : base;
        const int pos = base * 256 + s;
        ENT[pos] = pr; WTS[pos] = PWt[pr]; TAILROW[pr] = pos >= MOE_MAIN * 256 ? pos - MOE_MAIN * 256 : -1;
    }
}

__device__ __forceinline__ void moe_tail_reduce0(const Ctx& C) {
    const int gw = C.vcu * 8 + C.wave, NGW = C.G * 8;
    int tb[9]; moe_tile_bases(C, tb); const int ntail = tb[8] > MOE_MAIN ? tb[8] - MOE_MAIN : 0;
    const int* ENT = (const int*)(C.ws + WS_LIST + AL((size_t)NLAT * 2 * 4 * 3)); const float* WTS = (const float*)(ENT + MAXT * 256);
    const bf16* PART = (const bf16*)(C.arena + M_PT0); const float* gate = (const float*)(C.ws + WS_MOD) + (size_t)3 * 6144 + 5 * 1024;
    for (int r = gw; r < ntail * 256; r += NGW) {
        const int pos = MOE_MAIN * 256 + r, ent = ENT[pos]; const float w = WTS[pos];
        u32x2 t[4][MOE_NC0]; f32x4 gv[4];
#pragma unroll
        for (int j = 0; j < 4; ++j)
#pragma unroll
            for (int c = 0; c < MOE_NC0; ++c) t[j][c] = *(const u32x2*)(PART + ((size_t)c * 2048 + r) * 1024 + 256 * j + 4 * C.lane);
        if (ent < 0) continue;
        const int tok = ent >> 1; const float* g = gate + (tok >> 13) * 6144;
        bf16* Y = (bf16*)(C.ws + ((ent & 1) ? WS_H : WS_Y0)) + (size_t)tok * DM;
#pragma unroll
        for (int j = 0; j < 4; ++j) gv[j] = *(const f32x4*)(g + 256 * j + 4 * C.lane);
#pragma unroll
        for (int j = 0; j < 4; ++j) { f32x4 acc = {0.f, 0.f, 0.f, 0.f};
#pragma unroll
            for (int c = 0; c < MOE_NC0; ++c) acc += (f32x4){bflo(t[j][c].x), bfhi(t[j][c].x), bflo(t[j][c].y), bfhi(t[j][c].y)};
            const f32x4 y = gv[j] * w * acc; u32x2 o; o.x = pk2(y.x, y.y); o.y = pk2(y.z, y.w); *(u32x2*)(Y + 256 * j + 4 * C.lane) = o; }
    }
}
__device__ __forceinline__ void phase_final(const Ctx& C) {
    const int gw = C.vcu * 8 + C.wave, NGW = C.G * 8;
    const bf16* XL = (const bf16*)(C.ws + WS_XL); const bf16* Y2 = (const bf16*)(C.ws + WS_H); const bf16* Y0 = (const bf16*)(C.ws + WS_Y0); const float* g = C.in[I_FNG];
    const bf16* Y0b = (const bf16*)(C.arena + M_EGU); const bf16* Y2b = Y0b + (size_t)NLAT * DM;
    const int* TAILROW = (const int*)(C.ws + WS_LIST + AL((size_t)NLAT * 2 * 4 * 3) + AL((size_t)MAXT * 256 * 4 * 2)); const float* PWt = (const float*)(C.ws + WS_LIST) + NLAT * 4;
    const bf16* PART1 = (const bf16*)(C.arena + M_HS); const float* gate = (const float*)(C.ws + WS_MOD) + (size_t)3 * 6144 + 5 * 1024;
    const int maxit = (NLAT + NGW - 1) / NGW;
    for (int b0 = 0; b0 < maxit; b0 += 64) {
        int my_t0 = -1, my_t1 = -1;
        { const int r = gw + (b0 + C.lane) * NGW; if (b0 + C.lane < maxit && r < NLAT) { my_t0 = TAILROW[r * 2]; my_t1 = TAILROW[r * 2 + 1]; } }
        const int b1 = (b0 + 64 < maxit) ? b0 + 64 : maxit;
        for (int it = b0; it < b1; ++it) {
            const int row = gw + it * NGW; if (row >= NLAT) break;
            const int tr0 = __builtin_amdgcn_readlane(my_t0, it - b0), tr1 = __builtin_amdgcn_readlane(my_t1, it - b0);
            u32x2 xa[4], ya[4], za[4], pa[4], qa[4];
#pragma unroll
            for (int j = 0; j < 4; ++j) { const size_t o = (size_t)row * DM + 256 * j + 4 * C.lane;
                xa[j] = *(const u32x2*)(XL + o); ya[j] = *(const u32x2*)(Y2 + o); za[j] = *(const u32x2*)(Y0 + o);
                pa[j] = (u32x2){0u, 0u}; qa[j] = (u32x2){0u, 0u};
                if (tr0 < 0) pa[j] = *(const u32x2*)(Y0b + o);
                if (tr1 < 0) qa[j] = *(const u32x2*)(Y2b + o); }
            f32x4 v[4];
#pragma unroll
            for (int j = 0; j < 4; ++j) {
                v[j].x = bflo(xa[j].x) + (bflo(ya[j].x) + bflo(za[j].x)); v[j].y = bfhi(xa[j].x) + (bfhi(ya[j].x) + bfhi(za[j].x));
                v[j].z = bflo(xa[j].y) + (bflo(ya[j].y) + bflo(za[j].y)); v[j].w = bfhi(xa[j].y) + (bfhi(ya[j].y) + bfhi(za[j].y));
                v[j].x += bflo(pa[j].x); v[j].y += bfhi(pa[j].x); v[j].z += bflo(pa[j].y); v[j].w += bfhi(pa[j].y);
                v[j].x += bflo(qa[j].x); v[j].y += bfhi(qa[j].x); v[j].z += bflo(qa[j].y); v[j].w += bfhi(qa[j].y); }
#pragma unroll
            for (int k = 0; k < 2; ++k) { const int tr = k ? tr1 : tr0;
                if (tr >= 0) { const float w = PWt[row * 2 + k]; const float* gt = gate + (row >> 13) * 6144;
#pragma unroll
                    for (int j = 0; j < 4; ++j) { u32x2 t[MOE_NC1];
#pragma unroll
                        for (int c = 0; c < MOE_NC1; ++c) t[c] = *(const u32x2*)(PART1 + ((size_t)c * 2048 + tr) * 1024 + 256 * j + 4 * C.lane);
                        f32x4 acc = {0.f, 0.f, 0.f, 0.f};
#pragma unroll
                        for (int c = 0; c < MOE_NC1; ++c) acc += (f32x4){bflo(t[c].x), bfhi(t[c].x), bflo(t[c].y), bfhi(t[c].y)};
                        v[j] += *(const f32x4*)(gt + 256 * j + 4 * C.lane) * w * acc; } } }
            float ss = 0.f;
#pragma unroll
            for (int j = 0; j < 4; ++j) ss += (v[j].x * v[j].x + v[j].y * v[j].y) + (v[j].z * v[j].z + v[j].w * v[j].w);
            const float rs = 1.f / sqrtf(wave_sum(ss) * (1.f / DM) + EPS);
#pragma unroll
            for (int j = 0; j < 4; ++j) { const f32x4 gg = *(const f32x4*)(g + 256 * j + 4 * C.lane); *(f32x4*)(C.out + (size_t)row * DM + 256 * j + 4 * C.lane) = v[j] * rs * gg; }
        }
    }
}

__device__ __forceinline__ void phase_mla_prep(const Ctx& C, int gw, int NGW) {
    const bf16* P = (const bf16*)(C.arena + R_P); bf16* CQKV = (bf16*)(C.arena + R_CQKV); char* KBc = (char*)(C.arena + R_KB);
    const float* ROPE = (const float*)(C.ws + WS_ROPE);
    for (int row = gw; row < MR; row += NGW) {
        const bf16* pr = P + (size_t)row * PW;
        {   const u32x2 w = *(const u32x2*)(pr + PC_CQ + 4 * C.lane); float x0 = bflo(w.x), x1 = bfhi(w.x), x2 = bflo(w.y), x3 = bfhi(w.y);
            const float rs = 1.f / sqrtf(wave_sum(x0 * x0 + x1 * x1 + x2 * x2 + x3 * x3) * (1.f / 256.f) + EPS);
            u32x2 o; o.x = pk2(x0 * rs, x1 * rs); o.y = pk2(x2 * rs, x3 * rs); *(u32x2*)(CQKV + (size_t)row * 384 + 4 * C.lane) = o; }
        {   const unsigned w = *(const unsigned*)(pr + PC_CKV + 2 * C.lane); float x0 = bflo(w), x1 = bfhi(w);
            const float rs = 1.f / sqrtf(wave_sum(x0 * x0 + x1 * x1) * (1.f / 128.f) + EPS);
            *(unsigned*)(CQKV + (size_t)row * 384 + 256 + 2 * C.lane) = pk2(x0 * rs, x1 * rs); }
        {   float x = bf2f(pr[PC_KR + C.lane]); const float xo = __shfl_xor(x, 1);
            int b, pos; row_bpos(row, b, pos);
            if (row < NLAT) { const int pair = C.lane >> 1, fi = pair & 15, axis = pair >> 4; const int pidx = axis ? (pos & 63) : (pos >> 6);
                const float* cs = ROPE + ((axis ? 128 : 0) + pidx) * 32 + fi * 2; const float c = cs[0], s = cs[1];
                x = (C.lane & 1) ? (x * c + xo * s) : (x * c - xo * s); }
            const bf16 xb = (bf16)f2bf(x);
#pragma unroll
            for (int h = 0; h < 4; ++h) *(bf16*)(KBc + ((size_t)(b * 4 + h) * 132 + (pos >> 6)) * att::KT_BYTES + (16 + (C.lane >> 3)) * 1024 + (pos & 63) * 16 + (C.lane & 7) * 2) = xb; }
    }
}

__device__ __forceinline__ f32x4 mma16(bf16x8 a, bf16x8 b, f32x4 c) { return __builtin_amdgcn_mfma_f32_16x16x32_bf16(a, b, c, 0, 0, 0); }
constexpr int LS = 72;

__device__ __forceinline__ void phase_gla_local(const Ctx& C, int layer) {
    LAS float* codes = (LAS float*)C.lds;
    LAS float* bcum = codes + 64 * 32;
    LAS float* gsum = bcum + 2 * 64 * 64;
    LAS float* tot = gsum + 2 * 4 * 64;
    LAS bf16* vT = (LAS bf16*)(tot + 128);
    LAS bf16* khT = vT + 128 * LS;
    const bf16* P = (const bf16*)(C.arena + R_P);
    bf16* QT = (bf16*)(C.arena + R_QT); bf16* KT = (bf16*)(C.arena + R_KT);
    float* SLOC = (float*)(C.arena + R_SLOC); float* DEC = (float*)(C.arena + R_DEC);
    const float* WG2 = C.in[I_WG2] + (size_t)layer * 2 * 16 * 256; const float* BG2 = C.in[I_BG2] + (size_t)layer * 2 * 256;
    const int tid = C.tid, lane = C.lane;
    for (int L = C.bid; L < NB * NCH * 4; L += C.G) {
        const int h = L & 3, a = (L >> 2) % NCH, b = L / (NCH * 4);
        const int rbase = chunk_row(b, a);
        {
            const int t = tid >> 3, j4 = (tid & 7) * 4; const u32x2 w = *(const u32x2*)(P + (size_t)(rbase + t) * PW + PC_GF + j4);
            LAS float* cp = codes + t * 32 + j4; cp[0] = bflo(w.x); cp[1] = bfhi(w.x); cp[2] = bflo(w.y); cp[3] = bfhi(w.y);
            const int e0 = (tid & 7) * 16; const bf16* vp = P + (size_t)(rbase + t) * PW + PC_V + h * 128 + e0;
            const u32x4 v0 = *(const u32x4*)vp, v1 = *(const u32x4*)(vp + 8); bf16 vr[16]; unpack8_raw(v0, vr); unpack8_raw(v1, vr + 8);
#pragma unroll
            for (int i = 0; i < 16; ++i) vT[(e0 + i) * LS + t] = vr[i];
        }
        __syncthreads();
        const int dir = tid >> 8, tg = (tid >> 6) & 3, d = tid & 63;
        {
            float w[16];
#pragma unroll
            for (int r = 0; r < 16; ++r) w[r] = WG2[(dir * 16 + r) * 256 + h * 64 + d];
            const float bias = BG2[dir * 256 + h * 64 + d];
            float acc = 0.f;
#pragma unroll
            for (int ii = 0; ii < 16; ++ii) { const int i = dir ? 15 - ii : ii; const int t = tg * 16 + i; float pre = bias;
#pragma unroll
                for (int r4 = 0; r4 < 4; ++r4) { const f32x4 cv = *(const LAS f32x4*)(codes + t * 32 + dir * 16 + 4 * r4); pre += cv.x * w[4 * r4] + cv.y * w[4 * r4 + 1] + cv.z * w[4 * r4 + 2] + cv.w * w[4 * r4 + 3]; }
                acc += logsig_f(pre) * (1.f / 16.f); bcum[(dir * 64 + t) * 64 + d] = acc; }
            gsum[(dir * 4 + tg) * 64 + d] = acc;
        }
        __syncthreads();
        {   float off = 0.f, total = 0.f;
#pragma unroll
            for (int g2 = 0; g2 < 4; ++g2) { const float s = gsum[(dir * 4 + g2) * 64 + d]; total += s; if (dir ? (g2 > tg) : (g2 < tg)) off += s; }
#pragma unroll
            for (int i = 0; i < 16; ++i) bcum[(dir * 64 + tg * 16 + i) * 64 + d] += off;
            if (tg == 0) tot[dir * 64 + d] = __expf(total);
        }
        __syncthreads();
        {
            const int t = (tid >> 2) & 63, d0 = (tid & 3) * 16; const size_t row = (size_t)(rbase + t);
            const bf16* qp = P + row * PW + PC_Q + h * 64 + d0; const bf16* kp = P + row * PW + PC_K + h * 64 + d0;
            float q[16], k[16]; unpack8(*(const u32x4*)qp, q); unpack8(*(const u32x4*)(qp + 8), q + 8); unpack8(*(const u32x4*)kp, k); unpack8(*(const u32x4*)(kp + 8), k + 8);
            float qo[16], ko[16];
#pragma unroll
            for (int i = 0; i < 16; ++i) { const float eB = __expf(bcum[(dir * 64 + t) * 64 + d0 + i]), et = tot[dir * 64 + d0 + i];
                qo[i] = q[i] * 0.125f * eB; ko[i] = k[i] * __builtin_amdgcn_rcpf(eB); khT[(dir * 64 + d0 + i) * LS + t] = (bf16)f2bf(ko[i] * et); }
            bf16* qd = QT + ((size_t)dir * MR + row) * 256 + h * 64 + d0; bf16* kd = KT + ((size_t)dir * MR + row) * 256 + h * 64 + d0;
            *(u32x4*)qd = pack8h(qo); *(u32x4*)(qd + 8) = pack8h(qo + 8); *(u32x4*)kd = pack8h(ko); *(u32x4*)(kd + 8) = pack8h(ko + 8);
        }
        const int pf = a < 128 ? a + 4 : a - 128, pb = 131 - a;
        if (tid < 128) { const int dd = tid >> 6, d2 = tid & 63; const int chain = dd * 8 + b * 4 + h, p = dd ? pb : pf; DEC[((size_t)chain * NCH + p) * 64 + d2] = tot[dd * 64 + d2]; }
        __syncthreads();
        {
            const int fr = lane & 15, fq = lane >> 4;
#pragma unroll 2
            for (int i = 0; i < 8; ++i) { const int id = C.wave * 8 + i, dd = id >> 5, et = (id >> 2) & 7, dt = id & 3;
                f32x4 acc = {0.f, 0.f, 0.f, 0.f};
#pragma unroll
                for (int ks = 0; ks < 2; ++ks) { const bf16x8 av = *(const LAS bf16x8*)(vT + (et * 16 + fr) * LS + ks * 32 + fq * 8); const bf16x8 bv = *(const LAS bf16x8*)(khT + (dd * 64 + dt * 16 + fr) * LS + ks * 32 + fq * 8);
                    acc = mma16(av, bv, acc); }
                const int chain = dd * 8 + b * 4 + h, p = dd ? pb : pf; float* S = SLOC + ((size_t)chain * NCH + p) * 8192;
#pragma unroll
                for (int r = 0; r < 4; ++r) S[(et * 16 + fq * 4 + r) * 64 + dt * 16 + fr] = acc[r]; }
        }
        __syncthreads();
    }
}

__device__ __forceinline__ void phase_gla_scan(const Ctx& C) {
    const float* SLOC = (const float*)(C.arena + R_SLOC); const float* DEC = (const float*)(C.arena + R_DEC); bf16* SST = (bf16*)(C.arena + R_SST);
    for (int idx = C.bid * 512 + C.tid; idx < 16 * 8192; idx += C.G * 512) {
        const int chain = idx >> 13, el = idx & 8191, d = el & 63;
        const float* sl = SLOC + (size_t)chain * NCH * 8192 + el; const float* dc = DEC + (size_t)chain * NCH * 64 + d; bf16* so = SST + (size_t)chain * NCH * 8192 + el;
        float S = 0.f;
#pragma unroll 1
        for (int p0 = 0; p0 < NCH; p0 += 44) {
            float x[44], g[44];
#pragma unroll
            for (int i = 0; i < 44; ++i) { x[i] = sl[(size_t)(p0 + i) * 8192]; g[i] = dc[(p0 + i) * 64]; }
#pragma unroll
            for (int i = 0; i < 44; ++i) { so[(size_t)(p0 + i) * 8192] = (bf16)f2bf(S); S = S * g[i] + x[i]; }
        }
    }
}

__device__ __forceinline__ void phase_gla_out(const Ctx& C, int layer) {
    LAS bf16* qf = (LAS bf16*)C.lds; LAS bf16* kf = qf + 64 * LS; LAS bf16* qb = kf + 64 * LS; LAS bf16* kb = qb + 64 * LS;
    LAS bf16* vT = kb + 64 * LS;
    LAS bf16* SfT = vT + 128 * LS; LAS bf16* SbT = SfT + 128 * LS;
    LAS bf16* As = SbT + 128 * LS;
    LAS float* O = (LAS float*)(As + 64 * LS);
    const bf16* P = (const bf16*)(C.arena + R_P); const bf16* QT = (const bf16*)(C.arena + R_QT); const bf16* KT = (const bf16*)(C.arena + R_KT);
    const bf16* SST = (const bf16*)(C.arena + R_SST); bf16* MIX = (bf16*)(C.arena + R_MIX);
    const float* GG = C.in[I_GLAG] + layer * 128;
    const int tid = C.tid, lane = C.lane, fr = lane & 15, fq = lane >> 4;
    const int na = layer == 0 ? NCH : 128;
    const int nskip = (layer == 0 && C.G > 16) ? 8 : 0;
    if (C.bid < nskip) return;
    for (int L = C.G - 1 - C.bid; L < NB * na * 4; L += C.G - nskip) {
        const int h = L & 3, a = (L >> 2) % na, b = L / (na * 4);
        const int rbase = chunk_row(b, a);
        const int pf = a < 128 ? a + 4 : a - 128, pb = 131 - a;
        {
            const int which = tid >> 7, t = (tid >> 1) & 63, hf = tid & 1; const int dd = which >> 1;
            const bf16* src = ((which & 1) ? KT : QT) + ((size_t)dd * MR + rbase + t) * 256 + h * 64 + hf * 32;
            LAS bf16* dst = (which == 0 ? qf : which == 1 ? kf : which == 2 ? qb : kb) + t * LS + hf * 32;
#pragma unroll
            for (int i = 0; i < 4; ++i) *(LAS u32x4*)(dst + 8 * i) = *(const u32x4*)(src + 8 * i);
        }
        {
            const int t = tid >> 3, e0 = (tid & 7) * 16; const bf16* vp = P + (size_t)(rbase + t) * PW + PC_V + h * 128 + e0;
            const u32x4 v0 = *(const u32x4*)vp, v1 = *(const u32x4*)(vp + 8); bf16 vr[16]; unpack8_raw(v0, vr); unpack8_raw(v1, vr + 8);
#pragma unroll
            for (int i = 0; i < 16; ++i) vT[(e0 + i) * LS + t] = vr[i];
        }
        {
            const int dd = tid >> 8, e = (tid >> 1) & 127, hf = tid & 1; const int chain = dd * 8 + b * 4 + h, p = dd ? pb : pf;
            const bf16* src = SST + ((size_t)chain * NCH + p) * 8192 + e * 64 + hf * 32; LAS bf16* dst = (dd ? SbT : SfT) + e * LS + hf * 32;
#pragma unroll
            for (int i = 0; i < 4; ++i) *(LAS u32x4*)(dst + 8 * i) = *(const u32x4*)(src + 8 * i);
        }
        __syncthreads();
        {
#pragma unroll
            for (int i = 0; i < 2; ++i) { const int pos = C.wave * 2 + i, ti = pos >> 2, si = pos & 3;
                f32x4 af = {0.f, 0.f, 0.f, 0.f}, ab = af;
#pragma unroll
                for (int ks = 0; ks < 2; ++ks) {
                    const bf16x8 a1 = *(const LAS bf16x8*)(qf + (ti * 16 + fr) * LS + ks * 32 + fq * 8), b1 = *(const LAS bf16x8*)(kf + (si * 16 + fr) * LS + ks * 32 + fq * 8);
                    const bf16x8 a2 = *(const LAS bf16x8*)(qb + (ti * 16 + fr) * LS + ks * 32 + fq * 8), b2 = *(const LAS bf16x8*)(kb + (si * 16 + fr) * LS + ks * 32 + fq * 8);
                    af = mma16(a1, b1, af); ab = mma16(a2, b2, ab); }
#pragma unroll
                for (int r = 0; r < 4; ++r) { const int t = ti * 16 + fq * 4 + r, s = si * 16 + fr; const float val = (s <= t ? af[r] : 0.f) + (s >= t ? ab[r] : 0.f); As[t * LS + s] = (bf16)f2bf(val); } }
        }
        __syncthreads();
        {
#pragma unroll 2
            for (int i = 0; i < 4; ++i) { const int id = C.wave * 4 + i, tt = id >> 3, et = id & 7;
                f32x4 acc = {0.f, 0.f, 0.f, 0.f};
#pragma unroll
                for (int ks = 0; ks < 2; ++ks) {
                    const bf16x8 bv = *(const LAS bf16x8*)(vT + (et * 16 + fr) * LS + ks * 32 + fq * 8);
                    acc = mma16(*(const LAS bf16x8*)(As + (tt * 16 + fr) * LS + ks * 32 + fq * 8), bv, acc);
                    acc = mma16(*(const LAS bf16x8*)(qf + (tt * 16 + fr) * LS + ks * 32 + fq * 8), *(const LAS bf16x8*)(SfT + (et * 16 + fr) * LS + ks * 32 + fq * 8), acc);
                    acc = mma16(*(const LAS bf16x8*)(qb + (tt * 16 + fr) * LS + ks * 32 + fq * 8), *(const LAS bf16x8*)(SbT + (et * 16 + fr) * LS + ks * 32 + fq * 8), acc); }
#pragma unroll
                for (int r = 0; r < 4; ++r) O[(tt * 16 + fq * 4 + r) * 132 + et * 16 + fr] = acc[r]; }
        }
        __syncthreads();
        {
            const int t = tid >> 3, e0 = (tid & 7) * 16; float o[16], ss = 0.f;
#pragma unroll
            for (int i = 0; i < 16; ++i) { o[i] = O[t * 132 + e0 + i]; ss += o[i] * o[i]; }
            ss += __shfl_xor(ss, 1); ss += __shfl_xor(ss, 2); ss += __shfl_xor(ss, 4);
            const float rs = 1.f / sqrtf(ss * (1.f / 128.f) + EPS);
            const size_t row = (size_t)(rbase + t); const bf16* rp = P + row * PW + PC_R + h * 128 + e0; float rv[16]; unpack8(*(const u32x4*)rp, rv); unpack8(*(const u32x4*)(rp + 8), rv + 8);
#pragma unroll
            for (int i = 0; i < 16; ++i) o[i] = o[i] * rs * GG[e0 + i] * silu_f(rv[i]);
            bf16* mp = MIX + row * DM + h * 128 + e0; *(u32x4*)mp = pack8h(o); *(u32x4*)(mp + 8) = pack8h(o + 8);
        }
        __syncthreads();
    }
}

namespace att {
constexpr int NW = 8, QBLK = 32, KVBLK = 64;
constexpr float THR = 8.f;
constexpr int OFF_K = 0, OFF_V = 2 * KT_BYTES, OFF_WS = OFF_V + 2 * VT_BYTES, OFF_QR = OFF_WS + NW * 64 * 4, SHM_ATTN = OFF_QR + NW * 4096;
#define SBAR() __builtin_amdgcn_sched_barrier(0)
__device__ __forceinline__ int crow(int r, int hi) { return (r & 3) + 8 * (r >> 2) + 4 * hi; }
__device__ __forceinline__ unsigned cvtpk(float lo, float hi) { unsigned r; asm volatile("v_cvt_pk_bf16_f32 %0, %1, %2" : "=v"(r) : "v"(lo), "v"(hi)); return r; }
__device__ __forceinline__ void glds16(const void* gsrc, unsigned lds_dst) { unsigned keep;
    asm volatile("s_mov_b32 %0, m0\n\ts_mov_b32 m0, %2\n\ts_nop 0\n\tglobal_load_lds_dwordx4 %1, off\n\ts_mov_b32 m0, %0" : "=&s"(keep) : "v"(gsrc), "s"(lds_dst) : "memory"); }
__device__ __forceinline__ void partialSM(f32x16& p0, f32x16& p1, f32x16& negm, bool first, float& alpha) {
    constexpr float THRL = THR * 1.4426950408889634f;
    float ma = fmaxf(fmaxf(p0[0], p0[1]), p0[2]), mb = fmaxf(fmaxf(p0[8], p0[9]), p0[10]), mc = fmaxf(fmaxf(p1[0], p1[1]), p1[2]), md = fmaxf(fmaxf(p1[8], p1[9]), p1[10]);
    ma = fmaxf(fmaxf(ma, p0[3]), p0[4]); mb = fmaxf(fmaxf(mb, p0[11]), p0[12]); mc = fmaxf(fmaxf(mc, p1[3]), p1[4]); md = fmaxf(fmaxf(md, p1[11]), p1[12]);
    ma = fmaxf(fmaxf(ma, p0[5]), p0[6]); mb = fmaxf(fmaxf(mb, p0[13]), p0[14]); mc = fmaxf(fmaxf(mc, p1[5]), p1[6]); md = fmaxf(fmaxf(md, p1[13]), p1[14]);
    ma = fmaxf(ma, p0[7]); mb = fmaxf(mb, p0[15]); mc = fmaxf(mc, p1[7]); md = fmaxf(md, p1[15]);
    float pmax = fmaxf(fmaxf(ma, mb), fmaxf(mc, md));
    { auto rr = __builtin_amdgcn_permlane32_swap(__float_as_uint(pmax), __float_as_uint(pmax), false, false);
      pmax = fmaxf(__uint_as_float(rr[0]), __uint_as_float(rr[1])); }
    if (__builtin_expect(!first && __all(pmax <= THRL), 1)) { alpha = 1.f; }
    else { const float delta = first ? pmax : fmaxf(pmax, 0.f); alpha = first ? 1.f : __builtin_amdgcn_exp2f(-delta);
#pragma unroll
        for (int r = 0; r < 16; ++r) { p0[r] -= delta; p1[r] -= delta; negm[r] -= delta; } }
#pragma unroll
    for (int r = 0; r < 16; ++r) p0[r] = __builtin_amdgcn_exp2f(p0[r]);
}
__device__ __forceinline__ void finishSM(f32x16& p0, f32x16& p1, float alpha, float& l_reg, bf16x8& pa0, bf16x8& pa1, bf16x8& pa2, bf16x8& pa3) {
#pragma unroll
    for (int r = 0; r < 16; ++r) p1[r] = __builtin_amdgcn_exp2f(p1[r]);
    float sa = p0[0] + p0[1], sb = p0[8] + p0[9], sc = p1[0] + p1[1], sd = p1[8] + p1[9];
#pragma unroll
    for (int r = 2; r < 8; ++r) { sa += p0[r]; sb += p0[8 + r]; sc += p1[r]; sd += p1[8 + r]; }
    float ps = (sa + sb) + (sc + sd);
    { auto rr = __builtin_amdgcn_permlane32_swap(__float_as_uint(ps), __float_as_uint(ps), false, false);
      ps = __uint_as_float(rr[0]) + __uint_as_float(rr[1]); }
    l_reg = l_reg * alpha + ps;
#define PK4(P, BASE, OUT) do { unsigned a0 = cvtpk(P[BASE + 0], P[BASE + 1]), a1 = cvtpk(P[BASE + 2], P[BASE + 3]);   \
    unsigned b0 = cvtpk(P[BASE + 4], P[BASE + 5]), b1 = cvtpk(P[BASE + 6], P[BASE + 7]);                              \
    auto r0 = __builtin_amdgcn_permlane32_swap(a0, b0, false, false); auto r1 = __builtin_amdgcn_permlane32_swap(a1, b1, false, false); \
    u32x4 w = {r0[0], r1[0], r0[1], r1[1]}; OUT = *reinterpret_cast<bf16x8*>(&w); } while (0)
    PK4(p0, 0, pa0); PK4(p0, 8, pa1); PK4(p1, 0, pa2); PK4(p1, 8, pa3);
#undef PK4
}
__device__ __forceinline__ void qkt(f32x16& p0, f32x16& p1, const char* kl, const bf16x8* qr, const char* qrl, const f32x16& negm) {
    bf16x8 ka[8], kb[8], qv[4];
#define KLOAD(dst, g) do { _Pragma("unroll") for (int i = 0; i < 4; ++i) { dst[2 * i] = *reinterpret_cast<const bf16x8*>(kl + ((g) * 4 + i) * 2048); dst[2 * i + 1] = *reinterpret_cast<const bf16x8*>(kl + ((g) * 4 + i) * 2048 + 512); } } while (0)
    KLOAD(ka, 0); SBAR(); KLOAD(kb, 1);
#pragma unroll
    for (int i = 0; i < 4; ++i) qv[i] = *reinterpret_cast<const bf16x8*>(qrl + i * 1024);
    SBAR();
    p0 = __builtin_amdgcn_mfma_f32_32x32x16_bf16(ka[0], qr[0], negm, 0, 0, 0);
    p1 = __builtin_amdgcn_mfma_f32_32x32x16_bf16(ka[1], qr[0], negm, 0, 0, 0);
#pragma unroll
    for (int i = 1; i < 4; ++i) { p0 = __builtin_amdgcn_mfma_f32_32x32x16_bf16(ka[2 * i], qr[i], p0, 0, 0, 0); p1 = __builtin_amdgcn_mfma_f32_32x32x16_bf16(ka[2 * i + 1], qr[i], p1, 0, 0, 0); }
    SBAR(); KLOAD(ka, 2); SBAR();
#pragma unroll
    for (int i = 0; i < 4; ++i) { p0 = __builtin_amdgcn_mfma_f32_32x32x16_bf16(kb[2 * i], qr[4 + i], p0, 0, 0, 0); p1 = __builtin_amdgcn_mfma_f32_32x32x16_bf16(kb[2 * i + 1], qr[4 + i], p1, 0, 0, 0); }
    SBAR();
#pragma unroll
    for (int i = 0; i < 4; ++i) { p0 = __builtin_amdgcn_mfma_f32_32x32x16_bf16(ka[2 * i], qv[i], p0, 0, 0, 0); p1 = __builtin_amdgcn_mfma_f32_32x32x16_bf16(ka[2 * i + 1], qv[i], p1, 0, 0, 0); }
#undef KLOAD
}
__device__ __forceinline__ int v_rd_base(int lane) { return ((lane & 3) << 3) | (((lane >> 2) & 3) << 6) | (((lane >> 4) & 1) << 5) | (((lane >> 5) & 1) << 8); }
constexpr int v_rd_off(int d0, int ks, int half) { return d0 * 512 + ks * 4096 + half * 2048; }
template <int OFF> __device__ __forceinline__ s16x4 tr_read(int vb) {
    return __builtin_amdgcn_ds_read_tr16_b64_v4i16((LAS s16x4*)(uintptr_t)(unsigned)(vb + OFF));
}
struct VFrag { s16x4 l0, h0, l1, h1, l2, h2, l3, h3; };
template <int D0> __device__ __forceinline__ void v_reads(VFrag& f, int vb) {
    f.l0 = tr_read<v_rd_off(D0, 0, 0)>(vb); f.h0 = tr_read<v_rd_off(D0, 0, 1)>(vb); f.l1 = tr_read<v_rd_off(D0, 1, 0)>(vb); f.h1 = tr_read<v_rd_off(D0, 1, 1)>(vb);
    f.l2 = tr_read<v_rd_off(D0, 2, 0)>(vb); f.h2 = tr_read<v_rd_off(D0, 2, 1)>(vb); f.l3 = tr_read<v_rd_off(D0, 3, 0)>(vb); f.h3 = tr_read<v_rd_off(D0, 3, 1)>(vb);
}
__device__ __forceinline__ void pv_mma(f32x16& od, const VFrag& f, bf16x8 pa0, bf16x8 pa1, bf16x8 pa2, bf16x8 pa3) {
#define PKV(L, H) (bf16x8){L[0], L[1], L[2], L[3], H[0], H[1], H[2], H[3]}
    od = __builtin_amdgcn_mfma_f32_32x32x16_bf16(pa0, PKV(f.l0, f.h0), od, 0, 0, 0);
    od = __builtin_amdgcn_mfma_f32_32x32x16_bf16(pa1, PKV(f.l1, f.h1), od, 0, 0, 0);
    od = __builtin_amdgcn_mfma_f32_32x32x16_bf16(pa2, PKV(f.l2, f.h2), od, 0, 0, 0);
    od = __builtin_amdgcn_mfma_f32_32x32x16_bf16(pa3, PKV(f.l3, f.h3), od, 0, 0, 0);
#undef PKV
}
__device__ __forceinline__ void pv_d0(f32x16* o, int vb, bf16x8 pa0, bf16x8 pa1, bf16x8 pa2, bf16x8 pa3) {
    VFrag fa, fb;
    v_reads<0>(fa, vb); v_reads<1>(fb, vb);
    SBAR(); pv_mma(o[0], fa, pa0, pa1, pa2, pa3); SBAR();
    v_reads<2>(fa, vb);
    SBAR(); pv_mma(o[1], fb, pa0, pa1, pa2, pa3); SBAR();
    v_reads<3>(fb, vb);
    SBAR(); pv_mma(o[2], fa, pa0, pa1, pa2, pa3); SBAR();
    pv_mma(o[3], fb, pa0, pa1, pa2, pa3);
}
__device__ __forceinline__ void attn_body(const bf16* __restrict__ Qb, const char* __restrict__ Kt, const char* __restrict__ Vt, bf16* __restrict__ Ob, int t0, int NT, char* lds, const float* __restrict__ ROPE, int qpos0) {
    int tid = threadIdx.x; asm volatile("" : "+v"(tid));
    const int wid = __builtin_amdgcn_readfirstlane(tid >> 6), lane = tid & 63, r32 = lane & 31, hi = lane >> 5, grp = wid >> 2;
    float* ws = (float*)(lds + OFF_WS) + wid * 64; float* li_l = ws; float* al_l = ws + 32;
    float l_reg = 0; f32x16 o[4] = {}; f32x16 negm = {}; bf16x8 qr[8];
    const bf16* Qw = Qb + (long)(wid * QBLK + r32) * 192 + hi * 8;
#pragma unroll
    for (int d0 = 0; d0 < 8; ++d0) qr[d0] = *reinterpret_cast<const bf16x8*>(Qw + d0 * 16);
    char* qrl = lds + OFF_QR + wid * 4096 + lane * 16;
#pragma unroll
    for (int d0 = 0; d0 < 4; ++d0) {
        const u32x4 w = *reinterpret_cast<const u32x4*>(Qw + 128 + d0 * 16); float v[8]; unpack8(w, v);
        if (qpos0 >= 0) { const int pos = qpos0 + wid * QBLK + r32;
#pragma unroll
            for (int q = 0; q < 4; ++q) { const int pair = d0 * 8 + hi * 4 + q, fi = pair & 15, axis = pair >> 4; const int pidx = axis ? (pos & 63) : (pos >> 6);
                const float* cs = ROPE + ((axis ? 128 : 0) + pidx) * 32 + fi * 2; const float c = cs[0], sn = cs[1]; const float x1 = v[2 * q], x2 = v[2 * q + 1];
                v[2 * q] = x1 * c - x2 * sn; v[2 * q + 1] = x2 * c + x1 * sn; } }
        *reinterpret_cast<u32x4*>(qrl + d0 * 1024) = pack8(v); }
    asm volatile("s_waitcnt vmcnt(0)" ::: "memory");
    const unsigned ldsb = (unsigned)(uintptr_t)lds;
    const char* Ktw = Kt + (size_t)t0 * KT_BYTES + lane * 16; const char* Vtw = Vt + (size_t)t0 * VT_BYTES + lane * 16;
#define ISSUE_K(j) do { _Pragma("unroll") for (int _i = 0; _i < 3; ++_i) { const int q = wid * 3 + _i; \
        glds16(Ktw + (size_t)(j) * KT_BYTES + q * 1024, __builtin_amdgcn_readfirstlane(ldsb + OFF_K + ((j) & 1) * KT_BYTES + q * 1024)); } } while (0)
#define ISSUE_V(j) do { _Pragma("unroll") for (int _i = 0; _i < 2; ++_i) { const int q = wid * 2 + _i; \
        glds16(Vtw + (size_t)(j) * VT_BYTES + q * 1024, __builtin_amdgcn_readfirstlane(ldsb + OFF_V + ((j) & 1) * VT_BYTES + q * 1024)); } } while (0)
#define STEP_PRE(s) do { __builtin_amdgcn_s_barrier(); SBAR(); const int _s = (s), _m = _s >> 1; issued = 0; \
        if (_m + 1 < NT) { if (_s & 1) { ISSUE_V(_m + 1); issued = 2; } else { ISSUE_K(_m + 1); issued = 3; } } SBAR(); } while (0)
#define STEP_POST() do { SBAR(); if (issued == 3) asm volatile("s_waitcnt vmcnt(3)" ::: "memory"); else if (issued == 2) asm volatile("s_waitcnt vmcnt(2)" ::: "memory"); else asm volatile("s_waitcnt vmcnt(0)" ::: "memory"); } while (0)
#define RESC(a) do { if (__any((a) < 1.f)) { if (hi == 0) al_l[r32] = (a); asm volatile("s_waitcnt lgkmcnt(0)" ::: "memory"); \
    _Pragma("unroll") for (int d = 0; d < 4; ++d) _Pragma("unroll") for (int r = 0; r < 16; ++r) o[d][r] *= al_l[crow(r, hi)]; } } while (0)
    const char* kl0 = lds + OFF_K + hi * 1024 + r32 * 16;
    const int vb0 = (int)ldsb + OFF_V + v_rd_base(lane);
    f32x16 p0, p1; float al = 1.f; bf16x8 pa0, pa1, pa2, pa3;
    ISSUE_K(0); ISSUE_V(0);
    if (NT > 1) { ISSUE_K(1); ISSUE_V(1); asm volatile("s_waitcnt vmcnt(5)" ::: "memory"); } else asm volatile("s_waitcnt vmcnt(0)" ::: "memory");
    __builtin_amdgcn_s_barrier(); SBAR();
    for (int j = 0; j < NT; ++j) {
        const int sl = j & 1;
        qkt(p0, p1, kl0 + sl * KT_BYTES, qr, qrl, negm);
        partialSM(p0, p1, negm, j == 0, al);
        RESC(al);
        finishSM(p0, p1, al, l_reg, pa0, pa1, pa2, pa3); SBAR();
        pv_d0(o, vb0 + sl * VT_BYTES, pa0, pa1, pa2, pa3);
        SBAR(); asm volatile("s_waitcnt vmcnt(0)" ::: "memory"); __builtin_amdgcn_s_barrier(); SBAR();
        if (j + 2 < NT) { ISSUE_K(j + 2); ISSUE_V(j + 2); }
    }
    if (hi == 0) li_l[r32] = l_reg; asm volatile("s_waitcnt lgkmcnt(0)" ::: "memory");
    float rli[16];
#pragma unroll
    for (int r = 0; r < 16; ++r) rli[r] = __builtin_amdgcn_rcpf(li_l[crow(r, hi)]);
    bf16* Ow = Ob + (long)(wid * QBLK) * DM;
#pragma unroll
    for (int r = 0; r < 16; ++r) { const int orow = crow(r, hi);
#pragma unroll
        for (int d0 = 0; d0 < 4; ++d0) Ow[(long)orow * DM + d0 * 32 + r32] = (bf16)f2bf(o[d0][r] * rli[r]); }
    __syncthreads();
#undef ISSUE_K
#undef ISSUE_V
#undef STEP_PRE
#undef STEP_POST
#undef RESC
}
}

__device__ __forceinline__ void phase_attention(const Ctx& C, int layer) {
    const bf16* QB = (const bf16*)(C.arena + R_QB); const char* KB = (const char*)(C.arena + R_KB); const char* VB = (const char*)(C.arena + R_VB); bf16* MIX = (bf16*)(C.arena + R_MIX);
    const float* ROPE = (const float*)(C.ws + WS_ROPE);
    const int nunit = layer == 0 ? 264 : 256;
    for (int L = C.bid; L < nunit; L += C.G) {
        const bool lat = L < 256; const int bh = lat ? (L & 7) : (L - 256), qb = L >> 3, b = bh >> 2, h = bh & 3;
        const int qrow = lat ? qb * 256 : TT, orow = lat ? b * TT + qb * 256 : NLAT + b * TC;
        att::attn_body(QB + ((size_t)bh * TKV + qrow) * 192, KB + (size_t)bh * 132 * att::KT_BYTES, VB + (size_t)bh * 132 * att::VT_BYTES, MIX + (size_t)orow * DM + 512 + h * 128,
                       lat ? 0 : 128, lat ? 132 : 4, (char*)C.ldsg, ROPE, lat ? qb * 256 : -1);
    }
}

struct FStoreP { bf16* P;
    __device__ __forceinline__ void operator()(int row, int col, f32x4 v0, f32x4 v1) const { u32x4 w; w.x = pk2h(v0[0], v0[1]); w.y = pk2h(v0[2], v0[3]); w.z = pk2h(v1[0], v1[1]); w.w = pk2h(v1[2], v1[3]); *(u32x4*)(P + (size_t)row * PW + col) = w; } };
struct FStoreQKV { bf16* QB; char* KB; char* VB; int coff;
    __device__ __forceinline__ void operator()(int row, int colx, f32x4 v0, f32x4 v1) const {
        const int col = colx + coff; int b, pos; row_bpos(row, b, pos);
        if (col < 768) { constexpr float QS = MLA_SCALE * 1.4426950408889634f; v0 = v0 * QS; v1 = v1 * QS; }
        u32x4 w; w.x = pk2h(v0[0], v0[1]); w.y = pk2h(v0[2], v0[3]); w.z = pk2h(v1[0], v1[1]); w.w = pk2h(v1[2], v1[3]);
        if (col < 768) { const int h = col / 192, j = col - h * 192; *(u32x4*)(QB + ((size_t)(b * 4 + h) * TKV + pos) * 192 + j) = w; }
        else { const int c2 = col - 768, h = c2 >> 8, j = c2 & 255; const size_t tile = (size_t)(b * 4 + h) * 132 + (pos >> 6); const int k = pos & 63;
            if (j < 128) *(u32x4*)(KB + tile * att::KT_BYTES + (j >> 3) * 1024 + k * 16) = w;
            else *(u32x4*)(VB + tile * att::VT_BYTES + att::v_st(k, j - 128)) = w; }
    } };
struct FResidual { const float* x; const float* ctx; bf16* XL; const float* gate; int layer0;
    struct UnitV { f32x4 g[2][2]; };
    struct Pre { f32x4 s0, s1; u32x4 xw; };
    __device__ __forceinline__ void unit(UnitV& uv, int row0, int col0) const { const float* g = gate + mod_row(row0) * 6144 + col0;
#pragma unroll
        for (int bj = 0; bj < 2; ++bj) { uv.g[bj][0] = *(const f32x4*)(g + bj * 128); uv.g[bj][1] = *(const f32x4*)(g + bj * 128 + 4); } }
    __device__ __forceinline__ void load(Pre& p, int row, int col) const {
        if (layer0) { const float* src = (row < NLAT ? x + (size_t)row * DM : ctx + (size_t)(row - NLAT) * DM) + col; p.s0 = *(const f32x4*)src; p.s1 = *(const f32x4*)(src + 4); }
        else p.xw = *(const u32x4*)(XL + (size_t)row * DM + col); }
    __device__ __forceinline__ void apply(const UnitV& uv, const Pre& p, int bj, int row, int col, f32x4 v0, f32x4 v1) const {
        const f32x4 g0 = uv.g[bj][0], g1 = uv.g[bj][1];
        float r[8];
        if (layer0) { r[0] = p.s0[0]; r[1] = p.s0[1]; r[2] = p.s0[2]; r[3] = p.s0[3]; r[4] = p.s1[0]; r[5] = p.s1[1]; r[6] = p.s1[2]; r[7] = p.s1[3]; }
        else unpack8(p.xw, r);
        r[0] += g0[0] * v0[0]; r[1] += g0[1] * v0[1]; r[2] += g0[2] * v0[2]; r[3] += g0[3] * v0[3]; r[4] += g1[0] * v1[0]; r[5] += g1[1] * v1[1]; r[6] += g1[2] * v1[2]; r[7] += g1[3] * v1[3];
        *(u32x4*)(XL + (size_t)row * DM + col) = pack8h(r);
    } };
struct FStoreAct { bf16* ACT; int ld;
    __device__ __forceinline__ void operator()(int row, int col, const float* o) const { *(u32x4*)(ACT + (size_t)row * ld + col) = pack8h(o); } };
struct FMoeDown { const int* ENT; const float* WTS; bf16* Y0; bf16* Y2; const float* gate;
    struct UnitV { f32x4 g[2][2][2]; };
    struct Pre { int ent; float w; };
    __device__ __forceinline__ void unit(UnitV& uv, int row0, int colx0) const { const int col = colx0 & (DM - 1);
#pragma unroll
        for (int sm = 0; sm < 2; ++sm)
#pragma unroll
            for (int bj = 0; bj < 2; ++bj) { const float* g = gate + sm * 6144 + col + bj * 128; uv.g[sm][bj][0] = *(const f32x4*)g; uv.g[sm][bj][1] = *(const f32x4*)(g + 4); } }
    __device__ __forceinline__ void load(Pre& p, int row, int colx) const { p.ent = ENT[row]; p.w = WTS[row]; }
    __device__ __forceinline__ void apply(const UnitV& uv, const Pre& p, int bj, int row, int colx, f32x4 v0, f32x4 v1) const {
        const int col = colx & (DM - 1);
        const int ent = p.ent; if (ent < 0) return;
        const int tok = ent >> 1; const bool s1 = (tok >> 13) != 0;
        const f32x4 g0 = s1 ? uv.g[1][bj][0] : uv.g[0][bj][0], g1 = s1 ? uv.g[1][bj][1] : uv.g[0][bj][1];
        const f32x4 a0 = g0 * p.w * v0, a1 = g1 * p.w * v1;
        u32x4 o; o.x = pk2h(a0[0], a0[1]); o.y = pk2h(a0[2], a0[3]); o.z = pk2h(a1[0], a1[1]); o.w = pk2h(a1[2], a1[3]);
        *(u32x4*)(((ent & 1) ? Y2 : Y0) + (size_t)tok * DM + col) = o;
    } };

constexpr int PH_PER_LAYER = 13, PH_FINAL = 1 + 2 * PH_PER_LAYER, N_PHASES = PH_FINAL + 1;
__host__ __device__ constexpr bool phase_exists(int ph) { return ph == 0 || ph == PH_FINAL || (ph >= 1 && ph < PH_FINAL && ((((ph - 1) / PH_PER_LAYER) == 1 && ((ph - 1) % PH_PER_LAYER) != 7 && ((ph - 1) % PH_PER_LAYER) != 8) || (((ph - 1) / PH_PER_LAYER) == 0 && ((ph - 1) % PH_PER_LAYER) < 9))); }

#ifndef DBG_REP
#define DBG_REP(ph) 0
#endif
#ifndef DBG_DELAY
#define DBG_DELAY(ph) 0
#endif
#ifndef DBG_STOP
#define DBG_STOP 0
#endif
#ifndef DBG_SRC
#define DBG_SRC 0
#endif
__device__ __forceinline__ void phase_dump(const Ctx& C) {
    const int gw = C.vcu * 8 + C.wave, NGW = C.G * 8;
    for (int row = gw; row < NLAT; row += NGW) {
        float* o = C.out + (size_t)row * DM;
        if (DBG_SRC == 0) { const bf16* s = (const bf16*)(C.ws + WS_XL) + (size_t)row * DM; for (int c = C.lane; c < DM; c += 64) o[c] = bf2f(s[c]); }
        else { const bf16* s = DBG_SRC == 1 ? (const bf16*)(C.arena + R_MIX) + (size_t)row * DM : DBG_SRC == 2 ? (const bf16*)(C.ws + WS_H) + (size_t)row * DM
                             : DBG_SRC == 3 ? (const bf16*)(C.arena + R_P) + (size_t)row * PW : DBG_SRC == 4 ? (const bf16*)(C.arena + R_P) + (size_t)row * PW + 1024
                             : DBG_SRC == 5 ? (const bf16*)(C.arena + R_ACT) + (size_t)row * DFF : DBG_SRC == 6 ? (const bf16*)(C.arena + R_QT) + (size_t)row * 256
                             : (const bf16*)(C.arena + R_QB) + (size_t)row * 192;
            const int n = DBG_SRC == 6 ? 256 : DBG_SRC == 7 ? 192 : DM;
            for (int c = C.lane; c < DM; c += 64) o[c] = c < n ? bf2f(s[c]) : 0.f; }
    }
}
template <int PH, int SUB = 0> __device__ __forceinline__ void run_phase(const Ctx& C0) {
    Ctx C = C0; { int t = threadIdx.x; asm volatile("" : "+v"(t)); C.tid = t; C.lane = t & 63; C.wave = __builtin_amdgcn_readfirstlane(t >> 6); }
    constexpr int layer = (PH - 1) / PH_PER_LAYER, k = (PH - 1) % PH_PER_LAYER;
    const float* MODB = (const float*)(C.ws + WS_MOD);
    if constexpr (DBG_STOP > 0 && PH > DBG_STOP && PH != PH_FINAL) { }
    else if constexpr (DBG_STOP > 0 && PH == PH_FINAL) { phase_dump(C); }
    else if constexpr (PH == 0) { prologue(C); }
    else if constexpr (PH == PH_FINAL) { phase_final(C); }
    else if constexpr (k == 0) { phase_norm1(C, layer); }
    else if constexpr (k == 1) {
        pg8::Gemm g{(const bf16*)(C.ws + WS_H), (const bf16*)(C.arena + A_WIN) + (size_t)layer * 2048 * 1024, 1024, 1024, 1024};
        pg8::StaticOrder S; S.init(MR, PW, C.G, C.bid); pg8::Epi8<FStoreP> E{{(bf16*)(C.arena + R_P)}};
        pg8::gemm_phase(C.lds, g, S, E);
        if constexpr (layer == 0) { const int nfull = (MR / 256 * (PW / 256)) % C.G;
            if (C.bid >= nfull) convert_weights(C, false, (C.bid - nfull) * 8 + C.wave, (C.G - nfull) * 8); }
        else { const int nfull = (MR / 256 * (PW / 256)) % C.G;
            if (C.bid >= nfull) convert_expert_down(C, (C.bid - nfull) * 8 + C.wave, (C.G - nfull) * 8); }
    } else if constexpr (k == 2) {
        if (SUB != 2) phase_gla_local(C, layer);
        if (SUB != 1) {
            const int r5 = (NB * NCH * 4) % C.G;
            if (r5 == 0) phase_mla_prep(C, C.vcu * 8 + C.wave, C.G * 8);
            else if (C.bid >= r5) phase_mla_prep(C, (C.bid - r5) * 8 + C.wave, (C.G - r5) * 8); }
    } else if constexpr (k == 3) {
        if (SUB != 2) phase_gla_scan(C);
        if (SUB != 1)
        {
            const bf16* W = (const bf16*)(C.arena + A_WQKV) + (size_t)layer * 1792 * 384; const bf16* A = (const bf16*)(C.arena + R_CQKV);
#pragma unroll 1
            for (int pass = 0; pass < 2; ++pass) {
                int ps = pass; asm volatile("" : "+s"(ps));
                pg8::Gemm g{A + (ps ? 256 : 0), W + (ps ? (size_t)768 * 384 + 256 : 0), ps ? 128 : 256, 384, 384};
                pg8::StaticOrder S; S.init(ps ? MR : (layer == 0 ? MR : NLAT), ps ? 1024 : 768, C.G, C.bid);
                pg8::Epi8<FStoreQKV> E{{(bf16*)(C.arena + R_QB), (char*)(C.arena + R_KB), (char*)(C.arena + R_VB), ps ? 768 : 0}};
                pg8::gemm_phase(C.lds, g, S, E); }
        }
    } else if constexpr (k == 4) {
        if (SUB != 2) phase_gla_out(C, layer);
        if (SUB != 1) phase_attention(C, layer);
    } else if constexpr (k == 5) {
        pg8::Gemm g{(const bf16*)(C.arena + R_MIX), (const bf16*)(C.arena + A_WOUT) + (size_t)layer * 1024 * 1024, 1024, 1024, 1024};
        pg8::StaticOrder S; S.init(NLAT, DM, C.G, C.bid);
        pg8::Epi8P<FResidual> E{{C.in[I_X], C.in[I_CTX], (bf16*)(C.ws + WS_XL), MODB + (size_t)layer * 3 * 6144 + 2 * 1024, layer == 0 ? 1 : 0}};
        pg8::gemm_phase(C.lds, g, S, E);
        if constexpr (layer == 0) {
            pg8::Gemm g2{(const bf16*)(C.arena + R_MIX), (const bf16*)(C.arena + A_WOUT), 256, 1024, 1024};
            pg8::CtxSplitOrder S2{4, C.G, C.bid}; pg8::EpiPart E2{(float*)(C.arena + R_PART)};
            pg8::gemm_phase(C.lds, g2, S2, E2); }
    } else if constexpr (k == 6) { phase_norm2(C, layer); if constexpr (layer == 1) convert_expert_gu(C, C.vcu * 8 + C.wave, C.G * 8); }
    else if constexpr (layer == 0 && k == 7) {
        pg8::Gemm g{(const bf16*)(C.ws + WS_H), (const bf16*)(C.arena + A_FGU), 1024, 1024, 1024};
        pg8::StaticOrder S; S.init(MR, 2 * DFF, C.G, C.bid); pg8::EpiGU<FStoreAct> E{{(bf16*)(C.arena + R_ACT), DFF}, 1 << 20};
        pg8::gemm_phase(C.lds, g, S, E);
    } else if constexpr (layer == 0 && k == 8) {
        pg8::Gemm g{(const bf16*)(C.arena + R_ACT), (const bf16*)(C.arena + A_FD), DFF, DFF, DFF};
        pg8::StaticOrder S; S.init(NLAT, DM, C.G, C.bid);
        pg8::Epi8P<FResidual> E{{C.in[I_X], C.in[I_CTX], (bf16*)(C.ws + WS_XL), MODB + 5 * 1024, 0}};
        pg8::gemm_phase(C.lds, g, S, E);
        {
            pg8::Gemm g2{(const bf16*)(C.arena + R_ACT), (const bf16*)(C.arena + A_FD), 256, DFF, DFF};
            pg8::CtxSplitOrder S2{11, C.G, C.bid}; pg8::EpiPart E2{(float*)(C.arena + R_PART)};
            pg8::gemm_phase(C.lds, g2, S2, E2); }
    }
    else if constexpr (layer == 1 && (k == 9 || k == 11)) {
        constexpr int half = (k - 9) / 2;
        if constexpr (half == 1) moe_tail_reduce0(C);
        pg8::MoeGatherOrder S; moe_tile_bases(C, S.tb); S.ncol = half ? MOE_T1 : MOE_T0; S.tpe = 28; S.joff = half ? MOE_T0 : 0; S.G = C.G; S.c = C.bid;
        S.LISTE = (const int*)(C.arena + M_LISTE);
        { const unsigned* ctl = (const unsigned*)(C.ws + WS_CTL);
#pragma unroll
          for (int e = 0; e < 8; ++e) S.cnt[e] = (int)__hip_atomic_load(ctl + CW_CNT + 64 * e, __ATOMIC_RELAXED, __HIP_MEMORY_SCOPE_AGENT); }
        pg8::Gemm g{(const bf16*)(C.arena + M_HS), (const bf16*)(C.arena + M_EGU), 1024, 1024, 1024};
        pg8::EpiGU<FStoreAct> E{{(bf16*)(C.arena + M_ACT) - (size_t)(half ? MOE_K0 : 0), half ? MOE_K1 : MOE_K0}, 28};
        pg8::gemm_phase(C.lds, g, S, E);
        if constexpr (half == 0) moe_fill_lists(C);
    } else if constexpr (layer == 1 && (k == 10 || k == 12)) {
        constexpr int half = (k - 10) / 2;
        const int* ENT = (const int*)(C.ws + WS_LIST + AL((size_t)NLAT * 2 * 4 * 3)); const float* WTS = (const float*)(ENT + MAXT * 256);
        pg8::MoeTailOrder ST; moe_tile_bases(C, ST.tb); const int ntot = ST.tb[8];
        pg8::MoeOrder S;
#pragma unroll
        for (int e = 0; e < 9; ++e) S.tb[e] = ST.tb[e] < MOE_MAIN ? ST.tb[e] : MOE_MAIN;
        S.ncol = 4; S.tpe = 4; S.joff = 0; S.G = C.G; S.c = C.bid;
        constexpr int KP = half ? MOE_K1 : MOE_K0;
        pg8::Gemm g{(const bf16*)(C.arena + M_ACT), (const bf16*)(C.ws + WS_ED) + (size_t)(half ? MOE_K0 : 0), KP, KP, DFE};
        pg8::Epi8P<FMoeDown> E{{ENT, WTS, half ? (bf16*)(C.arena + M_EGU) : (bf16*)(C.ws + WS_Y0), half ? (bf16*)(C.arena + M_EGU) + (size_t)NLAT * DM : (bf16*)(C.ws + WS_H), MODB + (size_t)3 * 6144 + 5 * 1024}};
        pg8::gemm_phase(C.lds, g, S, E);
        if (ntot > MOE_MAIN) {
            constexpr int KC = half ? MOE_C1 : MOE_C0;
            ST.nm = MOE_MAIN; ST.ntail = ntot - MOE_MAIN; ST.nchunk = half ? MOE_NC1 : MOE_NC0; ST.G = C.G; ST.c = C.bid;
            pg8::Gemm g2{(const bf16*)(C.arena + M_ACT), (const bf16*)(C.ws + WS_ED) + (size_t)(half ? MOE_K0 : 0), KC, KP, DFE};
            pg8::EpiPartT E2{half ? (bf16*)(C.arena + M_HS) : (bf16*)(C.arena + M_PT0), MOE_MAIN};
            pg8::gemm_phase(C.lds, g2, ST, E2); }
    }
}

__device__ __forceinline__ void make_ctx(Ctx& C, const Args& args, unsigned char* lds_raw) {
    C.lds = (LAS unsigned char*)lds_raw; C.ldsg = lds_raw; C.ws = args.ws; C.arena = args.ws + WS_ARENA; C.in = args.in; C.out = args.out;
    C.tid = threadIdx.x; C.lane = C.tid & 63; C.wave = __builtin_amdgcn_readfirstlane(C.tid >> 6);
    C.G = gridDim.x; C.bid = blockIdx.x; C.vcu = (C.G % 8 == 0) ? (C.bid % 8) * (C.G / 8) + C.bid / 8 : C.bid;
}

template <int PH> __device__ __forceinline__ void run_from(const Ctx& C, const XcdBarrier& bar) {
    if constexpr (PH < N_PHASES) {
        if constexpr (phase_exists(PH)) {
            unsigned long long t0_ = 0; if constexpr (DBG_DELAY(PH) != 0) t0_ = __builtin_amdgcn_s_memrealtime();
            run_phase<PH>(C); if constexpr (PH != PH_FINAL) xcd_barrier(bar);
            if constexpr (DBG_DELAY(PH) != 0) { const unsigned long long t1_ = __builtin_amdgcn_s_memrealtime(); while (__builtin_amdgcn_s_memrealtime() - t1_ < t1_ - t0_) __builtin_amdgcn_s_sleep(8); __syncthreads(); }
            if constexpr (DBG_REP(PH) > 0) { run_phase<PH, DBG_REP(PH) - 1>(C); xcd_barrier(bar); } }
        run_from<PH + 1>(C, bar);
    }
}

#if !MK_PER_PHASE
__global__ void __launch_bounds__(512, 2) mega_fwd(Args args) {
    extern __shared__ __attribute__((aligned(16))) unsigned char lds_raw[];
    Ctx C; make_ctx(C, args, lds_raw);
    volatile LAS unsigned* MISC = (volatile LAS unsigned*)(C.lds + MISC_OFF);
    if (C.tid < 64) MISC[C.tid] = 0u;
    __syncthreads();
    unsigned* ctl = (unsigned*)(C.ws + WS_CTL);
    const XcdBarrier bar = xcd_barrier_post(ctl + CW_BAR, MISC + 8);
    run_from<0>(C, bar);
}
#else
template <int PH> __global__ void __launch_bounds__(512, 2) phase_kernel(Args args) {
    extern __shared__ __attribute__((aligned(16))) unsigned char lds_raw[];
    Ctx C; make_ctx(C, args, lds_raw);
    run_phase<PH>(C);
}
template <int PH> void launch_from(int grid, hipStream_t stream, const Args& a) {
    if constexpr (PH < N_PHASES) {
        if constexpr (phase_exists(PH)) {
            (void)hipFuncSetAttribute((const void*)phase_kernel<PH>, hipFuncAttributeMaxDynamicSharedMemorySize, LDS_BYTES);
            hipLaunchKernelGGL(phase_kernel<PH>, dim3(grid), dim3(512), LDS_BYTES, stream, a);
        }
        launch_from<PH + 1>(grid, stream, a);
    }
}
#endif

extern "C" void kernel_launch(void* const* d_in, const int* in_sizes, int n_in, void* d_out, int out_size, void* d_ws, size_t ws_size, hipStream_t stream) {
    static int grid = 0;
    if (grid == 0) {
        if (n_in != 25 || out_size != NLAT * DM || ws_size < WS_END) { fprintf(stderr, "kernel_launch: unexpected shapes (n_in %d, out %d, ws %zu < %zu); nothing launched\n", n_in, out_size, ws_size, (size_t)WS_END); grid = -1; return; }
        int dev = 0, cus = 0;
        if (hipGetDevice(&dev) != hipSuccess || hipDeviceGetAttribute(&cus, hipDeviceAttributeMultiprocessorCount, dev) != hipSuccess) { grid = -1; return; }
#if !MK_PER_PHASE
        if (hipFuncSetAttribute((const void*)mega_fwd, hipFuncAttributeMaxDynamicSharedMemorySize, LDS_BYTES) != hipSuccess) { fprintf(stderr, "kernel_launch: hipFuncSetAttribute failed\n"); grid = -1; return; }
        int per_cu = 0;
        if (hipOccupancyMaxActiveBlocksPerMultiprocessor(&per_cu, (const void*)mega_fwd, 512, LDS_BYTES) != hipSuccess || per_cu < 1) { fprintf(stderr, "kernel_launch: occupancy query reports %d blocks per CU\n", per_cu); }
        (void)hipGetLastError();
#endif
        grid = cus;
    }
    if (grid < 0) return;
    if (hipMemsetAsync((char*)d_ws + WS_CTL, 0, CTL_BYTES, stream) != hipSuccess) return;
    Args a{};
    for (int i = 0; i < 25; ++i) a.in[i] = (const float*)d_in[i];
    a.out = (float*)d_out; a.ws = (unsigned char*)d_ws;
#if MK_PER_PHASE
    launch_from<0>(grid, stream, a);
#else
    hipLaunchKernelGGL(mega_fwd, dim3(grid), dim3(512), LDS_BYTES, stream, a);
#endif
    const hipError_t le = hipPeekAtLastError();
    if (le != hipSuccess) fprintf(stderr, "kernel_launch: launch failed: %s\n", hipGetErrorName(le));
}
```

```cpp
#include <hip/hip_runtime.h>
#include <cstdio>
#include <cstdint>

#define LAS __attribute__((address_space(3)))
#define GAS __attribute__((address_space(1)))
typedef unsigned short bf16;
typedef short bf16x8 __attribute__((ext_vector_type(8)));
typedef short s16x4 __attribute__((ext_vector_type(4)));
typedef float f32x2 __attribute__((ext_vector_type(2)));
typedef float f32x4 __attribute__((ext_vector_type(4)));
typedef float f32x16 __attribute__((ext_vector_type(16)));
typedef unsigned u32x2 __attribute__((ext_vector_type(2)));
typedef unsigned u32x4 __attribute__((ext_vector_type(4)));

#ifndef MK_PER_PHASE
#define MK_PER_PHASE 0
#endif

constexpr int DM = 1024, NB = 2, TT = 8192, TC = 256, NLAT = NB * TT, NCTXR = NB * TC, MR = NLAT + NCTXR;
constexpr int TKV = TT + TC;
constexpr int PW = 2048;
constexpr int PC_Q = 0, PC_K = 256, PC_V = 512, PC_R = 1024, PC_CQ = 1536, PC_CKV = 1792, PC_KR = 1920, PC_GF = 1984, PC_GB = 2000;
constexpr int NCH = 132;
constexpr int DFF = 2816, DFE = 3584, NEXP = 8;
constexpr int MOE_T0 = 15, MOE_T1 = 28 - MOE_T0, MOE_K0 = MOE_T0 * 128, MOE_K1 = MOE_T1 * 128;
constexpr int MOE_MAIN = 128, MOE_C0 = 384, MOE_NC0 = 5, MOE_C1 = 128, MOE_NC1 = 13;
constexpr int MAXT = 136;
constexpr float EPS = 1e-6f;
constexpr float MLA_SCALE = 0.07216878364870322f;
namespace att {
constexpr int KT_BYTES = 24576, VT_BYTES = 16384;
__host__ __device__ __forceinline__ int v_st(int k, int c) { const int kk = (k & ~0xC) | ((k & 4) << 1) | ((k & 8) >> 1); return ((kk >> 3) * 4 + (c >> 5)) * 512 + ((kk & 7) * 32 + (c & 31)) * 2; }
}

constexpr size_t AL(size_t x) { return (x + 255) & ~(size_t)255; }
constexpr size_t WS_CTL = 0, CTL_BYTES = 65536;
constexpr size_t WS_MOD = WS_CTL + CTL_BYTES;
constexpr size_t WS_ROPE = WS_MOD + AL(2 * 3 * 6144 * 4);
constexpr size_t WS_XL = WS_ROPE + AL((128 + 64) * 32 * 4);
constexpr size_t WS_H = WS_XL + AL((size_t)MR * DM * 2);
constexpr size_t WS_LIST = WS_H + AL((size_t)MR * DM * 2);
constexpr size_t LIST_BYTES = AL((size_t)NLAT * 2 * 4 * 3) + AL((size_t)MAXT * 256 * 4 * 2) + AL((size_t)NLAT * 2 * 4);
constexpr size_t WS_Y0 = WS_LIST + LIST_BYTES;
constexpr size_t WS_ARENA = WS_Y0 + AL((size_t)NLAT * DM * 2);
constexpr size_t A_WIN = 0;
constexpr size_t A_WQKV = A_WIN + AL((size_t)2 * 2048 * 1024 * 2);
constexpr size_t A_WOUT = A_WQKV + AL((size_t)2 * 1792 * 384 * 2);
constexpr size_t A_FGU = A_WOUT + AL((size_t)2 * 1024 * 1024 * 2);
constexpr size_t A_FD = A_FGU + AL((size_t)2 * DFF * 1024 * 2);
constexpr size_t A_R = A_FD + AL((size_t)1024 * DFF * 2);
constexpr size_t R_P = A_R;
constexpr size_t R_QT = R_P + AL((size_t)MR * PW * 2);
constexpr size_t R_KT = R_QT + AL((size_t)2 * MR * 256 * 2);
constexpr size_t R_SLOC = R_KT + AL((size_t)2 * MR * 256 * 2);
constexpr size_t R_DEC = R_SLOC + AL((size_t)16 * NCH * 8192 * 4);
constexpr size_t R_SST = R_DEC + AL((size_t)16 * NCH * 64 * 4);
constexpr size_t R_CQKV = R_SST + AL((size_t)16 * NCH * 8192 * 2);
constexpr size_t R_QB = R_CQKV + AL((size_t)MR * 384 * 2);
constexpr size_t R_KB = R_QB + AL((size_t)8 * TKV * 192 * 2);
constexpr size_t R_VB = R_KB + AL((size_t)8 * TKV * 192 * 2);
constexpr size_t R_MIX = R_VB + AL((size_t)8 * TKV * 128 * 2);
constexpr size_t R_END = R_MIX + AL((size_t)MR * DM * 2);
constexpr size_t R_PART = R_SLOC;
constexpr size_t R_ACT = A_R;
static_assert(R_ACT + (size_t)MR * DFF * 2 <= R_SLOC && (size_t)11 * 512 * 1024 * 4 <= (size_t)16 * NCH * 8192 * 4, "ACT ends below SLOC; PART fits SLOC");
constexpr size_t M_EGU = 0;
constexpr size_t M_HS = M_EGU + AL((size_t)NEXP * 2 * DFE * 1024 * 2);
constexpr size_t M_LISTE = M_HS + AL((size_t)NLAT * DM * 2);
constexpr size_t M_ACT = M_HS + AL((size_t)MAXT * 256 * 1024 * 2);
constexpr size_t M_PT0 = M_ACT + AL((size_t)MAXT * 256 * MOE_K0 * 2);
constexpr size_t M_END = M_PT0 + AL((size_t)MOE_NC0 * 2048 * 1024 * 2);
constexpr size_t ARENA_BYTES = (R_END > M_END) ? R_END : M_END;
constexpr size_t WS_ED = WS_ARENA + ARENA_BYTES;
constexpr size_t WS_END = WS_ED + AL((size_t)NEXP * 1024 * DFE * 2);
static_assert(WS_END <= 534000000ull, "workspace map exceeds the guaranteed scratch size");

constexpr int CW_BAR = 4096;
constexpr int CW_CNT = 64;

constexpr int LDS_BYTES = 147456, MISC_OFF = LDS_BYTES - 256;

__device__ __forceinline__ unsigned f2bf_s(float f) { unsigned u = __builtin_bit_cast(unsigned, f); return (u + 0x7fffu + ((u >> 16) & 1u)) >> 16; }
__device__ __forceinline__ unsigned pk2s(float lo, float hi) { return f2bf_s(lo) | (f2bf_s(hi) << 16); }
typedef __bf16 bf16x2_t __attribute__((ext_vector_type(2)));
__device__ __forceinline__ unsigned pk2h(float lo, float hi) { const f32x2 v = {lo, hi}; return __builtin_bit_cast(unsigned, __builtin_convertvector(v, bf16x2_t)); }
__device__ __forceinline__ unsigned pk2(float lo, float hi) { return pk2h(lo, hi); }
__device__ __forceinline__ unsigned f2bf(float f) { return pk2h(f, 0.f) & 0xffffu; }
__device__ __forceinline__ u32x4 pack8h(const float* v) { u32x4 w; w.x = pk2h(v[0], v[1]); w.y = pk2h(v[2], v[3]); w.z = pk2h(v[4], v[5]); w.w = pk2h(v[6], v[7]); return w; }
__device__ __forceinline__ float bf2f(unsigned b) { return __builtin_bit_cast(float, b << 16); }
__device__ __forceinline__ float bflo(unsigned w) { return __builtin_bit_cast(float, w << 16); }
__device__ __forceinline__ float bfhi(unsigned w) { return __builtin_bit_cast(float, w & 0xffff0000u); }
__device__ __forceinline__ u32x4 pack8s(const float* v) { u32x4 w; w.x = pk2s(v[0], v[1]); w.y = pk2s(v[2], v[3]); w.z = pk2s(v[4], v[5]); w.w = pk2s(v[6], v[7]); return w; }
__device__ __forceinline__ u32x4 pack8(const float* v) { u32x4 w; w.x = pk2(v[0], v[1]); w.y = pk2(v[2], v[3]); w.z = pk2(v[4], v[5]); w.w = pk2(v[6], v[7]); return w; }
__device__ __forceinline__ void unpack8_raw(u32x4 w, bf16* v) { v[0] = (bf16)(w.x & 0xffffu); v[1] = (bf16)(w.x >> 16); v[2] = (bf16)(w.y & 0xffffu); v[3] = (bf16)(w.y >> 16); v[4] = (bf16)(w.z & 0xffffu); v[5] = (bf16)(w.z >> 16); v[6] = (bf16)(w.w & 0xffffu); v[7] = (bf16)(w.w >> 16); }
__device__ __forceinline__ void unpack8(u32x4 w, float* v) { v[0] = bflo(w.x); v[1] = bfhi(w.x); v[2] = bflo(w.y); v[3] = bfhi(w.y); v[4] = bflo(w.z); v[5] = bfhi(w.z); v[6] = bflo(w.w); v[7] = bfhi(w.w); }
__device__ __forceinline__ float wave_sum(float v) {
#pragma unroll
    for (int o = 1; o < 64; o <<= 1) v += __shfl_xor(v, o);
    return v;
}
__device__ __forceinline__ float silu_f(float x) { return x * __builtin_amdgcn_rcpf(1.f + __expf(-x)); }
__device__ __forceinline__ float logsig_f(float x) { return fminf(x, 0.f) - __logf(1.f + __expf(-fabsf(x))); }
#define LDS_WAIT() asm volatile("s_waitcnt lgkmcnt(0)" ::: "memory")
#define VM_WAIT() asm volatile("s_waitcnt vmcnt(0)" ::: "memory")

namespace pg8 {
constexpr int BM = 256, BK = 64, HALF = 128, HTB = HALF * BK * 2, NXCD = 8, WGM = 8;
__host__ __device__ __forceinline__ int lds_byte(int r, int c) { const int st = (r >> 4) * 2 + (c >> 5), rr = r & 15, cc = c & 31, ob = rr * 64 + cc * 2; return st * 1024 + (ob ^ (((ob >> 9) & 1) << 5)); }
__host__ __device__ __forceinline__ void stage_rc(int b, int& R, int& C) { const int st = b / 1024, sb = b % 1024, swz = sb ^ (((sb >> 9) & 1) << 5); R = (st >> 1) * 16 + swz / 64; C = (st & 1) * 32 + (swz % 64) / 2; }
__host__ __device__ __forceinline__ int perm32(int rho) { const int n = rho >> 4, i = rho & 15; return 8 * (i >> 2) + 4 * n + (i & 3); }

struct Unit { int pm, pn, kc; };
struct Gemm { const bf16* A; const bf16* Bt; int K, lda, ldb; };

struct StaticOrder {
    static constexpr bool GATHER = false;
    int nM, nN, nwg, G, c;
    __device__ void init(int M, int N, int G_, int c_) { nM = M / BM; nN = N / BM; nwg = nM * nN; G = G_; c = c_; }
    __device__ bool next(int i, Unit& u) const {
        const long L = (long)i * G + c; if (L >= nwg) return false;
        int wgid = (int)L; { const int q = nwg / NXCD, r = nwg % NXCD, xcd = wgid % NXCD, off = wgid / NXCD; wgid = (xcd < r ? xcd * (q + 1) : r * (q + 1) + (xcd - r) * q) + off; }
        const int nig = WGM * nN, gid = wgid / nig, fm = gid * WGM, gsz = (nM - fm) < WGM ? (nM - fm) : WGM;
        u.pm = fm + ((wgid % nig) % gsz); u.pn = (wgid % nig) / gsz; u.kc = 0; return true;
    }
};
struct MoeOrder {
    static constexpr bool GATHER = false;
    int tb[9]; int ncol, tpe, joff, G, c;
    __device__ bool next(int i, Unit& u) const {
        const int nM = tb[8], nwg = nM * ncol; const long L = (long)i * G + c; if (L >= nwg) return false;
        int wgid = (int)L; { const int q = nwg / NXCD, r = nwg % NXCD, xcd = wgid % NXCD, off = wgid / NXCD; wgid = (xcd < r ? xcd * (q + 1) : r * (q + 1) + (xcd - r) * q) + off; }
        const int nig = WGM * ncol, gid = wgid / nig, fm = gid * WGM, gsz = (nM - fm) < WGM ? (nM - fm) : WGM;
        const int tile = fm + ((wgid % nig) % gsz), j = (wgid % nig) / gsz; int e = 0;
#pragma unroll
        for (int k = 1; k < 8; ++k) e += (tile >= tb[k]) ? 1 : 0;
        u.pm = tile; u.pn = e * tpe + joff + j; u.kc = 0; return true;
    }
};
struct MoeTailOrder {
    static constexpr bool GATHER = false;
    int tb[9]; int nm, ntail, nchunk, G, c;
    __device__ bool next(int i, Unit& u) const {
        const int per = ntail * 4, L = i * G + c; if (L >= per * nchunk) return false;
        const int kc = L / per, r = L - kc * per, tile = nm + (r >> 2); int e = 0;
#pragma unroll
        for (int k = 1; k < 8; ++k) e += (tile >= tb[k]) ? 1 : 0;
        u.pm = tile; u.pn = e * 4 + (r & 3); u.kc = kc; return true;
    }
};
struct CtxSplitOrder {
    static constexpr bool GATHER = false;
    int nchunk, G, c;
    __device__ bool next(int i, Unit& u) const { const int L = i * G + c; if (L >= nchunk * 8) return false; const int r = L & 7; u.kc = L >> 3; u.pm = 64 + (r & 1); u.pn = r >> 1; return true; }
};
struct MoeGatherOrder : MoeOrder {
    static constexpr bool GATHER = true;
    const int* LISTE; int cnt[8];
    __device__ __forceinline__ void rows_of(const Unit& u, const int*& src, int& nvalid) const {
        int e = 0;
#pragma unroll
        for (int k = 1; k < 8; ++k) e += (u.pm >= tb[k]) ? 1 : 0;
        int tbe = 0, ce = 0;
#pragma unroll
        for (int k = 0; k < 8; ++k) { tbe = (e == k) ? tb[k] : tbe; ce = (e == k) ? cnt[k] : ce; }
        const int s0 = (u.pm - tbe) * 256; src = LISTE + e * 16384 + s0; nvalid = ce - s0;
    }
};
template <class Epi, class Sched>
__device__ __forceinline__ void gemm_phase(LAS unsigned char* lds, const Gemm g, const Sched& S, const Epi& E) {
    int tid = threadIdx.x; asm volatile("" : "+v"(tid));
    const int wid = __builtin_amdgcn_readfirstlane(tid >> 6), lane = tid & 63, wr = wid >> 2, wc = wid & 3, fr = lane & 15, fq = lane >> 4;
    const int K = g.K, nt = K / BK;
    constexpr bool GA = Sched::GATHER;
    unsigned voffA[2], voffB[2], vG[2][2]; int RA[2], CA[2];
#pragma unroll
    for (int i = 0; i < 2; ++i) { int R, C; stage_rc(tid * 16 + i * 8192, R, C); const int Rb = (R & ~31) + perm32(R & 31); RA[i] = R; CA[i] = C;
        voffA[i] = (unsigned)(R * g.lda + C) * 2u; voffB[i] = (unsigned)(Rb * g.ldb + C) * 2u; vG[0][i] = vG[1][i] = 0u; }
    const size_t kstep = (size_t)(BK * 2);
    const size_t hstepA = GA ? (size_t)0 : (size_t)HALF * g.lda * 2, hstepB = (size_t)HALF * g.ldb * 2;
    constexpr int TAB_OFF = 8 * HTB;
#define PG8_IDX_ISSUE(u, par) do { if constexpr (GA) { const int* _src; int _nv; S.rows_of(u, _src, _nv); \
        __builtin_amdgcn_global_load_lds((const unsigned*)(_src + (wid & 3) * 64 + lane), (LAS unsigned*)(lds + TAB_OFF + (par) * 1024 + (wid & 3) * 256), 4, 0, 0); } } while (0)
#define PG8_IDX_READ(u, par) do { if constexpr (GA) { const int* _src; int _nv; S.rows_of(u, _src, _nv); _Pragma("unroll") for (int _h = 0; _h < 2; ++_h) _Pragma("unroll") for (int _i = 0; _i < 2; ++_i) { \
        const int _r = _h * HALF + RA[_i]; const int _raw = *(const LAS int*)(lds + TAB_OFF + (par) * 1024 + _r * 4); const int _row = _r < _nv ? (_raw >> 1) : 0; vG[_h][_i] = (unsigned)(_row * g.lda + CA[_i]) * 2u; } } } while (0)
    const size_t tstepA = 2 * hstepA, tstepB = 2 * hstepB;
    const unsigned ldsw = (unsigned)wid * 1024u;
    const int aoff = lds_byte(wr * 64 + fr, fq * 8), boff = lds_byte(wc * 32 + fr, fq * 8);
#define PG8_SA(b, h) (((b) * 2 + (h)) * HTB)
#define PG8_SB(b, h) ((4 + (b) * 2 + (h)) * HTB)
#define PG8_STAGE(bufoff, gbase, voff) do { _Pragma("unroll") for (int _i = 0; _i < 2; ++_i) \
        __builtin_amdgcn_global_load_lds((const unsigned*)((const char*)(gbase) + (voff)[_i]), (LAS unsigned*)(lds + (bufoff) + ldsw + _i * 8192), 16, 0, 0); } while (0)
#define PG8_STAGE_A(bufoff, gbase, h) do { if constexpr (GA) PG8_STAGE(bufoff, gbase, vG[h]); else PG8_STAGE(bufoff, gbase, voffA); } while (0)
#define PG8_LDA(dst, b, h) do { _Pragma("unroll") for (int m = 0; m < 4; ++m) _Pragma("unroll") for (int k = 0; k < 2; ++k) dst[m][k] = *(const LAS bf16x8*)(lds + PG8_SA(b, h) + aoff + m * 2048 + k * 1024); } while (0)
#define PG8_LDB(dst, b, h) do { _Pragma("unroll") for (int n = 0; n < 2; ++n) _Pragma("unroll") for (int k = 0; k < 2; ++k) dst[n][k] = *(const LAS bf16x8*)(lds + PG8_SB(b, h) + boff + n * 2048 + k * 1024); } while (0)
#define PG8_MMA(ai, bj, At, Bt) do { __builtin_amdgcn_s_setprio(1); _Pragma("unroll") for (int m = 0; m < 4; ++m) _Pragma("unroll") for (int n = 0; n < 2; ++n) _Pragma("unroll") for (int k = 0; k < 2; ++k) \
        acc[ai][bj][m][n] = __builtin_amdgcn_mfma_f32_16x16x32_bf16(Bt[n][k], At[m][k], acc[ai][bj][m][n], 0, 0, 0); __builtin_amdgcn_s_setprio(0); } while (0)
#define PG8_WAIT_V(n) asm volatile("s_waitcnt vmcnt(" #n ")" ::: "memory")
#define PG8_WAIT_L(n) asm volatile("s_waitcnt lgkmcnt(" #n ")" ::: "memory")
#define PG8_BAR __builtin_amdgcn_s_barrier()
#define PG8_SCHED __builtin_amdgcn_sched_barrier(0)
    Unit cur, nxt; int ui = 0;
    if (!S.next(0, cur)) return;
    f32x4 acc[2][2][4][2];
#pragma unroll
    for (int a = 0; a < 2; ++a)
#pragma unroll
        for (int b = 0; b < 2; ++b)
#pragma unroll
            for (int m = 0; m < 4; ++m)
#pragma unroll
                for (int n = 0; n < 2; ++n) acc[a][b][m][n] = (f32x4){0.f, 0.f, 0.f, 0.f};
    bf16x8 At[4][2], B0[2][2], B1[2][2];
    const size_t cstep = (size_t)K * 2;
    const char* cA = (const char*)g.A + (GA ? (size_t)0 : (size_t)cur.pm * tstepA) + cur.kc * cstep; const char* cB = (const char*)g.Bt + (size_t)cur.pn * tstepB + cur.kc * cstep;
    if constexpr (GA) { PG8_IDX_ISSUE(cur, 0); PG8_WAIT_V(0); PG8_BAR; PG8_IDX_READ(cur, 0); }
    PG8_STAGE(PG8_SB(0, 0), cB, voffB); PG8_STAGE(PG8_SB(0, 1), cB + hstepB, voffB); PG8_STAGE_A(PG8_SA(0, 0), cA, 0); PG8_STAGE_A(PG8_SA(0, 1), cA + hstepA, 1);
    if (wr == 1) PG8_BAR;
    PG8_WAIT_V(2); PG8_BAR;
    PG8_STAGE(PG8_SB(1, 0), cB + kstep, voffB); PG8_STAGE_A(PG8_SA(1, 0), cA + kstep, 0); PG8_STAGE(PG8_SB(1, 1), cB + hstepB + kstep, voffB);
    PG8_WAIT_V(6); PG8_BAR;
    for (;;) {
        const bool has_next = S.next(ui + 1, nxt);
        if (has_next) PG8_IDX_ISSUE(nxt, (ui + 1) & 1);
        const char* nA = has_next ? (const char*)g.A + (GA ? (size_t)0 : (size_t)nxt.pm * tstepA) + nxt.kc * cstep : cA; const char* nB = has_next ? (const char*)g.Bt + (size_t)nxt.pn * tstepB + nxt.kc * cstep : cB;
#pragma unroll 1
        for (int t = 0; t < nt; t += 2) {
            const bool last = (t == nt - 2);
            const char* a1 = cA + (size_t)(t + 1) * kstep;
            const char* a2 = last ? nA : cA + (size_t)(t + 2) * kstep; const char* b2 = last ? nB : cB + (size_t)(t + 2) * kstep;
            const char* a3 = a2 + kstep; const char* b3 = b2 + kstep;
            PG8_LDB(B0, 0, 0); PG8_LDB(B1, 0, 1); PG8_SCHED; PG8_LDA(At, 0, 0); PG8_STAGE_A(PG8_SA(1, 1), a1 + hstepA, 1);
            if constexpr (GA) { if (last && has_next) PG8_IDX_READ(nxt, (ui + 1) & 1); }
            PG8_WAIT_V(8); PG8_WAIT_L(0); PG8_BAR; PG8_MMA(0, 0, At, B0); PG8_MMA(0, 1, At, B1); PG8_BAR; PG8_SCHED;
            PG8_LDA(At, 0, 1); PG8_STAGE(PG8_SB(0, 0), b2, voffB); PG8_STAGE(PG8_SB(0, 1), b2 + hstepB, voffB); PG8_STAGE_A(PG8_SA(0, 0), a2, 0);
            PG8_WAIT_V(8); PG8_WAIT_L(0); PG8_BAR; PG8_MMA(1, 0, At, B0); PG8_MMA(1, 1, At, B1); PG8_BAR; PG8_SCHED;
            PG8_LDB(B0, 1, 0); PG8_LDB(B1, 1, 1); PG8_SCHED; PG8_LDA(At, 1, 0); PG8_STAGE_A(PG8_SA(0, 1), a2 + hstepA, 1);
            PG8_WAIT_V(8); PG8_WAIT_L(0); PG8_BAR; PG8_MMA(0, 0, At, B0); PG8_MMA(0, 1, At, B1); PG8_BAR; PG8_SCHED;
            PG8_LDA(At, 1, 1); PG8_STAGE(PG8_SB(1, 0), b3, voffB); PG8_STAGE(PG8_SB(1, 1), b3 + hstepB, voffB); PG8_STAGE_A(PG8_SA(1, 0), a3, 0);
            PG8_WAIT_V(8); PG8_WAIT_L(0); PG8_BAR; PG8_MMA(1, 0, At, B0); PG8_MMA(1, 1, At, B1); PG8_BAR; PG8_SCHED;
        }
        if (wr == 0) PG8_BAR;
        E(acc, cur, wr, wc, fr, fq);
        if (!has_next) break;
#pragma unroll
        for (int a = 0; a < 2; ++a)
#pragma unroll
            for (int b = 0; b < 2; ++b)
#pragma unroll
                for (int m = 0; m < 4; ++m)
#pragma unroll
                    for (int n = 0; n < 2; ++n) acc[a][b][m][n] = (f32x4){0.f, 0.f, 0.f, 0.f};
        cur = nxt; cA = nA; cB = nB; ++ui;
        if (wr == 1) PG8_BAR;
    }
    PG8_WAIT_V(0);
    PG8_BAR;
#undef PG8_SA
#undef PG8_SB
#undef PG8_STAGE
#undef PG8_STAGE_A
#undef PG8_IDX_ISSUE
#undef PG8_IDX_READ
#undef PG8_LDA
#undef PG8_LDB
#undef PG8_MMA
#undef PG8_WAIT_V
#undef PG8_WAIT_L
#undef PG8_BAR
#undef PG8_SCHED
}

template <class F> struct Epi8 {
    F f;
    __device__ __forceinline__ void operator()(const f32x4 (&acc)[2][2][4][2], const Unit& u, int wr, int wc, int fr, int fq) const {
        const int row0 = u.pm * BM + wr * 64 + fr, col0 = u.pn * BM + wc * 32 + 8 * fq;
#pragma unroll
        for (int ai = 0; ai < 2; ++ai)
#pragma unroll
            for (int m = 0; m < 4; ++m)
#pragma unroll
                for (int bj = 0; bj < 2; ++bj) { f(row0 + ai * HALF + m * 16, col0 + bj * HALF, acc[ai][bj][m][0], acc[ai][bj][m][1]); __builtin_amdgcn_sched_barrier(0); }
    }
};
template <class F> struct Epi8P {
    F f;
    __device__ __forceinline__ void operator()(const f32x4 (&acc)[2][2][4][2], const Unit& u, int wr, int wc, int fr, int fq) const {
        const int row0 = u.pm * BM + wr * 64 + fr, col0 = u.pn * BM + wc * 32 + 8 * fq;
        typename F::UnitV uv; f.unit(uv, row0, col0);
#pragma unroll
        for (int ai = 0; ai < 2; ++ai) {
            typename F::Pre pre[4][2];
#pragma unroll
            for (int m = 0; m < 4; ++m)
#pragma unroll
                for (int bj = 0; bj < 2; ++bj) f.load(pre[m][bj], row0 + ai * HALF + m * 16, col0 + bj * HALF);
#pragma unroll
            for (int m = 0; m < 4; ++m)
#pragma unroll
                for (int bj = 0; bj < 2; ++bj) f.apply(uv, pre[m][bj], bj, row0 + ai * HALF + m * 16, col0 + bj * HALF, acc[ai][bj][m][0], acc[ai][bj][m][1]);
            __builtin_amdgcn_sched_barrier(0);
        }
    }
};
struct EpiPart {
    float* PART;
    __device__ __forceinline__ void operator()(const f32x4 (&acc)[2][2][4][2], const Unit& u, int wr, int wc, int fr, int fq) const {
        const int row0 = (u.pm - 64) * BM + wr * 64 + fr, col0 = u.pn * BM + wc * 32 + 8 * fq; float* base = PART + (size_t)u.kc * 512 * 1024;
#pragma unroll
        for (int ai = 0; ai < 2; ++ai)
#pragma unroll
            for (int m = 0; m < 4; ++m)
#pragma unroll
                for (int bj = 0; bj < 2; ++bj) { float* d = base + (size_t)(row0 + ai * HALF + m * 16) * 1024 + col0 + bj * HALF; *(f32x4*)d = acc[ai][bj][m][0]; *(f32x4*)(d + 4) = acc[ai][bj][m][1]; }
    }
};
struct EpiPartT {
    bf16* PART; int nm;
    __device__ __forceinline__ void operator()(const f32x4 (&acc)[2][2][4][2], const Unit& u, int wr, int wc, int fr, int fq) const {
        const int row0 = (u.pm - nm) * BM + wr * 64 + fr, col0 = (u.pn & 3) * BM + wc * 32 + 8 * fq; bf16* base = PART + (size_t)u.kc * 2048 * 1024;
#pragma unroll
        for (int ai = 0; ai < 2; ++ai)
#pragma unroll
            for (int m = 0; m < 4; ++m)
#pragma unroll
                for (int bj = 0; bj < 2; ++bj) { const f32x4 v0 = acc[ai][bj][m][0], v1 = acc[ai][bj][m][1]; u32x4 w; w.x = pk2s(v0[0], v0[1]); w.y = pk2s(v0[2], v0[3]); w.z = pk2s(v1[0], v1[1]); w.w = pk2s(v1[2], v1[3]);
                    *(u32x4*)(base + (size_t)(row0 + ai * HALF + m * 16) * 1024 + col0 + bj * HALF) = w; }
    }
};
template <class F> struct EpiGU {
    F f; int tiles_per_mat;
    __device__ __forceinline__ void operator()(const f32x4 (&acc)[2][2][4][2], const Unit& u, int wr, int wc, int fr, int fq) const {
        const int row0 = u.pm * BM + wr * 64 + fr, col0 = (u.pn % tiles_per_mat) * HALF + wc * 32 + 8 * fq;
#pragma unroll
        for (int ai = 0; ai < 2; ++ai)
#pragma unroll
            for (int m = 0; m < 4; ++m) {
                float o[8];
#pragma unroll
                for (int n = 0; n < 2; ++n)
#pragma unroll
                    for (int q = 0; q < 4; ++q) { const float gt = acc[ai][0][m][n][q], up = acc[ai][1][m][n][q]; o[n * 4 + q] = gt * __builtin_amdgcn_rcpf(1.f + __expf(-gt)) * up; }
                f(row0 + ai * HALF + m * 16, col0, o);
            }
    }
};
}

#define XB_TMO      128
#define XB_XCNT(j)  (256  + 64 * (j))
#define XB_XSUB(j)  (1280 + 64 * (j))
#define XB_XGEN(j)  (2304 + 64 * (j))
#define XB_TOP      3328
#define XB_TOPGEN   3392
#define XCD_BAR_WORDS 3456
#define XB_SPIN_CAP (1u << 18)
__device__ __forceinline__ unsigned xb_ld(unsigned* p)              { return __hip_atomic_load(p, __ATOMIC_RELAXED, __HIP_MEMORY_SCOPE_AGENT); }
__device__ __forceinline__ unsigned xb_add(unsigned* p, unsigned v) { return __hip_atomic_fetch_add(p, v, __ATOMIC_RELAXED, __HIP_MEMORY_SCOPE_AGENT); }
__device__ __forceinline__ unsigned xb_xcc_id() { return (unsigned)__builtin_amdgcn_s_getreg((3 << 11) | 20) & 0xFu; }
#define XB_SPIN(cond, bar) do { unsigned _sp = 0; while (cond) { __builtin_amdgcn_s_sleep(1); \
    if ((++_sp & 255u) == 0u) { if (xb_ld(&(bar)[XB_TMO])) break; if (_sp > XB_SPIN_CAP) { atomicAdd(&(bar)[XB_TMO], 1u); break; } } } } while (0)
struct XcdBarrier { unsigned* bar; unsigned x; volatile LAS unsigned* st; };
__device__ __forceinline__ XcdBarrier xcd_barrier_post(unsigned* bar, volatile LAS unsigned* st) {
    XcdBarrier b; b.bar = bar; b.x = xb_xcc_id(); b.st = st;
    if (threadIdx.x == 0) (void)xb_add(&bar[XB_XCNT(b.x)], 1u);
    return b;
}
__device__ __forceinline__ void xcd_barrier_complete(unsigned* bar, unsigned x, unsigned& nloc, unsigned& nx) {
    const unsigned G = gridDim.x * gridDim.y * gridDim.z;
    unsigned sum, cnt, mine, sp = 0u;
    for (;;) {
        sum = 0u; cnt = 0u; mine = 0u;
#pragma unroll
        for (unsigned j = 0; j < 16; ++j) { const unsigned c = xb_ld(&bar[XB_XCNT(j)]); sum += c; cnt += (c > 0u) ? 1u : 0u; mine = (j == x) ? c : mine; }
        if (sum == G) break;
        __builtin_amdgcn_s_sleep(1);
        if ((++sp & 255u) == 0u) { if (xb_ld(&bar[XB_TMO])) break; if (sp > XB_SPIN_CAP) { atomicAdd(&bar[XB_TMO], 1u); break; } }
    }
    nloc = mine > 0u ? mine : 1u; nx = cnt > 0u ? cnt : 1u;
}
__device__ __forceinline__ void xcd_barrier(const XcdBarrier& b) {
    asm volatile("s_waitcnt vmcnt(0)" ::: "memory");
    __syncthreads();
    if (threadIdx.x == 0) {
        unsigned* bar = b.bar;
        __builtin_amdgcn_s_waitcnt(0);
        unsigned nloc = b.st[0], nx = b.st[1];
        if (nloc == 0u) { xcd_barrier_complete(bar, b.x, nloc, nx); b.st[0] = nloc; b.st[1] = nx; }
        const unsigned old = xb_add(&bar[XB_XSUB(b.x)], 1u);
        const unsigned gen = old / nloc;
        if (old + 1u == (gen + 1u) * nloc) {
            __builtin_amdgcn_fence(__ATOMIC_RELEASE, "agent");
            asm volatile("s_waitcnt vmcnt(0)" ::: "memory");
            const unsigned og = xb_add(&bar[XB_TOP], 1u);
            const unsigned tg = og / nx;
            if (og + 1u == (tg + 1u) * nx) xb_add(&bar[XB_TOPGEN], 1u);
            else XB_SPIN(xb_ld(&bar[XB_TOPGEN]) == tg, bar);
            __builtin_amdgcn_fence(__ATOMIC_ACQUIRE, "agent");
            xb_add(&bar[XB_XGEN(b.x)], 1u);
            asm volatile("s_waitcnt vmcnt(0)" ::: "memory");
        } else {
            XB_SPIN(xb_ld(&bar[XB_XGEN(b.x)]) == gen, bar);
            __builtin_amdgcn_fence(__ATOMIC_ACQUIRE, "agent");
            asm volatile("s_waitcnt vmcnt(0)" ::: "memory");
        }
    }
    __syncthreads();
}

struct Args {
    const float* in[25];
    float* out; unsigned char* ws;
    int ph_lo, ph_hi;
};
enum { I_X = 0, I_C, I_CTX, I_CCTX, I_WMOD, I_BMOD, I_LN1, I_LN2, I_WIN, I_WG2, I_BG2, I_GLAG, I_QNG, I_WUQ, I_KVNG, I_WUKV, I_WOUT, I_FG, I_FU, I_FD, I_RW, I_EG, I_EU, I_ED, I_FNG };

struct Ctx {
    LAS unsigned char* lds; unsigned char* ldsg; unsigned char* ws; unsigned char* arena; const float* const* in; float* out;
    int tid, lane, wave, G, bid, vcu;
};

__device__ __forceinline__ int mod_row(int row) { return row < NLAT ? (row >> 13) : 2; }
__device__ __forceinline__ void row_bpos(int row, int& b, int& pos) { if (row < NLAT) { b = row >> 13; pos = row & (TT - 1); } else { const int r2 = row - NLAT; b = r2 >> 8; pos = TT + (r2 & 255); } }
__device__ __forceinline__ int chunk_row(int b, int a) { return a < 128 ? b * TT + a * 64 : NLAT + b * TC + (a - 128) * 64; }

template <class SrcFn>
__device__ __forceinline__ void transpose_item(const SrcFn& src, bf16* dst, int ldk, int k0, int n0, LAS float* scr, int lane, const float* kscale = nullptr) {
    float tv[64];
#pragma unroll
    for (int i = 0; i < 64; ++i) tv[i] = src(k0 + i, n0 + lane);
#pragma unroll
    for (int i = 0; i < 64; ++i) scr[i * 65 + lane] = tv[i];
    LDS_WAIT(); asm volatile("" ::: "memory");
    const int c = lane & 7;
    f32x4 ks0 = {1.f, 1.f, 1.f, 1.f}, ks1 = ks0;
    if (kscale) { ks0 = *(const f32x4*)(kscale + k0 + 8 * c); ks1 = *(const f32x4*)(kscale + k0 + 8 * c + 4); }
#pragma unroll
    for (int j = 0; j < 8; ++j) { const int n = (lane >> 3) + 8 * j; const LAS float* s = scr + (8 * c) * 65 + n;
        u32x4 o; o.x = pk2(s[0 * 65] * ks0.x, s[1 * 65] * ks0.y); o.y = pk2(s[2 * 65] * ks0.z, s[3 * 65] * ks0.w); o.z = pk2(s[4 * 65] * ks1.x, s[5 * 65] * ks1.y); o.w = pk2(s[6 * 65] * ks1.z, s[7 * 65] * ks1.w);
        *(u32x4*)(dst + (size_t)(n0 + n) * ldk + k0 + 8 * c) = o; }
    LDS_WAIT(); asm volatile("" ::: "memory");
}
__device__ __forceinline__ void transpose_item_fast(const float* S, int ld, bf16* dst, int ldk, int k0, int n0, LAS float* scr, int lane, const float* rowscale = nullptr) {
    f32x4 v[16];
#pragma unroll
    for (int i = 0; i < 16; ++i) v[i] = __builtin_nontemporal_load((const f32x4*)(S + (size_t)(i * 4 + (lane >> 4)) * ld + (lane & 15) * 4));
    if (rowscale) { float rsc[16];
#pragma unroll
        for (int i = 0; i < 16; ++i) rsc[i] = rowscale[i * 4 + (lane >> 4)];
#pragma unroll
        for (int i = 0; i < 16; ++i) v[i] *= rsc[i]; }
#pragma unroll
    for (int i = 0; i < 16; ++i) { LAS float* p = scr + (i * 4 + (lane >> 4)) * 65 + (lane & 15) * 4; p[0] = v[i].x; p[1] = v[i].y; p[2] = v[i].z; p[3] = v[i].w; }
    LDS_WAIT(); asm volatile("" ::: "memory");
    const int c = lane & 7;
#pragma unroll
    for (int j = 0; j < 8; ++j) { const int n = (lane >> 3) + 8 * j; const LAS float* s = scr + (8 * c) * 65 + n;
        u32x4 o; o.x = pk2(s[0 * 65], s[1 * 65]); o.y = pk2(s[2 * 65], s[3 * 65]); o.z = pk2(s[4 * 65], s[5 * 65]); o.w = pk2(s[6 * 65], s[7 * 65]);
        *(u32x4*)(dst + (size_t)(n0 + n) * ldk + k0 + 8 * c) = o; }
    LDS_WAIT(); asm volatile("" ::: "memory");
}
__device__ __forceinline__ int rope_unperm(int jj) { const int pair = jj >> 1, which = jj & 1; return pair < 16 ? pair + 16 * which : 32 + (pair - 16) + 16 * which; }
__device__ __forceinline__ int win_src_col(int n) {
    if (n < 1024) return n;
    if (n < 1536) return 1056 + (n - 1024);
    if (n < 1792) return 1568 + (n - 1536);
    if (n < 1920) return 1824 + (n - 1792);
    if (n < 1984) return 1952 + rope_unperm(n - 1920);
    if (n < 2000) return 1024 + (n - 1984);
    if (n < 2016) return 1040 + (n - 2000);
    return -1;
}

__device__ __forceinline__ void convert_weights(const Ctx& C, bool first, int gw, int NGW) {
    LAS float* scr = (LAS float*)(C.lds + C.wave * 16640);
    int rr = 0;
#define CW_FIRST(N) ((gw - rr % NGW + NGW) % NGW); rr += (N)
    for (int l = 0; l < 2; ++l) {
        if (first == (l == 0))
        {
            const float* W = C.in[I_WIN] + (size_t)l * 1024 * 2016; bf16* dst = (bf16*)(C.arena + A_WIN) + (size_t)l * 2048 * 1024;
            auto f = [=](int k, int n) -> float { const int sc = win_src_col(n); return sc < 0 ? 0.f : W[(size_t)k * 2016 + sc]; };
            const int f0 = CW_FIRST(16 * 32);
            for (int it = f0; it < 16 * 32; it += NGW) { const int k0 = (it >> 5) * 64, n0 = (it & 31) * 64;
                if (n0 < 1920) transpose_item_fast(W + (size_t)k0 * 2016 + win_src_col(n0), 2016, dst, 1024, k0, n0, scr, C.lane);
                else transpose_item(f, dst, 1024, k0, n0, scr, C.lane); }
        }
        if (!first)
        {
            const float* Wq = C.in[I_WUQ] + (size_t)l * 256 * 768; const float* gq = C.in[I_QNG] + l * 256; const float* Wk = C.in[I_WUKV] + (size_t)l * 128 * 1024; const float* gk = C.in[I_KVNG] + l * 128;
            bf16* dst = (bf16*)(C.arena + A_WQKV) + (size_t)l * 1792 * 384;
            auto f = [=](int k, int n) -> float {
                if (n < 768) { if (k >= 256) return 0.f; const int h = n / 192, j = n % 192; const int sc = h * 192 + (j < 128 ? j : 128 + rope_unperm(j - 128)); return gq[k] * Wq[(size_t)k * 768 + sc]; }
                if (k < 256) return 0.f; return gk[k - 256] * Wk[(size_t)(k - 256) * 1024 + (n - 768)]; };
            const int f1 = CW_FIRST(6 * 28);
            for (int it = f1; it < 6 * 28; it += NGW) { const int k0 = (it % 6) * 64, n0 = (it / 6) * 64;
                const bool qcol = n0 < 768, qrow = k0 < 256;
                if (qcol != qrow) {
                    const int c = C.lane & 7;
#pragma unroll
                    for (int j = 0; j < 8; ++j) *(u32x4*)(dst + (size_t)(n0 + (C.lane >> 3) + 8 * j) * 384 + k0 + 8 * c) = (u32x4){0u, 0u, 0u, 0u};
                } else if (qcol && (n0 % 192) == 128) {
                    const int scl = (n0 / 192) * 192 + 128 + rope_unperm(C.lane);
                    auto f2 = [=](int k, int) -> float { return Wq[(size_t)k * 768 + scl]; };
                    transpose_item(f2, dst, 384, k0, n0, scr, C.lane, gq); }
                else if (qcol) transpose_item_fast(Wq + (size_t)k0 * 768 + n0, 768, dst, 384, k0, n0, scr, C.lane, gq + k0);
                else transpose_item_fast(Wk + (size_t)(k0 - 256) * 1024 + (n0 - 768), 1024, dst, 384, k0, n0, scr, C.lane, gk + (k0 - 256)); }
        }
        if (!first)
        {
            const float* W = C.in[I_WOUT] + (size_t)l * 1024 * 1024; bf16* dst = (bf16*)(C.arena + A_WOUT) + (size_t)l * 1024 * 1024;
            const int f2 = CW_FIRST(16 * 16);
            for (int it = f2; it < 16 * 16; it += NGW) { const int k0 = (it >> 4) * 64, n0 = (it & 15) * 64; transpose_item_fast(W + (size_t)k0 * 1024 + n0, 1024, dst, 1024, k0, n0, scr, C.lane); }
        }
    }
    if (!first)
    {
        bf16* dst = (bf16*)(C.arena + A_FGU);
        const int f3 = CW_FIRST(16 * 88);
        for (int it = f3; it < 16 * 88; it += NGW) { const int k0 = (it & 15) * 64, n0 = (it >> 4) * 64; const int tj = n0 >> 8, c = n0 & 255;
            const float* W = (c < 128) ? C.in[I_FG] : C.in[I_FU]; const int sc = tj * 128 + (c & 127);
            transpose_item_fast(W + (size_t)k0 * DFF + sc, DFF, dst, 1024, k0, n0, scr, C.lane); }
    }
    if (!first)
    {
        bf16* dst = (bf16*)(C.arena + A_FD); const float* W = C.in[I_FD];
        const int f4 = CW_FIRST(44 * 16);
        for (int it = f4; it < 44 * 16; it += NGW) { const int k0 = (it % 44) * 64, n0 = (it / 44) * 64; transpose_item_fast(W + (size_t)k0 * 1024 + n0, 1024, dst, DFF, k0, n0, scr, C.lane); }
    }
}
#undef CW_FIRST
__device__ __forceinline__ void prologue(const Ctx& C) {
    convert_weights(C, true, C.vcu * 8 + C.wave, C.G * 8);
    __syncthreads();
    if (C.vcu < 6) {
        float* R = (float*)(C.ws + WS_ROPE);
        const int i = C.vcu * 512 + C.tid; const int j = i & 15, p = i >> 4; const int pos = p < 128 ? p : p - 128;
        const float inv = powf(10000.f, -(float)j / 16.f); const float ang = (float)pos * inv; R[2 * i] = cosf(ang); R[2 * i + 1] = sinf(ang);
    }
    for (int item = C.G - 1 - C.vcu; item < 192; item += C.G) {
        const int l = item / 96, cg = item % 96;
        LAS float* sil = (LAS float*)C.lds; LAS float* part = sil + 3 * 1024;
        for (int i = C.tid; i < 3 * 1024; i += 512) { const int v = i >> 10, k = i & 1023; const float x = v < 2 ? C.in[I_C][v * 1024 + k] : C.in[I_CCTX][k]; sil[i] = silu_f(x); }
        __syncthreads();
        const int rsub = C.lane >> 4, c4 = (C.lane & 15) * 4;
        f32x4 a0 = {0, 0, 0, 0}, a1 = a0, a2 = a0;
        const float* W = C.in[I_WMOD] + (size_t)l * 1024 * 6144 + cg * 64 + c4;
#pragma unroll 16
        for (int i = 0; i < 32; ++i) { const int k = C.wave * 128 + 4 * i + rsub; const f32x4 w = __builtin_nontemporal_load((const f32x4*)(W + (size_t)k * 6144));
            a0 += w * sil[k]; a1 += w * sil[1024 + k]; a2 += w * sil[2048 + k]; }
        LAS float* pp = part + (C.wave * 4 + rsub) * 192 + c4;
#pragma unroll
        for (int q = 0; q < 4; ++q) { pp[q] = a0[q]; pp[64 + q] = a1[q]; pp[128 + q] = a2[q]; }
        __syncthreads();
        if (C.tid < 192) { const int v = C.tid >> 6, c = C.tid & 63; float s = C.in[I_BMOD][l * 6144 + cg * 64 + c];
#pragma unroll
            for (int p = 0; p < 32; ++p) s += part[p * 192 + v * 64 + c];
            ((float*)(C.ws + WS_MOD))[(l * 3 + v) * 6144 + cg * 64 + c] = s; }
        __syncthreads();
    }
}

__device__ __forceinline__ void load_row16(const float* p, int lane, f32x4 (&v)[4]) {
#pragma unroll
    for (int j = 0; j < 4; ++j) v[j] = *(const f32x4*)(p + 256 * j + 4 * lane);
}
__device__ __forceinline__ void norm_mod_row(f32x4 (&v)[4], const float* g, const float* sc, const float* sh, int lane) {
    float ss = 0.f;
#pragma unroll
    for (int j = 0; j < 4; ++j) ss += (v[j].x * v[j].x + v[j].y * v[j].y) + (v[j].z * v[j].z + v[j].w * v[j].w);
    const float rs = 1.f / sqrtf(wave_sum(ss) * (1.f / DM) + EPS);
#pragma unroll
    for (int j = 0; j < 4; ++j) { const f32x4 gg = *(const f32x4*)(g + 256 * j + 4 * lane), s1 = *(const f32x4*)(sc + 256 * j + 4 * lane), s0 = *(const f32x4*)(sh + 256 * j + 4 * lane);
        v[j] = (v[j] * rs * gg) * (s1 + 1.f) + s0; }
}
__device__ __forceinline__ void store_row16_bf16(bf16* p, int lane, const f32x4 (&v)[4]) {
#pragma unroll
    for (int j = 0; j < 4; ++j) { u32x2 w; w.x = pk2(v[j].x, v[j].y); w.y = pk2(v[j].z, v[j].w); *(u32x2*)(p + 256 * j + 4 * lane) = w; }
}
__device__ __forceinline__ void load_row16_bf16(const bf16* p, int lane, f32x4 (&v)[4]) {
#pragma unroll
    for (int j = 0; j < 4; ++j) { const u32x2 w = *(const u32x2*)(p + 256 * j + 4 * lane); v[j] = (f32x4){bflo(w.x), bfhi(w.x), bflo(w.y), bfhi(w.y)}; }
}
__device__ __forceinline__ void load_xin_row(const Ctx& C, int layer, int row, f32x4 (&v)[4]) {
    if (layer == 0) load_row16(row < NLAT ? C.in[I_X] + (size_t)row * DM : C.in[I_CTX] + (size_t)(row - NLAT) * DM, C.lane, v);
    else load_row16_bf16((const bf16*)(C.ws + WS_XL) + (size_t)row * DM, C.lane, v);
}

__device__ __forceinline__ void phase_norm1(const Ctx& C, int layer) {
    const int gw = C.vcu * 8 + C.wave, NGW = C.G * 8;
    const float* g = C.in[I_LN1] + layer * DM; const float* MOD = (const float*)(C.ws + WS_MOD) + (size_t)layer * 3 * 6144; bf16* H = (bf16*)(C.ws + WS_H);
    for (int row = gw; row < MR; row += NGW) {
        f32x4 v[4]; load_xin_row(C, layer, row, v);
        if (layer == 1 && row >= NLAT) {
            const float* PART = (const float*)(C.arena + R_PART) + (size_t)(row - NLAT) * 1024; const float* g2c = (const float*)(C.ws + WS_MOD) + 2 * 6144 + 5 * 1024;
#pragma unroll
            for (int j = 0; j < 4; ++j) { f32x4 t[11];
#pragma unroll
                for (int c = 0; c < 11; ++c) t[c] = *(const f32x4*)(PART + (size_t)c * 512 * 1024 + 256 * j + 4 * C.lane);
                f32x4 acc = t[0];
#pragma unroll
                for (int c = 1; c < 11; ++c) acc += t[c];
                v[j] += *(const f32x4*)(g2c + 256 * j + 4 * C.lane) * acc; } }
        const float* m = MOD + mod_row(row) * 6144;
        norm_mod_row(v, g, m + 1024, m, C.lane);
        store_row16_bf16(H + (size_t)row * DM, C.lane, v);
    }
}

__device__ __forceinline__ void phase_norm2(const Ctx& C, int layer) {
    const int gw = C.vcu * 8 + C.wave, NGW = C.G * 8;
    const float* g = C.in[I_LN2] + layer * DM; const float* MOD = (const float*)(C.ws + WS_MOD) + (size_t)layer * 3 * 6144; bf16* H = layer == 0 ? (bf16*)(C.ws + WS_H) : (bf16*)(C.arena + M_HS);
    const bf16* XL = (const bf16*)(C.ws + WS_XL); int* LISTE = (int*)(C.arena + M_LISTE);
    const int nrow = layer == 0 ? MR : NLAT;
    unsigned* ctl = (unsigned*)(C.ws + WS_CTL);
    int* PE = (int*)(C.ws + WS_LIST); int* PS = PE + NLAT * 2; float* PWt = (float*)(PS + NLAT * 2);
    LAS unsigned* lcnt = (LAS unsigned*)(C.lds + 140000); LAS unsigned* gbase = lcnt + 8;
    const int maxit = (nrow + NGW - 1) / NGW;
    f32x4 rw[32];
    if (layer == 1) {
#pragma unroll
        for (int j = 0; j < 4; ++j)
#pragma unroll
            for (int q = 0; q < 4; ++q) { const float* RWp = C.in[I_RW] + (256 * j + 4 * C.lane + q) * 8; rw[(j * 4 + q) * 2] = *(const f32x4*)RWp; rw[(j * 4 + q) * 2 + 1] = *(const f32x4*)(RWp + 4); }
    }
    for (int b0 = 0; b0 < maxit; b0 += 64) {
        int my_e1 = 0, my_e2 = 0, my_row = -1; float my_d = 0.f;
        if (layer == 1) { if (C.tid < 8) lcnt[C.tid] = 0u; }
        const int b1 = (b0 + 64 < maxit) ? b0 + 64 : maxit;
        for (int it = b0; it < b1; ++it) {
            const int row = gw + it * NGW; if (row >= nrow) break;
            f32x4 v[4];
            if (layer == 0 && row >= NLAT) {
                load_row16(C.in[I_CTX] + (size_t)(row - NLAT) * DM, C.lane, v);
                const float* PART = (const float*)(C.arena + R_PART) + (size_t)(row - NLAT) * 1024; const float* g1c = MOD + 2 * 6144 + 2 * 1024;
#pragma unroll
                for (int j = 0; j < 4; ++j) { f32x4 t[4];
#pragma unroll
                    for (int c = 0; c < 4; ++c) t[c] = *(const f32x4*)(PART + (size_t)c * 512 * 1024 + 256 * j + 4 * C.lane);
                    const f32x4 acc = ((t[0] + t[1]) + t[2]) + t[3];
                    v[j] += *(const f32x4*)(g1c + 256 * j + 4 * C.lane) * acc; }
                store_row16_bf16((bf16*)(C.ws + WS_XL) + (size_t)row * DM, C.lane, v);
                load_row16_bf16(XL + (size_t)row * DM, C.lane, v);
            } else load_row16_bf16(XL + (size_t)row * DM, C.lane, v);
            const float* m = MOD + mod_row(row) * 6144;
            norm_mod_row(v, g, m + 4096, m + 3072, C.lane);
            store_row16_bf16(H + (size_t)row * DM, C.lane, v);
            if (layer == 1) {
                float lg[8];
#pragma unroll
                for (int e = 0; e < 8; ++e) lg[e] = 0.f;
#pragma unroll
                for (int j = 0; j < 4; ++j)
#pragma unroll
                    for (int q = 0; q < 4; ++q) { const f32x4 w0 = rw[(j * 4 + q) * 2], w1 = rw[(j * 4 + q) * 2 + 1]; const float x = v[j][q];
                        lg[0] += x * w0.x; lg[1] += x * w0.y; lg[2] += x * w0.z; lg[3] += x * w0.w; lg[4] += x * w1.x; lg[5] += x * w1.y; lg[6] += x * w1.z; lg[7] += x * w1.w; }
#pragma unroll
                for (int e = 0; e < 8; ++e) lg[e] = wave_sum(lg[e]);
                int e1 = 0; float v1 = lg[0];
#pragma unroll
                for (int e = 1; e < 8; ++e) if (lg[e] > v1) { v1 = lg[e]; e1 = e; }
                int e2 = -1; float v2 = -3.0e38f;
#pragma unroll
                for (int e = 0; e < 8; ++e) if (e != e1 && lg[e] > v2) { v2 = lg[e]; e2 = e; }
                if (C.lane == (it & 63)) { my_e1 = e1; my_e2 = e2; my_row = row; my_d = v2 - v1; }
            }
        }
        if (layer == 1) {
            __syncthreads();
            unsigned r1 = 0u, r2 = 0u;
            if (my_row >= 0) { r1 = __hip_atomic_fetch_add(lcnt + my_e1, 1u, __ATOMIC_RELAXED, __HIP_MEMORY_SCOPE_WORKGROUP); r2 = __hip_atomic_fetch_add(lcnt + my_e2, 1u, __ATOMIC_RELAXED, __HIP_MEMORY_SCOPE_WORKGROUP); }
            __syncthreads();
            if (C.tid < 8) { const unsigned n = lcnt[C.tid]; gbase[C.tid] = n ? atomicAdd(ctl + CW_CNT + 64 * C.tid, n) : 0u; }
            __syncthreads();
            if (my_row >= 0) {
                const float w1 = 1.f / (1.f + expf(my_d)), w2 = 1.f - w1;
                const unsigned s1 = gbase[my_e1] + r1, s2 = gbase[my_e2] + r2;
                PE[my_row * 2] = my_e1; PE[my_row * 2 + 1] = my_e2; PS[my_row * 2] = (int)s1; PS[my_row * 2 + 1] = (int)s2; PWt[my_row * 2] = w1; PWt[my_row * 2 + 1] = w2;
                LISTE[my_e1 * 16384 + (int)s1] = my_row * 2; LISTE[my_e2 * 16384 + (int)s2] = my_row * 2 + 1;
            }
            __syncthreads();
        }
    }
    if (layer == 1) {
        int* ENT = (int*)(C.ws + WS_LIST + AL((size_t)NLAT * 2 * 4 * 3));
        for (int i = C.vcu * 512 + C.tid; i < MAXT * 256; i += C.G * 512) ENT[i] = -1;
    }
}

__device__ __forceinline__ void convert_expert_gu(const Ctx& C, int gw, int NGW) {
    LAS float* scr = (LAS float*)(C.lds + C.wave * 16640); bf16* EGU = (bf16*)(C.arena + M_EGU);
    for (int it = gw; it < NEXP * 16 * 112; it += NGW) { const int e = it / (16 * 112), r = it % (16 * 112), k0 = (r & 15) * 64, n0 = (r >> 4) * 64; const int tj = n0 >> 8, c = n0 & 255;
        const float* W = ((c < 128) ? C.in[I_EG] : C.in[I_EU]) + (size_t)e * 1024 * DFE; const int sc = tj * 128 + (c & 127);
        transpose_item_fast(W + (size_t)k0 * DFE + sc, DFE, EGU + (size_t)e * 2 * DFE * 1024, 1024, k0, n0, scr, C.lane); }
}
constexpr int ED_ITEMS = NEXP * 56 * 16, ED_EARLY = 1920;
__device__ __forceinline__ void convert_expert_down(const Ctx& C, int gw, int NGW, int it0, int it1) {
    LAS float* scr = (LAS float*)(C.lds + C.wave * 16640); bf16* ED = (bf16*)(C.ws + WS_ED);
    for (int it = it0 + gw; it < it1; it += NGW) { const int e = it / (56 * 16), r = it % (56 * 16), k0 = (r % 56) * 64, n0 = (r / 56) * 64;
        const float* W = C.in[I_ED] + (size_t)e * DFE * 1024;
        transpose_item_fast(W + (size_t)k0 * 1024 + n0, 1024, ED + (size_t)e * 1024 * DFE, DFE, k0, n0, scr, C.lane); }
}

__device__ __forceinline__ void moe_tile_bases(const Ctx& C, int (&tb)[9]) {
    unsigned* ctl = (unsigned*)(C.ws + WS_CTL); int acc = 0;
#pragma unroll
    for (int e = 0; e < 8; ++e) { tb[e] = acc; const unsigned c = __hip_atomic_load(ctl + CW_CNT + 64 * e, __ATOMIC_RELAXED, __HIP_MEMORY_SCOPE_AGENT); acc += (int)((c + 255u) >> 8); }
    tb[8] = acc;
}
__device__ __forceinline__ void moe_fill_lists(const Ctx& C) {
    int tb[9]; moe_tile_bases(C, tb);
    const int* PE = (const int*)(C.ws + WS_LIST); const int* PS = PE + NLAT * 2; const float* PWt = (const float*)(PS + NLAT * 2);
    int* ENT = (int*)(C.ws + WS_LIST + AL((size_t)NLAT * 2 * 4 * 3)); float* WTS = (float*)(ENT + MAXT * 256); int* TAILROW = (int*)(C.ws + WS_LIST + AL((size_t)NLAT * 2 * 4 * 3) + AL((size_t)MAXT * 256 * 4 * 2));
    for (int pr = C.vcu * 512 + C.tid; pr < NLAT * 2; pr += C.G * 512) {
        const int e = PE[pr], s = PS[pr]; int base = 0;
#pragma unroll
        for (int k = 0; k < 8; ++k) base = (e == k) ? tb[k] : base;
        const int pos = base * 256 + s;
        ENT[pos] = pr; WTS[pos] = PWt[pr]; TAILROW[pr] = pos >= MOE_MAIN * 256 ? pos - MOE_MAIN * 256 : -1;
    }
}

__device__ __forceinline__ void moe_tail_reduce0(const Ctx& C) {
    const int gw = C.vcu * 8 + C.wave, NGW = C.G * 8;
    int tb[9]; moe_tile_bases(C, tb); const int ntail = tb[8] > MOE_MAIN ? tb[8] - MOE_MAIN : 0;
    const int* ENT = (const int*)(C.ws + WS_LIST + AL((size_t)NLAT * 2 * 4 * 3)); const float* WTS = (const float*)(ENT + MAXT * 256);
    const bf16* PART = (const bf16*)(C.arena + M_PT0); const float* gate = (const float*)(C.ws + WS_MOD) + (size_t)3 * 6144 + 5 * 1024;
    for (int r = gw; r < ntail * 256; r += NGW) {
        const int pos = MOE_MAIN * 256 + r, ent = ENT[pos]; const float w = WTS[pos];
        u32x2 t[4][MOE_NC0]; f32x4 gv[4];
#pragma unroll
        for (int j = 0; j < 4; ++j)
#pragma unroll
            for (int c = 0; c < MOE_NC0; ++c) t[j][c] = *(const u32x2*)(PART + ((size_t)c * 2048 + r) * 1024 + 256 * j + 4 * C.lane);
        if (ent < 0) continue;
        const int tok = ent >> 1; const float* g = gate + (tok >> 13) * 6144;
        bf16* Y = (bf16*)(C.ws + ((ent & 1) ? WS_H : WS_Y0)) + (size_t)tok * DM;
#pragma unroll
        for (int j = 0; j < 4; ++j) gv[j] = *(const f32x4*)(g + 256 * j + 4 * C.lane);
#pragma unroll
        for (int j = 0; j < 4; ++j) { f32x4 acc = {0.f, 0.f, 0.f, 0.f};
#pragma unroll
            for (int c = 0; c < MOE_NC0; ++c) acc += (f32x4){bflo(t[j][c].x), bfhi(t[j][c].x), bflo(t[j][c].y), bfhi(t[j][c].y)};
            const f32x4 y = gv[j] * w * acc; u32x2 o; o.x = pk2(y.x, y.y); o.y = pk2(y.z, y.w); *(u32x2*)(Y + 256 * j + 4 * C.lane) = o; }
    }
}
__device__ __forceinline__ void phase_final(const Ctx& C) {
    const int gw = C.vcu * 8 + C.wave, NGW = C.G * 8;
    const bf16* XL = (const bf16*)(C.ws + WS_XL); const bf16* Y2 = (const bf16*)(C.ws + WS_H); const bf16* Y0 = (const bf16*)(C.ws + WS_Y0); const float* g = C.in[I_FNG];
    const bf16* Y0b = (const bf16*)(C.arena + M_EGU); const bf16* Y2b = Y0b + (size_t)NLAT * DM;
    const int* TAILROW = (const int*)(C.ws + WS_LIST + AL((size_t)NLAT * 2 * 4 * 3) + AL((size_t)MAXT * 256 * 4 * 2)); const float* PWt = (const float*)(C.ws + WS_LIST) + NLAT * 4;
    const bf16* PART1 = (const bf16*)(C.arena + M_HS); const float* gate = (const float*)(C.ws + WS_MOD) + (size_t)3 * 6144 + 5 * 1024;
    const int maxit = (NLAT + NGW - 1) / NGW;
    for (int b0 = 0; b0 < maxit; b0 += 64) {
        int my_t0 = -1, my_t1 = -1;
        { const int r = gw + (b0 + C.lane) * NGW; if (b0 + C.lane < maxit && r < NLAT) { my_t0 = TAILROW[r * 2]; my_t1 = TAILROW[r * 2 + 1]; } }
        const int b1 = (b0 + 64 < maxit) ? b0 + 64 : maxit;
        for (int it = b0; it < b1; ++it) {
            const int row = gw + it * NGW; if (row >= NLAT) break;
            const int tr0 = __builtin_amdgcn_readlane(my_t0, it - b0), tr1 = __builtin_amdgcn_readlane(my_t1, it - b0);
            u32x2 xa[4], ya[4], za[4], pa[4], qa[4];
#pragma unroll
            for (int j = 0; j < 4; ++j) { const size_t o = (size_t)row * DM + 256 * j + 4 * C.lane;
                xa[j] = *(const u32x2*)(XL + o); ya[j] = *(const u32x2*)(Y2 + o); za[j] = *(const u32x2*)(Y0 + o);
                pa[j] = (u32x2){0u, 0u}; qa[j] = (u32x2){0u, 0u};
                if (tr0 < 0) pa[j] = *(const u32x2*)(Y0b + o);
                if (tr1 < 0) qa[j] = *(const u32x2*)(Y2b + o); }
            f32x4 v[4];
#pragma unroll
            for (int j = 0; j < 4; ++j) {
                v[j].x = bflo(xa[j].x) + (bflo(ya[j].x) + bflo(za[j].x)); v[j].y = bfhi(xa[j].x) + (bfhi(ya[j].x) + bfhi(za[j].x));
                v[j].z = bflo(xa[j].y) + (bflo(ya[j].y) + bflo(za[j].y)); v[j].w = bfhi(xa[j].y) + (bfhi(ya[j].y) + bfhi(za[j].y));
                v[j].x += bflo(pa[j].x); v[j].y += bfhi(pa[j].x); v[j].z += bflo(pa[j].y); v[j].w += bfhi(pa[j].y);
                v[j].x += bflo(qa[j].x); v[j].y += bfhi(qa[j].x); v[j].z += bflo(qa[j].y); v[j].w += bfhi(qa[j].y); }
#pragma unroll
            for (int k = 0; k < 2; ++k) { const int tr = k ? tr1 : tr0;
                if (tr >= 0) { const float w = PWt[row * 2 + k]; const float* gt = gate + (row >> 13) * 6144;
#pragma unroll
                    for (int j = 0; j < 4; ++j) { u32x2 t[MOE_NC1];
#pragma unroll
                        for (int c = 0; c < MOE_NC1; ++c) t[c] = *(const u32x2*)(PART1 + ((size_t)c * 2048 + tr) * 1024 + 256 * j + 4 * C.lane);
                        f32x4 acc = {0.f, 0.f, 0.f, 0.f};
#pragma unroll
                        for (int c = 0; c < MOE_NC1; ++c) acc += (f32x4){bflo(t[c].x), bfhi(t[c].x), bflo(t[c].y), bfhi(t[c].y)};
                        v[j] += *(const f32x4*)(gt + 256 * j + 4 * C.lane) * w * acc; } } }
            float ss = 0.f;
#pragma unroll
            for (int j = 0; j < 4; ++j) ss += (v[j].x * v[j].x + v[j].y * v[j].y) + (v[j].z * v[j].z + v[j].w * v[j].w);
            const float rs = 1.f / sqrtf(wave_sum(ss) * (1.f / DM) + EPS);
#pragma unroll
            for (int j = 0; j < 4; ++j) { const f32x4 gg = *(const f32x4*)(g + 256 * j + 4 * C.lane); *(f32x4*)(C.out + (size_t)row * DM + 256 * j + 4 * C.lane) = v[j] * rs * gg; }
        }
    }
}

__device__ __forceinline__ void phase_mla_prep(const Ctx& C, int gw, int NGW) {
    const bf16* P = (const bf16*)(C.arena + R_P); bf16* CQKV = (bf16*)(C.arena + R_CQKV); char* KBc = (char*)(C.arena + R_KB);
    const float* ROPE = (const float*)(C.ws + WS_ROPE);
    for (int row = gw; row < MR; row += NGW) {
        const bf16* pr = P + (size_t)row * PW;
        {   const u32x2 w = *(const u32x2*)(pr + PC_CQ + 4 * C.lane); float x0 = bflo(w.x), x1 = bfhi(w.x), x2 = bflo(w.y), x3 = bfhi(w.y);
            const float rs = 1.f / sqrtf(wave_sum(x0 * x0 + x1 * x1 + x2 * x2 + x3 * x3) * (1.f / 256.f) + EPS);
            u32x2 o; o.x = pk2(x0 * rs, x1 * rs); o.y = pk2(x2 * rs, x3 * rs); *(u32x2*)(CQKV + (size_t)row * 384 + 4 * C.lane) = o; }
        {   const unsigned w = *(const unsigned*)(pr + PC_CKV + 2 * C.lane); float x0 = bflo(w), x1 = bfhi(w);
            const float rs = 1.f / sqrtf(wave_sum(x0 * x0 + x1 * x1) * (1.f / 128.f) + EPS);
            *(unsigned*)(CQKV + (size_t)row * 384 + 256 + 2 * C.lane) = pk2(x0 * rs, x1 * rs); }
        {   float x = bf2f(pr[PC_KR + C.lane]); const float xo = __shfl_xor(x, 1);
            int b, pos; row_bpos(row, b, pos);
            if (row < NLAT) { const int pair = C.lane >> 1, fi = pair & 15, axis = pair >> 4; const int pidx = axis ? (pos & 63) : (pos >> 6);
                const float* cs = ROPE + ((axis ? 128 : 0) + pidx) * 32 + fi * 2; const float c = cs[0], s = cs[1];
                x = (C.lane & 1) ? (x * c + xo * s) : (x * c - xo * s); }
            const bf16 xb = (bf16)f2bf(x);
#pragma unroll
            for (int h = 0; h < 4; ++h) *(bf16*)(KBc + ((size_t)(b * 4 + h) * 132 + (pos >> 6)) * att::KT_BYTES + (16 + (C.lane >> 3)) * 1024 + (pos & 63) * 16 + (C.lane & 7) * 2) = xb; }
    }
}

__device__ __forceinline__ f32x4 mma16(bf16x8 a, bf16x8 b, f32x4 c) { return __builtin_amdgcn_mfma_f32_16x16x32_bf16(a, b, c, 0, 0, 0); }
constexpr int LS = 72;

__device__ __forceinline__ void phase_gla_local(const Ctx& C, int layer) {
    LAS float* codes = (LAS float*)C.lds;
    LAS float* bcum = codes + 64 * 32;
    LAS float* gsum = bcum + 2 * 64 * 64;
    LAS float* tot = gsum + 2 * 4 * 64;
    LAS bf16* vT = (LAS bf16*)(tot + 128);
    LAS bf16* khT = vT + 128 * LS;
    const bf16* P = (const bf16*)(C.arena + R_P);
    bf16* QT = (bf16*)(C.arena + R_QT); bf16* KT = (bf16*)(C.arena + R_KT);
    float* SLOC = (float*)(C.arena + R_SLOC); float* DEC = (float*)(C.arena + R_DEC);
    const float* WG2 = C.in[I_WG2] + (size_t)layer * 2 * 16 * 256; const float* BG2 = C.in[I_BG2] + (size_t)layer * 2 * 256;
    const int tid = C.tid, lane = C.lane;
    for (int L = C.bid; L < NB * NCH * 4; L += C.G) {
        const int h = L & 3, a = (L >> 2) % NCH, b = L / (NCH * 4);
        const int rbase = chunk_row(b, a);
        {
            const int t = tid >> 3, j4 = (tid & 7) * 4; const u32x2 w = *(const u32x2*)(P + (size_t)(rbase + t) * PW + PC_GF + j4);
            LAS float* cp = codes + t * 32 + j4; cp[0] = bflo(w.x); cp[1] = bfhi(w.x); cp[2] = bflo(w.y); cp[3] = bfhi(w.y);
            const int e0 = (tid & 7) * 16; const bf16* vp = P + (size_t)(rbase + t) * PW + PC_V + h * 128 + e0;
            const u32x4 v0 = *(const u32x4*)vp, v1 = *(const u32x4*)(vp + 8); bf16 vr[16]; unpack8_raw(v0, vr); unpack8_raw(v1, vr + 8);
#pragma unroll
            for (int i = 0; i < 16; ++i) vT[(e0 + i) * LS + t] = vr[i];
        }
        __syncthreads();
        const int dir = tid >> 8, tg = (tid >> 6) & 3, d = tid & 63;
        {
            float w[16];
#pragma unroll
            for (int r = 0; r < 16; ++r) w[r] = WG2[(dir * 16 + r) * 256 + h * 64 + d];
            const float bias = BG2[dir * 256 + h * 64 + d];
            float acc = 0.f;
#pragma unroll
            for (int ii = 0; ii < 16; ++ii) { const int i = dir ? 15 - ii : ii; const int t = tg * 16 + i; float pre = bias;
#pragma unroll
                for (int r4 = 0; r4 < 4; ++r4) { const f32x4 cv = *(const LAS f32x4*)(codes + t * 32 + dir * 16 + 4 * r4); pre += cv.x * w[4 * r4] + cv.y * w[4 * r4 + 1] + cv.z * w[4 * r4 + 2] + cv.w * w[4 * r4 + 3]; }
                acc += logsig_f(pre) * (1.f / 16.f); bcum[(dir * 64 + t) * 64 + d] = acc; }
            gsum[(dir * 4 + tg) * 64 + d] = acc;
        }
        __syncthreads();
        {   float off = 0.f, total = 0.f;
#pragma unroll
            for (int g2 = 0; g2 < 4; ++g2) { const float s = gsum[(dir * 4 + g2) * 64 + d]; total += s; if (dir ? (g2 > tg) : (g2 < tg)) off += s; }
#pragma unroll
            for (int i = 0; i < 16; ++i) bcum[(dir * 64 + tg * 16 + i) * 64 + d] += off;
            if (tg == 0) tot[dir * 64 + d] = __expf(total);
        }
        __syncthreads();
        {
            const int t = (tid >> 2) & 63, d0 = (tid & 3) * 16; const size_t row = (size_t)(rbase + t);
            const bf16* qp = P + row * PW + PC_Q + h * 64 + d0; const bf16* kp = P + row * PW + PC_K + h * 64 + d0;
            float q[16], k[16]; unpack8(*(const u32x4*)qp, q); unpack8(*(const u32x4*)(qp + 8), q + 8); unpack8(*(const u32x4*)kp, k); unpack8(*(const u32x4*)(kp + 8), k + 8);
            float qo[16], ko[16];
#pragma unroll
            for (int i = 0; i < 16; ++i) { const float eB = __expf(bcum[(dir * 64 + t) * 64 + d0 + i]), et = tot[dir * 64 + d0 + i];
                qo[i] = q[i] * 0.125f * eB; ko[i] = k[i] * __builtin_amdgcn_rcpf(eB); khT[(dir * 64 + d0 + i) * LS + t] = (bf16)f2bf(ko[i] * et); }
            bf16* qd = QT + ((size_t)dir * MR + row) * 256 + h * 64 + d0; bf16* kd = KT + ((size_t)dir * MR + row) * 256 + h * 64 + d0;
            *(u32x4*)qd = pack8h(qo); *(u32x4*)(qd + 8) = pack8h(qo + 8); *(u32x4*)kd = pack8h(ko); *(u32x4*)(kd + 8) = pack8h(ko + 8);
        }
        const int pf = a < 128 ? a + 4 : a - 128, pb = 131 - a;
        if (tid < 128) { const int dd = tid >> 6, d2 = tid & 63; const int chain = dd * 8 + b * 4 + h, p = dd ? pb : pf; DEC[((size_t)chain * NCH + p) * 64 + d2] = tot[dd * 64 + d2]; }
        __syncthreads();
        {
            const int fr = lane & 15, fq = lane >> 4;
#pragma unroll 2
            for (int i = 0; i < 8; ++i) { const int id = C.wave * 8 + i, dd = id >> 5, et = (id >> 2) & 7, dt = id & 3;
                f32x4 acc = {0.f, 0.f, 0.f, 0.f};
#pragma unroll
                for (int ks = 0; ks < 2; ++ks) { const bf16x8 av = *(const LAS bf16x8*)(vT + (et * 16 + fr) * LS + ks * 32 + fq * 8); const bf16x8 bv = *(const LAS bf16x8*)(khT + (dd * 64 + dt * 16 + fr) * LS + ks * 32 + fq * 8);
                    acc = mma16(av, bv, acc); }
                const int chain = dd * 8 + b * 4 + h, p = dd ? pb : pf; float* S = SLOC + ((size_t)chain * NCH + p) * 8192;
#pragma unroll
                for (int r = 0; r < 4; ++r) S[(et * 16 + fq * 4 + r) * 64 + dt * 16 + fr] = acc[r]; }
        }
        __syncthreads();
    }
}

__device__ __forceinline__ void phase_gla_scan(const Ctx& C) {
    const float* SLOC = (const float*)(C.arena + R_SLOC); const float* DEC = (const float*)(C.arena + R_DEC); bf16* SST = (bf16*)(C.arena + R_SST);
    for (int idx = C.bid * 512 + C.tid; idx < 16 * 8192; idx += C.G * 512) {
        const int chain = idx >> 13, el = idx & 8191, d = el & 63;
        const float* sl = SLOC + (size_t)chain * NCH * 8192 + el; const float* dc = DEC + (size_t)chain * NCH * 64 + d; bf16* so = SST + (size_t)chain * NCH * 8192 + el;
        float S = 0.f;
#pragma unroll 1
        for (int p0 = 0; p0 < NCH; p0 += 44) {
            float x[44], g[44];
#pragma unroll
            for (int i = 0; i < 44; ++i) { x[i] = sl[(size_t)(p0 + i) * 8192]; g[i] = dc[(p0 + i) * 64]; }
#pragma unroll
            for (int i = 0; i < 44; ++i) { so[(size_t)(p0 + i) * 8192] = (bf16)f2bf(S); S = S * g[i] + x[i]; }
        }
    }
}

__device__ __forceinline__ void phase_gla_out(const Ctx& C, int layer) {
    LAS bf16* qf = (LAS bf16*)C.lds; LAS bf16* kf = qf + 64 * LS; LAS bf16* qb = kf + 64 * LS; LAS bf16* kb = qb + 64 * LS;
    LAS bf16* vT = kb + 64 * LS;
    LAS bf16* SfT = vT + 128 * LS; LAS bf16* SbT = SfT + 128 * LS;
    LAS bf16* As = SbT + 128 * LS;
    LAS float* O = (LAS float*)(As + 64 * LS);
    const bf16* P = (const bf16*)(C.arena + R_P); const bf16* QT = (const bf16*)(C.arena + R_QT); const bf16* KT = (const bf16*)(C.arena + R_KT);
    const bf16* SST = (const bf16*)(C.arena + R_SST); bf16* MIX = (bf16*)(C.arena + R_MIX);
    const float* GG = C.in[I_GLAG] + layer * 128;
    const int tid = C.tid, lane = C.lane, fr = lane & 15, fq = lane >> 4;
    const int na = layer == 0 ? NCH : 128;
    const int nskip = (layer == 0 && C.G > 16) ? 8 : 0;
    if (C.bid < nskip) return;
    for (int L = C.G - 1 - C.bid; L < NB * na * 4; L += C.G - nskip) {
        const int h = L & 3, a = (L >> 2) % na, b = L / (na * 4);
        const int rbase = chunk_row(b, a);
        const int pf = a < 128 ? a + 4 : a - 128, pb = 131 - a;
        {
            const int which = tid >> 7, t = (tid >> 1) & 63, hf = tid & 1; const int dd = which >> 1;
            const bf16* src = ((which & 1) ? KT : QT) + ((size_t)dd * MR + rbase + t) * 256 + h * 64 + hf * 32;
            LAS bf16* dst = (which == 0 ? qf : which == 1 ? kf : which == 2 ? qb : kb) + t * LS + hf * 32;
#pragma unroll
            for (int i = 0; i < 4; ++i) *(LAS u32x4*)(dst + 8 * i) = *(const u32x4*)(src + 8 * i);
        }
        {
            const int t = tid >> 3, e0 = (tid & 7) * 16; const bf16* vp = P + (size_t)(rbase + t) * PW + PC_V + h * 128 + e0;
            const u32x4 v0 = *(const u32x4*)vp, v1 = *(const u32x4*)(vp + 8); bf16 vr[16]; unpack8_raw(v0, vr); unpack8_raw(v1, vr + 8);
#pragma unroll
            for (int i = 0; i < 16; ++i) vT[(e0 + i) * LS + t] = vr[i];
        }
        {
            const int dd = tid >> 8, e = (tid >> 1) & 127, hf = tid & 1; const int chain = dd * 8 + b * 4 + h, p = dd ? pb : pf;
            const bf16* src = SST + ((size_t)chain * NCH + p) * 8192 + e * 64 + hf * 32; LAS bf16* dst = (dd ? SbT : SfT) + e * LS + hf * 32;
#pragma unroll
            for (int i = 0; i < 4; ++i) *(LAS u32x4*)(dst + 8 * i) = *(const u32x4*)(src + 8 * i);
        }
        __syncthreads();
        {
#pragma unroll
            for (int i = 0; i < 2; ++i) { const int pos = C.wave * 2 + i, ti = pos >> 2, si = pos & 3;
                f32x4 af = {0.f, 0.f, 0.f, 0.f}, ab = af;
#pragma unroll
                for (int ks = 0; ks < 2; ++ks) {
                    const bf16x8 a1 = *(const LAS bf16x8*)(qf + (ti * 16 + fr) * LS + ks * 32 + fq * 8), b1 = *(const LAS bf16x8*)(kf + (si * 16 + fr) * LS + ks * 32 + fq * 8);
                    const bf16x8 a2 = *(const LAS bf16x8*)(qb + (ti * 16 + fr) * LS + ks * 32 + fq * 8), b2 = *(const LAS bf16x8*)(kb + (si * 16 + fr) * LS + ks * 32 + fq * 8);
                    af = mma16(a1, b1, af); ab = mma16(a2, b2, ab); }
#pragma unroll
                for (int r = 0; r < 4; ++r) { const int t = ti * 16 + fq * 4 + r, s = si * 16 + fr; const float val = (s <= t ? af[r] : 0.f) + (s >= t ? ab[r] : 0.f); As[t * LS + s] = (bf16)f2bf(val); } }
        }
        __syncthreads();
        {
#pragma unroll 2
            for (int i = 0; i < 4; ++i) { const int id = C.wave * 4 + i, tt = id >> 3, et = id & 7;
                f32x4 acc = {0.f, 0.f, 0.f, 0.f};
#pragma unroll
                for (int ks = 0; ks < 2; ++ks) {
                    const bf16x8 bv = *(const LAS bf16x8*)(vT + (et * 16 + fr) * LS + ks * 32 + fq * 8);
                    acc = mma16(*(const LAS bf16x8*)(As + (tt * 16 + fr) * LS + ks * 32 + fq * 8), bv, acc);
                    acc = mma16(*(const LAS bf16x8*)(qf + (tt * 16 + fr) * LS + ks * 32 + fq * 8), *(const LAS bf16x8*)(SfT + (et * 16 + fr) * LS + ks * 32 + fq * 8), acc);
                    acc = mma16(*(const LAS bf16x8*)(qb + (tt * 16 + fr) * LS + ks * 32 + fq * 8), *(const LAS bf16x8*)(SbT + (et * 16 + fr) * LS + ks * 32 + fq * 8), acc); }
#pragma unroll
                for (int r = 0; r < 4; ++r) O[(tt * 16 + fq * 4 + r) * 132 + et * 16 + fr] = acc[r]; }
        }
        __syncthreads();
        {
            const int t = tid >> 3, e0 = (tid & 7) * 16; float o[16], ss = 0.f;
#pragma unroll
            for (int i = 0; i < 16; ++i) { o[i] = O[t * 132 + e0 + i]; ss += o[i] * o[i]; }
            ss += __shfl_xor(ss, 1); ss += __shfl_xor(ss, 2); ss += __shfl_xor(ss, 4);
            const float rs = 1.f / sqrtf(ss * (1.f / 128.f) + EPS);
            const size_t row = (size_t)(rbase + t); const bf16* rp = P + row * PW + PC_R + h * 128 + e0; float rv[16]; unpack8(*(const u32x4*)rp, rv); unpack8(*(const u32x4*)(rp + 8), rv + 8);
#pragma unroll
            for (int i = 0; i < 16; ++i) o[i] = o[i] * rs * GG[e0 + i] * silu_f(rv[i]);
            bf16* mp = MIX + row * DM + h * 128 + e0; *(u32x4*)mp = pack8h(o); *(u32x4*)(mp + 8) = pack8h(o + 8);
        }
        __syncthreads();
    }
}

namespace att {
constexpr int NW = 8, QBLK = 32, KVBLK = 64;
constexpr float THR = 8.f;
constexpr int OFF_K = 0, OFF_V = 2 * KT_BYTES, OFF_WS = OFF_V + 2 * VT_BYTES, OFF_QR = OFF_WS + NW * 64 * 4, SHM_ATTN = OFF_QR + NW * 4096;
#define SBAR() __builtin_amdgcn_sched_barrier(0)
__device__ __forceinline__ int crow(int r, int hi) { return (r & 3) + 8 * (r >> 2) + 4 * hi; }
__device__ __forceinline__ unsigned cvtpk(float lo, float hi) { unsigned r; asm volatile("v_cvt_pk_bf16_f32 %0, %1, %2" : "=v"(r) : "v"(lo), "v"(hi)); return r; }
__device__ __forceinline__ void glds16(const void* gsrc, unsigned lds_dst) { unsigned keep;
    asm volatile("s_mov_b32 %0, m0\n\ts_mov_b32 m0, %2\n\ts_nop 0\n\tglobal_load_lds_dwordx4 %1, off\n\ts_mov_b32 m0, %0" : "=&s"(keep) : "v"(gsrc), "s"(lds_dst) : "memory"); }
__device__ __forceinline__ void partialSM(f32x16& p0, f32x16& p1, f32x16& negm, bool first, float& alpha) {
    constexpr float THRL = THR * 1.4426950408889634f;
    float ma = fmaxf(fmaxf(p0[0], p0[1]), p0[2]), mb = fmaxf(fmaxf(p0[8], p0[9]), p0[10]), mc = fmaxf(fmaxf(p1[0], p1[1]), p1[2]), md = fmaxf(fmaxf(p1[8], p1[9]), p1[10]);
    ma = fmaxf(fmaxf(ma, p0[3]), p0[4]); mb = fmaxf(fmaxf(mb, p0[11]), p0[12]); mc = fmaxf(fmaxf(mc, p1[3]), p1[4]); md = fmaxf(fmaxf(md, p1[11]), p1[12]);
    ma = fmaxf(fmaxf(ma, p0[5]), p0[6]); mb = fmaxf(fmaxf(mb, p0[13]), p0[14]); mc = fmaxf(fmaxf(mc, p1[5]), p1[6]); md = fmaxf(fmaxf(md, p1[13]), p1[14]);
    ma = fmaxf(ma, p0[7]); mb = fmaxf(mb, p0[15]); mc = fmaxf(mc, p1[7]); md = fmaxf(md, p1[15]);
    float pmax = fmaxf(fmaxf(ma, mb), fmaxf(mc, md));
    { auto rr = __builtin_amdgcn_permlane32_swap(__float_as_uint(pmax), __float_as_uint(pmax), false, false);
      pmax = fmaxf(__uint_as_float(rr[0]), __uint_as_float(rr[1])); }
    if (__builtin_expect(!first && __all(pmax <= THRL), 1)) { alpha = 1.f; }
    else { const float delta = first ? pmax : fmaxf(pmax, 0.f); alpha = first ? 1.f : __builtin_amdgcn_exp2f(-delta);
#pragma unroll
        for (int r = 0; r < 16; ++r) { p0[r] -= delta; p1[r] -= delta; negm[r] -= delta; } }
#pragma unroll
    for (int r = 0; r < 16; ++r) p0[r] = __builtin_amdgcn_exp2f(p0[r]);
}
__device__ __forceinline__ void finishSM(f32x16& p0, f32x16& p1, float alpha, float& l_reg, bf16x8& pa0, bf16x8& pa1, bf16x8& pa2, bf16x8& pa3) {
#pragma unroll
    for (int r = 0; r < 16; ++r) p1[r] = __builtin_amdgcn_exp2f(p1[r]);
    float sa = p0[0] + p0[1], sb = p0[8] + p0[9], sc = p1[0] + p1[1], sd = p1[8] + p1[9];
#pragma unroll
    for (int r = 2; r < 8; ++r) { sa += p0[r]; sb += p0[8 + r]; sc += p1[r]; sd += p1[8 + r]; }
    float ps = (sa + sb) + (sc + sd);
    { auto rr = __builtin_amdgcn_permlane32_swap(__float_as_uint(ps), __float_as_uint(ps), false, false);
      ps = __uint_as_float(rr[0]) + __uint_as_float(rr[1]); }
    l_reg = l_reg * alpha + ps;
#define PK4(P, BASE, OUT) do { unsigned a0 = cvtpk(P[BASE + 0], P[BASE + 1]), a1 = cvtpk(P[BASE + 2], P[BASE + 3]);   \
    unsigned b0 = cvtpk(P[BASE + 4], P[BASE + 5]), b1 = cvtpk(P[BASE + 6], P[BASE + 7]);                              \
    auto r0 = __builtin_amdgcn_permlane32_swap(a0, b0, false, false); auto r1 = __builtin_amdgcn_permlane32_swap(a1, b1, false, false); \
    u32x4 w = {r0[0], r1[0], r0[1], r1[1]}; OUT = *reinterpret_cast<bf16x8*>(&w); } while (0)
    PK4(p0, 0, pa0); PK4(p0, 8, pa1); PK4(p1, 0, pa2); PK4(p1, 8, pa3);
#undef PK4
}
__device__ __forceinline__ void qkt(f32x16& p0, f32x16& p1, const char* kl, const bf16x8* qr, const char* qrl, const f32x16& negm) {
    bf16x8 ka[8], kb[8], qv[4];
#define KLOAD(dst, g) do { _Pragma("unroll") for (int i = 0; i < 4; ++i) { dst[2 * i] = *reinterpret_cast<const bf16x8*>(kl + ((g) * 4 + i) * 2048); dst[2 * i + 1] = *reinterpret_cast<const bf16x8*>(kl + ((g) * 4 + i) * 2048 + 512); } } while (0)
    KLOAD(ka, 0); SBAR(); KLOAD(kb, 1);
#pragma unroll
    for (int i = 0; i < 4; ++i) qv[i] = *reinterpret_cast<const bf16x8*>(qrl + i * 1024);
    SBAR();
    p0 = __builtin_amdgcn_mfma_f32_32x32x16_bf16(ka[0], qr[0], negm, 0, 0, 0);
    p1 = __builtin_amdgcn_mfma_f32_32x32x16_bf16(ka[1], qr[0], negm, 0, 0, 0);
#pragma unroll
    for (int i = 1; i < 4; ++i) { p0 = __builtin_amdgcn_mfma_f32_32x32x16_bf16(ka[2 * i], qr[i], p0, 0, 0, 0); p1 = __builtin_amdgcn_mfma_f32_32x32x16_bf16(ka[2 * i + 1], qr[i], p1, 0, 0, 0); }
    SBAR(); KLOAD(ka, 2); SBAR();
#pragma unroll
    for (int i = 0; i < 4; ++i) { p0 = __builtin_amdgcn_mfma_f32_32x32x16_bf16(kb[2 * i], qr[4 + i], p0, 0, 0, 0); p1 = __builtin_amdgcn_mfma_f32_32x32x16_bf16(kb[2 * i + 1], qr[4 + i], p1, 0, 0, 0); }
    SBAR();
#pragma unroll
    for (int i = 0; i < 4; ++i) { p0 = __builtin_amdgcn_mfma_f32_32x32x16_bf16(ka[2 * i], qv[i], p0, 0, 0, 0); p1 = __builtin_amdgcn_mfma_f32_32x32x16_bf16(ka[2 * i + 1], qv[i], p1, 0, 0, 0); }
#undef KLOAD
}
__device__ __forceinline__ int v_rd_base(int lane) { return ((lane & 3) << 3) | (((lane >> 2) & 3) << 6) | (((lane >> 4) & 1) << 5) | (((lane >> 5) & 1) << 8); }
constexpr int v_rd_off(int d0, int ks, int half) { return d0 * 512 + ks * 4096 + half * 2048; }
template <int OFF> __device__ __forceinline__ s16x4 tr_read(int vb) {
    return __builtin_amdgcn_ds_read_tr16_b64_v4i16((LAS s16x4*)(uintptr_t)(unsigned)(vb + OFF));
}
struct VFrag { s16x4 l0, h0, l1, h1, l2, h2, l3, h3; };
template <int D0> __device__ __forceinline__ void v_reads(VFrag& f, int vb) {
    f.l0 = tr_read<v_rd_off(D0, 0, 0)>(vb); f.h0 = tr_read<v_rd_off(D0, 0, 1)>(vb); f.l1 = tr_read<v_rd_off(D0, 1, 0)>(vb); f.h1 = tr_read<v_rd_off(D0, 1, 1)>(vb);
    f.l2 = tr_read<v_rd_off(D0, 2, 0)>(vb); f.h2 = tr_read<v_rd_off(D0, 2, 1)>(vb); f.l3 = tr_read<v_rd_off(D0, 3, 0)>(vb); f.h3 = tr_read<v_rd_off(D0, 3, 1)>(vb);
}
__device__ __forceinline__ void pv_mma(f32x16& od, const VFrag& f, bf16x8 pa0, bf16x8 pa1, bf16x8 pa2, bf16x8 pa3) {
#define PKV(L, H) (bf16x8){L[0], L[1], L[2], L[3], H[0], H[1], H[2], H[3]}
    od = __builtin_amdgcn_mfma_f32_32x32x16_bf16(pa0, PKV(f.l0, f.h0), od, 0, 0, 0);
    od = __builtin_amdgcn_mfma_f32_32x32x16_bf16(pa1, PKV(f.l1, f.h1), od, 0, 0, 0);
    od = __builtin_amdgcn_mfma_f32_32x32x16_bf16(pa2, PKV(f.l2, f.h2), od, 0, 0, 0);
    od = __builtin_amdgcn_mfma_f32_32x32x16_bf16(pa3, PKV(f.l3, f.h3), od, 0, 0, 0);
#undef PKV
}
__device__ __forceinline__ void pv_d0(f32x16* o, int vb, bf16x8 pa0, bf16x8 pa1, bf16x8 pa2, bf16x8 pa3) {
    VFrag fa, fb;
    v_reads<0>(fa, vb); v_reads<1>(fb, vb);
    SBAR(); pv_mma(o[0], fa, pa0, pa1, pa2, pa3); SBAR();
    v_reads<2>(fa, vb);
    SBAR(); pv_mma(o[1], fb, pa0, pa1, pa2, pa3); SBAR();
    v_reads<3>(fb, vb);
    SBAR(); pv_mma(o[2], fa, pa0, pa1, pa2, pa3); SBAR();
    pv_mma(o[3], fb, pa0, pa1, pa2, pa3);
}
__device__ __forceinline__ void attn_body(const bf16* __restrict__ Qb, const char* __restrict__ Kt, const char* __restrict__ Vt, bf16* __restrict__ Ob, int t0, int NT, char* lds, const float* __restrict__ ROPE, int qpos0) {
    int tid = threadIdx.x; asm volatile("" : "+v"(tid));
    const int wid = __builtin_amdgcn_readfirstlane(tid >> 6), lane = tid & 63, r32 = lane & 31, hi = lane >> 5, grp = wid >> 2;
    float* ws = (float*)(lds + OFF_WS) + wid * 64; float* li_l = ws; float* al_l = ws + 32;
    float l_reg = 0; f32x16 o[4] = {}; f32x16 negm = {}; bf16x8 qr[8];
    const bf16* Qw = Qb + (long)(wid * QBLK + r32) * 192 + hi * 8;
#pragma unroll
    for (int d0 = 0; d0 < 8; ++d0) qr[d0] = *reinterpret_cast<const bf16x8*>(Qw + d0 * 16);
    char* qrl = lds + OFF_QR + wid * 4096 + lane * 16;
#pragma unroll
    for (int d0 = 0; d0 < 4; ++d0) {
        const u32x4 w = *reinterpret_cast<const u32x4*>(Qw + 128 + d0 * 16); float v[8]; unpack8(w, v);
        if (qpos0 >= 0) { const int pos = qpos0 + wid * QBLK + r32;
#pragma unroll
            for (int q = 0; q < 4; ++q) { const int pair = d0 * 8 + hi * 4 + q, fi = pair & 15, axis = pair >> 4; const int pidx = axis ? (pos & 63) : (pos >> 6);
                const float* cs = ROPE + ((axis ? 128 : 0) + pidx) * 32 + fi * 2; const float c = cs[0], sn = cs[1]; const float x1 = v[2 * q], x2 = v[2 * q + 1];
                v[2 * q] = x1 * c - x2 * sn; v[2 * q + 1] = x2 * c + x1 * sn; } }
        *reinterpret_cast<u32x4*>(qrl + d0 * 1024) = pack8(v); }
    asm volatile("s_waitcnt vmcnt(0)" ::: "memory");
    const unsigned ldsb = (unsigned)(uintptr_t)lds;
    const char* Ktw = Kt + (size_t)t0 * KT_BYTES + lane * 16; const char* Vtw = Vt + (size_t)t0 * VT_BYTES + lane * 16;
#define ISSUE_K(j) do { _Pragma("unroll") for (int _i = 0; _i < 3; ++_i) { const int q = wid * 3 + _i; \
        glds16(Ktw + (size_t)(j) * KT_BYTES + q * 1024, __builtin_amdgcn_readfirstlane(ldsb + OFF_K + ((j) & 1) * KT_BYTES + q * 1024)); } } while (0)
#define ISSUE_V(j) do { _Pragma("unroll") for (int _i = 0; _i < 2; ++_i) { const int q = wid * 2 + _i; \
        glds16(Vtw + (size_t)(j) * VT_BYTES + q * 1024, __builtin_amdgcn_readfirstlane(ldsb + OFF_V + ((j) & 1) * VT_BYTES + q * 1024)); } } while (0)
#define STEP_PRE(s) do { __builtin_amdgcn_s_barrier(); SBAR(); const int _s = (s), _m = _s >> 1; issued = 0; \
        if (_m + 1 < NT) { if (_s & 1) { ISSUE_V(_m + 1); issued = 2; } else { ISSUE_K(_m + 1); issued = 3; } } SBAR(); } while (0)
#define STEP_POST() do { SBAR(); if (issued == 3) asm volatile("s_waitcnt vmcnt(3)" ::: "memory"); else if (issued == 2) asm volatile("s_waitcnt vmcnt(2)" ::: "memory"); else asm volatile("s_waitcnt vmcnt(0)" ::: "memory"); } while (0)
#define RESC(a) do { if (__any((a) < 1.f)) { if (hi == 0) al_l[r32] = (a); asm volatile("s_waitcnt lgkmcnt(0)" ::: "memory"); \
    _Pragma("unroll") for (int d = 0; d < 4; ++d) _Pragma("unroll") for (int r = 0; r < 16; ++r) o[d][r] *= al_l[crow(r, hi)]; } } while (0)
    const char* kl0 = lds + OFF_K + hi * 1024 + r32 * 16;
    const int vb0 = (int)ldsb + OFF_V + v_rd_base(lane);
    f32x16 p0, p1; float al = 1.f; bf16x8 pa0, pa1, pa2, pa3;
    ISSUE_K(0); ISSUE_V(0);
    if (NT > 1) { ISSUE_K(1); ISSUE_V(1); asm volatile("s_waitcnt vmcnt(5)" ::: "memory"); } else asm volatile("s_waitcnt vmcnt(0)" ::: "memory");
    __builtin_amdgcn_s_barrier(); SBAR();
    for (int j = 0; j < NT; ++j) {
        const int sl = j & 1;
        qkt(p0, p1, kl0 + sl * KT_BYTES, qr, qrl, negm);
        partialSM(p0, p1, negm, j == 0, al);
        RESC(al);
        finishSM(p0, p1, al, l_reg, pa0, pa1, pa2, pa3); SBAR();
        pv_d0(o, vb0 + sl * VT_BYTES, pa0, pa1, pa2, pa3);
        SBAR(); asm volatile("s_waitcnt vmcnt(0)" ::: "memory"); __builtin_amdgcn_s_barrier(); SBAR();
        if (j + 2 < NT) { ISSUE_K(j + 2); ISSUE_V(j + 2); }
    }
    if (hi == 0) li_l[r32] = l_reg; asm volatile("s_waitcnt lgkmcnt(0)" ::: "memory");
    float rli[16];
#pragma unroll
    for (int r = 0; r < 16; ++r) rli[r] = __builtin_amdgcn_rcpf(li_l[crow(r, hi)]);
    bf16* Ow = Ob + (long)(wid * QBLK) * DM;
    {
        char* ot = lds + wid * 8704;
#pragma unroll
        for (int r = 0; r < 16; ++r) { const int orow = crow(r, hi);
#pragma unroll
            for (int d0 = 0; d0 < 4; ++d0) *reinterpret_cast<bf16*>(ot + orow * 272 + (d0 * 32 + r32) * 2) = (bf16)f2bf(o[d0][r] * rli[r]); }
        asm volatile("s_waitcnt lgkmcnt(0)" ::: "memory");
#pragma unroll
        for (int i = 0; i < 8; ++i) { const int row = 4 * i + (lane >> 4), ch = lane & 15;
            *reinterpret_cast<u32x4*>(Ow + (long)row * DM + ch * 8) = *reinterpret_cast<const u32x4*>(ot + row * 272 + ch * 16); }
    }
    __syncthreads();
#undef ISSUE_K
#undef ISSUE_V
#undef STEP_PRE
#undef STEP_POST
#undef RESC
}
}

__device__ __forceinline__ void phase_attention(const Ctx& C, int layer) {
    const bf16* QB = (const bf16*)(C.arena + R_QB); const char* KB = (const char*)(C.arena + R_KB); const char* VB = (const char*)(C.arena + R_VB); bf16* MIX = (bf16*)(C.arena + R_MIX);
    const float* ROPE = (const float*)(C.ws + WS_ROPE);
    const int nunit = layer == 0 ? 264 : 256;
    for (int L = C.bid; L < nunit; L += C.G) {
        const bool lat = L < 256; const int bh = lat ? (L & 7) : (L - 256), qb = L >> 3, b = bh >> 2, h = bh & 3;
        const int qrow = lat ? qb * 256 : TT, orow = lat ? b * TT + qb * 256 : NLAT + b * TC;
        att::attn_body(QB + ((size_t)bh * TKV + qrow) * 192, KB + (size_t)bh * 132 * att::KT_BYTES, VB + (size_t)bh * 132 * att::VT_BYTES, MIX + (size_t)orow * DM + 512 + h * 128,
                       lat ? 0 : 128, lat ? 132 : 4, (char*)C.ldsg, ROPE, lat ? qb * 256 : -1);
    }
}

struct FStoreP { bf16* P;
    __device__ __forceinline__ void operator()(int row, int col, f32x4 v0, f32x4 v1) const { u32x4 w; w.x = pk2h(v0[0], v0[1]); w.y = pk2h(v0[2], v0[3]); w.z = pk2h(v1[0], v1[1]); w.w = pk2h(v1[2], v1[3]); *(u32x4*)(P + (size_t)row * PW + col) = w; } };
struct FStoreQKV { bf16* QB; char* KB; char* VB; int coff;
    __device__ __forceinline__ void operator()(int row, int colx, f32x4 v0, f32x4 v1) const {
        const int col = colx + coff; int b, pos; row_bpos(row, b, pos);
        if (col < 768) { constexpr float QS = MLA_SCALE * 1.4426950408889634f; v0 = v0 * QS; v1 = v1 * QS; }
        u32x4 w; w.x = pk2h(v0[0], v0[1]); w.y = pk2h(v0[2], v0[3]); w.z = pk2h(v1[0], v1[1]); w.w = pk2h(v1[2], v1[3]);
        if (col < 768) { const int h = col / 192, j = col - h * 192; *(u32x4*)(QB + ((size_t)(b * 4 + h) * TKV + pos) * 192 + j) = w; }
        else { const int c2 = col - 768, h = c2 >> 8, j = c2 & 255; const size_t tile = (size_t)(b * 4 + h) * 132 + (pos >> 6); const int k = pos & 63;
            if (j < 128) *(u32x4*)(KB + tile * att::KT_BYTES + (j >> 3) * 1024 + k * 16) = w;
            else *(u32x4*)(VB + tile * att::VT_BYTES + att::v_st(k, j - 128)) = w; }
    } };
struct FResidual { const float* x; const float* ctx; bf16* XL; const float* gate; int layer0;
    struct UnitV { f32x4 g[2][2]; };
    struct Pre { f32x4 s0, s1; u32x4 xw; };
    __device__ __forceinline__ void unit(UnitV& uv, int row0, int col0) const { const float* g = gate + mod_row(row0) * 6144 + col0;
#pragma unroll
        for (int bj = 0; bj < 2; ++bj) { uv.g[bj][0] = *(const f32x4*)(g + bj * 128); uv.g[bj][1] = *(const f32x4*)(g + bj * 128 + 4); } }
    __device__ __forceinline__ void load(Pre& p, int row, int col) const {
        if (layer0) { const float* src = (row < NLAT ? x + (size_t)row * DM : ctx + (size_t)(row - NLAT) * DM) + col; p.s0 = *(const f32x4*)src; p.s1 = *(const f32x4*)(src + 4); }
        else p.xw = *(const u32x4*)(XL + (size_t)row * DM + col); }
    __device__ __forceinline__ void apply(const UnitV& uv, const Pre& p, int bj, int row, int col, f32x4 v0, f32x4 v1) const {
        const f32x4 g0 = uv.g[bj][0], g1 = uv.g[bj][1];
        float r[8];
        if (layer0) { r[0] = p.s0[0]; r[1] = p.s0[1]; r[2] = p.s0[2]; r[3] = p.s0[3]; r[4] = p.s1[0]; r[5] = p.s1[1]; r[6] = p.s1[2]; r[7] = p.s1[3]; }
        else unpack8(p.xw, r);
        r[0] += g0[0] * v0[0]; r[1] += g0[1] * v0[1]; r[2] += g0[2] * v0[2]; r[3] += g0[3] * v0[3]; r[4] += g1[0] * v1[0]; r[5] += g1[1] * v1[1]; r[6] += g1[2] * v1[2]; r[7] += g1[3] * v1[3];
        *(u32x4*)(XL + (size_t)row * DM + col) = pack8h(r);
    } };
struct FStoreAct { bf16* ACT; int ld;
    __device__ __forceinline__ void operator()(int row, int col, const float* o) const { *(u32x4*)(ACT + (size_t)row * ld + col) = pack8h(o); } };
struct FMoeDown { const int* ENT; const float* WTS; bf16* Y0; bf16* Y2; const float* gate;
    struct UnitV { f32x4 g[2][2][2]; };
    struct Pre { int ent; float w; };
    __device__ __forceinline__ void unit(UnitV& uv, int row0, int colx0) const { const int col = colx0 & (DM - 1);
#pragma unroll
        for (int sm = 0; sm < 2; ++sm)
#pragma unroll
            for (int bj = 0; bj < 2; ++bj) { const float* g = gate + sm * 6144 + col + bj * 128; uv.g[sm][bj][0] = *(const f32x4*)g; uv.g[sm][bj][1] = *(const f32x4*)(g + 4); } }
    __device__ __forceinline__ void load(Pre& p, int row, int colx) const { p.ent = ENT[row]; p.w = WTS[row]; }
    __device__ __forceinline__ void apply(const UnitV& uv, const Pre& p, int bj, int row, int colx, f32x4 v0, f32x4 v1) const {
        const int col = colx & (DM - 1);
        const int ent = p.ent; if (ent < 0) return;
        const int tok = ent >> 1; const bool s1 = (tok >> 13) != 0;
        const f32x4 g0 = s1 ? uv.g[1][bj][0] : uv.g[0][bj][0], g1 = s1 ? uv.g[1][bj][1] : uv.g[0][bj][1];
        const f32x4 a0 = g0 * p.w * v0, a1 = g1 * p.w * v1;
        u32x4 o; o.x = pk2h(a0[0], a0[1]); o.y = pk2h(a0[2], a0[3]); o.z = pk2h(a1[0], a1[1]); o.w = pk2h(a1[2], a1[3]);
        *(u32x4*)(((ent & 1) ? Y2 : Y0) + (size_t)tok * DM + col) = o;
    } };

constexpr int PH_PER_LAYER = 13, PH_FINAL = 1 + 2 * PH_PER_LAYER, N_PHASES = PH_FINAL + 1;
__host__ __device__ constexpr bool phase_exists(int ph) { return ph == 0 || ph == PH_FINAL || (ph >= 1 && ph < PH_FINAL && ((((ph - 1) / PH_PER_LAYER) == 1 && ((ph - 1) % PH_PER_LAYER) != 7 && ((ph - 1) % PH_PER_LAYER) != 8) || (((ph - 1) / PH_PER_LAYER) == 0 && ((ph - 1) % PH_PER_LAYER) < 9))); }

#ifndef DBG_REP
#define DBG_REP(ph) 0
#endif
#ifndef DBG_DELAY
#define DBG_DELAY(ph) 0
#endif
#ifndef DBG_STOP
#define DBG_STOP 0
#endif
#ifndef DBG_SRC
#define DBG_SRC 0
#endif
__device__ __forceinline__ void phase_dump(const Ctx& C) {
    const int gw = C.vcu * 8 + C.wave, NGW = C.G * 8;
    for (int row = gw; row < NLAT; row += NGW) {
        float* o = C.out + (size_t)row * DM;
        if (DBG_SRC == 0) { const bf16* s = (const bf16*)(C.ws + WS_XL) + (size_t)row * DM; for (int c = C.lane; c < DM; c += 64) o[c] = bf2f(s[c]); }
        else { const bf16* s = DBG_SRC == 1 ? (const bf16*)(C.arena + R_MIX) + (size_t)row * DM : DBG_SRC == 2 ? (const bf16*)(C.ws + WS_H) + (size_t)row * DM
                             : DBG_SRC == 3 ? (const bf16*)(C.arena + R_P) + (size_t)row * PW : DBG_SRC == 4 ? (const bf16*)(C.arena + R_P) + (size_t)row * PW + 1024
                             : DBG_SRC == 5 ? (const bf16*)(C.arena + R_ACT) + (size_t)row * DFF : DBG_SRC == 6 ? (const bf16*)(C.arena + R_QT) + (size_t)row * 256
                             : (const bf16*)(C.arena + R_QB) + (size_t)row * 192;
            const int n = DBG_SRC == 6 ? 256 : DBG_SRC == 7 ? 192 : DM;
            for (int c = C.lane; c < DM; c += 64) o[c] = c < n ? bf2f(s[c]) : 0.f; }
    }
}
template <int PH, int SUB = 0> __device__ __forceinline__ void run_phase(const Ctx& C0) {
    Ctx C = C0; { int t = threadIdx.x; asm volatile("" : "+v"(t)); C.tid = t; C.lane = t & 63; C.wave = __builtin_amdgcn_readfirstlane(t >> 6); }
    constexpr int layer = (PH - 1) / PH_PER_LAYER, k = (PH - 1) % PH_PER_LAYER;
    const float* MODB = (const float*)(C.ws + WS_MOD);
    if constexpr (DBG_STOP > 0 && PH > DBG_STOP && PH != PH_FINAL) { }
    else if constexpr (DBG_STOP > 0 && PH == PH_FINAL) { phase_dump(C); }
    else if constexpr (PH == 0) { prologue(C); }
    else if constexpr (PH == PH_FINAL) { phase_final(C); }
    else if constexpr (k == 0) { phase_norm1(C, layer); }
    else if constexpr (k == 1) {
        pg8::Gemm g{(const bf16*)(C.ws + WS_H), (const bf16*)(C.arena + A_WIN) + (size_t)layer * 2048 * 1024, 1024, 1024, 1024};
        pg8::StaticOrder S; S.init(MR, PW, C.G, C.bid); pg8::Epi8<FStoreP> E{{(bf16*)(C.arena + R_P)}};
        if constexpr (layer == 0) { const int nfull = (MR / 256 * (PW / 256)) % C.G;
            if (C.bid >= nfull) { convert_weights(C, false, (C.bid - nfull) * 8 + C.wave, (C.G - nfull) * 8); convert_expert_down(C, (C.bid - nfull) * 8 + C.wave, (C.G - nfull) * 8, 0, ED_EARLY); __syncthreads(); } }
        pg8::gemm_phase(C.lds, g, S, E);
        if constexpr (layer == 0) { }
        else { const int nfull = (MR / 256 * (PW / 256)) % C.G;
            if (C.bid >= nfull) convert_expert_down(C, (C.bid - nfull) * 8 + C.wave, (C.G - nfull) * 8, ED_EARLY, ED_ITEMS); }
    } else if constexpr (k == 2) {
        if (SUB != 2) phase_gla_local(C, layer);
        if (SUB != 1) {
            const int r5 = (NB * NCH * 4) % C.G;
            if (r5 == 0) phase_mla_prep(C, C.vcu * 8 + C.wave, C.G * 8);
            else if (C.bid >= r5) phase_mla_prep(C, (C.bid - r5) * 8 + C.wave, (C.G - r5) * 8); }
    } else if constexpr (k == 3) {
        if (SUB != 2) phase_gla_scan(C);
        if (SUB != 1)
        {
            const bf16* W = (const bf16*)(C.arena + A_WQKV) + (size_t)layer * 1792 * 384; const bf16* A = (const bf16*)(C.arena + R_CQKV);
#pragma unroll 1
            for (int pass = 0; pass < 2; ++pass) {
                int ps = pass; asm volatile("" : "+s"(ps));
                pg8::Gemm g{A + (ps ? 256 : 0), W + (ps ? (size_t)768 * 384 + 256 : 0), ps ? 128 : 256, 384, 384};
                pg8::StaticOrder S; S.init(ps ? MR : (layer == 0 ? MR : NLAT), ps ? 1024 : 768, C.G, ps ? C.G - 1 - C.bid : C.bid);
                pg8::Epi8<FStoreQKV> E{{(bf16*)(C.arena + R_QB), (char*)(C.arena + R_KB), (char*)(C.arena + R_VB), ps ? 768 : 0}};
                pg8::gemm_phase(C.lds, g, S, E); }
        }
    } else if constexpr (k == 4) {
        if (C.vcu & 1) { if (SUB != 1) phase_attention(C, layer); if (SUB != 2) phase_gla_out(C, layer); }
        else { if (SUB != 2) phase_gla_out(C, layer); if (SUB != 1) phase_attention(C, layer); }
    } else if constexpr (k == 5) {
        pg8::Gemm g{(const bf16*)(C.arena + R_MIX), (const bf16*)(C.arena + A_WOUT) + (size_t)layer * 1024 * 1024, 1024, 1024, 1024};
        pg8::StaticOrder S; S.init(NLAT, DM, C.G, C.bid);
        pg8::Epi8P<FResidual> E{{C.in[I_X], C.in[I_CTX], (bf16*)(C.ws + WS_XL), MODB + (size_t)layer * 3 * 6144 + 2 * 1024, layer == 0 ? 1 : 0}};
        pg8::gemm_phase(C.lds, g, S, E);
        if constexpr (layer == 0) {
            pg8::Gemm g2{(const bf16*)(C.arena + R_MIX), (const bf16*)(C.arena + A_WOUT), 256, 1024, 1024};
            pg8::CtxSplitOrder S2{4, C.G, C.bid}; pg8::EpiPart E2{(float*)(C.arena + R_PART)};
            pg8::gemm_phase(C.lds, g2, S2, E2); }
    } else if constexpr (k == 6) { phase_norm2(C, layer); if constexpr (layer == 1) convert_expert_gu(C, C.vcu * 8 + C.wave, C.G * 8); }
    else if constexpr (layer == 0 && k == 7) {
        pg8::Gemm g{(const bf16*)(C.ws + WS_H), (const bf16*)(C.arena + A_FGU), 1024, 1024, 1024};
        pg8::StaticOrder S; S.init(MR, 2 * DFF, C.G, C.bid); pg8::EpiGU<FStoreAct> E{{(bf16*)(C.arena + R_ACT), DFF}, 1 << 20};
        pg8::gemm_phase(C.lds, g, S, E);
    } else if constexpr (layer == 0 && k == 8) {
        pg8::Gemm g{(const bf16*)(C.arena + R_ACT), (const bf16*)(C.arena + A_FD), DFF, DFF, DFF};
        pg8::StaticOrder S; S.init(NLAT, DM, C.G, C.bid);
        pg8::Epi8P<FResidual> E{{C.in[I_X], C.in[I_CTX], (bf16*)(C.ws + WS_XL), MODB + 5 * 1024, 0}};
        pg8::gemm_phase(C.lds, g, S, E);
        {
            pg8::Gemm g2{(const bf16*)(C.arena + R_ACT), (const bf16*)(C.arena + A_FD), 256, DFF, DFF};
            pg8::CtxSplitOrder S2{11, C.G, C.bid}; pg8::EpiPart E2{(float*)(C.arena + R_PART)};
            pg8::gemm_phase(C.lds, g2, S2, E2); }
    }
    else if constexpr (layer == 1 && (k == 9 || k == 11)) {
        constexpr int half = (k - 9) / 2;
        if constexpr (half == 1) moe_tail_reduce0(C);
        pg8::MoeGatherOrder S; moe_tile_bases(C, S.tb); S.ncol = half ? MOE_T1 : MOE_T0; S.tpe = 28; S.joff = half ? MOE_T0 : 0; S.G = C.G; S.c = C.bid;
        S.LISTE = (const int*)(C.arena + M_LISTE);
        { const unsigned* ctl = (const unsigned*)(C.ws + WS_CTL);
#pragma unroll
          for (int e = 0; e < 8; ++e) S.cnt[e] = (int)__hip_atomic_load(ctl + CW_CNT + 64 * e, __ATOMIC_RELAXED, __HIP_MEMORY_SCOPE_AGENT); }
        pg8::Gemm g{(const bf16*)(C.arena + M_HS), (const bf16*)(C.arena + M_EGU), 1024, 1024, 1024};
        pg8::EpiGU<FStoreAct> E{{(bf16*)(C.arena + M_ACT) - (size_t)(half ? MOE_K0 : 0), half ? MOE_K1 : MOE_K0}, 28};
        pg8::gemm_phase(C.lds, g, S, E);
        if constexpr (half == 0) moe_fill_lists(C);
    } else if constexpr (layer == 1 && (k == 10 || k == 12)) {
        constexpr int half = (k - 10) / 2;
        const int* ENT = (const int*)(C.ws + WS_LIST + AL((size_t)NLAT * 2 * 4 * 3)); const float* WTS = (const float*)(ENT + MAXT * 256);
        pg8::MoeTailOrder ST; moe_tile_bases(C, ST.tb); const int ntot = ST.tb[8];
        pg8::MoeOrder S;
#pragma unroll
        for (int e = 0; e < 9; ++e) S.tb[e] = ST.tb[e] < MOE_MAIN ? ST.tb[e] : MOE_MAIN;
        S.ncol = 4; S.tpe = 4; S.joff = 0; S.G = C.G; S.c = C.bid;
        constexpr int KP = half ? MOE_K1 : MOE_K0;
        pg8::Gemm g{(const bf16*)(C.arena + M_ACT), (const bf16*)(C.ws + WS_ED) + (size_t)(half ? MOE_K0 : 0), KP, KP, DFE};
        pg8::Epi8P<FMoeDown> E{{ENT, WTS, half ? (bf16*)(C.arena + M_EGU) : (bf16*)(C.ws + WS_Y0), half ? (bf16*)(C.arena + M_EGU) + (size_t)NLAT * DM : (bf16*)(C.ws + WS_H), MODB + (size_t)3 * 6144 + 5 * 1024}};
        pg8::gemm_phase(C.lds, g, S, E);
        if (ntot > MOE_MAIN) {
            constexpr int KC = half ? MOE_C1 : MOE_C0;
            ST.nm = MOE_MAIN; ST.ntail = ntot - MOE_MAIN; ST.nchunk = half ? MOE_NC1 : MOE_NC0; ST.G = C.G; ST.c = C.bid;
            pg8::Gemm g2{(const bf16*)(C.arena + M_ACT), (const bf16*)(C.ws + WS_ED) + (size_t)(half ? MOE_K0 : 0), KC, KP, DFE};
            pg8::EpiPartT E2{half ? (bf16*)(C.arena + M_HS) : (bf16*)(C.arena + M_PT0), MOE_MAIN};
            pg8::gemm_phase(C.lds, g2, ST, E2); }
    }
}

__device__ __forceinline__ void make_ctx(Ctx& C, const Args& args, unsigned char* lds_raw) {
    C.lds = (LAS unsigned char*)lds_raw; C.ldsg = lds_raw; C.ws = args.ws; C.arena = args.ws + WS_ARENA; C.in = args.in; C.out = args.out;
    C.tid = threadIdx.x; C.lane = C.tid & 63; C.wave = __builtin_amdgcn_readfirstlane(C.tid >> 6);
    C.G = gridDim.x; C.bid = blockIdx.x; C.vcu = (C.G % 8 == 0) ? (C.bid % 8) * (C.G / 8) + C.bid / 8 : C.bid;
}

template <int PH> __device__ __forceinline__ void run_from(const Ctx& C, const XcdBarrier& bar) {
    if constexpr (PH < N_PHASES) {
        if constexpr (phase_exists(PH)) {
            unsigned long long t0_ = 0; if constexpr (DBG_DELAY(PH) != 0) t0_ = __builtin_amdgcn_s_memrealtime();
            run_phase<PH>(C); if constexpr (PH != PH_FINAL) xcd_barrier(bar);
            if constexpr (DBG_DELAY(PH) != 0) { const unsigned long long t1_ = __builtin_amdgcn_s_memrealtime(); while (__builtin_amdgcn_s_memrealtime() - t1_ < t1_ - t0_) __builtin_amdgcn_s_sleep(8); __syncthreads(); }
            if constexpr (DBG_REP(PH) > 0) { run_phase<PH, DBG_REP(PH) - 1>(C); xcd_barrier(bar); } }
        run_from<PH + 1>(C, bar);
    }
}

#if !MK_PER_PHASE
__global__ void __launch_bounds__(512, 2) mega_fwd(Args args) {
    extern __shared__ __attribute__((aligned(16))) unsigned char lds_raw[];
    Ctx C; make_ctx(C, args, lds_raw);
    volatile LAS unsigned* MISC = (volatile LAS unsigned*)(C.lds + MISC_OFF);
    if (C.tid < 64) MISC[C.tid] = 0u;
    __syncthreads();
    unsigned* ctl = (unsigned*)(C.ws + WS_CTL);
    const XcdBarrier bar = xcd_barrier_post(ctl + CW_BAR, MISC + 8);
    run_from<0>(C, bar);
}
#else
template <int PH> __global__ void __launch_bounds__(512, 2) phase_kernel(Args args) {
    extern __shared__ __attribute__((aligned(16))) unsigned char lds_raw[];
    Ctx C; make_ctx(C, args, lds_raw);
    run_phase<PH>(C);
}
template <int PH> void launch_from(int grid, hipStream_t stream, const Args& a) {
    if constexpr (PH < N_PHASES) {
        if constexpr (phase_exists(PH)) {
            (void)hipFuncSetAttribute((const void*)phase_kernel<PH>, hipFuncAttributeMaxDynamicSharedMemorySize, LDS_BYTES);
            hipLaunchKernelGGL(phase_kernel<PH>, dim3(grid), dim3(512), LDS_BYTES, stream, a);
        }
        launch_from<PH + 1>(grid, stream, a);
    }
}
#endif

extern "C" void kernel_launch(void* const* d_in, const int* in_sizes, int n_in, void* d_out, int out_size, void* d_ws, size_t ws_size, hipStream_t stream) {
    static int grid = 0;
    if (grid == 0) {
        if (n_in != 25 || out_size != NLAT * DM || ws_size < WS_END) { fprintf(stderr, "kernel_launch: unexpected shapes (n_in %d, out %d, ws %zu < %zu); nothing launched\n", n_in, out_size, ws_size, (size_t)WS_END); grid = -1; return; }
        int dev = 0, cus = 0;
        if (hipGetDevice(&dev) != hipSuccess || hipDeviceGetAttribute(&cus, hipDeviceAttributeMultiprocessorCount, dev) != hipSuccess) { grid = -1; return; }
#if !MK_PER_PHASE
        if (hipFuncSetAttribute((const void*)mega_fwd, hipFuncAttributeMaxDynamicSharedMemorySize, LDS_BYTES) != hipSuccess) { fprintf(stderr, "kernel_launch: hipFuncSetAttribute failed\n"); grid = -1; return; }
        int per_cu = 0;
        if (hipOccupancyMaxActiveBlocksPerMultiprocessor(&per_cu, (const void*)mega_fwd, 512, LDS_BYTES) != hipSuccess || per_cu < 1) { fprintf(stderr, "kernel_launch: occupancy query reports %d blocks per CU\n", per_cu); }
        (void)hipGetLastError();
#endif
        grid = cus;
    }
    if (grid < 0) return;
    if (hipMemsetAsync((char*)d_ws + WS_CTL, 0, CTL_BYTES, stream) != hipSuccess) return;
    Args a{};
    for (int i = 0; i < 25; ++i) a.in[i] = (const float*)d_in[i];
    a.out = (float*)d_out; a.ws = (unsigned char*)d_ws;
#if MK_PER_PHASE
    launch_from<0>(grid, stream, a);
#else
    hipLaunchKernelGGL(mega_fwd, dim3(grid), dim3(512), LDS_BYTES, stream, a);
#endif
    const hipError_t le = hipPeekAtLastError();
    if (le != hipSuccess) fprintf(stderr, "kernel_launch: launch failed: %s\n", hipGetErrorName(le));
}
```
